# Optimizing an MI355X kernel written in HIP

```python
import math
import jax, jax.numpy as jnp
from jax import lax
import numpy as np

D_MODEL = 1024
BATCH = 8
SEQ = 2048
DEPTH = 4
DEC_BATCH = 128
DEC_SEQ = 4
PAST_LEN = 8192
PAGE_SIZE = 128

N_MIXERS = 2
N_ATTN_LAYERS = (DEPTH + 1) // 2
N_MLSTM_LAYERS = DEPTH // 2
N_META = 16
EPS = 1e-6
ATT_HEADS = 16
ATT_KV_HEADS = 4
ATT_GROUP = ATT_HEADS // ATT_KV_HEADS
ATT_HEAD_DIM = D_MODEL // ATT_HEADS
WINDOW = 128
ATT_BLOCK = 128
NUM_BUCKETS = 32
MAX_DISTANCE = 128
ML_HEADS = 4
ML_DK = (D_MODEL // 2) // ML_HEADS
ML_DV = D_MODEL // ML_HEADS
ML_CHUNK = 64
GATE_SOFTCAP = 15.0
D_FF = 4 * D_MODEL

kernel_name = "hybrid_swa_sink_mlstm_decoder_step"


def rms_norm(x, g):
    xf = x.astype(jnp.float32)
    y = xf * lax.rsqrt(jnp.mean(xf * xf, axis=-1, keepdims=True) + EPS)
    return (y * g.astype(jnp.float32)).astype(x.dtype)


def t5_bucket(dist):
    n = jnp.maximum(dist, 0)
    max_exact = NUM_BUCKETS // 2
    nf = jnp.maximum(n, max_exact).astype(jnp.float32)
    large = max_exact + (jnp.log(nf / max_exact) / math.log(MAX_DISTANCE / max_exact)
                         * (NUM_BUCKETS - max_exact)).astype(jnp.int32)
    large = jnp.minimum(large, NUM_BUCKETS - 1)
    return jnp.where(n < max_exact, n, large)


def rel_bias(dist, rel_table):
    b = rel_table[t5_bucket(dist)].astype(jnp.float32)
    q_len, k_len = dist.shape
    return jnp.transpose(b, (2, 0, 1)).reshape(ATT_KV_HEADS, ATT_GROUP, q_len, k_len)


def window_attention(q, k, v, dist, key_valid, sinks, rel_table):
    *lead, q_len, _, hd = q.shape
    qg = q.reshape(*lead, q_len, ATT_KV_HEADS, ATT_GROUP, hd)
    s = jnp.einsum('...qkgd,...skd->...kgqs', qg, k, preferred_element_type=jnp.float32)
    s = s * (hd ** -0.5) + rel_bias(dist, rel_table)
    mask = ((dist >= 0) & (dist <= WINDOW)) & key_valid[..., None, None, None, :]
    s = jnp.where(mask, s, -jnp.inf)
    sink = sinks.astype(jnp.float32).reshape(ATT_KV_HEADS, ATT_GROUP, 1, 1)
    m = jnp.maximum(jnp.max(s, axis=-1, keepdims=True), sink)
    p = jnp.exp(s - m)
    den = jnp.sum(p, axis=-1, keepdims=True) + jnp.exp(sink - m)
    o = jnp.einsum('...kgqs,...skd->...qkgd', (p / den).astype(v.dtype), v)
    return o.reshape(*lead, q_len, ATT_HEADS * hd)


def attn_project(h, w_qkv, g_q, g_k):
    b, l, _ = h.shape
    qkv = h @ w_qkv
    nq = ATT_HEADS * ATT_HEAD_DIM
    nk = ATT_KV_HEADS * ATT_HEAD_DIM
    q = rms_norm(qkv[..., :nq].reshape(b, l, ATT_HEADS, ATT_HEAD_DIM), g_q)
    k = rms_norm(qkv[..., nq:nq + nk].reshape(b, l, ATT_KV_HEADS, ATT_HEAD_DIM), g_k)
    v = qkv[..., nq + nk:].reshape(b, l, ATT_KV_HEADS, ATT_HEAD_DIM)
    return q, k, v


def attn_prompt(h, w_qkv, g_q, g_k, sinks, w_o, rel_table):
    b, l, _ = h.shape
    q, k, v = attn_project(h, w_qkv, g_q, g_k)
    lead = ATT_BLOCK - N_META
    qp = jnp.pad(q, ((0, 0), (lead, 0), (0, 0), (0, 0)))
    kp = jnp.pad(k, ((0, 0), (lead + ATT_BLOCK, 0), (0, 0), (0, 0)))
    vp = jnp.pad(v, ((0, 0), (lead + ATT_BLOCK, 0), (0, 0), (0, 0)))
    nb = qp.shape[1] // ATT_BLOCK
    qb = qp.reshape(b, nb, ATT_BLOCK, ATT_HEADS, ATT_HEAD_DIM)
    kb = kp.reshape(b, nb + 1, ATT_BLOCK, ATT_KV_HEADS, ATT_HEAD_DIM)
    vb = vp.reshape(b, nb + 1, ATT_BLOCK, ATT_KV_HEADS, ATT_HEAD_DIM)
    k_band = jnp.concatenate([kb[:, :-1], kb[:, 1:]], axis=2)
    v_band = jnp.concatenate([vb[:, :-1], vb[:, 1:]], axis=2)
    dist = jnp.arange(ATT_BLOCK)[:, None] + ATT_BLOCK - jnp.arange(2 * ATT_BLOCK)[None, :]
    k_pos = (jnp.arange(nb)[:, None] * ATT_BLOCK + jnp.arange(2 * ATT_BLOCK)[None, :]
             - (lead + ATT_BLOCK))
    key_valid = k_pos >= 0
    o = window_attention(qb, k_band, v_band, dist, key_valid, sinks, rel_table)
    o = o.reshape(b, nb * ATT_BLOCK, ATT_HEADS * ATT_HEAD_DIM)[:, lead:]
    return o @ w_o, k[:, -WINDOW:], v[:, -WINDOW:]


def attn_sample(h, cache_k, cache_v, w_qkv, g_q, g_k, sinks, w_o, rel_table):
    s_len = h.shape[1]
    q, k, v = attn_project(h, w_qkv, g_q, g_k)
    win = cache_k.shape[1]
    k_all = jnp.concatenate([cache_k.astype(k.dtype), k], axis=1)
    v_all = jnp.concatenate([cache_v.astype(v.dtype), v], axis=1)
    dist = (win + jnp.arange(s_len))[:, None] - jnp.arange(win + s_len)[None, :]
    key_valid = jnp.ones((win + s_len,), dtype=bool)
    o = window_attention(q, k_all, v_all, dist, key_valid, sinks, rel_table)
    return o @ w_o, k_all[:, -win:], v_all[:, -win:]


def mlstm_chunk(carry, inputs):
    c_prev, n_prev, m_prev = carry
    q, k, v, logi, logf = inputs
    lc = q.shape[2]
    bcum = jnp.cumsum(logf, axis=-1)
    causal = jnp.tril(jnp.ones((lc, lc), dtype=bool))
    dmat = jnp.where(causal, bcum[..., :, None] - bcum[..., None, :] + logi[..., None, :], -jnp.inf)
    inter = bcum + m_prev[..., None]
    m_row = jnp.maximum(inter, jnp.max(dmat, axis=-1))
    w_inter = jnp.exp(inter - m_row)
    scores = jnp.einsum('bhtd,bhjd->bhtj', q, k) * jnp.exp(dmat - m_row[..., None])
    num = (w_inter[..., None] * jnp.einsum('bhtd,bhdv->bhtv', q, c_prev)
           + jnp.einsum('bhtj,bhjv->bhtv', scores, v))
    den = w_inter * jnp.einsum('bhtd,bhd->bht', q, n_prev) + jnp.sum(scores, axis=-1)
    h = num / jnp.maximum(jnp.abs(den), jnp.exp(-m_row))[..., None]
    b_last = bcum[..., -1]
    gk = b_last[..., None] - bcum + logi
    m_new = jnp.maximum(b_last + m_prev, jnp.max(gk, axis=-1))
    a = jnp.exp(b_last + m_prev - m_new)
    wk = jnp.exp(gk - m_new[..., None])
    c_new = a[..., None, None] * c_prev + jnp.einsum('bhj,bhjd,bhjv->bhdv', wk, k, v)
    n_new = a[..., None] * n_prev + jnp.einsum('bhj,bhjd->bhd', wk, k)
    return (c_new, n_new, m_new), h


def mlstm_project(h, w_in, w_gate, b_gate):
    b, l, _ = h.shape
    z = h @ w_in
    nqk = ML_HEADS * ML_DK
    nv = ML_HEADS * ML_DV

    def heads(t, d):
        return t.reshape(b, l, ML_HEADS, d).transpose(0, 2, 1, 3).astype(jnp.float32)

    q = heads(z[..., :nqk], ML_DK)
    k = heads(z[..., nqk:2 * nqk], ML_DK) * (ML_DK ** -0.5)
    v = heads(z[..., 2 * nqk:2 * nqk + nv], ML_DV)
    o = z[..., 2 * nqk + nv:]
    g = (h @ w_gate + b_gate).astype(jnp.float32)
    g = GATE_SOFTCAP * jnp.tanh(g / GATE_SOFTCAP)
    logi = g[..., :ML_HEADS].transpose(0, 2, 1)
    logf = jax.nn.log_sigmoid(g[..., ML_HEADS:]).transpose(0, 2, 1)
    return (q, k, v, logi, logf), o


def mlstm_output(hh, o, g_norm, w_out, dtype):
    b, _, l, _ = hh.shape
    hh = hh.transpose(0, 2, 1, 3)
    hn = hh * lax.rsqrt(jnp.mean(hh * hh, axis=-1, keepdims=True) + EPS)
    hn = hn * g_norm.astype(jnp.float32).reshape(ML_HEADS, ML_DV)
    out = (jax.nn.sigmoid(o.astype(jnp.float32)) * hn.reshape(b, l, ML_HEADS * ML_DV)).astype(dtype)
    return out @ w_out


def mlstm_prompt(h, w_in, w_gate, b_gate, g_norm, w_out):
    b = h.shape[0]
    ins, o = mlstm_project(h, w_in, w_gate, b_gate)
    state0 = (jnp.zeros((b, ML_HEADS, ML_DK, ML_DV), jnp.float32),
              jnp.zeros((b, ML_HEADS, ML_DK), jnp.float32),
              jnp.zeros((b, ML_HEADS), jnp.float32))
    meta_in = tuple(t[:, :, :N_META] for t in ins)
    rest_in = tuple(t[:, :, N_META:] for t in ins)
    state1, h_meta = mlstm_chunk(state0, meta_in)
    nc = rest_in[0].shape[2] // ML_CHUNK

    def to_chunks(t):
        return jnp.moveaxis(t.reshape(b, ML_HEADS, nc, ML_CHUNK, *t.shape[3:]), 2, 0)

    state, h_rest = lax.scan(mlstm_chunk, state1, tuple(to_chunks(t) for t in rest_in))
    h_rest = jnp.moveaxis(h_rest, 0, 2).reshape(b, ML_HEADS, nc * ML_CHUNK, ML_DV)
    hh = jnp.concatenate([h_meta, h_rest], axis=2)
    return mlstm_output(hh, o, g_norm, w_out, h.dtype), state


def mlstm_sample(h, c0, n0, m0, w_in, w_gate, b_gate, g_norm, w_out):
    ins, o = mlstm_project(h, w_in, w_gate, b_gate)
    state = (c0.astype(jnp.float32), n0.astype(jnp.float32), m0.astype(jnp.float32))
    state, hh = mlstm_chunk(state, ins)
    return mlstm_output(hh, o, g_norm, w_out, h.dtype), state


def sqrelu_mlp(h, w_up, w_down):
    return jnp.square(jax.nn.relu(h @ w_up)) @ w_down


def setup_inputs(seed: int = 0) -> dict:
    key = jax.random.key(seed)
    ks = jax.random.split(key, 24)
    nrm = jax.random.normal
    f32 = jnp.float32
    win_buf = min(WINDOW, PAST_LEN)
    qkv_w = (ATT_HEADS + 2 * ATT_KV_HEADS) * ATT_HEAD_DIM
    ml_in_w = 2 * ML_HEADS * ML_DK + 2 * ML_HEADS * ML_DV
    b_gate = jnp.concatenate([0.1 * nrm(ks[20], (N_MLSTM_LAYERS, ML_HEADS), f32),
                              3.0 + 0.1 * nrm(ks[21], (N_MLSTM_LAYERS, ML_HEADS), f32)], axis=-1)
    return {
        "x_prompt": nrm(ks[0], (BATCH, SEQ, D_MODEL), f32),
        "x_sample": nrm(ks[1], (DEC_BATCH, DEC_SEQ, D_MODEL), f32),
        "cache_k": nrm(ks[2], (N_ATTN_LAYERS, DEC_BATCH, win_buf, ATT_KV_HEADS, ATT_HEAD_DIM), f32),
        "cache_v": nrm(ks[3], (N_ATTN_LAYERS, DEC_BATCH, win_buf, ATT_KV_HEADS, ATT_HEAD_DIM), f32),
        "state_C": nrm(ks[4], (N_MLSTM_LAYERS, DEC_BATCH, ML_HEADS, ML_DK, ML_DV), f32),
        "state_n": nrm(ks[5], (N_MLSTM_LAYERS, DEC_BATCH, ML_HEADS, ML_DK), f32),
        "state_m": nrm(ks[6], (N_MLSTM_LAYERS, DEC_BATCH, ML_HEADS), f32),
        "meta_tokens": nrm(ks[7], (N_META, D_MODEL), f32),
        "rel_table": 0.5 * nrm(ks[8], (NUM_BUCKETS, ATT_HEADS), f32),
        "norm_mix": 1.0 + 0.02 * nrm(ks[9], (DEPTH, D_MODEL), f32),
        "norm_mlp": 1.0 + 0.02 * nrm(ks[10], (DEPTH, D_MODEL), f32),
        "attn_w_qkv": nrm(ks[11], (N_ATTN_LAYERS, D_MODEL, qkv_w), f32) * D_MODEL ** -0.5,
        "attn_q_norm": 1.0 + 0.02 * nrm(ks[12], (N_ATTN_LAYERS, ATT_HEAD_DIM), f32),
        "attn_k_norm": 1.0 + 0.02 * nrm(ks[13], (N_ATTN_LAYERS, ATT_HEAD_DIM), f32),
        "attn_sinks": 0.5 * nrm(ks[14], (N_ATTN_LAYERS, ATT_HEADS), f32),
        "attn_w_o": nrm(ks[15], (N_ATTN_LAYERS, ATT_HEADS * ATT_HEAD_DIM, D_MODEL), f32) * (ATT_HEADS * ATT_HEAD_DIM) ** -0.5,
        "mlstm_w_in": nrm(ks[16], (N_MLSTM_LAYERS, D_MODEL, ml_in_w), f32) * D_MODEL ** -0.5,
        "mlstm_w_gate": nrm(ks[17], (N_MLSTM_LAYERS, D_MODEL, 2 * ML_HEADS), f32) * D_MODEL ** -0.5,
        "mlstm_b_gate": b_gate,
        "mlstm_out_norm": 1.0 + 0.02 * nrm(ks[18], (N_MLSTM_LAYERS, ML_HEADS * ML_DV), f32),
        "mlstm_w_out": nrm(ks[19], (N_MLSTM_LAYERS, ML_HEADS * ML_DV, D_MODEL), f32) * (ML_HEADS * ML_DV) ** -0.5,
        "mlp_w_up": nrm(ks[22], (DEPTH, D_MODEL, D_FF), f32) * D_MODEL ** -0.5,
        "mlp_w_down": nrm(ks[23], (DEPTH, D_FF, D_MODEL), f32) * D_FF ** -0.5,
    }


def reference(x_prompt, x_sample, cache_k, cache_v, state_C, state_n, state_m,
              meta_tokens, rel_table, norm_mix, norm_mlp,
              attn_w_qkv, attn_q_norm, attn_k_norm, attn_sinks, attn_w_o,
              mlstm_w_in, mlstm_w_gate, mlstm_b_gate, mlstm_out_norm, mlstm_w_out,
              mlp_w_up, mlp_w_down):
    b = x_prompt.shape[0]
    meta = jnp.broadcast_to(meta_tokens.astype(x_prompt.dtype)[None], (b, N_META, D_MODEL))
    xp = jnp.concatenate([meta, x_prompt], axis=1)
    xs = x_sample
    kp_l, vp_l, ks_l, vs_l = [], [], [], []
    cp_l, np_l, mp_l, cs_l, ns_l, ms_l = [], [], [], [], [], []
    for i in range(DEPTH):
        hp = rms_norm(xp, norm_mix[i])
        hs = rms_norm(xs, norm_mix[i])
        j = i // N_MIXERS
        if i % N_MIXERS == 0:
            op, kp, vp = attn_prompt(hp, attn_w_qkv[j], attn_q_norm[j], attn_k_norm[j],
                                     attn_sinks[j], attn_w_o[j], rel_table)
            os_, kn, vn = attn_sample(hs, cache_k[j], cache_v[j], attn_w_qkv[j], attn_q_norm[j],
                                      attn_k_norm[j], attn_sinks[j], attn_w_o[j], rel_table)
            kp_l.append(kp); vp_l.append(vp)
            ks_l.append(kn.astype(cache_k.dtype)); vs_l.append(vn.astype(cache_v.dtype))
        else:
            op, (cp, n_p, mp) = mlstm_prompt(hp, mlstm_w_in[j], mlstm_w_gate[j], mlstm_b_gate[j],
                                             mlstm_out_norm[j], mlstm_w_out[j])
            os_, (cs, n_s, ms) = mlstm_sample(hs, state_C[j], state_n[j], state_m[j],
                                              mlstm_w_in[j], mlstm_w_gate[j], mlstm_b_gate[j],
                                              mlstm_out_norm[j], mlstm_w_out[j])
            cp_l.append(cp.astype(x_prompt.dtype)); np_l.append(n_p.astype(x_prompt.dtype))
            mp_l.append(mp.astype(x_prompt.dtype))
            cs_l.append(cs.astype(state_C.dtype)); ns_l.append(n_s.astype(state_n.dtype))
            ms_l.append(ms.astype(state_m.dtype))
        xp = xp + op
        xs = xs + os_
        xp = xp + sqrelu_mlp(rms_norm(xp, norm_mlp[i]), mlp_w_up[i], mlp_w_down[i])
        xs = xs + sqrelu_mlp(rms_norm(xs, norm_mlp[i]), mlp_w_up[i], mlp_w_down[i])
    y_prompt = xp[:, N_META:]
    y_sample = xs
    return (y_prompt, y_sample,
            jnp.stack(kp_l), jnp.stack(vp_l), jnp.stack(ks_l), jnp.stack(vs_l),
            jnp.stack(cp_l), jnp.stack(np_l), jnp.stack(mp_l),
            jnp.stack(cs_l), jnp.stack(ns_l), jnp.stack(ms_l))
```

```cpp
#include <hip/hip_runtime.h>
#include <cstdio>
#include <cstdint>
namespace pg8 {
#define PG8_LAS __attribute__((address_space(3)))
typedef unsigned short bf16_t;
typedef short bf16x8 __attribute__((ext_vector_type(8)));
typedef float f32x4 __attribute__((ext_vector_type(4)));
typedef unsigned u32x4 __attribute__((ext_vector_type(4)));
constexpr int BM = 256, BK = 64, HALF = 128, HTB = HALF * BK * 2  , STAGE_BYTES = 8 * HTB, NXCD = 8, WGM = 8;

__host__ __device__ __forceinline__ int lds_byte(int r, int c) { const int st = (r >> 4) * 2 + (c >> 5), rr = r & 15, cc = c & 31, ob = rr * 64 + cc * 2; return st * 1024 + (ob ^ (((ob >> 9) & 1) << 5)); }
__host__ __device__ __forceinline__ void stage_rc(int b, int& R, int& C) { const int st = b / 1024, sb = b % 1024, swz = sb ^ (((sb >> 9) & 1) << 5); R = (st >> 1) * 16 + swz / 64; C = (st & 1) * 32 + (swz % 64) / 2; }
__host__ __device__ __forceinline__ int perm32(int rho) { const int n = rho >> 4, i = rho & 15; return 8 * (i >> 2) + 4 * n + (i & 3); }

struct Unit { int pm, pn; };
struct Gemm { const bf16_t* A; const bf16_t* Bt; int M, N, K; };

struct StaticOrder {
    int nM, nN, nwg, G, c;
    __host__ __device__ void init(int M, int N, int G_, int c_) { nM = M / BM; nN = N / BM; nwg = nM * nN; G = G_; c = c_; }
    __host__ __device__ bool next(int i, Unit& u) const {
        const long L = (long)i * G + c; if (L >= nwg) return false;
        int wgid = (int)L; { const int q = nwg / NXCD, r = nwg % NXCD, xcd = wgid % NXCD, off = wgid / NXCD; wgid = (xcd < r ? xcd * (q + 1) : r * (q + 1) + (xcd - r) * q) + off; }
        const int nig = WGM * nN, gid = wgid / nig, fm = gid * WGM, gsz = (nM - fm) < WGM ? (nM - fm) : WGM;
        u.pm = fm + ((wgid % nig) % gsz); u.pn = (wgid % nig) / gsz; return true;
    }
    __device__ __forceinline__ void a_ready(const Unit&) const {}
    __device__ __forceinline__ void done(const Unit&) const {}
};
__device__ __forceinline__ unsigned cvt_pk_bf16(float lo, float hi) { unsigned r; asm volatile("v_cvt_pk_bf16_f32 %0, %1, %2" : "=v"(r) : "v"(lo), "v"(hi)); return r; }
typedef unsigned u32x2 __attribute__((ext_vector_type(2)));
constexpr int RM_MP = 16512, RM_MTOT = 17024, RM_LP = 2064, RM_META = 16, RM_SEQ = 2048;
__device__ __forceinline__ float row_rscale(const float* SS, int row) {
    const f32x4* p = (const f32x4*)(SS + (size_t)row * 16); const f32x4 a = p[0], b = p[1], c = p[2], d = p[3];
    const float s = ((a[0] + a[1]) + (a[2] + a[3])) + ((b[0] + b[1]) + (b[2] + b[3])) + ((c[0] + c[1]) + (c[2] + c[3])) + ((d[0] + d[1]) + (d[2] + d[3]));
    return 1.0f / sqrtf(s * (1.0f / 1024.0f) + 1e-6f);
}
__device__ __forceinline__ float softcap15(float x) { return 15.0f * tanhf(x * (1.0f / 15.0f)); }
__device__ __forceinline__ float logsigmoidf(float x) { return x < 0.f ? x - log1pf(expf(x)) : -log1pf(expf(-x)); }
template <int ACT, bool GATES> struct EpiNormBf16 {
    static constexpr bool PERM = true, AFTER_DRAIN = false;
    bf16_t* O; int ldc; const float* SS; float* G; const float* bgate; int gate_pn;
    __device__ __forceinline__ void operator()(const f32x4 (&acc)[2][2][4][2], const Unit& u, int wr, int wc, int fr, int fq) const {
        const int row0 = u.pm * BM + wr * 64 + fr;
        if (GATES && u.pn == gate_pn) {
            if (wc == 0 && fq == 0) {
                const f32x4 b0 = *(const f32x4*)bgate, b1 = *(const f32x4*)(bgate + 4);
#pragma unroll
                for (int ai = 0; ai < 2; ++ai)
#pragma unroll
                    for (int m = 0; m < 4; ++m) { const int row = row0 + ai * HALF + m * 16; const float r = row_rscale(SS, row);
                        f32x4 gi = acc[ai][0][m][0] * r + b0, gf = acc[ai][0][m][1] * r + b1;
#pragma unroll
                        for (int j = 0; j < 4; ++j) { gi[j] = softcap15(gi[j]); gf[j] = logsigmoidf(softcap15(gf[j])); }
                        *(f32x4*)(G + (size_t)row * 8) = gi; *(f32x4*)(G + (size_t)row * 8 + 4) = gf; }
            }
            return;
        }
        const int col0 = u.pn * BM + wc * 32 + 8 * fq;
#pragma unroll
        for (int ai = 0; ai < 2; ++ai)
#pragma unroll
            for (int m = 0; m < 4; ++m) { const int row = row0 + ai * HALF + m * 16; const float r = row_rscale(SS, row); bf16_t* rowp = O + (size_t)row * ldc + col0;
#pragma unroll
                for (int bj = 0; bj < 2; ++bj) { f32x4 v0 = acc[ai][bj][m][0] * r, v1 = acc[ai][bj][m][1] * r;
                    if (ACT == 1) {
#pragma unroll
                        for (int j = 0; j < 4; ++j) { const float a = fmaxf(v0[j], 0.f), b = fmaxf(v1[j], 0.f); v0[j] = a * a; v1[j] = b * b; } }
                    u32x4 w; w.x = cvt_pk_bf16(v0[0], v0[1]); w.y = cvt_pk_bf16(v0[2], v0[3]); w.z = cvt_pk_bf16(v1[0], v1[1]); w.w = cvt_pk_bf16(v1[2], v1[3]);
                    *(u32x4*)(rowp + bj * HALF) = w; } }
    }
};
template <bool FINAL> struct EpiResid {
    static constexpr bool PERM = false, AFTER_DRAIN = false;
    float* X; bf16_t* Xb; float* SS; float* y_prompt; float* y_sample;
    __device__ __forceinline__ void operator()(const f32x4 (&acc)[2][2][4][2], const Unit& u, int wr, int wc, int fr, int fq) const {
        const int row0 = u.pm * BM + wr * 64 + fr, col0 = u.pn * BM + wc * 32 + 4 * fq;
#pragma unroll
        for (int ai = 0; ai < 2; ++ai)
#pragma unroll
            for (int m = 0; m < 4; ++m) { const int row = row0 + ai * HALF + m * 16; const size_t off = (size_t)row * 1024 + col0;
                f32x4 x[2][2];
#pragma unroll
                for (int bj = 0; bj < 2; ++bj)
#pragma unroll
                    for (int n = 0; n < 2; ++n) x[bj][n] = *(const f32x4*)(X + off + bj * HALF + n * 16) + acc[ai][bj][m][n];
                if (!FINAL) {
                    float s = 0.f;
#pragma unroll
                    for (int bj = 0; bj < 2; ++bj)
#pragma unroll
                        for (int n = 0; n < 2; ++n) { const f32x4 v = x[bj][n]; *(f32x4*)(X + off + bj * HALF + n * 16) = v; s += (v[0] * v[0] + v[1] * v[1]) + (v[2] * v[2] + v[3] * v[3]);
                            u32x2 w; w.x = cvt_pk_bf16(v[0], v[1]); w.y = cvt_pk_bf16(v[2], v[3]); *(u32x2*)(Xb + off + bj * HALF + n * 16) = w; }
                    s += __shfl_xor(s, 16); s += __shfl_xor(s, 32);
                    if (fq == 0) SS[(size_t)row * 16 + u.pn * 4 + wc] = s;
                } else {
                    float* dst = nullptr;
                    if (row < RM_MP) { const int b = row / RM_LP, t = row - b * RM_LP; if (t >= RM_META) dst = y_prompt + ((size_t)b * RM_SEQ + (t - RM_META)) * 1024 + col0; }
                    else if (row < RM_MTOT) dst = y_sample + (size_t)(row - RM_MP) * 1024 + col0;
                    if (dst) {
#pragma unroll
                        for (int bj = 0; bj < 2; ++bj)
#pragma unroll
                            for (int n = 0; n < 2; ++n) *(f32x4*)(dst + bj * HALF + n * 16) = x[bj][n]; }
                }
            }
    }
};

template <class Epi, class Sched, bool ALIGN_EPI = false, bool SP2 = false>
__device__ __forceinline__ void gemm_phase(PG8_LAS unsigned char* lds, const Gemm g, const Sched& S, const Epi& E) {
    int tid_o = threadIdx.x; asm volatile("" : "+v"(tid_o));
    const int tid = tid_o, wid = __builtin_amdgcn_readfirstlane(tid >> 6), lane = tid & 63, wr = wid >> 2, wc = wid & 3, fr = lane & 15, fq = lane >> 4;
    const int K = g.K, nt = K / BK;
    unsigned voffA[2], voffB[2];
#pragma unroll
    for (int i = 0; i < 2; ++i) { int R, C; stage_rc(tid * 16 + i * 8192, R, C); const int Rb = Epi::PERM ? ((R & ~31) + perm32(R & 31)) : R;
        voffA[i] = (unsigned)(R * K + C) * 2u; voffB[i] = (unsigned)(Rb * K + C) * 2u; }
    const size_t kstep = (size_t)(BK * 2);
    const size_t hstep = (size_t)HALF * K * 2;
    const size_t tstep = 2 * hstep;
    const unsigned ldsw = (unsigned)wid * 1024u;
    const int aoff = lds_byte(wr * 64 + fr, fq * 8), boff = lds_byte(wc * 32 + fr, fq * 8);
#define PG8_SA(b, h) (((b) * 2 + (h)) * HTB)
#define PG8_SB(b, h) ((4 + (b) * 2 + (h)) * HTB)
#define PG8_STAGE(bufoff, gbase, voff) do { _Pragma("unroll") for (int _i = 0; _i < 2; ++_i) \
        __builtin_amdgcn_global_load_lds((const unsigned*)((const char*)(gbase) + (voff)[_i]), (PG8_LAS unsigned*)(lds + (bufoff) + ldsw + _i * 8192), 16, 0, 0); } while (0)
#define PG8_LDA(dst, b, h) do { _Pragma("unroll") for (int m = 0; m < 4; ++m) _Pragma("unroll") for (int k = 0; k < 2; ++k) dst[m][k] = *(const PG8_LAS bf16x8*)(lds + PG8_SA(b, h) + aoff + m * 2048 + k * 1024); } while (0)
#define PG8_LDB(dst, b, h) do { _Pragma("unroll") for (int n = 0; n < 2; ++n) _Pragma("unroll") for (int k = 0; k < 2; ++k) dst[n][k] = *(const PG8_LAS bf16x8*)(lds + PG8_SB(b, h) + boff + n * 2048 + k * 1024); } while (0)
#define PG8_MMA(ai, bj, At, Bt) do { __builtin_amdgcn_s_setprio(1); _Pragma("unroll") for (int m = 0; m < 4; ++m) _Pragma("unroll") for (int n = 0; n < 2; ++n) _Pragma("unroll") for (int k = 0; k < 2; ++k) \
        acc[ai][bj][m][n] = __builtin_amdgcn_mfma_f32_16x16x32_bf16(Bt[n][k], At[m][k], acc[ai][bj][m][n], 0, 0, 0); __builtin_amdgcn_s_setprio(0); } while (0)
#define PG8_WAIT_V(n) asm volatile("s_waitcnt vmcnt(" #n ")" ::: "memory")
#define PG8_WAIT_L(n) asm volatile("s_waitcnt lgkmcnt(" #n ")" ::: "memory")
#define PG8_BAR __builtin_amdgcn_s_barrier()
#define PG8_SCHED __builtin_amdgcn_sched_barrier(0)
    Unit cur, nxt; int ui = 0;
    if (!S.next(0, cur)) return;
    f32x4 acc[2][2][4][2];
#pragma unroll
    for (int a = 0; a < 2; ++a)
#pragma unroll
        for (int b = 0; b < 2; ++b)
#pragma unroll
            for (int m = 0; m < 4; ++m)
#pragma unroll
                for (int n = 0; n < 2; ++n) acc[a][b][m][n] = (f32x4){0.f, 0.f, 0.f, 0.f};
    bf16x8 At[4][2], B0[2][2], B1[2][2];
    const char* cA = (const char*)g.A + (size_t)cur.pm * tstep; const char* cB = (const char*)g.Bt + (size_t)cur.pn * tstep;
    S.a_ready(cur);
    if constexpr (SP2) {
        PG8_STAGE(PG8_SB(0, 0), cB, voffB); PG8_STAGE(PG8_SB(0, 1), cB + hstep, voffB); PG8_STAGE(PG8_SA(0, 0), cA, voffA); PG8_STAGE(PG8_SA(0, 1), cA + hstep, voffA);
        if (wr == 1) PG8_BAR;
        PG8_WAIT_V(2); PG8_BAR;
        PG8_STAGE(PG8_SB(1, 0), cB + kstep, voffB); PG8_STAGE(PG8_SA(1, 0), cA + kstep, voffA); PG8_STAGE(PG8_SB(1, 1), cB + hstep + kstep, voffB);
        PG8_WAIT_V(6); PG8_BAR;
    } else {
        PG8_STAGE(PG8_SB(0, 0), cB, voffB); PG8_STAGE(PG8_SA(0, 0), cA, voffA); PG8_STAGE(PG8_SB(0, 1), cB + hstep, voffB); PG8_STAGE(PG8_SA(0, 1), cA + hstep, voffA);
        if (wr == 1) PG8_BAR;
        PG8_WAIT_V(4); PG8_BAR;
        PG8_STAGE(PG8_SB(1, 0), cB + kstep, voffB); PG8_STAGE(PG8_SA(1, 0), cA + kstep, voffA); PG8_STAGE(PG8_SB(1, 1), cB + hstep + kstep, voffB);
        PG8_WAIT_V(6); PG8_BAR;
    }
    for (;;) {
        const bool has_next = S.next(ui + 1, nxt);
        const char* nA = has_next ? (const char*)g.A + (size_t)nxt.pm * tstep : cA; const char* nB = has_next ? (const char*)g.Bt + (size_t)nxt.pn * tstep : cB;
        for (int t = 0; t < nt; t += 2) {
            const bool last = (t == nt - 2);
            const char* a1 = cA + (size_t)(t + 1) * kstep;
            const char* a2 = last ? nA : cA + (size_t)(t + 2) * kstep; const char* b2 = last ? nB : cB + (size_t)(t + 2) * kstep;
            const char* a3 = a2 + kstep; const char* b3 = b2 + kstep;
            if (last && has_next) S.a_ready(nxt);
            if constexpr (SP2) {
            PG8_LDB(B0, 0, 0); PG8_LDB(B1, 0, 1); PG8_SCHED; PG8_LDA(At, 0, 0); PG8_STAGE(PG8_SA(1, 1), a1 + hstep, voffA);
            PG8_WAIT_V(8); PG8_WAIT_L(0); PG8_BAR; PG8_MMA(0, 0, At, B0); PG8_MMA(0, 1, At, B1); PG8_BAR; PG8_SCHED;
            PG8_LDA(At, 0, 1); PG8_STAGE(PG8_SB(0, 0), b2, voffB); PG8_STAGE(PG8_SB(0, 1), b2 + hstep, voffB); PG8_STAGE(PG8_SA(0, 0), a2, voffA);
            PG8_WAIT_V(8); PG8_WAIT_L(0); PG8_BAR; PG8_MMA(1, 0, At, B0); PG8_MMA(1, 1, At, B1); PG8_BAR; PG8_SCHED;
            PG8_LDB(B0, 1, 0); PG8_LDB(B1, 1, 1); PG8_SCHED; PG8_LDA(At, 1, 0); PG8_STAGE(PG8_SA(0, 1), a2 + hstep, voffA);
            PG8_WAIT_V(8); PG8_WAIT_L(0); PG8_BAR; PG8_MMA(0, 0, At, B0); PG8_MMA(0, 1, At, B1); PG8_BAR; PG8_SCHED;
            PG8_LDA(At, 1, 1); PG8_STAGE(PG8_SB(1, 0), b3, voffB); PG8_STAGE(PG8_SB(1, 1), b3 + hstep, voffB); PG8_STAGE(PG8_SA(1, 0), a3, voffA);
            PG8_WAIT_V(8); PG8_WAIT_L(0); PG8_BAR; PG8_MMA(1, 0, At, B0); PG8_MMA(1, 1, At, B1); PG8_BAR; PG8_SCHED;
            } else {
            PG8_LDB(B0, 0, 0); PG8_SCHED; PG8_LDA(At, 0, 0); PG8_STAGE(PG8_SA(1, 1), a1 + hstep, voffA);
            PG8_WAIT_L(8); PG8_BAR; PG8_WAIT_L(0); PG8_MMA(0, 0, At, B0); PG8_BAR; PG8_SCHED;
            PG8_LDB(B1, 0, 1); PG8_STAGE(PG8_SB(0, 0), b2, voffB);
            PG8_BAR; PG8_WAIT_L(0); PG8_MMA(0, 1, At, B1); PG8_BAR;
            PG8_LDA(At, 0, 1); PG8_STAGE(PG8_SA(0, 0), a2, voffA);
            PG8_BAR; PG8_WAIT_L(0); PG8_MMA(1, 0, At, B0); PG8_BAR; PG8_SCHED;
            PG8_STAGE(PG8_SB(0, 1), b2 + hstep, voffB);
            PG8_WAIT_V(6); PG8_BAR; PG8_MMA(1, 1, At, B1); PG8_BAR;
            PG8_LDB(B0, 1, 0); PG8_SCHED; PG8_LDA(At, 1, 0); PG8_STAGE(PG8_SA(0, 1), a2 + hstep, voffA);
            PG8_WAIT_L(8); PG8_BAR; PG8_WAIT_L(0); PG8_MMA(0, 0, At, B0); PG8_BAR; PG8_SCHED;
            PG8_LDB(B1, 1, 1); PG8_STAGE(PG8_SB(1, 0), b3, voffB);
            PG8_BAR; PG8_WAIT_L(0); PG8_MMA(0, 1, At, B1); PG8_BAR;
            PG8_LDA(At, 1, 1); PG8_STAGE(PG8_SA(1, 0), a3, voffA);
            PG8_BAR; PG8_WAIT_L(0); PG8_MMA(1, 0, At, B0); PG8_BAR; PG8_SCHED;
            PG8_STAGE(PG8_SB(1, 1), b3 + hstep, voffB);
            PG8_WAIT_V(6); PG8_BAR; PG8_MMA(1, 1, At, B1); PG8_BAR;
            }
        }
        if constexpr (ALIGN_EPI) { if (wr == 0) PG8_BAR; }
        if constexpr (!Epi::AFTER_DRAIN) { E(acc, cur, wr, wc, fr, fq); S.done(cur); }
        if (!has_next) break;
#pragma unroll
        for (int a = 0; a < 2; ++a)
#pragma unroll
            for (int b = 0; b < 2; ++b)
#pragma unroll
                for (int m = 0; m < 4; ++m)
#pragma unroll
                    for (int n = 0; n < 2; ++n) acc[a][b][m][n] = (f32x4){0.f, 0.f, 0.f, 0.f};
        cur = nxt; cA = nA; cB = nB; ++ui;
        if constexpr (ALIGN_EPI) { if (wr == 1) PG8_BAR; }
    }
    PG8_WAIT_V(0);
    if constexpr (!ALIGN_EPI) { if (wr == 0) PG8_BAR; }
    PG8_BAR;
    if constexpr (Epi::AFTER_DRAIN) { E.fused(acc, cur, wr, wc, fr, fq, lds, wid, lane); S.done(cur); }
#undef PG8_SA
#undef PG8_SB
#undef PG8_STAGE
#undef PG8_LDA
#undef PG8_LDB
#undef PG8_MMA
#undef PG8_WAIT_V
#undef PG8_WAIT_L
#undef PG8_BAR
#undef PG8_SCHED
}
}
#ifndef PG8_SP2
#define PG8_SP2 true
#endif
#ifndef PG8_ALIGN
#define PG8_ALIGN true
#endif
constexpr int NWAVES = 8;
constexpr int D = 1024, NB = 8, SEQ = 2048, NMETA = 16, LP = SEQ + NMETA, DBATCH = 128, DSEQ = 4;
constexpr int MP = NB * LP, MS = DBATCH * DSEQ, MTOT = MP + MS, MPAD = 17152;
constexpr int NQKV = 1536, NIN = 3072, NINP = 3328, FF = 4096;
constexpr int AH = 16, AKV = 4, AHD = 64, WIN = 128;
constexpr int MH = 4, MDK = 128, MDV = 256, MCH = 64, VS = 32, NSL = MDV / VS;
constexpr float EPS = 1e-6f;
static_assert(MPAD % 256 == 0 && MPAD >= MTOT, "row padding");
constexpr size_t MiB = 1u << 20;
constexpr size_t WS_CTL = 0, CTL_ZERO_BYTES = 1 * MiB;
constexpr size_t WS_WQKV = 2 * MiB, WS_WO = 8 * MiB, WS_WIN = 12 * MiB, WS_WOUT = 25 * MiB, WS_WUP = 29 * MiB, WS_WDN = 61 * MiB;
constexpr size_t SZ_WQKV = (size_t)NQKV * D * 2, SZ_WO = (size_t)D * D * 2, SZ_WIN = (size_t)NINP * D * 2, SZ_WUP = (size_t)FF * D * 2;
constexpr size_t WS_SS = 93 * MiB, WS_G = 95 * MiB, WS_HSS = 96 * MiB;
constexpr size_t WS_X = 100 * MiB, WS_XB = 167 * MiB, WS_Z = 201 * MiB, WS_AO = 302 * MiB, WS_FF = 336 * MiB, WS_END = 470 * MiB;
static_assert(WS_WQKV + 2 * SZ_WQKV <= WS_WO && WS_WO + 2 * SZ_WO <= WS_WIN && WS_WIN + 2 * SZ_WIN <= WS_WOUT && WS_WOUT + 2 * SZ_WO <= WS_WUP && WS_WUP + 4 * SZ_WUP <= WS_WDN && WS_WDN + 4 * SZ_WUP <= WS_SS, "weights map");
static_assert(WS_SS + (size_t)MPAD * 16 * 4 <= WS_G && WS_G + (size_t)MPAD * 8 * 4 <= WS_HSS && WS_HSS + (size_t)MPAD * 32 * 4 <= WS_X, "small maps");
static_assert(WS_X + (size_t)MPAD * D * 4 <= WS_XB && WS_XB + (size_t)MPAD * D * 2 <= WS_Z && WS_Z + (size_t)MPAD * NIN * 2 <= WS_AO && WS_AO + (size_t)MPAD * D * 2 <= WS_FF && WS_FF + (size_t)MPAD * FF * 2 <= WS_END, "activation map");
constexpr int CW_BAR = 4096;
constexpr size_t O_YP = 0, O_YS = O_YP + (size_t)NB * SEQ * D, O_KP = O_YS + (size_t)MS * D, O_VP = O_KP + (size_t)2 * NB * WIN * AKV * AHD, O_KS = O_VP + (size_t)2 * NB * WIN * AKV * AHD,
    O_VS = O_KS + (size_t)2 * DBATCH * WIN * AKV * AHD, O_CP = O_VS + (size_t)2 * DBATCH * WIN * AKV * AHD, O_NP = O_CP + (size_t)2 * NB * MH * MDK * MDV, O_MP = O_NP + (size_t)2 * NB * MH * MDK,
    O_CS = O_MP + (size_t)2 * NB * MH, O_NS = O_CS + (size_t)2 * DBATCH * MH * MDK * MDV, O_MS = O_NS + (size_t)2 * DBATCH * MH * MDK, O_END = O_MS + (size_t)2 * DBATCH * MH;
constexpr int RING_OFF = 0, RING_BYTES = 131072;
constexpr int LDSCTL_OFF = RING_BYTES, MISC_OFF = LDSCTL_OFF + 320;
constexpr int LDS_BYTES = 147456;
#define GAS __attribute__((address_space(1)))
#define LAS __attribute__((address_space(3)))
typedef unsigned short bf16;
typedef unsigned v4u __attribute__((ext_vector_type(4)));
typedef float f32x4 __attribute__((ext_vector_type(4)));
typedef short bf16x8 __attribute__((ext_vector_type(8)));
typedef GAS unsigned gu32;
typedef GAS unsigned long long gu64;
#define RLX_AGENT __ATOMIC_RELAXED, __HIP_MEMORY_SCOPE_AGENT
#define LDS_WAIT() asm volatile("s_waitcnt lgkmcnt(0)" ::: "memory")
#define VM_WAIT() asm volatile("s_waitcnt vmcnt(0)" ::: "memory")
__device__ __forceinline__ unsigned long long rt() { return __builtin_amdgcn_s_memrealtime(); }
__device__ __forceinline__ unsigned f2bf(float f) { unsigned u = __builtin_bit_cast(unsigned, f); return (u + 0x7fffu + ((u >> 16) & 1u)) >> 16; }
__device__ __forceinline__ unsigned pk2(float lo, float hi) { return f2bf(lo) | (f2bf(hi) << 16); }

#define XB_TMO      128
#define XB_XCNT(j)  (256  + 64 * (j))
#define XB_XSUB(j)  (1280 + 64 * (j))
#define XB_XGEN(j)  (2304 + 64 * (j))
#define XB_TOP      3328
#define XB_TOPGEN   3392
#define XCD_BAR_WORDS 3456
#define XB_SPIN_CAP (1u << 18)

__device__ __forceinline__ unsigned xb_ld(unsigned* p)              { return __hip_atomic_load(p, __ATOMIC_RELAXED, __HIP_MEMORY_SCOPE_AGENT); }
__device__ __forceinline__ unsigned xb_add(unsigned* p, unsigned v) { return __hip_atomic_fetch_add(p, v, __ATOMIC_RELAXED, __HIP_MEMORY_SCOPE_AGENT); }
__device__ __forceinline__ unsigned xb_xcc_id() { return (unsigned)__builtin_amdgcn_s_getreg((3 << 11) | 20) & 0xFu; }
#define XB_SPIN(cond, bar) do { unsigned _sp = 0; while (cond) { __builtin_amdgcn_s_sleep(1); \
    if ((++_sp & 255u) == 0u) { if (xb_ld(&(bar)[XB_TMO])) break; if (_sp > XB_SPIN_CAP) { atomicAdd(&(bar)[XB_TMO], 1u); break; } } } } while (0)

struct XcdBarrier {
    unsigned* bar; unsigned x;
    volatile LAS unsigned* st;
};

__device__ __forceinline__ XcdBarrier xcd_barrier_post(unsigned* bar, volatile LAS unsigned* st) {
    XcdBarrier b; b.bar = bar; b.x = xb_xcc_id(); b.st = st;
    if (threadIdx.x == 0) (void)xb_add(&bar[XB_XCNT(b.x)], 1u);
    return b;
}
__device__ __forceinline__ void xcd_barrier_complete(unsigned* bar, unsigned x, unsigned& nloc, unsigned& nx) {
    const unsigned G = gridDim.x * gridDim.y * gridDim.z;
    unsigned sum, cnt, mine, sp = 0u;
    for (;;) {
        sum = 0u; cnt = 0u; mine = 0u;
#pragma unroll
        for (unsigned j = 0; j < 16; ++j) { const unsigned c = xb_ld(&bar[XB_XCNT(j)]); sum += c; cnt += (c > 0u) ? 1u : 0u; mine = (j == x) ? c : mine; }
        if (sum == G) break;
        __builtin_amdgcn_s_sleep(1);
        if ((++sp & 255u) == 0u) { if (xb_ld(&bar[XB_TMO])) break; if (sp > XB_SPIN_CAP) { atomicAdd(&bar[XB_TMO], 1u); break; } }
    }
    nloc = mine > 0u ? mine : 1u; nx = cnt > 0u ? cnt : 1u;
}

__device__ __forceinline__ void xcd_barrier(const XcdBarrier& b) {
    asm volatile("s_waitcnt vmcnt(0)" ::: "memory");
    __syncthreads();
    if (threadIdx.x == 0) {
        unsigned* bar = b.bar;
        __builtin_amdgcn_s_waitcnt(0);
        unsigned nloc = b.st[0], nx = b.st[1];
        if (nloc == 0u) { xcd_barrier_complete(bar, b.x, nloc, nx); b.st[0] = nloc; b.st[1] = nx; }
        const unsigned old = xb_add(&bar[XB_XSUB(b.x)], 1u);
        const unsigned gen = old / nloc;
        if (old + 1u == (gen + 1u) * nloc) {
            __builtin_amdgcn_fence(__ATOMIC_RELEASE, "agent");
            asm volatile("s_waitcnt vmcnt(0)" ::: "memory");
            const unsigned og = xb_add(&bar[XB_TOP], 1u);
            const unsigned tg = og / nx;
            if (og + 1u == (tg + 1u) * nx) xb_add(&bar[XB_TOPGEN], 1u);
            else XB_SPIN(xb_ld(&bar[XB_TOPGEN]) == tg, bar);
            __builtin_amdgcn_fence(__ATOMIC_ACQUIRE, "agent");
            xb_add(&bar[XB_XGEN(b.x)], 1u);
            asm volatile("s_waitcnt vmcnt(0)" ::: "memory");
        } else {
            XB_SPIN(xb_ld(&bar[XB_XGEN(b.x)]) == gen, bar);
            __builtin_amdgcn_fence(__ATOMIC_ACQUIRE, "agent");
            asm volatile("s_waitcnt vmcnt(0)" ::: "memory");
        }
    }
    __syncthreads();
}

typedef unsigned v2u __attribute__((ext_vector_type(2)));
__device__ __forceinline__ float bf_lo(unsigned w) { return __builtin_bit_cast(float, w << 16); }
__device__ __forceinline__ float bf_hi(unsigned w) { return __builtin_bit_cast(float, w & 0xffff0000u); }
__device__ __forceinline__ float bf1(bf16 b) { return __builtin_bit_cast(float, (unsigned)b << 16); }
__device__ __forceinline__ void unpack8(const v4u w, float (&f)[8]) { f[0] = bf_lo(w.x); f[1] = bf_hi(w.x); f[2] = bf_lo(w.y); f[3] = bf_hi(w.y); f[4] = bf_lo(w.z); f[5] = bf_hi(w.z); f[6] = bf_lo(w.w); f[7] = bf_hi(w.w); }
__device__ __forceinline__ v4u pack8(const float (&f)[8]) { v4u o; o.x = pk2(f[0], f[1]); o.y = pk2(f[2], f[3]); o.z = pk2(f[4], f[5]); o.w = pk2(f[6], f[7]); return o; }
__device__ __forceinline__ float wave_sum(float v) {
#pragma unroll
    for (int o = 1; o < 64; o <<= 1) v += __shfl_xor(v, o);
    return v;
}
__device__ __forceinline__ f32x4 mfma16(bf16x8 a, bf16x8 b, f32x4 c) { return __builtin_amdgcn_mfma_f32_16x16x32_bf16(a, b, c, 0, 0, 0); }
#define WG_BAR() do { asm volatile("s_waitcnt vmcnt(0) lgkmcnt(0)" ::: "memory"); __builtin_amdgcn_s_barrier(); asm volatile("" ::: "memory"); } while (0)
#define LDS_BAR() do { asm volatile("s_waitcnt lgkmcnt(0)" ::: "memory"); __builtin_amdgcn_s_barrier(); asm volatile("" ::: "memory"); } while (0)

__device__ __forceinline__ void p0_transpose_item(const float* W, const float* gs, int K, int N, bf16* WT, int row_off, int mlo, int mhi, float mul, LAS float* scr, int item, int lane) {
    const int nblk = N / 32, kb = item / nblk, nb = item % nblk, k0 = 64 * kb, n0 = 32 * nb;
    const float cm = (n0 >= mlo && n0 < mhi) ? mul : 1.0f;
#pragma unroll 8
    for (int i = 0; i < 32; ++i) { const int kk = 2 * i + (lane >> 5); const float g = gs ? gs[k0 + kk] * cm : cm; scr[kk * 33 + (lane & 31)] = W[(size_t)(k0 + kk) * N + n0 + (lane & 31)] * g; }
    LDS_WAIT(); asm volatile("" ::: "memory");
    const int c = lane & 7;
#pragma unroll
    for (int j = 0; j < 4; ++j) { const int n = (lane >> 3) + 8 * j; const LAS float* s = scr + (8 * c) * 33 + n;
        v4u o; o.x = pk2(s[0 * 33], s[1 * 33]); o.y = pk2(s[2 * 33], s[3 * 33]); o.z = pk2(s[4 * 33], s[5 * 33]); o.w = pk2(s[6 * 33], s[7 * 33]);
        *(GAS v4u*)(WT + (size_t)(row_off + n0 + n) * K + k0 + 8 * c) = o; }
    LDS_WAIT(); asm volatile("" ::: "memory");
}
struct P0Args { const float *xp, *xs, *meta, *norm_mix, *norm_mlp, *wqkv, *wo, *win, *wgate, *wout, *wup, *wdn; unsigned char* ws; };
__device__ __forceinline__ void p0_prologue(const P0Args& A, LAS unsigned char* lds, int vcu, int G, int wave, int lane, int tid) {
    LAS float* scr = (LAS float*)(lds + RING_OFF + wave * 16384);
    const int gw = vcu * NWAVES + wave, NGW = G * NWAVES;
    constexpr int I_QKV = (D / 64) * (NQKV / 32), I_O = (D / 64) * (D / 32), I_IN = (D / 64) * (NIN / 32), I_UP = (D / 64) * (FF / 32), I_DN = (FF / 64) * (D / 32);
    constexpr int I_MIX = I_QKV + I_O + I_IN + I_O, I_MLP = I_UP + I_DN, NITEMS = 2 * I_MIX + 4 * I_MLP;
    unsigned char* ws = A.ws;
    for (int it = gw; it < NITEMS; it += NGW) {
        int r = it;
        if (r < 2 * I_MIX) { const int j = r / I_MIX; r -= j * I_MIX;
            if (r < I_QKV) { p0_transpose_item(A.wqkv + (size_t)j * D * NQKV, A.norm_mix + (2 * j) * D, D, NQKV, (bf16*)(ws + WS_WQKV + j * SZ_WQKV), 0, 0, 0, 1.f, scr, r, lane); continue; } r -= I_QKV;
            if (r < I_O) { p0_transpose_item(A.wo + (size_t)j * D * D, nullptr, D, D, (bf16*)(ws + WS_WO + j * SZ_WO), 0, 0, 0, 1.f, scr, r, lane); continue; } r -= I_O;
            if (r < I_IN) { p0_transpose_item(A.win + (size_t)j * D * NIN, A.norm_mix + (2 * j + 1) * D, D, NIN, (bf16*)(ws + WS_WIN + j * SZ_WIN), 0, 512, 1024, 0.08838834764831845f, scr, r, lane); continue; } r -= I_IN;
            p0_transpose_item(A.wout + (size_t)j * D * D, nullptr, D, D, (bf16*)(ws + WS_WOUT + j * SZ_WO), 0, 0, 0, 1.f, scr, r, lane); continue; }
        r -= 2 * I_MIX;
        { const int i = r / I_MLP; r -= i * I_MLP;
            if (r < I_UP) { p0_transpose_item(A.wup + (size_t)i * D * FF, A.norm_mlp + i * D, D, FF, (bf16*)(ws + WS_WUP + i * SZ_WUP), 0, 0, 0, 1.f, scr, r, lane); continue; } r -= I_UP;
            p0_transpose_item(A.wdn + (size_t)i * FF * D, nullptr, FF, D, (bf16*)(ws + WS_WDN + i * SZ_WUP), 0, 0, 0, 1.f, scr, r, lane); }
    }
    { const int gt = vcu * (NWAVES * 64) + tid, NT = G * NWAVES * 64;
      for (int e = gt; e < 2 * 256 * (D / 8); e += NT) { const int j = e / (256 * (D / 8)), rem = e % (256 * (D / 8)), n = rem / (D / 8), k8 = (rem % (D / 8)) * 8;
          float f[8];
#pragma unroll
          for (int q = 0; q < 8; ++q) f[q] = (n < 8) ? A.wgate[((size_t)j * D + k8 + q) * 8 + n] * A.norm_mix[(2 * j + 1) * D + k8 + q] : 0.f;
          *(GAS v4u*)((bf16*)(ws + WS_WIN + j * SZ_WIN) + (size_t)(NIN + n) * D + k8) = pack8(f); } }
    float* X = (float*)(ws + WS_X); bf16* XB = (bf16*)(ws + WS_XB); float* SS = (float*)(ws + WS_SS); bf16* AO = (bf16*)(ws + WS_AO);
    for (int m = gw; m < MPAD; m += NGW) {
        const float* src = nullptr;
        if (m < MP) { const int b = m / LP, t = m - b * LP; src = (t < NMETA) ? A.meta + (size_t)t * D : A.xp + ((size_t)b * SEQ + (t - NMETA)) * D; }
        else if (m < MTOT) src = A.xs + (size_t)(m - MP) * D;
        f32x4 v[4]; float ss[4];
#pragma unroll
        for (int j = 0; j < 4; ++j) { v[j] = src ? ((const GAS f32x4*)src)[lane + 64 * j] : (f32x4){0.f, 0.f, 0.f, 0.f}; ss[j] = wave_sum((v[j][0] * v[j][0] + v[j][1] * v[j][1]) + (v[j][2] * v[j][2] + v[j][3] * v[j][3])); }
#pragma unroll
        for (int j = 0; j < 4; ++j) { ((GAS f32x4*)(X + (size_t)m * D))[lane + 64 * j] = v[j]; v2u w; w.x = pk2(v[j][0], v[j][1]); w.y = pk2(v[j][2], v[j][3]); ((GAS v2u*)(XB + (size_t)m * D))[lane + 64 * j] = w; }
        if (lane < 16) { const int j = lane >> 2; const float s = (lane & 3) ? 0.f : (j == 0 ? ss[0] : j == 1 ? ss[1] : j == 2 ? ss[2] : ss[3]); SS[(size_t)m * 16 + lane] = s; }
        if (m >= MTOT) {
#pragma unroll
            for (int j = 0; j < 4; ++j) ((GAS v2u*)(AO + (size_t)m * D))[lane + 64 * j] = (v2u){0u, 0u}; }
    }
}

constexpr int A_KS = 0, A_KSTR = 144, A_VT = 36864, A_VSTR = 552, A_LUT = 72192, A_END = 74304;
__device__ __forceinline__ int t5_bucket(int n) {
    if (n < 16) return n;
    const int v = 16 + (int)(logf((float)n * (1.0f / 16.0f)) * (16.0f / 2.0794415416798357f));
    return v < 31 ? v : 31;
}
struct AttnP { const bf16* QKV; const float *gq, *gk, *sinks, *rel; bf16* AO; };
__device__ __forceinline__ void attn_subtile(LAS unsigned char* L, int i0, const bf16* qptr, int hh, int dist0, int jmin, float sink, const float* gq, bf16* optr, bool store, int lane) {
    const int g = lane >> 4, c = lane & 15;
    bf16x8 Bq[2];
    {
        const v4u q0 = *(const GAS v4u*)(qptr + 8 * g), q1 = *(const GAS v4u*)(qptr + 32 + 8 * g);
        float f0[8], f1[8]; unpack8(q0, f0); unpack8(q1, f1);
        float ss = 0.f;
#pragma unroll
        for (int e = 0; e < 8; ++e) ss += f0[e] * f0[e] + f1[e] * f1[e];
        ss += __shfl_xor(ss, 16); ss += __shfl_xor(ss, 32);
        const float rq = 0.125f / sqrtf(ss * (1.0f / 64.0f) + EPS);
        const f32x4 ga = *(const f32x4*)(gq + 8 * g), gb = *(const f32x4*)(gq + 8 * g + 4), gc = *(const f32x4*)(gq + 32 + 8 * g), gd = *(const f32x4*)(gq + 36 + 8 * g);
#pragma unroll
        for (int e = 0; e < 4; ++e) { f0[e] *= rq * ga[e]; f0[4 + e] *= rq * gb[e]; f1[e] *= rq * gc[e]; f1[4 + e] *= rq * gd[e]; }
        const v4u p0 = pack8(f0), p1 = pack8(f1);
        Bq[0] = __builtin_bit_cast(bf16x8, p0); Bq[1] = __builtin_bit_cast(bf16x8, p1);
    }
    f32x4 s[10];
    float mx = -1e30f;
#pragma unroll
    for (int kt = 0; kt < 9; ++kt) {
        const LAS unsigned char* kp = L + A_KS + (i0 + 16 * kt + c) * A_KSTR + 16 * g;
        f32x4 acc = {0.f, 0.f, 0.f, 0.f};
        acc = mfma16(*(const LAS bf16x8*)kp, Bq[0], acc);
        acc = mfma16(*(const LAS bf16x8*)(kp + 64), Bq[1], acc);
#pragma unroll
        for (int r = 0; r < 4; ++r) {
            const int rel = 16 * kt + 4 * g + r, dist = dist0 - rel;
            const bool ok = (dist >= 0) && (dist <= WIN) && (i0 + rel >= jmin);
            const int di = dist < 0 ? 0 : (dist > WIN ? WIN : dist);
            const float bias = *(const LAS float*)(L + A_LUT + (hh * 132 + di) * 4);
            const float v = ok ? acc[r] + bias : -1e30f;
            s[kt][r] = v; mx = fmaxf(mx, v);
        }
    }
    mx = fmaxf(mx, __shfl_xor(mx, 16)); mx = fmaxf(mx, __shfl_xor(mx, 32));
    mx = fmaxf(mx, sink);
    float l = 0.f;
#pragma unroll
    for (int kt = 0; kt < 9; ++kt)
#pragma unroll
        for (int r = 0; r < 4; ++r) { const float p = __expf(s[kt][r] - mx); s[kt][r] = p; l += p; }
    s[9] = (f32x4){0.f, 0.f, 0.f, 0.f};
    l += __shfl_xor(l, 16); l += __shfl_xor(l, 32);
    const float inv = 1.0f / (l + __expf(sink - mx));
    bf16x8 Bp[5];
#pragma unroll
    for (int ks = 0; ks < 5; ++ks) { v4u w; w.x = pk2(s[2 * ks][0], s[2 * ks][1]); w.y = pk2(s[2 * ks][2], s[2 * ks][3]); w.z = pk2(s[2 * ks + 1][0], s[2 * ks + 1][1]); w.w = pk2(s[2 * ks + 1][2], s[2 * ks + 1][3]); Bp[ks] = __builtin_bit_cast(bf16x8, w); }
#pragma unroll
    for (int dt = 0; dt < 4; ++dt) {
        f32x4 acc = {0.f, 0.f, 0.f, 0.f};
        const LAS unsigned char* vp = L + A_VT + (16 * dt + c) * A_VSTR + (i0 + 4 * g) * 2;
#pragma unroll
        for (int ks = 0; ks < 5; ++ks) { const v2u lo = *(const LAS v2u*)(vp + 64 * ks), hi = *(const LAS v2u*)(vp + 64 * ks + 32); const v4u a = {lo.x, lo.y, hi.x, hi.y};
            acc = mfma16(__builtin_bit_cast(bf16x8, a), Bp[ks], acc); }
        if (store) { v2u w; w.x = pk2(acc[0] * inv, acc[1] * inv); w.y = pk2(acc[2] * inv, acc[3] * inv); *(GAS v2u*)(optr + 16 * dt + 4 * g) = w; }
    }
}
__device__ __forceinline__ void attn_stage_row(LAS unsigned char* L, int j, int half, const bf16* krow, const bf16* vrow, const float* gk, float* ck, float* cv) {
    float kf[32], vf[32];
    if (krow) {
#pragma unroll
        for (int i = 0; i < 4; ++i) { float t[8]; unpack8(*(const GAS v4u*)(krow + 8 * i), t);
#pragma unroll
            for (int e = 0; e < 8; ++e) kf[8 * i + e] = t[e];
            unpack8(*(const GAS v4u*)(vrow + 8 * i), t);
#pragma unroll
            for (int e = 0; e < 8; ++e) vf[8 * i + e] = t[e]; }
    } else {
#pragma unroll
        for (int e = 0; e < 32; ++e) { kf[e] = 0.f; vf[e] = 0.f; }
    }
    float ss = 0.f;
#pragma unroll
    for (int e = 0; e < 32; ++e) ss += kf[e] * kf[e];
    ss += __shfl_xor(ss, 1);
    const float rk = 1.0f / sqrtf(ss * (1.0f / 64.0f) + EPS);
#pragma unroll
    for (int i = 0; i < 8; ++i) { const f32x4 gg = *(const f32x4*)(gk + half * 32 + 4 * i);
#pragma unroll
        for (int e = 0; e < 4; ++e) kf[4 * i + e] *= rk * gg[e]; }
#pragma unroll
    for (int i = 0; i < 4; ++i) { float t[8];
#pragma unroll
        for (int e = 0; e < 8; ++e) t[e] = kf[8 * i + e];
        *(LAS v4u*)(L + A_KS + j * A_KSTR + half * 64 + 16 * i) = pack8(t); }
#pragma unroll
    for (int e = 0; e < 32; ++e) *(LAS unsigned short*)(L + A_VT + (half * 32 + e) * A_VSTR + 2 * j) = (unsigned short)f2bf(vf[e]);
    if (ck) {
#pragma unroll
        for (int i = 0; i < 8; ++i) { *(GAS f32x4*)(ck + half * 32 + 4 * i) = (f32x4){kf[4 * i], kf[4 * i + 1], kf[4 * i + 2], kf[4 * i + 3]};
            *(GAS f32x4*)(cv + half * 32 + 4 * i) = (f32x4){vf[4 * i], vf[4 * i + 1], vf[4 * i + 2], vf[4 * i + 3]}; }
    }
}
__device__ __forceinline__ void attn_phase(LAS unsigned char* L, const AttnP& P, const float* cache_k, const float* cache_v, float* out, int jl, int vcu, int G, int tid_in, int wave_in, int lane_in) {
    constexpr int N_PROMPT = NB * 17 * AKV, N_ITEMS = N_PROMPT + DBATCH * AKV;
#pragma unroll 1
    for (int it = vcu; it < N_ITEMS; it += G) {
        int tid = tid_in; asm volatile("" : "+v"(tid));
        const int lane = tid & 63, wave = __builtin_amdgcn_readfirstlane(tid >> 6);
        const bool prompt = it < N_PROMPT;
        int b = 0, qb = 0, kvh, db = 0;
        if (prompt) { b = it / (17 * AKV); const int rem = it % (17 * AKV); qb = rem / AKV; kvh = rem % AKV; }
        else { const int si = it - N_PROMPT; db = si / AKV; kvh = si % AKV; }
        for (int e = tid; e < 4 * 129; e += NWAVES * 64) { const int hh = e / 129, d = e % 129; *(LAS float*)(L + A_LUT + (hh * 132 + d) * 4) = P.rel[t5_bucket(d) * AH + kvh * 4 + hh]; }
        if (prompt) {
            const int j = tid >> 1, half = tid & 1, tok = 128 * qb - 240 + j;
            const bf16* krow = nullptr; const bf16* vrow = nullptr; float* ck = nullptr; float* cv = nullptr;
            if (tok >= 0) { const size_t row = (size_t)b * LP + tok; krow = P.QKV + row * NQKV + 1024 + kvh * 64 + half * 32; vrow = P.QKV + row * NQKV + 1280 + kvh * 64 + half * 32; }
            if (qb == 16 && j >= 128) { const size_t o = ((((size_t)jl * NB + b) * WIN + (j - 128)) * AKV + kvh) * AHD; ck = out + O_KP + o; cv = out + O_VP + o; }
            attn_stage_row(L, j, half, krow, vrow, P.gk, ck, cv);
            for (int e = tid; e < 64 * 16; e += NWAVES * 64) *(LAS unsigned short*)(L + A_VT + (e >> 4) * A_VSTR + 2 * (256 + (e & 15))) = 0;
        } else {
            const float* ckin = cache_k + (((size_t)jl * DBATCH + db) * WIN * AKV + kvh) * AHD; const float* cvin = cache_v + (((size_t)jl * DBATCH + db) * WIN * AKV + kvh) * AHD;
            float* cko = out + O_KS + (((size_t)jl * DBATCH + db) * WIN * AKV + kvh) * AHD; float* cvo = out + O_VS + (((size_t)jl * DBATCH + db) * WIN * AKV + kvh) * AHD;
#pragma unroll
            for (int i = 0; i < 4; ++i) { const int idx = tid + 512 * i, row = idx >> 4, c4 = idx & 15;
                const f32x4 kv = *(const GAS f32x4*)(ckin + (size_t)row * (AKV * AHD) + 4 * c4), vv = *(const GAS f32x4*)(cvin + (size_t)row * (AKV * AHD) + 4 * c4);
                v2u w; w.x = pk2(kv[0], kv[1]); w.y = pk2(kv[2], kv[3]); *(LAS v2u*)(L + A_KS + row * A_KSTR + 8 * c4) = w;
#pragma unroll
                for (int e = 0; e < 4; ++e) *(LAS unsigned short*)(L + A_VT + (4 * c4 + e) * A_VSTR + 2 * row) = (unsigned short)f2bf(vv[e]);
                if (row >= DSEQ) { *(GAS f32x4*)(cko + (size_t)(row - DSEQ) * (AKV * AHD) + 4 * c4) = kv; *(GAS f32x4*)(cvo + (size_t)(row - DSEQ) * (AKV * AHD) + 4 * c4) = vv; } }
            if (tid < 2 * DSEQ) { const int s = tid >> 1, half = tid & 1; const size_t row = (size_t)MP + db * DSEQ + s;
                attn_stage_row(L, WIN + s, half, P.QKV + row * NQKV + 1024 + kvh * 64 + half * 32, P.QKV + row * NQKV + 1280 + kvh * 64 + half * 32, P.gk,
                               cko + (size_t)(WIN - DSEQ + s) * (AKV * AHD), cvo + (size_t)(WIN - DSEQ + s) * (AKV * AHD)); }
            for (int e = tid; e < 12 * 8; e += NWAVES * 64) *(LAS v4u*)(L + A_KS + (132 + e / 8) * A_KSTR + 16 * (e & 7)) = (v4u){0u, 0u, 0u, 0u};
            for (int e = tid; e < 64 * 28; e += NWAVES * 64) *(LAS unsigned short*)(L + A_VT + (e / 28) * A_VSTR + 2 * (132 + e % 28)) = 0;
        }
        LDS_BAR();
        if (prompt) {
            const int hh = wave & 3, rhalf = wave >> 2, head = kvh * 4 + hh; const float sink = P.sinks[head];
            const int jmin = 240 - 128 * qb;
#pragma unroll 1
            for (int st = 0; st < 4; ++st) {
                const int i0 = 64 * rhalf + 16 * st;
                if (qb == 0 && i0 < 112) continue;
                const int tok = 128 * qb - 112 + i0 + (lane & 15); const size_t row = (size_t)b * LP + tok;
                attn_subtile(L, i0, P.QKV + row * NQKV + head * 64, hh, (lane & 15) + WIN, jmin, sink, P.gq, P.AO + row * D + head * 64, true, lane);
            }
        } else if (wave == 0) {
            const int q = lane & 15, hh = q >> 2, s = q & 3, head = kvh * 4 + hh; const size_t row = (size_t)MP + db * DSEQ + s;
            attn_subtile(L, 0, P.QKV + row * NQKV + head * 64, hh, WIN + s, 0, P.sinks[head], P.gq, P.AO + row * D + head * 64, true, lane);
        }
        LDS_BAR();
    }
}

constexpr int M_QS = 0, M_KS = 17408, M_KT = 34816, M_VT = 53248, M_VW = 60160, M_CT = 67072, M_CTB = 13056, M_GT = 93184, M_END = 94208;
constexpr int M_RS = 272, M_TS = 144;
struct MlP { const bf16* Z; const float* G; const float* gnorm; bf16* AO; float* HSS; };
__device__ __forceinline__ float wave_scan_add(float x, int lane) {
#pragma unroll
    for (int o = 1; o < 64; o <<= 1) { const float t = __shfl_up(x, o); if (lane >= o) x += t; }
    return x;
}
__device__ __forceinline__ float wave_scan_max(float x, int lane) {
#pragma unroll
    for (int o = 1; o < 64; o <<= 1) { const float t = __shfl_up(x, o); if (lane >= o) x = fmaxf(x, t); }
    return x;
}
__device__ __forceinline__ float sigmoidf_(float x) { return 1.0f / (1.0f + __expf(-x)); }
__device__ __forceinline__ void mlstm_prompt_item(LAS unsigned char* L, const MlP& P, float* out, int jl, int b, int h, int sl, int tid, int wave, int lane) {
    const int g = lane >> 4, c = lane & 15;
    for (int e = tid; e < 16 * 72; e += NWAVES * 64) { const int r = e / 72, cc = e % 72; const unsigned short one = 0x3f80;
        *(LAS unsigned short*)(L + M_VT + (32 + r) * M_TS + 2 * cc) = (r == 0) ? one : (unsigned short)0; *(LAS unsigned short*)(L + M_VW + (32 + r) * M_TS + 2 * cc) = 0; }
    for (int e = tid; e < M_CTB / 16; e += NWAVES * 64) *(LAS v4u*)(L + M_CT + 16 * e) = (v4u){0u, 0u, 0u, 0u};
    f32x4 cacc[6];
#pragma unroll
    for (int i = 0; i < 6; ++i) cacc[i] = (f32x4){0.f, 0.f, 0.f, 0.f};
    float m_prev = 0.f;
    const int srow = tid >> 3, spiece = tid & 7, vrow = (tid >> 2) & 63, vpiece = tid & 3;
    v4u pq0, pq1, pk0, pk1, pv; float pli, plf;
#define ML_LOAD(ch) do { const int t0_ = (ch) == 0 ? 0 : 16 + 64 * ((ch) - 1), nv_ = (ch) == 0 ? 16 : 64; \
        if (srow < nv_) { const bf16* zr = P.Z + ((size_t)b * LP + t0_ + srow) * NIN + h * MDK + 16 * spiece; pq0 = *(const GAS v4u*)zr; pq1 = *(const GAS v4u*)(zr + 8); pk0 = *(const GAS v4u*)(zr + 512); pk1 = *(const GAS v4u*)(zr + 520); } \
        else { pq0 = pq1 = pk0 = pk1 = (v4u){0u, 0u, 0u, 0u}; } \
        if (tid < 256 && vrow < nv_) pv = *(const GAS v4u*)(P.Z + ((size_t)b * LP + t0_ + vrow) * NIN + 1024 + h * MDV + VS * sl + 8 * vpiece); else pv = (v4u){0u, 0u, 0u, 0u}; \
        if (lane < nv_) { const float* gr = P.G + ((size_t)b * LP + t0_ + lane) * 8; pli = gr[h]; plf = gr[4 + h]; } else { pli = -1e30f; plf = 0.f; } } while (0)
    ML_LOAD(0);
#pragma unroll 1
    for (int ch = 0; ch < 33; ++ch) {
        const int t0 = ch == 0 ? 0 : 16 + 64 * (ch - 1), nvalid = ch == 0 ? 16 : 64, cur = ch & 1;
        const float bcum = wave_scan_add(plf, lane), wj = pli - bcum, cm = wave_scan_max(wj, lane);
        const float cm63 = __shfl(cm, 63), blast = __shfl(bcum, 63);
        const float Mt = fmaxf(m_prev, cm), Mx = fmaxf(m_prev, cm63);
        const float wk = __expf(wj - Mx), a = __expf(m_prev - Mx), m_new = blast + Mx;
        *(LAS v4u*)(L + M_QS + srow * M_RS + 32 * spiece) = pq0; *(LAS v4u*)(L + M_QS + srow * M_RS + 32 * spiece + 16) = pq1;
        *(LAS v4u*)(L + M_KS + srow * M_RS + 32 * spiece) = pk0; *(LAS v4u*)(L + M_KS + srow * M_RS + 32 * spiece + 16) = pk1;
        { const unsigned kw[8] = {pk0.x, pk0.y, pk0.z, pk0.w, pk1.x, pk1.y, pk1.z, pk1.w};
#pragma unroll
          for (int e = 0; e < 8; ++e) { *(LAS unsigned short*)(L + M_KT + (16 * spiece + 2 * e) * M_TS + 2 * srow) = (unsigned short)(kw[e] & 0xffffu); *(LAS unsigned short*)(L + M_KT + (16 * spiece + 2 * e + 1) * M_TS + 2 * srow) = (unsigned short)(kw[e] >> 16); } }
        if (tid < 256) { const float wkr = __shfl(wk, vrow); float vf[8]; unpack8(pv, vf); const unsigned vw_[4] = {pv.x, pv.y, pv.z, pv.w};
#pragma unroll
            for (int e = 0; e < 4; ++e) { *(LAS unsigned short*)(L + M_VT + (8 * vpiece + 2 * e) * M_TS + 2 * vrow) = (unsigned short)(vw_[e] & 0xffffu); *(LAS unsigned short*)(L + M_VT + (8 * vpiece + 2 * e + 1) * M_TS + 2 * vrow) = (unsigned short)(vw_[e] >> 16); }
#pragma unroll
            for (int e = 0; e < 8; ++e) *(LAS unsigned short*)(L + M_VW + (8 * vpiece + e) * M_TS + 2 * vrow) = (unsigned short)f2bf(vf[e] * wkr); }
        if (wave == 4) *(LAS unsigned short*)(L + M_VW + 32 * M_TS + 2 * lane) = (unsigned short)f2bf(wk);
        if (wave == 5) { LAS float* gt = (LAS float*)(L + M_GT); gt[lane] = -Mt; gt[64 + lane] = wj; gt[128 + lane] = __expf(m_prev - Mt); gt[192 + lane] = __expf(-(bcum + Mt)); }
        LDS_BAR();
        if (ch + 1 < 33) ML_LOAD(ch + 1);
        if (wave < 4) {
            const int tt = wave, trow = 16 * tt + c;
            bf16x8 Bq[4];
#pragma unroll
            for (int ks = 0; ks < 4; ++ks) Bq[ks] = *(const LAS bf16x8*)(L + M_QS + trow * M_RS + 64 * ks + 16 * g);
            const LAS float* gt = (const LAS float*)(L + M_GT);
            const float ut = gt[trow], wint = gt[128 + trow], einv = gt[192 + trow];
            f32x4 s[4];
#pragma unroll
            for (int jt = 0; jt < 4; ++jt) {
                if (jt <= tt) {
                    f32x4 acc = {0.f, 0.f, 0.f, 0.f};
#pragma unroll
                    for (int ks = 0; ks < 4; ++ks) acc = mfma16(*(const LAS bf16x8*)(L + M_KS + (16 * jt + c) * M_RS + 64 * ks + 16 * g), Bq[ks], acc);
                    const f32x4 wjj = *(const LAS f32x4*)(L + M_GT + (64 + 16 * jt + 4 * g) * 4);
#pragma unroll
                    for (int r = 0; r < 4; ++r) { const int j = 16 * jt + 4 * g + r; acc[r] = (j <= trow) ? acc[r] * __expf(ut + wjj[r]) : 0.f; }
                    s[jt] = acc;
                } else s[jt] = (f32x4){0.f, 0.f, 0.f, 0.f};
            }
            bf16x8 Bs[2];
#pragma unroll
            for (int k2 = 0; k2 < 2; ++k2) { v4u w; w.x = pk2(s[2 * k2][0], s[2 * k2][1]); w.y = pk2(s[2 * k2][2], s[2 * k2][3]); w.z = pk2(s[2 * k2 + 1][0], s[2 * k2 + 1][1]); w.w = pk2(s[2 * k2 + 1][2], s[2 * k2 + 1][3]); Bs[k2] = __builtin_bit_cast(bf16x8, w); }
            f32x4 nm[3];
#pragma unroll
            for (int vt = 0; vt < 3; ++vt) {
                f32x4 acc = {0.f, 0.f, 0.f, 0.f};
#pragma unroll
                for (int ks = 0; ks < 4; ++ks) acc = mfma16(*(const LAS bf16x8*)(L + M_CT + cur * M_CTB + (16 * vt + c) * M_RS + 64 * ks + 16 * g), Bq[ks], acc);
                acc = acc * wint;
#pragma unroll
                for (int k2 = 0; k2 < 2; ++k2) {
                    if (2 * k2 <= tt) { const LAS unsigned char* vp = L + M_VT + (16 * vt + c) * M_TS + (32 * k2 + 4 * g) * 2; const v2u lo = *(const LAS v2u*)vp, hi = *(const LAS v2u*)(vp + 32); const v4u av = {lo.x, lo.y, hi.x, hi.y};
                        acc = mfma16(__builtin_bit_cast(bf16x8, av), Bs[k2], acc); }
                }
                nm[vt] = acc;
            }
            const float den = __shfl(nm[2][0], c);
            const float inv = 1.0f / fmaxf(fabsf(den), einv);
            float hss = 0.f;
#pragma unroll
            for (int vt = 0; vt < 2; ++vt)
#pragma unroll
                for (int r = 0; r < 4; ++r) { nm[vt][r] *= inv; hss += nm[vt][r] * nm[vt][r]; }
            hss += __shfl_xor(hss, 16); hss += __shfl_xor(hss, 32);
            if (trow < nvalid) {
                const size_t grow = (size_t)b * LP + t0 + trow;
#pragma unroll
                for (int vt = 0; vt < 2; ++vt) { const int col = h * MDV + VS * sl + 16 * vt + 4 * g;
                    const v2u ow = *(const GAS v2u*)(P.Z + grow * NIN + 2048 + col); const f32x4 gn = *(const f32x4*)(P.gnorm + col);
                    v2u w; w.x = pk2(sigmoidf_(bf_lo(ow.x)) * gn[0] * nm[vt][0], sigmoidf_(bf_hi(ow.x)) * gn[1] * nm[vt][1]); w.y = pk2(sigmoidf_(bf_lo(ow.y)) * gn[2] * nm[vt][2], sigmoidf_(bf_hi(ow.y)) * gn[3] * nm[vt][3]);
                    *(GAS v2u*)(P.AO + grow * D + col) = w; }
                if (g == 0) P.HSS[grow * 32 + h * 8 + sl] = hss;
            }
        } else {
            const int w4 = wave - 4, nxt = cur ^ 1;
#pragma unroll
            for (int i = 0; i < 6; ++i) cacc[i] = cacc[i] * a;
#pragma unroll
            for (int k2 = 0; k2 < 2; ++k2) {
                bf16x8 Bv[3];
#pragma unroll
                for (int vt = 0; vt < 3; ++vt) Bv[vt] = *(const LAS bf16x8*)(L + M_VW + (16 * vt + c) * M_TS + 64 * k2 + 16 * g);
#pragma unroll
                for (int dd = 0; dd < 2; ++dd) { const bf16x8 Ak = *(const LAS bf16x8*)(L + M_KT + (16 * (2 * w4 + dd) + c) * M_TS + 64 * k2 + 16 * g);
#pragma unroll
                    for (int vt = 0; vt < 3; ++vt) cacc[dd * 3 + vt] = mfma16(Ak, Bv[vt], cacc[dd * 3 + vt]); }
            }
#pragma unroll
            for (int dd = 0; dd < 2; ++dd)
#pragma unroll
                for (int vt = 0; vt < 3; ++vt) { const f32x4 v = cacc[dd * 3 + vt]; v2u w; w.x = pk2(v[0], v[1]); w.y = pk2(v[2], v[3]);
                    *(LAS v2u*)(L + M_CT + nxt * M_CTB + (16 * vt + c) * M_RS + (16 * (2 * w4 + dd) + 4 * g) * 2) = w; }
        }
        m_prev = m_new;
        LDS_BAR();
    }
#undef ML_LOAD
    if (wave >= 4) {
        const int w4 = wave - 4; const size_t sb = ((size_t)jl * NB + b) * MH + h;
#pragma unroll
        for (int dd = 0; dd < 2; ++dd) {
#pragma unroll
            for (int vt = 0; vt < 2; ++vt)
#pragma unroll
                for (int r = 0; r < 4; ++r) out[O_CP + (sb * MDK + 16 * (2 * w4 + dd) + 4 * g + r) * MDV + VS * sl + 16 * vt + c] = cacc[dd * 3 + vt][r];
            if (sl == 0 && c == 0) {
#pragma unroll
                for (int r = 0; r < 4; ++r) out[O_NP + sb * MDK + 16 * (2 * w4 + dd) + 4 * g + r] = cacc[dd * 3 + 2][r]; }
        }
        if (sl == 0 && wave == 4 && lane == 0) out[O_MP + sb] = m_prev;
    }
}
constexpr int S_Q = 0, S_K = 2048, S_V = 4096, S_P = 8192, S_M = 40960, S_END = 41472;
__device__ __forceinline__ void mlstm_sample_item(LAS unsigned char* L, const MlP& P, const float* stC, const float* stN, const float* stM, float* out, int jl, int db, int h, int tid, int wave, int lane) {
    LAS float* SQ = (LAS float*)(L + S_Q); LAS float* SK = (LAS float*)(L + S_K); LAS float* SV = (LAS float*)(L + S_V); LAS float* SP = (LAS float*)(L + S_P); LAS float* SM = (LAS float*)(L + S_M);
    const size_t r0 = (size_t)MP + db * DSEQ; const size_t sb = ((size_t)jl * DBATCH + db) * MH + h;
    { const int s = tid >> 7, d = tid & 127; const bf16* zr = P.Z + (r0 + s) * NIN; SQ[s * 128 + d] = bf1(zr[h * MDK + d]); SK[s * 128 + d] = bf1(zr[512 + h * MDK + d]);
      SV[s * 256 + 2 * d] = bf1(zr[1024 + h * MDV + 2 * d]); SV[s * 256 + 2 * d + 1] = bf1(zr[1024 + h * MDV + 2 * d + 1]); }
    float li[4], lf[4], bc[4], wjv[4], Mt[4];
#pragma unroll
    for (int s = 0; s < 4; ++s) { li[s] = P.G[(r0 + s) * 8 + h]; lf[s] = P.G[(r0 + s) * 8 + 4 + h]; }
    const float m0 = stM[sb];
    { float acc = 0.f, cmx = -1e30f;
#pragma unroll
      for (int s = 0; s < 4; ++s) { acc += lf[s]; bc[s] = acc; wjv[s] = li[s] - acc; cmx = fmaxf(cmx, wjv[s]); Mt[s] = fmaxf(m0, cmx); } }
    const float Mx = Mt[3], blast = bc[3], m_new = blast + Mx, a = __expf(m0 - Mx);
    float wk[4];
#pragma unroll
    for (int s = 0; s < 4; ++s) wk[s] = __expf(wjv[s] - Mx);
    LDS_BAR();
    if (wave == 0) { const int p = lane >> 2, qd = lane & 3, t = p >> 2, j = p & 3; float acc = 0.f;
        for (int d = 0; d < 32; ++d) acc += SQ[t * 128 + 32 * qd + d] * SK[j * 128 + 32 * qd + d];
        acc += __shfl_xor(acc, 1); acc += __shfl_xor(acc, 2);
        const float Mtt = t == 0 ? Mt[0] : t == 1 ? Mt[1] : t == 2 ? Mt[2] : Mt[3], wjj = j == 0 ? wjv[0] : j == 1 ? wjv[1] : j == 2 ? wjv[2] : wjv[3];
        if (qd == 0) SM[p] = (j <= t) ? acc * __expf(wjj - Mtt) : 0.f; }
    if (wave == 1) { const int t = lane >> 4, part = lane & 15; float acc = 0.f;
        for (int d = 0; d < 8; ++d) acc += SQ[t * 128 + 8 * part + d] * stN[sb * MDK + 8 * part + d];
        acc += __shfl_xor(acc, 1); acc += __shfl_xor(acc, 2); acc += __shfl_xor(acc, 4); acc += __shfl_xor(acc, 8);
        if (part == 0) SM[16 + t] = acc; }
    { const int vq = tid & 63, dg = tid >> 6; const float* c0p = stC + sb * MDK * MDV; float* c1p = out + O_CS + sb * MDK * MDV;
      f32x4 vj[4];
#pragma unroll
      for (int j = 0; j < 4; ++j) vj[j] = *(const LAS f32x4*)(SV + j * 256 + 4 * vq);
      f32x4 acc[4];
#pragma unroll
      for (int t = 0; t < 4; ++t) acc[t] = (f32x4){0.f, 0.f, 0.f, 0.f};
#pragma unroll 4
      for (int i = 0; i < 16; ++i) { const int dk = 16 * dg + i; const f32x4 c0 = *(const GAS f32x4*)(c0p + (size_t)dk * MDV + 4 * vq);
          f32x4 cn = c0 * a;
#pragma unroll
          for (int t = 0; t < 4; ++t) { acc[t] += c0 * SQ[t * 128 + dk]; cn += vj[t] * (wk[t] * SK[t * 128 + dk]); }
          *(GAS f32x4*)(c1p + (size_t)dk * MDV + 4 * vq) = cn; }
#pragma unroll
      for (int t = 0; t < 4; ++t) *(LAS f32x4*)(SP + (dg * 4 + t) * 256 + 4 * vq) = acc[t];
    }
    if (tid < 128) { float nn = a * stN[sb * MDK + tid];
#pragma unroll
        for (int j = 0; j < 4; ++j) nn += wk[j] * SK[j * 128 + tid];
        out[O_NS + sb * MDK + tid] = nn; }
    if (tid == 0) out[O_MS + sb] = m_new;
    LDS_BAR();
    if (tid < 256) { const int v = tid; float hv[4];
#pragma unroll
        for (int t = 0; t < 4; ++t) { float qc = 0.f;
#pragma unroll
            for (int dg = 0; dg < 8; ++dg) qc += SP[(dg * 4 + t) * 256 + v];
            const float wint = __expf(m0 - Mt[t]); float num = wint * qc, den = wint * SM[16 + t];
#pragma unroll
            for (int j = 0; j < 4; ++j) { const float sc = SM[t * 4 + j]; num += sc * SV[j * 256 + v]; den += sc; }
            hv[t] = num / fmaxf(fabsf(den), __expf(-(bc[t] + Mt[t]))); }
#pragma unroll
        for (int t = 0; t < 4; ++t) { const float q = wave_sum(hv[t] * hv[t]); if (lane == 0) SM[32 + wave * 4 + t] = q; }
        const float gn = P.gnorm[h * MDV + v];
#pragma unroll
        for (int t = 0; t < 4; ++t) { const float o = bf1(P.Z[(r0 + t) * NIN + 2048 + h * MDV + v]); P.AO[(r0 + t) * D + h * MDV + v] = (bf16)f2bf(sigmoidf_(o) * gn * hv[t]); }
    }
    LDS_BAR();
    if (tid < 32) { const int t = tid >> 3, slot = tid & 7; P.HSS[(r0 + t) * 32 + h * 8 + slot] = (slot == 0) ? (SM[32 + t] + SM[36 + t]) + (SM[40 + t] + SM[44 + t]) : 0.f; }
    LDS_BAR();
}
__device__ __forceinline__ void mlstm_phase(LAS unsigned char* L, const MlP& P, const float* stC, const float* stN, const float* stM, float* out, int jl, int vcu, int G, int tid_in, int wave_in, int lane_in) {
    constexpr int N_PROMPT = NB * MH * NSL, N_ITEMS = N_PROMPT + DBATCH * MH;
#pragma unroll 1
    for (int it = vcu; it < N_ITEMS; it += G) {
        int tid = tid_in; asm volatile("" : "+v"(tid));
        const int lane = tid & 63, wave = __builtin_amdgcn_readfirstlane(tid >> 6);
        if (it < N_PROMPT) { const int bh = it / NSL, sl = it % NSL; mlstm_prompt_item(L, P, out, jl, bh / MH, bh % MH, sl, tid, wave, lane); }
        else { const int si = it - N_PROMPT; mlstm_sample_item(L, P, stC, stN, stM, out, jl, si / MH, si % MH, tid, wave, lane); }
    }
}
__device__ __forceinline__ void mlstm_fixup(bf16* AO, const float* HSS, int vcu, int G, int wave, int lane) {
    const int gw = vcu * NWAVES + wave, NGW = G * NWAVES;
    for (int m = gw; m < MTOT; m += NGW) {
        const int hd = lane >> 4; const f32x4 a = *(const GAS f32x4*)(HSS + (size_t)m * 32 + hd * 8), bq = *(const GAS f32x4*)(HSS + (size_t)m * 32 + hd * 8 + 4);
        const float r = 1.0f / sqrtf((((a[0] + a[1]) + (a[2] + a[3])) + ((bq[0] + bq[1]) + (bq[2] + bq[3]))) * (1.0f / 256.0f) + EPS);
        GAS v4u* p = (GAS v4u*)(AO + (size_t)m * D + 16 * lane);
#pragma unroll
        for (int i = 0; i < 2; ++i) { float f[8]; unpack8(p[i], f);
#pragma unroll
            for (int e = 0; e < 8; ++e) f[e] *= r;
            p[i] = pack8(f); }
    }
}

struct Args { const float* in[23]; float* out; unsigned char* ws; };
constexpr int PTAB_OFF = LDSCTL_OFF + 1024;
__device__ __forceinline__ unsigned long long ld_ptr(volatile LAS unsigned* T, int i) {
    const unsigned lo = __builtin_amdgcn_readfirstlane(T[2 * i]), hi = __builtin_amdgcn_readfirstlane(T[2 * i + 1]);
    return ((unsigned long long)hi << 32) | lo;
}
__global__ void __launch_bounds__(NWAVES * 64, 2) hybrid_fwd(Args args) {
    extern __shared__ __attribute__((aligned(16))) unsigned char lds_raw[];
    LAS unsigned char* lds = (LAS unsigned char*)lds_raw;
    volatile LAS unsigned* MISC = (volatile LAS unsigned*)(lds + MISC_OFF);
    const int tid = threadIdx.x, lane = tid & 63, wave = __builtin_amdgcn_readfirstlane(tid >> 6);
#define GG_ g_o
#define BX_ b_o
#define OPQ_GB() int g_o = (int)gridDim.x, b_o = (int)blockIdx.x; asm volatile("" : "+s"(g_o), "+s"(b_o))
#define VCU_ ((BX_ & 7) * (GG_ >> 3) + (BX_ >> 3))
    for (int u = tid; u < (LDS_BYTES - LDSCTL_OFF) / 4; u += NWAVES * 64) ((LAS unsigned*)(lds + LDSCTL_OFF))[u] = 0u;
    __syncthreads();
    volatile LAS unsigned* PT = (volatile LAS unsigned*)(lds + PTAB_OFF);
    if (tid == 0) {
#pragma unroll
        for (int i = 0; i < 23; ++i) { const unsigned long long p = (unsigned long long)args.in[i]; PT[2 * i] = (unsigned)p; PT[2 * i + 1] = (unsigned)(p >> 32); }
        { const unsigned long long p = (unsigned long long)args.out; PT[46] = (unsigned)p; PT[47] = (unsigned)(p >> 32); }
        { const unsigned long long p = (unsigned long long)args.ws; PT[48] = (unsigned)p; PT[49] = (unsigned)(p >> 32); }
    }
    __syncthreads();
#define OPAQUE_TID() int tid_p = threadIdx.x; asm volatile("" : "+v"(tid_p)); const int lane_p = tid_p & 63, wave_p = __builtin_amdgcn_readfirstlane(tid_p >> 6)
#define PIN(i) ((const float*)(const GAS float*)ld_ptr(PT, (i)))
#define POUT() ((float*)(GAS float*)ld_ptr(PT, 23))
#define PWS() ((unsigned char*)(GAS unsigned char*)ld_ptr(PT, 24))
    (void)xcd_barrier_post((unsigned*)((gu32*)(PWS() + WS_CTL) + CW_BAR), MISC + 8);
#define GRID_BAR() do { XcdBarrier b_; b_.bar = (unsigned*)((gu32*)(PWS() + WS_CTL) + CW_BAR); b_.x = xb_xcc_id(); b_.st = MISC + 8; xcd_barrier(b_); } while (0)

    { OPAQUE_TID(); OPQ_GB(); P0Args A{PIN(0), PIN(1), PIN(7), PIN(9), PIN(10), PIN(11), PIN(15), PIN(16), PIN(17), PIN(20), PIN(21), PIN(22), PWS()};
#ifndef NO_P0
      p0_prologue(A, lds, VCU_, GG_, wave_p, lane_p, tid_p);
#endif
    }
    GRID_BAR();

#pragma unroll 1
    for (;;) {
        const int layer = (int)__builtin_amdgcn_readfirstlane(MISC[12]);
        if (layer >= 4) break;
        const int jl = layer >> 1;
        if ((layer & 1) == 0) {
            { OPQ_GB(); unsigned char* ws = PWS(); pg8::Gemm g{(const bf16*)(ws + WS_XB), (const bf16*)(ws + WS_WQKV + jl * SZ_WQKV), MPAD, NQKV, D}; pg8::StaticOrder S; S.init(MPAD, NQKV, GG_, BX_);
              pg8::EpiNormBf16<0, false> E{(bf16*)(ws + WS_Z), NQKV, (const float*)(ws + WS_SS), nullptr, nullptr, -1};
              pg8::gemm_phase<pg8::EpiNormBf16<0, false>, pg8::StaticOrder, PG8_ALIGN, PG8_SP2>(lds + RING_OFF, g, S, E); }
            GRID_BAR();
            { OPAQUE_TID(); OPQ_GB(); unsigned char* ws = PWS(); AttnP P{(const bf16*)(ws + WS_Z), PIN(12) + jl * AHD, PIN(13) + jl * AHD, PIN(14) + jl * AH, PIN(8), (bf16*)(ws + WS_AO)};
#ifndef NO_ATTN
              attn_phase(lds + RING_OFF, P, PIN(2), PIN(3), POUT(), jl, VCU_, GG_, tid_p, wave_p, lane_p);
#endif
            }
            GRID_BAR();
            { OPQ_GB(); unsigned char* ws = PWS(); pg8::Gemm g{(const bf16*)(ws + WS_AO), (const bf16*)(ws + WS_WO + jl * SZ_WO), MPAD, D, D}; pg8::StaticOrder S; S.init(MPAD, D, GG_, BX_);
              pg8::EpiResid<false> E{(float*)(ws + WS_X), (bf16*)(ws + WS_XB), (float*)(ws + WS_SS), nullptr, nullptr};
              pg8::gemm_phase<pg8::EpiResid<false>, pg8::StaticOrder, PG8_ALIGN, PG8_SP2>(lds + RING_OFF, g, S, E); }
            GRID_BAR();
        } else {
            { OPQ_GB(); unsigned char* ws = PWS(); pg8::Gemm g{(const bf16*)(ws + WS_XB), (const bf16*)(ws + WS_WIN + jl * SZ_WIN), MPAD, NINP, D}; pg8::StaticOrder S; S.init(MPAD, NINP, GG_, BX_);
              pg8::EpiNormBf16<0, true> E{(bf16*)(ws + WS_Z), NIN, (const float*)(ws + WS_SS), (float*)(ws + WS_G), PIN(18) + jl * 8, NIN / 256};
              pg8::gemm_phase<pg8::EpiNormBf16<0, true>, pg8::StaticOrder, PG8_ALIGN, PG8_SP2>(lds + RING_OFF, g, S, E); }
            GRID_BAR();
            { OPAQUE_TID(); OPQ_GB(); unsigned char* ws = PWS(); MlP P{(const bf16*)(ws + WS_Z), (const float*)(ws + WS_G), PIN(19) + jl * D, (bf16*)(ws + WS_AO), (float*)(ws + WS_HSS)};
#ifndef NO_MLSTM
              mlstm_phase(lds + RING_OFF, P, PIN(4), PIN(5), PIN(6), POUT(), jl, VCU_, GG_, tid_p, wave_p, lane_p);
#endif
            }
            GRID_BAR();
            { OPAQUE_TID(); OPQ_GB(); unsigned char* ws = PWS(); mlstm_fixup((bf16*)(ws + WS_AO), (const float*)(ws + WS_HSS), VCU_, GG_, wave_p, lane_p); }
            GRID_BAR();
            { OPQ_GB(); unsigned char* ws = PWS(); pg8::Gemm g{(const bf16*)(ws + WS_AO), (const bf16*)(ws + WS_WOUT + jl * SZ_WO), MPAD, D, D}; pg8::StaticOrder S; S.init(MPAD, D, GG_, BX_);
              pg8::EpiResid<false> E{(float*)(ws + WS_X), (bf16*)(ws + WS_XB), (float*)(ws + WS_SS), nullptr, nullptr};
              pg8::gemm_phase<pg8::EpiResid<false>, pg8::StaticOrder, PG8_ALIGN, PG8_SP2>(lds + RING_OFF, g, S, E); }
            GRID_BAR();
        }
        { OPQ_GB(); unsigned char* ws = PWS(); pg8::Gemm g{(const bf16*)(ws + WS_XB), (const bf16*)(ws + WS_WUP + layer * SZ_WUP), MPAD, FF, D}; pg8::StaticOrder S; S.init(MPAD, FF, GG_, BX_);
          pg8::EpiNormBf16<1, false> E{(bf16*)(ws + WS_FF), FF, (const float*)(ws + WS_SS), nullptr, nullptr, -1};
          pg8::gemm_phase<pg8::EpiNormBf16<1, false>, pg8::StaticOrder, PG8_ALIGN, PG8_SP2>(lds + RING_OFF, g, S, E); }
        GRID_BAR();
        { OPQ_GB(); unsigned char* ws = PWS(); pg8::Gemm g{(const bf16*)(ws + WS_FF), (const bf16*)(ws + WS_WDN + layer * SZ_WUP), MPAD, D, FF}; pg8::StaticOrder S; S.init(MPAD, D, GG_, BX_);
          if (layer < 3) { pg8::EpiResid<false> E{(float*)(ws + WS_X), (bf16*)(ws + WS_XB), (float*)(ws + WS_SS), nullptr, nullptr};
              pg8::gemm_phase<pg8::EpiResid<false>, pg8::StaticOrder, PG8_ALIGN, PG8_SP2>(lds + RING_OFF, g, S, E); GRID_BAR(); }
          else { float* out = POUT(); pg8::EpiResid<true> E{(float*)(ws + WS_X), nullptr, nullptr, out + O_YP, out + O_YS};
              pg8::gemm_phase<pg8::EpiResid<true>, pg8::StaticOrder, PG8_ALIGN, PG8_SP2>(lds + RING_OFF, g, S, E); } }
        __syncthreads();
        if (tid == 0) MISC[12] = MISC[12] + 1u;
        __syncthreads();
    }
#undef PIN
#undef OPAQUE_TID
#undef GRID_BAR
#undef GG_
#undef OPQ_GB
#undef BX_
#undef VCU_
#undef POUT
#undef PWS
}

extern "C" void kernel_launch(void* const* d_in, const int* in_sizes, int n_in, void* d_out, int out_size, void* d_ws, size_t ws_size, hipStream_t stream) {
    static int grid = 0;
    if (grid == 0) {
        if (n_in != 23 || ws_size < WS_END) { fprintf(stderr, "kernel_launch: built for 23 inputs, %zu outputs, >= %zu bytes of workspace; got n_in %d, out %d, ws %zu; nothing launched\n", (size_t)O_END, (size_t)WS_END, n_in, out_size, ws_size); grid = -1; return; }
        int dev = 0, cus = 0, per_cu = 0;
        if (hipGetDevice(&dev) != hipSuccess || hipDeviceGetAttribute(&cus, hipDeviceAttributeMultiprocessorCount, dev) != hipSuccess) { fprintf(stderr, "kernel_launch: device query failed\n"); grid = -1; return; }
        if (hipFuncSetAttribute((const void*)hybrid_fwd, hipFuncAttributeMaxDynamicSharedMemorySize, LDS_BYTES) != hipSuccess) { fprintf(stderr, "kernel_launch: hipFuncSetAttribute failed\n"); grid = -1; return; }
        if (hipOccupancyMaxActiveBlocksPerMultiprocessor(&per_cu, (const void*)hybrid_fwd, NWAVES * 64, LDS_BYTES) != hipSuccess || per_cu < 1)
            fprintf(stderr, "kernel_launch: note: occupancy query reports %d workgroups per CU\n", per_cu);
        (void)hipGetLastError();
        grid = cus - (cus % 8);
    }
    if (grid < 0) return;
    if (hipMemsetAsync((char*)d_ws + WS_CTL, 0, CTL_ZERO_BYTES, stream) != hipSuccess) { fprintf(stderr, "kernel_launch: hipMemsetAsync failed\n"); return; }
    Args a{};
    for (int i = 0; i < 23; ++i) a.in[i] = (const float*)d_in[i];
    a.out = (float*)d_out; a.ws = (unsigned char*)d_ws;
    hipLaunchKernelGGL(hybrid_fwd, dim3(grid), dim3(NWAVES * 64), LDS_BYTES, stream, a);
    const hipError_t le = hipPeekAtLastError();
    if (le != hipSuccess) fprintf(stderr, "kernel_launch: launch failed: %s\n", hipGetErrorName(le));
}
```

```cpp
#define CH_PUB_T 6
#include <hip/hip_runtime.h>
#include <cstdio>
#include <cstdint>
namespace pg8 {
#define PG8_LAS __attribute__((address_space(3)))
typedef unsigned short bf16_t;
typedef short bf16x8 __attribute__((ext_vector_type(8)));
typedef float f32x4 __attribute__((ext_vector_type(4)));
typedef unsigned u32x4 __attribute__((ext_vector_type(4)));
constexpr int BM = 256, BK = 64, HALF = 128, HTB = HALF * BK * 2  , STAGE_BYTES = 8 * HTB, NXCD = 8, WGM = 8;

__host__ __device__ __forceinline__ int lds_byte(int r, int c) { const int st = (r >> 4) * 2 + (c >> 5), rr = r & 15, cc = c & 31, ob = rr * 64 + cc * 2; return st * 1024 + (ob ^ (((ob >> 9) & 1) << 5)); }
__host__ __device__ __forceinline__ void stage_rc(int b, int& R, int& C) { const int st = b / 1024, sb = b % 1024, swz = sb ^ (((sb >> 9) & 1) << 5); R = (st >> 1) * 16 + swz / 64; C = (st & 1) * 32 + (swz % 64) / 2; }
__host__ __device__ __forceinline__ int perm32(int rho) { const int n = rho >> 4, i = rho & 15; return 8 * (i >> 2) + 4 * n + (i & 3); }

struct Unit { int pm, pn; };
struct Gemm { const bf16_t* A; const bf16_t* Bt; int M, N, K; };

struct StaticOrder {
    int nM, nN, nwg, G, c;
    __host__ __device__ void init(int M, int N, int G_, int c_) { nM = M / BM; nN = N / BM; nwg = nM * nN; G = G_; c = c_; }
    __host__ __device__ bool next(int i, Unit& u) const {
        const long L = (long)i * G + c; if (L >= nwg) return false;
        int wgid = (int)L; { const int q = nwg / NXCD, r = nwg % NXCD, xcd = wgid % NXCD, off = wgid / NXCD; wgid = (xcd < r ? xcd * (q + 1) : r * (q + 1) + (xcd - r) * q) + off; }
        const int nig = WGM * nN, gid = wgid / nig, fm = gid * WGM, gsz = (nM - fm) < WGM ? (nM - fm) : WGM;
        u.pm = fm + ((wgid % nig) % gsz); u.pn = (wgid % nig) / gsz; return true;
    }
    __device__ __forceinline__ void a_ready(const Unit&) const {}
    __device__ __forceinline__ void done(const Unit&) const {}
};
__device__ __forceinline__ unsigned cvt_pk_bf16(float lo, float hi) { unsigned r; asm volatile("v_cvt_pk_bf16_f32 %0, %1, %2" : "=v"(r) : "v"(lo), "v"(hi)); return r; }
__device__ __forceinline__ float shx(float v, int mask, int lane) { return __builtin_bit_cast(float, __builtin_amdgcn_ds_bpermute((lane ^ mask) << 2, __builtin_bit_cast(int, v))); }
__device__ __forceinline__ float shl_from(float v, int src) { return __builtin_bit_cast(float, __builtin_amdgcn_ds_bpermute(src << 2, __builtin_bit_cast(int, v))); }
typedef unsigned u32x2 __attribute__((ext_vector_type(2)));
constexpr int RM_MP = 16512, RM_MTOT = 17024, RM_LP = 2064, RM_META = 16, RM_SEQ = 2048;
__device__ __forceinline__ float row_rscale(const float* SS, int row) {
    const f32x4* p = (const f32x4*)(SS + (size_t)row * 16); const f32x4 a = p[0], b = p[1], c = p[2], d = p[3];
    const float s = ((a[0] + a[1]) + (a[2] + a[3])) + ((b[0] + b[1]) + (b[2] + b[3])) + ((c[0] + c[1]) + (c[2] + c[3])) + ((d[0] + d[1]) + (d[2] + d[3]));
    return 1.0f / sqrtf(s * (1.0f / 1024.0f) + 1e-6f);
}
__device__ __forceinline__ float softcap15(float x) { return 15.0f * tanhf(x * (1.0f / 15.0f)); }
__device__ __forceinline__ float logsigmoidf(float x) { return x < 0.f ? x - log1pf(expf(x)) : -log1pf(expf(-x)); }
template <int ACT, bool GATES> struct EpiNormBf16 {
    static constexpr bool PERM = true, AFTER_DRAIN = false;
    bf16_t* O; int ldc; const float* SS; float* G; const float* bgate; int gate_pn;
    __device__ __forceinline__ void operator()(const f32x4 (&acc)[2][2][4][2], const Unit& u, int wr, int wc, int fr, int fq) const {
        const int row0 = u.pm * BM + wr * 64 + fr;
        if (GATES && u.pn == gate_pn) {
            if (wc == 0 && fq == 0) {
                const f32x4 b0 = *(const f32x4*)bgate, b1 = *(const f32x4*)(bgate + 4);
#pragma unroll
                for (int ai = 0; ai < 2; ++ai)
#pragma unroll
                    for (int m = 0; m < 4; ++m) { const int row = row0 + ai * HALF + m * 16; const float r = row_rscale(SS, row);
                        f32x4 gi = acc[ai][0][m][0] * r + b0, gf = acc[ai][0][m][1] * r + b1;
#pragma unroll
                        for (int j = 0; j < 4; ++j) { gi[j] = softcap15(gi[j]); gf[j] = logsigmoidf(softcap15(gf[j])); }
                        *(f32x4*)(G + (size_t)row * 8) = gi; *(f32x4*)(G + (size_t)row * 8 + 4) = gf; }
            }
            return;
        }
        const int col0 = u.pn * BM + wc * 32 + 8 * fq;
#pragma unroll
        for (int ai = 0; ai < 2; ++ai)
#pragma unroll
            for (int m = 0; m < 4; ++m) { const int row = row0 + ai * HALF + m * 16; const float r = row_rscale(SS, row); bf16_t* rowp = O + (size_t)row * ldc + col0;
#pragma unroll
                for (int bj = 0; bj < 2; ++bj) { f32x4 v0 = acc[ai][bj][m][0] * r, v1 = acc[ai][bj][m][1] * r;
                    if (ACT == 1) {
#pragma unroll
                        for (int j = 0; j < 4; ++j) { const float a = fmaxf(v0[j], 0.f), b = fmaxf(v1[j], 0.f); v0[j] = a * a; v1[j] = b * b; } }
                    u32x4 w; w.x = cvt_pk_bf16(v0[0], v0[1]); w.y = cvt_pk_bf16(v0[2], v0[3]); w.z = cvt_pk_bf16(v1[0], v1[1]); w.w = cvt_pk_bf16(v1[2], v1[3]);
                    *(u32x4*)(rowp + bj * HALF) = w; } }
    }
};
template <bool FINAL> struct EpiResid {
    static constexpr bool PERM = false, AFTER_DRAIN = false;
    float* X; bf16_t* Xb; float* SS; float* y_prompt; float* y_sample;
    __device__ __forceinline__ void operator()(const f32x4 (&acc)[2][2][4][2], const Unit& u, int wr, int wc, int fr, int fq) const {
        const int row0 = u.pm * BM + wr * 64 + fr, col0 = u.pn * BM + wc * 32 + 4 * fq;
#pragma unroll
        for (int ai = 0; ai < 2; ++ai)
#pragma unroll
            for (int m = 0; m < 4; ++m) { const int row = row0 + ai * HALF + m * 16; const size_t off = (size_t)row * 1024 + col0;
                f32x4 x[2][2];
#pragma unroll
                for (int bj = 0; bj < 2; ++bj)
#pragma unroll
                    for (int n = 0; n < 2; ++n) x[bj][n] = *(const f32x4*)(X + off + bj * HALF + n * 16) + acc[ai][bj][m][n];
                if (!FINAL) {
                    float s = 0.f;
#pragma unroll
                    for (int bj = 0; bj < 2; ++bj)
#pragma unroll
                        for (int n = 0; n < 2; ++n) { const f32x4 v = x[bj][n]; *(f32x4*)(X + off + bj * HALF + n * 16) = v; s += (v[0] * v[0] + v[1] * v[1]) + (v[2] * v[2] + v[3] * v[3]);
                            u32x2 w; w.x = cvt_pk_bf16(v[0], v[1]); w.y = cvt_pk_bf16(v[2], v[3]); *(u32x2*)(Xb + off + bj * HALF + n * 16) = w; }
                    s += shx(s, 16, (fr + 16 * fq)); s += shx(s, 32, (fr + 16 * fq));
                    if (fq == 0) SS[(size_t)row * 16 + u.pn * 4 + wc] = s;
                } else {
                    float* dst = nullptr;
                    if (row < RM_MP) { const int b = row / RM_LP, t = row - b * RM_LP; if (t >= RM_META) dst = y_prompt + ((size_t)b * RM_SEQ + (t - RM_META)) * 1024 + col0; }
                    else if (row < RM_MTOT) dst = y_sample + (size_t)(row - RM_MP) * 1024 + col0;
                    if (dst) {
#pragma unroll
                        for (int bj = 0; bj < 2; ++bj)
#pragma unroll
                            for (int n = 0; n < 2; ++n) *(f32x4*)(dst + bj * HALF + n * 16) = x[bj][n]; }
                }
            }
    }
};

template <class Epi, class Sched, bool ALIGN_EPI = false, bool SP2 = false>
__device__ __forceinline__ void gemm_phase(PG8_LAS unsigned char* lds, const Gemm g, const Sched& S, const Epi& E) {
    int tid_o = threadIdx.x; asm volatile("" : "+v"(tid_o));
    const int tid = tid_o, wid = __builtin_amdgcn_readfirstlane(tid >> 6), lane = tid & 63, wr = wid >> 2, wc = wid & 3, fr = lane & 15, fq = lane >> 4;
    const int K = g.K, nt = K / BK;
    unsigned voffA[2], voffB[2];
#pragma unroll
    for (int i = 0; i < 2; ++i) { int R, C; stage_rc(tid * 16 + i * 8192, R, C); const int Rb = Epi::PERM ? ((R & ~31) + perm32(R & 31)) : R;
        voffA[i] = (unsigned)(R * K + C) * 2u; voffB[i] = (unsigned)(Rb * K + C) * 2u; }
    const size_t kstep = (size_t)(BK * 2);
    const size_t hstep = (size_t)HALF * K * 2;
    const size_t tstep = 2 * hstep;
    const unsigned ldsw = (unsigned)wid * 1024u;
    const int aoff = lds_byte(wr * 64 + fr, fq * 8), boff = lds_byte(wc * 32 + fr, fq * 8);
#define PG8_SA(b, h) (((b) * 2 + (h)) * HTB)
#define PG8_SB(b, h) ((4 + (b) * 2 + (h)) * HTB)
#define PG8_STAGE(bufoff, gbase, voff) do { _Pragma("unroll") for (int _i = 0; _i < 2; ++_i) \
        __builtin_amdgcn_global_load_lds((const unsigned*)((const char*)(gbase) + (voff)[_i]), (PG8_LAS unsigned*)(lds + (bufoff) + ldsw + _i * 8192), 16, 0, 0); } while (0)
#define PG8_LDA(dst, b, h) do { _Pragma("unroll") for (int m = 0; m < 4; ++m) _Pragma("unroll") for (int k = 0; k < 2; ++k) dst[m][k] = *(const PG8_LAS bf16x8*)(lds + PG8_SA(b, h) + aoff + m * 2048 + k * 1024); } while (0)
#define PG8_LDB(dst, b, h) do { _Pragma("unroll") for (int n = 0; n < 2; ++n) _Pragma("unroll") for (int k = 0; k < 2; ++k) dst[n][k] = *(const PG8_LAS bf16x8*)(lds + PG8_SB(b, h) + boff + n * 2048 + k * 1024); } while (0)
#define PG8_MMA(ai, bj, At, Bt) do { __builtin_amdgcn_s_setprio(1); _Pragma("unroll") for (int m = 0; m < 4; ++m) _Pragma("unroll") for (int n = 0; n < 2; ++n) _Pragma("unroll") for (int k = 0; k < 2; ++k) \
        acc[ai][bj][m][n] = __builtin_amdgcn_mfma_f32_16x16x32_bf16(Bt[n][k], At[m][k], acc[ai][bj][m][n], 0, 0, 0); __builtin_amdgcn_s_setprio(0); } while (0)
#define PG8_WAIT_V(n) asm volatile("s_waitcnt vmcnt(" #n ")" ::: "memory")
#define PG8_WAIT_L(n) asm volatile("s_waitcnt lgkmcnt(" #n ")" ::: "memory")
#define PG8_BAR __builtin_amdgcn_s_barrier()
#define PG8_SCHED __builtin_amdgcn_sched_barrier(0)
    Unit cur, nxt; int ui = 0;
    if (!S.next(0, cur)) return;
    f32x4 acc[2][2][4][2];
#pragma unroll
    for (int a = 0; a < 2; ++a)
#pragma unroll
        for (int b = 0; b < 2; ++b)
#pragma unroll
            for (int m = 0; m < 4; ++m)
#pragma unroll
                for (int n = 0; n < 2; ++n) acc[a][b][m][n] = (f32x4){0.f, 0.f, 0.f, 0.f};
    bf16x8 At[4][2], B0[2][2], B1[2][2];
    const char* cA = (const char*)g.A + (size_t)cur.pm * tstep; const char* cB = (const char*)g.Bt + (size_t)cur.pn * tstep;
    S.a_ready(cur);
    if constexpr (SP2) {
        PG8_STAGE(PG8_SB(0, 0), cB, voffB); PG8_STAGE(PG8_SB(0, 1), cB + hstep, voffB); PG8_STAGE(PG8_SA(0, 0), cA, voffA); PG8_STAGE(PG8_SA(0, 1), cA + hstep, voffA);
        if (wr == 1) PG8_BAR;
        PG8_WAIT_V(2); PG8_BAR;
        PG8_STAGE(PG8_SB(1, 0), cB + kstep, voffB); PG8_STAGE(PG8_SA(1, 0), cA + kstep, voffA); PG8_STAGE(PG8_SB(1, 1), cB + hstep + kstep, voffB);
        PG8_WAIT_V(6); PG8_BAR;
    } else {
        PG8_STAGE(PG8_SB(0, 0), cB, voffB); PG8_STAGE(PG8_SA(0, 0), cA, voffA); PG8_STAGE(PG8_SB(0, 1), cB + hstep, voffB); PG8_STAGE(PG8_SA(0, 1), cA + hstep, voffA);
        if (wr == 1) PG8_BAR;
        PG8_WAIT_V(4); PG8_BAR;
        PG8_STAGE(PG8_SB(1, 0), cB + kstep, voffB); PG8_STAGE(PG8_SA(1, 0), cA + kstep, voffA); PG8_STAGE(PG8_SB(1, 1), cB + hstep + kstep, voffB);
        PG8_WAIT_V(6); PG8_BAR;
    }
    for (;;) {
        const bool has_next = S.next(ui + 1, nxt);
        const char* nA = has_next ? (const char*)g.A + (size_t)nxt.pm * tstep : cA; const char* nB = has_next ? (const char*)g.Bt + (size_t)nxt.pn * tstep : cB;
        for (int t = 0; t < nt; t += 2) {
            const bool last = (t == nt - 2);
            const char* a1 = cA + (size_t)(t + 1) * kstep;
            const char* a2 = last ? nA : cA + (size_t)(t + 2) * kstep; const char* b2 = last ? nB : cB + (size_t)(t + 2) * kstep;
            const char* a3 = a2 + kstep; const char* b3 = b2 + kstep;
            if (last && has_next) S.a_ready(nxt);
            if constexpr (SP2) {
            PG8_LDB(B0, 0, 0); PG8_LDB(B1, 0, 1); PG8_SCHED; PG8_LDA(At, 0, 0); PG8_STAGE(PG8_SA(1, 1), a1 + hstep, voffA);
            PG8_WAIT_V(8); PG8_WAIT_L(0); PG8_BAR; PG8_MMA(0, 0, At, B0); PG8_MMA(0, 1, At, B1); PG8_BAR; PG8_SCHED;
            PG8_LDA(At, 0, 1); PG8_STAGE(PG8_SB(0, 0), b2, voffB); PG8_STAGE(PG8_SB(0, 1), b2 + hstep, voffB); PG8_STAGE(PG8_SA(0, 0), a2, voffA);
            PG8_WAIT_V(8); PG8_WAIT_L(0); PG8_BAR; PG8_MMA(1, 0, At, B0); PG8_MMA(1, 1, At, B1); PG8_BAR; PG8_SCHED;
            PG8_LDB(B0, 1, 0); PG8_LDB(B1, 1, 1); PG8_SCHED; PG8_LDA(At, 1, 0); PG8_STAGE(PG8_SA(0, 1), a2 + hstep, voffA);
            PG8_WAIT_V(8); PG8_WAIT_L(0); PG8_BAR; PG8_MMA(0, 0, At, B0); PG8_MMA(0, 1, At, B1); PG8_BAR; PG8_SCHED;
            PG8_LDA(At, 1, 1); PG8_STAGE(PG8_SB(1, 0), b3, voffB); PG8_STAGE(PG8_SB(1, 1), b3 + hstep, voffB); PG8_STAGE(PG8_SA(1, 0), a3, voffA);
            PG8_WAIT_V(8); PG8_WAIT_L(0); PG8_BAR; PG8_MMA(1, 0, At, B0); PG8_MMA(1, 1, At, B1); PG8_BAR; PG8_SCHED;
            } else {
            PG8_LDB(B0, 0, 0); PG8_SCHED; PG8_LDA(At, 0, 0); PG8_STAGE(PG8_SA(1, 1), a1 + hstep, voffA);
            PG8_WAIT_L(8); PG8_BAR; PG8_WAIT_L(0); PG8_MMA(0, 0, At, B0); PG8_BAR; PG8_SCHED;
            PG8_LDB(B1, 0, 1); PG8_STAGE(PG8_SB(0, 0), b2, voffB);
            PG8_BAR; PG8_WAIT_L(0); PG8_MMA(0, 1, At, B1); PG8_BAR;
            PG8_LDA(At, 0, 1); PG8_STAGE(PG8_SA(0, 0), a2, voffA);
            PG8_BAR; PG8_WAIT_L(0); PG8_MMA(1, 0, At, B0); PG8_BAR; PG8_SCHED;
            PG8_STAGE(PG8_SB(0, 1), b2 + hstep, voffB);
            PG8_WAIT_V(6); PG8_BAR; PG8_MMA(1, 1, At, B1); PG8_BAR;
            PG8_LDB(B0, 1, 0); PG8_SCHED; PG8_LDA(At, 1, 0); PG8_STAGE(PG8_SA(0, 1), a2 + hstep, voffA);
            PG8_WAIT_L(8); PG8_BAR; PG8_WAIT_L(0); PG8_MMA(0, 0, At, B0); PG8_BAR; PG8_SCHED;
            PG8_LDB(B1, 1, 1); PG8_STAGE(PG8_SB(1, 0), b3, voffB);
            PG8_BAR; PG8_WAIT_L(0); PG8_MMA(0, 1, At, B1); PG8_BAR;
            PG8_LDA(At, 1, 1); PG8_STAGE(PG8_SA(1, 0), a3, voffA);
            PG8_BAR; PG8_WAIT_L(0); PG8_MMA(1, 0, At, B0); PG8_BAR; PG8_SCHED;
            PG8_STAGE(PG8_SB(1, 1), b3 + hstep, voffB);
            PG8_WAIT_V(6); PG8_BAR; PG8_MMA(1, 1, At, B1); PG8_BAR;
            }
        }
        if constexpr (ALIGN_EPI) { if (wr == 0) PG8_BAR; }
        if constexpr (!Epi::AFTER_DRAIN) { E(acc, cur, wr, wc, fr, fq); S.done(cur); }
        if (!has_next) break;
#pragma unroll
        for (int a = 0; a < 2; ++a)
#pragma unroll
            for (int b = 0; b < 2; ++b)
#pragma unroll
                for (int m = 0; m < 4; ++m)
#pragma unroll
                    for (int n = 0; n < 2; ++n) acc[a][b][m][n] = (f32x4){0.f, 0.f, 0.f, 0.f};
        cur = nxt; cA = nA; cB = nB; ++ui;
        if constexpr (ALIGN_EPI) { if (wr == 1) PG8_BAR; }
    }
    PG8_WAIT_V(0);
    if constexpr (!ALIGN_EPI) { if (wr == 0) PG8_BAR; }
    PG8_BAR;
    if constexpr (Epi::AFTER_DRAIN) { E.fused(acc, cur, wr, wc, fr, fq, lds, wid, lane); S.done(cur); }
#undef PG8_SA
#undef PG8_SB
#undef PG8_STAGE
#undef PG8_LDA
#undef PG8_LDB
#undef PG8_MMA
#undef PG8_WAIT_V
#undef PG8_WAIT_L
#undef PG8_BAR
#undef PG8_SCHED
}

#define PG8_GAS __attribute__((address_space(1)))
#ifndef CH_PUB_T
#define CH_PUB_T 4
#endif
#ifndef CH_FF_WT
#define CH_FF_WT 0
#endif
#ifndef CH_X_AUX
#define CH_X_AUX 0
#endif
#ifndef CH_A_AUX
#define CH_A_AUX 0
#endif
enum ChainKind { CK_NORM = 0, CK_NORM_GATES = 1, CK_UP = 2, CK_RESID = 3, CK_FINAL = 4, CK_PART = 5 };
constexpr int CC = 64, CSLOT = 96;
struct UnitD { int valid, seg, pm, pn, K, kind, ld, kq; const char* A; const char* B; };
__device__ __forceinline__ unsigned cw(volatile PG8_LAS unsigned* c, int i) { return (unsigned)__builtin_amdgcn_readfirstlane((int)c[i]); }
__device__ __forceinline__ unsigned long long cp(volatile PG8_LAS unsigned* c, int i) { const unsigned lo = cw(c, i), hi = cw(c, i + 1); return ((unsigned long long)hi << 32) | lo; }
constexpr int CCUM = CC + 24, CQ = CSLOT + 8;
__device__ __forceinline__ int chain_np(int x) { return x < 3 ? 9 : 8; }
__device__ __forceinline__ int seg_count(volatile PG8_LAS unsigned* c, int s, int np) {
    const unsigned w = cw(c, 16 * s + 14); const int lpoff = (int)(w & 0xffu), cap = (int)((w >> 8) & 0xffu), nsub = (int)(w >> 16);
    int nps = np - lpoff; nps = nps < 0 ? 0 : (nps > cap ? cap : nps);
    return nps * (int)cw(c, 16 * s + 5) * nsub;
}
__device__ __forceinline__ void decode_unit(volatile PG8_LAS unsigned* c, unsigned code, UnitD& u) {
    u.valid = code != 0xffffffffu; u.seg = 0; u.pm = 0; u.pn = 0; u.K = 1024; u.kind = 0; u.ld = 1024; u.kq = 0; u.A = nullptr; u.B = nullptr;
    if (!u.valid) return;
    const int x = (int)(code >> 16), np = chain_np(x); int i = (int)(code & 0xffffu);
    const int nseg = (int)cw(c, CC); int s = 0;
#pragma unroll
    for (int k = 0; k < 3; ++k) { if (s == k && k + 1 < nseg) { const int cnt = seg_count(c, k, np); if (i >= cnt) { i -= cnt; s = k + 1; } } }
    const unsigned w = cw(c, 16 * s + 14); const int lpoff = (int)(w & 0xffu), nsub = (int)(w >> 16);
    const int nN = (int)cw(c, 16 * s + 5), per = nN * nsub, lp = i / per, rem = i - lp * per;
    u.seg = s; u.pm = x + 8 * (lpoff + lp); u.pn = rem / nsub; u.kq = rem - u.pn * nsub; u.K = (int)cw(c, 16 * s + 4); u.kind = (int)cw(c, 16 * s + 6); u.ld = (int)cw(c, 16 * s + 9);
    u.A = (const char*)(const PG8_GAS char*)cp(c, 16 * s) + (size_t)u.pm * 512 * u.ld + (size_t)u.kq * 2 * u.K; u.B = (const char*)(const PG8_GAS char*)cp(c, 16 * s + 2) + (size_t)u.pn * 512 * u.ld + (size_t)u.kq * 2 * u.K;
}
__device__ __forceinline__ unsigned chain_deq_from(volatile PG8_LAS unsigned* c, unsigned* heads, unsigned v  ) {
    int q = (int)c[CQ], tries = (int)c[CQ + 1]; const unsigned tot8 = c[CC + 1], tot9 = c[CC + 23];
    while (v >= (q < 3 ? tot9 : tot8) && tries < 8) { q = (q + 1) & 7; ++tries; if (tries < 8) v = __hip_atomic_fetch_add(heads + 64 * q, 1u, __ATOMIC_RELAXED, __HIP_MEMORY_SCOPE_AGENT); }
    c[CQ] = (unsigned)q; c[CQ + 1] = (unsigned)tries;
    return tries < 8 ? (((unsigned)q << 16) | v) : 0xffffffffu;
}
__device__ __forceinline__ unsigned ld_relaxed(const unsigned* p) { return __hip_atomic_load(p, __ATOMIC_RELAXED, __HIP_MEMORY_SCOPE_AGENT); }
__device__ __forceinline__ void chain_wait(volatile PG8_LAS unsigned* c, const UnitD& u, int wid) {
    const unsigned long long dep = cp(c, 16 * u.seg + 10);
    if (dep) {
        if (wid == 0) { const unsigned* p = (const unsigned*)(const PG8_GAS unsigned*)dep + 64 * u.pm; const unsigned need = cw(c, 16 * u.seg + 8); unsigned spins = 0;
            while ((unsigned)__builtin_amdgcn_readfirstlane((int)ld_relaxed(p)) < need) { __builtin_amdgcn_s_sleep(2); if (++spins > (1u << 20)) break; }
            if (CH_A_AUX == 0 && u.seg == 3) __builtin_amdgcn_fence(__ATOMIC_ACQUIRE, "agent"); }
        asm volatile("s_waitcnt vmcnt(0) lgkmcnt(0)" ::: "memory"); __builtin_amdgcn_s_barrier(); asm volatile("" ::: "memory");
    }
}
__device__ __forceinline__ bool chain_try(volatile PG8_LAS unsigned* c, const UnitD& u, int wid, int lane, int ui) {
    const unsigned long long dep = cp(c, 16 * u.seg + 10);
    if (!dep) return true;
    if (wid == 0) { const unsigned* p = (const unsigned*)(const PG8_GAS unsigned*)dep + 64 * u.pm; const unsigned need = cw(c, 16 * u.seg + 8);
        const unsigned ok = (unsigned)__builtin_amdgcn_readfirstlane((int)ld_relaxed(p)) >= need ? 1u : 0u;
        if (lane == 0) c[CSLOT + 4 + (ui & 1)] = ok;
        if (CH_A_AUX == 0 && ok && u.seg == 3) { __builtin_amdgcn_fence(__ATOMIC_ACQUIRE, "agent"); asm volatile("s_waitcnt vmcnt(0)" ::: "memory"); } }
    asm volatile("s_waitcnt lgkmcnt(0)" ::: "memory"); __builtin_amdgcn_s_barrier(); asm volatile("" ::: "memory");
    return cw(c, CSLOT + 4 + (ui & 1)) != 0u;
}
typedef unsigned cu32x4 __attribute__((ext_vector_type(4)));
__device__ __forceinline__ __amdgpu_buffer_rsrc_t mk_rsrc(unsigned long long p, unsigned bytes) { return __builtin_amdgcn_make_buffer_rsrc((void*)(PG8_GAS void*)p, (short)0, (int)bytes, 0x00020000); }
__device__ __forceinline__ f32x4 ld16_sc1(__amdgpu_buffer_rsrc_t r, unsigned off) { const cu32x4 v = __builtin_amdgcn_raw_buffer_load_b128(r, (int)off, 0, CH_X_AUX); return __builtin_bit_cast(f32x4, v); }
__device__ __forceinline__ void st16_sc1(__amdgpu_buffer_rsrc_t r, unsigned off, f32x4 v) { __builtin_amdgcn_raw_buffer_store_b128(__builtin_bit_cast(cu32x4, v), r, (int)off, 0, CH_X_AUX); }
__device__ __forceinline__ void st16u_sc1(__amdgpu_buffer_rsrc_t r, unsigned off, cu32x4 v) { __builtin_amdgcn_raw_buffer_store_b128(v, r, (int)off, 0, CH_X_AUX); }
__device__ __forceinline__ void st16u_wt(__amdgpu_buffer_rsrc_t r, unsigned off, cu32x4 v) { __builtin_amdgcn_raw_buffer_store_b128(v, r, (int)off, 0, 16); }
constexpr unsigned CH_MPAD = 17152;
__device__ __forceinline__ void row_rscales_sc1(__amdgpu_buffer_rsrc_t rss, int row0, int fr, int fq, float (&rr)[2][4]) {
    f32x4 v[2][4];
#pragma unroll
    for (int ai = 0; ai < 2; ++ai)
#pragma unroll
        for (int m = 0; m < 4; ++m) { const cu32x4 t = __builtin_amdgcn_raw_buffer_load_b128(rss, (int)((unsigned)(row0 + ai * HALF + m * 16) * 64u + 16u * (unsigned)fq), 0, CH_X_AUX); v[ai][m] = __builtin_bit_cast(f32x4, t); }
#pragma unroll
    for (int ai = 0; ai < 2; ++ai)
#pragma unroll
        for (int m = 0; m < 4; ++m) { float s = (v[ai][m][0] + v[ai][m][1]) + (v[ai][m][2] + v[ai][m][3]); s += shx(s, 16, (fr + 16 * fq)); s += shx(s, 32, (fr + 16 * fq)); rr[ai][m] = 1.0f / sqrtf(s * (1.0f / 1024.0f) + 1e-6f); }
}
__device__ __forceinline__ void chain_epilogue(volatile PG8_LAS unsigned* c, const UnitD& u, const f32x4 (&acc)[2][2][4][2], int wr, int wc, int fr, int fq) {
    const int row0 = u.pm * BM + wr * 64 + fr, colw = wc * 32 + 8 * fq;
    const __amdgpu_buffer_rsrc_t rss = mk_rsrc(cp(c, CC + 8), CH_MPAD * 64u);
    if (u.kind <= CK_UP) {
        float rr[2][4]; row_rscales_sc1(rss, row0, fr, fq, rr);
        if (u.kind == CK_NORM_GATES && u.pn == 12) {
            if (wc == 0 && fq == 0) { const float* bg = (const float*)(const PG8_GAS float*)cp(c, CC + 16); float* G = (float*)(PG8_GAS float*)cp(c, CC + 14);
                const f32x4 b0 = *(const f32x4*)bg, b1 = *(const f32x4*)(bg + 4);
#pragma unroll
                for (int ai = 0; ai < 2; ++ai)
#pragma unroll
                    for (int m = 0; m < 4; ++m) { const int row = row0 + ai * HALF + m * 16; const float r = rr[ai][m];
                        const f32x4 gi = acc[ai][0][m][0] * r + b0, gf = acc[ai][0][m][1] * r + b1;
                        *(f32x4*)(G + (size_t)row * 8) = gi; *(f32x4*)(G + (size_t)row * 8 + 4) = gf; } }
            return;
        }
        const bool up = u.kind == CK_UP; const int ldc = up ? 4096 : (int)cw(c, CC + 22);
        const unsigned long long obase = up ? cp(c, CC + 12) : cp(c, CC + 10);
        const __amdgpu_buffer_rsrc_t ro = mk_rsrc(obase, CH_MPAD * (unsigned)ldc * 2u);
        const int col0 = u.pn * BM + colw;
#pragma unroll
        for (int ai = 0; ai < 2; ++ai)
#pragma unroll
            for (int m = 0; m < 4; ++m) { const int row = row0 + ai * HALF + m * 16; const float r = rr[ai][m];
#pragma unroll
                for (int bj = 0; bj < 2; ++bj) { f32x4 v0 = acc[ai][bj][m][0] * r, v1 = acc[ai][bj][m][1] * r;
                    if (up) {
#pragma unroll
                        for (int j = 0; j < 4; ++j) { const float a = fmaxf(v0[j], 0.f), b = fmaxf(v1[j], 0.f); v0[j] = a * a; v1[j] = b * b; } }
                    cu32x4 w; w.x = cvt_pk_bf16(v0[0], v0[1]); w.y = cvt_pk_bf16(v0[2], v0[3]); w.z = cvt_pk_bf16(v1[0], v1[1]); w.w = cvt_pk_bf16(v1[2], v1[3]);
                    if (up && CH_FF_WT) st16u_wt(ro, ((unsigned)row * (unsigned)ldc + (unsigned)(col0 + bj * HALF)) * 2u, w); else st16u_sc1(ro, ((unsigned)row * (unsigned)ldc + (unsigned)(col0 + bj * HALF)) * 2u, w); } }
        return;
    }
    if (u.kind == CK_PART) {
        float* P = (float*)(PG8_GAS float*)cp(c, CC + 30) + ((size_t)(u.kq * 3 + (u.pm - 64)) * 256) * 1024; const int colp = u.pn * BM + colw;
#pragma unroll
        for (int ai = 0; ai < 2; ++ai)
#pragma unroll
            for (int m = 0; m < 4; ++m) { float* rp = P + (size_t)(wr * 64 + fr + ai * HALF + m * 16) * 1024 + colp;
#pragma unroll
                for (int bj = 0; bj < 2; ++bj)
#pragma unroll
                    for (int n = 0; n < 2; ++n) *(f32x4*)(rp + bj * HALF + 4 * n) = acc[ai][bj][m][n]; }
        return;
    }
    const __amdgpu_buffer_rsrc_t rx = mk_rsrc(cp(c, CC + 4), CH_MPAD * 4096u);
    const int col0 = u.pn * BM + colw;
    if (u.kind == CK_RESID) {
        const __amdgpu_buffer_rsrc_t rxb = mk_rsrc(cp(c, CC + 6), CH_MPAD * 2048u);
        f32x4 xin[4][2][2];
#define CH_XLOAD(i) do { const unsigned off_ = (unsigned)(row0 + ((i) >> 2) * HALF + ((i) & 3) * 16) * 1024u + (unsigned)col0; \
            _Pragma("unroll") for (int bj = 0; bj < 2; ++bj) _Pragma("unroll") for (int n = 0; n < 2; ++n) xin[(i) & 3][bj][n] = ld16_sc1(rx, (off_ + bj * HALF + 4 * n) * 4u); } while (0)
        CH_XLOAD(0); CH_XLOAD(1); CH_XLOAD(2);
#pragma unroll
        for (int i = 0; i < 8; ++i) { const int ai = i >> 2, m = i & 3; const int row = row0 + ai * HALF + m * 16; const unsigned off = (unsigned)row * 1024u + (unsigned)col0;
            if (i + 3 < 8) CH_XLOAD(i + 3);
            f32x4 x[2][2];
#pragma unroll
            for (int bj = 0; bj < 2; ++bj)
#pragma unroll
                for (int n = 0; n < 2; ++n) x[bj][n] = xin[i & 3][bj][n] + acc[ai][bj][m][n];
            float s = 0.f;
#pragma unroll
            for (int bj = 0; bj < 2; ++bj) {
#pragma unroll
                for (int n = 0; n < 2; ++n) { const f32x4 v = x[bj][n]; st16_sc1(rx, (off + bj * HALF + 4 * n) * 4u, v); s += (v[0] * v[0] + v[1] * v[1]) + (v[2] * v[2] + v[3] * v[3]); }
                cu32x4 w; w.x = cvt_pk_bf16(x[bj][0][0], x[bj][0][1]); w.y = cvt_pk_bf16(x[bj][0][2], x[bj][0][3]); w.z = cvt_pk_bf16(x[bj][1][0], x[bj][1][1]); w.w = cvt_pk_bf16(x[bj][1][2], x[bj][1][3]);
                st16u_sc1(rxb, (off + bj * HALF) * 2u, w); }
            s += shx(s, 16, (fr + 16 * fq)); s += shx(s, 32, (fr + 16 * fq));
            if (fq == 0) __builtin_amdgcn_raw_buffer_store_b32(__builtin_bit_cast(unsigned, s), rss, (int)((unsigned)row * 64u + (unsigned)(u.pn * 4 + wc) * 4u), 0, CH_X_AUX);
        }
#undef CH_XLOAD
    } else {
        float* yp = (float*)(PG8_GAS float*)cp(c, CC + 18); float* ys = (float*)(PG8_GAS float*)cp(c, CC + 20);
#pragma unroll
        for (int ai = 0; ai < 2; ++ai)
#pragma unroll
            for (int m = 0; m < 4; ++m) { const int row = row0 + ai * HALF + m * 16; const unsigned off = (unsigned)row * 1024u + (unsigned)col0;
                float* dst = nullptr;
                if (row < RM_MP) { const int b = row / RM_LP, t = row - b * RM_LP; if (t >= RM_META) dst = yp + ((size_t)b * RM_SEQ + (t - RM_META)) * 1024 + col0; }
                else if (row < RM_MTOT) dst = ys + (size_t)(row - RM_MP) * 1024 + col0;
                f32x4 x[2][2];
#pragma unroll
                for (int bj = 0; bj < 2; ++bj)
#pragma unroll
                    for (int n = 0; n < 2; ++n) x[bj][n] = ld16_sc1(rx, (off + bj * HALF + 4 * n) * 4u) + acc[ai][bj][m][n];
                asm volatile("" : "+v"(x[0][0]), "+v"(x[0][1]), "+v"(x[1][0]), "+v"(x[1][1]));
                if (dst) {
#pragma unroll
                    for (int bj = 0; bj < 2; ++bj)
#pragma unroll
                        for (int n = 0; n < 2; ++n) *(f32x4*)(dst + bj * HALF + 4 * n) = x[bj][n]; }
            }
    }
}
__device__ __forceinline__ int lane_now() { int l; asm volatile("v_mbcnt_lo_u32_b32 %0, -1, 0\n\tv_mbcnt_hi_u32_b32 %0, -1, %0" : "=v"(l)); return l; }
__device__ __forceinline__ void gemm_chain(PG8_LAS unsigned char* lds, volatile PG8_LAS unsigned* c, int tid_in) {
    int tid_o = tid_in; asm volatile("" : "+v"(tid_o));
    const int tid = tid_o, wid = __builtin_amdgcn_readfirstlane(tid >> 6), lane = tid & 63, wr = wid >> 2, wc = wid & 3, fr = lane & 15, fq = lane >> 4;
    unsigned rc;
    { int R, C; stage_rc(tid * 16, R, C); rc = (2u * (unsigned)R) | ((2u * (unsigned)C) << 16); }
#define ra2 (rc & 0xffffu)
#define c2 (rc >> 16)
#define CH_RB2() (2u * (unsigned)((int)((ra2 >> 1) & ~31u) + perm32((int)((ra2 >> 1) & 31u))))
    const unsigned ldsw = (unsigned)wid * 1024u;
    const int aoff = lds_byte(wr * 64 + fr, fq * 8), boff = lds_byte(wc * 32 + fr, fq * 8);
    constexpr size_t kstep = (size_t)(BK * 2);
#define PG8_SA(b, h) (((b) * 2 + (h)) * HTB)
#define PG8_SB(b, h) ((4 + (b) * 2 + (h)) * HTB)
#define CH_STAGE_A(bufoff, gbase, K_)   do { const unsigned _vo = ra2 * (unsigned)(K_) + c2; const char* _g1 = (const char*)(gbase); const char* _g2 = _g1 + 128 * (size_t)(K_); \
        __builtin_amdgcn_global_load_lds((const unsigned*)(_g1 + _vo), (PG8_LAS unsigned*)(lds + (bufoff) + ldsw), 16, 0, CH_A_AUX); \
        __builtin_amdgcn_global_load_lds((const unsigned*)(_g2 + _vo), (PG8_LAS unsigned*)(lds + (bufoff) + ldsw + 8192), 16, 0, CH_A_AUX); } while (0)
#define CH_STAGE_B(bufoff, gbase, K_) do { const unsigned _vo = CH_RB2() * (unsigned)(K_) + c2; const char* _g1 = (const char*)(gbase); const char* _g2 = _g1 + 128 * (size_t)(K_); \
        __builtin_amdgcn_global_load_lds((const unsigned*)(_g1 + _vo), (PG8_LAS unsigned*)(lds + (bufoff) + ldsw), 16, 0, 0); \
        __builtin_amdgcn_global_load_lds((const unsigned*)(_g2 + _vo), (PG8_LAS unsigned*)(lds + (bufoff) + ldsw + 8192), 16, 0, 0); } while (0)
#define PG8_LDA(dst, b, h) do { _Pragma("unroll") for (int m = 0; m < 4; ++m) _Pragma("unroll") for (int k = 0; k < 2; ++k) dst[m][k] = *(const PG8_LAS bf16x8*)(lds + PG8_SA(b, h) + aoff + m * 2048 + k * 1024); } while (0)
#define PG8_LDB(dst, b, h) do { _Pragma("unroll") for (int n = 0; n < 2; ++n) _Pragma("unroll") for (int k = 0; k < 2; ++k) dst[n][k] = *(const PG8_LAS bf16x8*)(lds + PG8_SB(b, h) + boff + n * 2048 + k * 1024); } while (0)
#define PG8_MMA(ai, bj, At, Bt) do { __builtin_amdgcn_s_setprio(1); _Pragma("unroll") for (int m = 0; m < 4; ++m) _Pragma("unroll") for (int n = 0; n < 2; ++n) _Pragma("unroll") for (int k = 0; k < 2; ++k) \
        acc[ai][bj][m][n] = __builtin_amdgcn_mfma_f32_16x16x32_bf16(Bt[n][k], At[m][k], acc[ai][bj][m][n], 0, 0, 0); __builtin_amdgcn_s_setprio(0); } while (0)
#define PG8_WAIT_V(n) asm volatile("s_waitcnt vmcnt(" #n ")" ::: "memory")
#define PG8_WAIT_L(n) asm volatile("s_waitcnt lgkmcnt(" #n ")" ::: "memory")
#define PG8_BAR __builtin_amdgcn_s_barrier()
#define PG8_SCHED __builtin_amdgcn_sched_barrier(0)
    unsigned* heads = (unsigned*)(PG8_GAS unsigned*)cp(c, CC + 2);
    unsigned pend = 0u;
    if (wid == 0 && lane == 0) { const int x0 = (int)(__builtin_amdgcn_s_getreg((3 << 11) | 20) & 7u); c[CQ] = (unsigned)x0; c[CQ + 1] = 0u;
        const unsigned u0 = chain_deq_from(c, heads, __hip_atomic_fetch_add(heads + 64 * x0, 1u, __ATOMIC_RELAXED, __HIP_MEMORY_SCOPE_AGENT)); c[CSLOT] = u0;
        const int x1 = (int)c[CQ]; const unsigned u1 = (u0 == 0xffffffffu) ? u0 : chain_deq_from(c, heads, __hip_atomic_fetch_add(heads + 64 * x1, 1u, __ATOMIC_RELAXED, __HIP_MEMORY_SCOPE_AGENT)); c[CSLOT + 1] = u1; }
    asm volatile("s_waitcnt vmcnt(0) lgkmcnt(0)" ::: "memory"); PG8_BAR; asm volatile("" ::: "memory");
    if (wid == 0 && lane == 0) pend = __hip_atomic_fetch_add(heads + 64 * (int)c[CQ], 1u, __ATOMIC_RELAXED, __HIP_MEMORY_SCOPE_AGENT);
    UnitD cur, nxt; int ui = 0;
    decode_unit(c, cw(c, CSLOT), cur);
    if (!cur.valid) return;
    f32x4 acc[2][2][4][2];
#pragma unroll
    for (int a = 0; a < 2; ++a)
#pragma unroll
        for (int b = 0; b < 2; ++b)
#pragma unroll
            for (int m = 0; m < 4; ++m)
#pragma unroll
                for (int n = 0; n < 2; ++n) acc[a][b][m][n] = (f32x4){0.f, 0.f, 0.f, 0.f};
    bf16x8 At[4][2], B0[2][2], B1[2][2];
    unsigned long long pub = 0ull;
    for (;;) {
    chain_wait(c, cur, wid);
    { const char* cA = cur.A; const char* cB = cur.B; const int K = cur.ld; const size_t hs = (size_t)256 * K;
      CH_STAGE_B(PG8_SB(0, 0), cB, K); CH_STAGE_B(PG8_SB(0, 1), cB + hs, K); CH_STAGE_A(PG8_SA(0, 0), cA, K); CH_STAGE_A(PG8_SA(0, 1), cA + hs, K);
      if (wr == 1) PG8_BAR;
      PG8_WAIT_V(2); PG8_BAR;
      CH_STAGE_B(PG8_SB(1, 0), cB + kstep, K); CH_STAGE_A(PG8_SA(1, 0), cA + kstep, K); CH_STAGE_B(PG8_SB(1, 1), cB + hs + kstep, K);
      PG8_WAIT_V(6); PG8_BAR; }
    bool done_all = false;
    for (;;) {
        bool has_next = false, go_on = false;
        const char* cA = cur.A; const char* cB = cur.B; const int Kc = cur.ld, nt = cur.K / BK; const size_t hsc = (size_t)256 * Kc;
        for (int t = 0; t < nt; t += 2) {
            const bool last = (t == nt - 2);
            if (last) { decode_unit(c, cw(c, CSLOT + ((ui + 1) & 3)), nxt); has_next = nxt.valid != 0; if (has_next) go_on = chain_try(c, nxt, wid, lane_now(), ui); }
            const bool into = last && go_on;
            const char* a1 = cA + (size_t)(t + 1) * kstep;
            const char* a2 = last ? (into ? nxt.A : cA) : cA + (size_t)(t + 2) * kstep; const char* b2 = last ? (into ? nxt.B : cB) : cB + (size_t)(t + 2) * kstep;
            const char* a3 = a2 + kstep; const char* b3 = b2 + kstep;
            const int K2 = into ? nxt.ld : Kc; const size_t hs2 = (size_t)256 * K2;
            PG8_LDB(B0, 0, 0); PG8_LDB(B1, 0, 1); PG8_SCHED; PG8_LDA(At, 0, 0); CH_STAGE_A(PG8_SA(1, 1), a1 + hsc, Kc);
            PG8_WAIT_V(8); PG8_WAIT_L(0); PG8_BAR; PG8_MMA(0, 0, At, B0); PG8_MMA(0, 1, At, B1); PG8_BAR; PG8_SCHED;
            PG8_LDA(At, 0, 1); CH_STAGE_B(PG8_SB(0, 0), b2, K2); CH_STAGE_B(PG8_SB(0, 1), b2 + hs2, K2); CH_STAGE_A(PG8_SA(0, 0), a2, K2);
            PG8_WAIT_V(8); PG8_WAIT_L(0); PG8_BAR; PG8_MMA(1, 0, At, B0); PG8_MMA(1, 1, At, B1); PG8_BAR; PG8_SCHED;
            if (t == CH_PUB_T) {
                const int lane_t = lane_now();
                if (pub) { asm volatile("s_waitcnt vmcnt(0)" ::: "memory"); if (lane_t == 0) __hip_atomic_fetch_add((unsigned*)(PG8_GAS unsigned*)pub, 1u, __ATOMIC_RELAXED, __HIP_MEMORY_SCOPE_AGENT); pub = 0ull; }
                if (wid == 0 && lane_t == 0) { unsigned* heads = (unsigned*)(PG8_GAS unsigned*)cp(c, CC + 2); c[CSLOT + ((ui + 2) & 3)] = chain_deq_from(c, heads, pend); pend = __hip_atomic_fetch_add(heads + 64 * (int)c[CQ], 1u, __ATOMIC_RELAXED, __HIP_MEMORY_SCOPE_AGENT); }
            }
            PG8_LDB(B0, 1, 0); PG8_LDB(B1, 1, 1); PG8_SCHED; PG8_LDA(At, 1, 0); CH_STAGE_A(PG8_SA(0, 1), a2 + hs2, K2);
            PG8_WAIT_V(8); PG8_WAIT_L(0); PG8_BAR; PG8_MMA(0, 0, At, B0); PG8_MMA(0, 1, At, B1); PG8_BAR; PG8_SCHED;
            PG8_LDA(At, 1, 1); CH_STAGE_B(PG8_SB(1, 0), b3, K2); CH_STAGE_B(PG8_SB(1, 1), b3 + hs2, K2); CH_STAGE_A(PG8_SA(1, 0), a3, K2);
            PG8_WAIT_V(8); PG8_WAIT_L(0); PG8_BAR; PG8_MMA(1, 0, At, B0); PG8_MMA(1, 1, At, B1); PG8_BAR; PG8_SCHED;
        }
        if (wr == 0) PG8_BAR;
        { const int lane_e = lane_now();
          chain_epilogue(c, cur, acc, wr, wc, lane_e & 15, lane_e >> 4); }
        { const unsigned long long dn = cp(c, 16 * cur.seg + 12); pub = dn ? dn + (unsigned long long)(256 * cur.pm) : 0ull; }
#pragma unroll
        for (int a = 0; a < 2; ++a)
#pragma unroll
            for (int b = 0; b < 2; ++b)
#pragma unroll
                for (int m = 0; m < 4; ++m)
#pragma unroll
                    for (int n = 0; n < 2; ++n) acc[a][b][m][n] = (f32x4){0.f, 0.f, 0.f, 0.f};
        if (!has_next) { done_all = true; break; }
        cur = nxt; ++ui;
        if (!go_on) break;
        if (wr == 1) PG8_BAR;
    }
    PG8_WAIT_V(0);
    if (pub) { if (lane_now() == 0) __hip_atomic_fetch_add((unsigned*)(PG8_GAS unsigned*)pub, 1u, __ATOMIC_RELAXED, __HIP_MEMORY_SCOPE_AGENT); pub = 0ull; }
    PG8_BAR;
    if (done_all) break;
    }
#undef PG8_SA
#undef PG8_SB
#undef CH_STAGE_A
#undef CH_STAGE_B
#undef CH_RB2
#undef ra2
#undef c2
#undef PG8_LDA
#undef PG8_LDB
#undef PG8_MMA
#undef PG8_WAIT_V
#undef PG8_WAIT_L
#undef PG8_BAR
#undef PG8_SCHED
}
}
#ifndef PG8_SP2
#define PG8_SP2 true
#endif
#ifndef PG8_ALIGN
#define PG8_ALIGN true
#endif
constexpr int NWAVES = 8;
constexpr int D = 1024, NB = 8, SEQ = 2048, NMETA = 16, LP = SEQ + NMETA, DBATCH = 128, DSEQ = 4;
constexpr int MP = NB * LP, MS = DBATCH * DSEQ, MTOT = MP + MS, MPAD = 17152;
constexpr int NQKV = 1536, NIN = 3072, NINP = 3328, FF = 4096;
constexpr int AH = 16, AKV = 4, AHD = 64, WIN = 128;
constexpr int MH = 4, MDK = 128, MDV = 256, MCH = 64, VS = 32, NSL = MDV / VS;
constexpr float EPS = 1e-6f;
static_assert(MPAD % 256 == 0 && MPAD >= MTOT, "row padding");
constexpr size_t MiB = 1u << 20;
constexpr size_t WS_CTL = 0, CTL_ZERO_BYTES = 1 * MiB;
constexpr size_t WS_WQKV = 2 * MiB, WS_WO = 8 * MiB, WS_WIN = 12 * MiB, WS_WOUT = 25 * MiB, WS_WUP = 29 * MiB, WS_WDN = 61 * MiB;
constexpr size_t SZ_WQKV = (size_t)NQKV * D * 2, SZ_WO = (size_t)D * D * 2, SZ_WIN = (size_t)NINP * D * 2, SZ_WUP = (size_t)FF * D * 2;
constexpr size_t WS_SS = 93 * MiB, WS_G = 95 * MiB, WS_HSS = 96 * MiB;
constexpr size_t WS_X = 100 * MiB, WS_XB = 167 * MiB, WS_Z = 201 * MiB, WS_AO = 302 * MiB, WS_FF = 336 * MiB, WS_PT = 470 * MiB, WS_END = 483 * MiB;
static_assert(WS_WQKV + 2 * SZ_WQKV <= WS_WO && WS_WO + 2 * SZ_WO <= WS_WIN && WS_WIN + 2 * SZ_WIN <= WS_WOUT && WS_WOUT + 2 * SZ_WO <= WS_WUP && WS_WUP + 4 * SZ_WUP <= WS_WDN && WS_WDN + 4 * SZ_WUP <= WS_SS, "weights map");
static_assert(WS_SS + (size_t)MPAD * 16 * 4 <= WS_G && WS_G + (size_t)MPAD * 8 * 4 <= WS_HSS && WS_HSS + (size_t)MPAD * 32 * 4 <= WS_X, "small maps");
static_assert(WS_X + (size_t)MPAD * D * 4 <= WS_XB && WS_XB + (size_t)MPAD * D * 2 <= WS_Z && WS_Z + (size_t)MPAD * NIN * 2 <= WS_AO && WS_AO + (size_t)MPAD * D * 2 <= WS_FF && WS_FF + (size_t)MPAD * FF * 2 <= WS_PT && WS_PT + (size_t)4 * 768 * D * 4 <= WS_END, "activation map");
constexpr int CW_BAR = 4096;
constexpr size_t O_YP = 0, O_YS = O_YP + (size_t)NB * SEQ * D, O_KP = O_YS + (size_t)MS * D, O_VP = O_KP + (size_t)2 * NB * WIN * AKV * AHD, O_KS = O_VP + (size_t)2 * NB * WIN * AKV * AHD,
    O_VS = O_KS + (size_t)2 * DBATCH * WIN * AKV * AHD, O_CP = O_VS + (size_t)2 * DBATCH * WIN * AKV * AHD, O_NP = O_CP + (size_t)2 * NB * MH * MDK * MDV, O_MP = O_NP + (size_t)2 * NB * MH * MDK,
    O_CS = O_MP + (size_t)2 * NB * MH, O_NS = O_CS + (size_t)2 * DBATCH * MH * MDK * MDV, O_MS = O_NS + (size_t)2 * DBATCH * MH * MDK, O_END = O_MS + (size_t)2 * DBATCH * MH;
constexpr int RING_OFF = 0, RING_BYTES = 131072;
constexpr int LDSCTL_OFF = RING_BYTES, MISC_OFF = LDSCTL_OFF + 320;
constexpr int LDS_BYTES = 147456;
#define GAS __attribute__((address_space(1)))
#define LAS __attribute__((address_space(3)))
typedef unsigned short bf16;
typedef unsigned v4u __attribute__((ext_vector_type(4)));
typedef float f32x4 __attribute__((ext_vector_type(4)));
typedef short bf16x8 __attribute__((ext_vector_type(8)));
typedef GAS unsigned gu32;
typedef GAS unsigned long long gu64;
#define RLX_AGENT __ATOMIC_RELAXED, __HIP_MEMORY_SCOPE_AGENT
#define LDS_WAIT() asm volatile("s_waitcnt lgkmcnt(0)" ::: "memory")
#define VM_WAIT() asm volatile("s_waitcnt vmcnt(0)" ::: "memory")
__device__ __forceinline__ unsigned long long rt() { return __builtin_amdgcn_s_memrealtime(); }
__device__ __forceinline__ unsigned f2bf(float f) { unsigned u = __builtin_bit_cast(unsigned, f); return (u + 0x7fffu + ((u >> 16) & 1u)) >> 16; }
__device__ __forceinline__ unsigned pk2(float lo, float hi) { return f2bf(lo) | (f2bf(hi) << 16); }

#define XB_TMO      128
#define XB_XCNT(j)  (256  + 64 * (j))
#define XB_XSUB(j)  (1280 + 64 * (j))
#define XB_XGEN(j)  (2304 + 64 * (j))
#define XB_TOP      3328
#define XB_TOPGEN   3392
#define XCD_BAR_WORDS 3456
#define XB_SPIN_CAP (1u << 18)

__device__ __forceinline__ unsigned xb_ld(unsigned* p)              { return __hip_atomic_load(p, __ATOMIC_RELAXED, __HIP_MEMORY_SCOPE_AGENT); }
__device__ __forceinline__ unsigned xb_add(unsigned* p, unsigned v) { return __hip_atomic_fetch_add(p, v, __ATOMIC_RELAXED, __HIP_MEMORY_SCOPE_AGENT); }
__device__ __forceinline__ unsigned xb_xcc_id() { return (unsigned)__builtin_amdgcn_s_getreg((3 << 11) | 20) & 0xFu; }
#define XB_SPIN(cond, bar) do { unsigned _sp = 0; while (cond) { __builtin_amdgcn_s_sleep(1); \
    if ((++_sp & 255u) == 0u) { if (xb_ld(&(bar)[XB_TMO])) break; if (_sp > XB_SPIN_CAP) { atomicAdd(&(bar)[XB_TMO], 1u); break; } } } } while (0)

struct XcdBarrier {
    unsigned* bar; unsigned x;
    volatile LAS unsigned* st;
};

__device__ __forceinline__ XcdBarrier xcd_barrier_post(unsigned* bar, volatile LAS unsigned* st) {
    XcdBarrier b; b.bar = bar; b.x = xb_xcc_id(); b.st = st;
    if (threadIdx.x == 0) (void)xb_add(&bar[XB_XCNT(b.x)], 1u);
    return b;
}
__device__ __forceinline__ void xcd_barrier_complete(unsigned* bar, unsigned x, unsigned& nloc, unsigned& nx) {
    const unsigned G = gridDim.x * gridDim.y * gridDim.z;
    unsigned sum, cnt, mine, sp = 0u;
    for (;;) {
        sum = 0u; cnt = 0u; mine = 0u;
#pragma unroll
        for (unsigned j = 0; j < 16; ++j) { const unsigned c = xb_ld(&bar[XB_XCNT(j)]); sum += c; cnt += (c > 0u) ? 1u : 0u; mine = (j == x) ? c : mine; }
        if (sum == G) break;
        __builtin_amdgcn_s_sleep(1);
        if ((++sp & 255u) == 0u) { if (xb_ld(&bar[XB_TMO])) break; if (sp > XB_SPIN_CAP) { atomicAdd(&bar[XB_TMO], 1u); break; } }
    }
    nloc = mine > 0u ? mine : 1u; nx = cnt > 0u ? cnt : 1u;
}

__device__ __forceinline__ void xcd_barrier(const XcdBarrier& b) {
    asm volatile("s_waitcnt vmcnt(0)" ::: "memory");
    __syncthreads();
    if (threadIdx.x == 0) {
        unsigned* bar = b.bar;
        __builtin_amdgcn_s_waitcnt(0);
        unsigned nloc = b.st[0], nx = b.st[1];
        if (nloc == 0u) { xcd_barrier_complete(bar, b.x, nloc, nx); b.st[0] = nloc; b.st[1] = nx; }
        const unsigned old = xb_add(&bar[XB_XSUB(b.x)], 1u);
        const unsigned gen = old / nloc;
        if (old + 1u == (gen + 1u) * nloc) {
            __builtin_amdgcn_fence(__ATOMIC_RELEASE, "agent");
            asm volatile("s_waitcnt vmcnt(0)" ::: "memory");
            const unsigned og = xb_add(&bar[XB_TOP], 1u);
            const unsigned tg = og / nx;
            if (og + 1u == (tg + 1u) * nx) xb_add(&bar[XB_TOPGEN], 1u);
            else XB_SPIN(xb_ld(&bar[XB_TOPGEN]) == tg, bar);
            __builtin_amdgcn_fence(__ATOMIC_ACQUIRE, "agent");
            xb_add(&bar[XB_XGEN(b.x)], 1u);
            asm volatile("s_waitcnt vmcnt(0)" ::: "memory");
        } else {
            XB_SPIN(xb_ld(&bar[XB_XGEN(b.x)]) == gen, bar);
            __builtin_amdgcn_fence(__ATOMIC_ACQUIRE, "agent");
            asm volatile("s_waitcnt vmcnt(0)" ::: "memory");
        }
    }
    __syncthreads();
}

typedef unsigned v2u __attribute__((ext_vector_type(2)));
__device__ __forceinline__ float bf_lo(unsigned w) { return __builtin_bit_cast(float, w << 16); }
__device__ __forceinline__ float bf_hi(unsigned w) { return __builtin_bit_cast(float, w & 0xffff0000u); }
__device__ __forceinline__ float bf1(bf16 b) { return __builtin_bit_cast(float, (unsigned)b << 16); }
__device__ __forceinline__ void unpack8(const v4u w, float (&f)[8]) { f[0] = bf_lo(w.x); f[1] = bf_hi(w.x); f[2] = bf_lo(w.y); f[3] = bf_hi(w.y); f[4] = bf_lo(w.z); f[5] = bf_hi(w.z); f[6] = bf_lo(w.w); f[7] = bf_hi(w.w); }
__device__ __forceinline__ v4u pack8(const float (&f)[8]) { v4u o; o.x = pk2(f[0], f[1]); o.y = pk2(f[2], f[3]); o.z = pk2(f[4], f[5]); o.w = pk2(f[6], f[7]); return o; }
__device__ __forceinline__ float wave_sum(float v, int lane) {
#pragma unroll
    for (int o = 1; o < 64; o <<= 1) v += pg8::shx(v, o, lane);
    return v;
}
__device__ __forceinline__ f32x4 mfma16(bf16x8 a, bf16x8 b, f32x4 c) { return __builtin_amdgcn_mfma_f32_16x16x32_bf16(a, b, c, 0, 0, 0); }
#define WG_BAR() do { asm volatile("s_waitcnt vmcnt(0) lgkmcnt(0)" ::: "memory"); __builtin_amdgcn_s_barrier(); asm volatile("" ::: "memory"); } while (0)
#define LDS_BAR() do { asm volatile("s_waitcnt lgkmcnt(0)" ::: "memory"); __builtin_amdgcn_s_barrier(); asm volatile("" ::: "memory"); } while (0)

__device__ __forceinline__ void p0_transpose_item(const float* W, const float* gs, int K, int N, bf16* WT, int row_off, int mlo, int mhi, float mul, LAS float* scr, int item, int lane) {
    const int nblk = N / 32, kb = item / nblk, nb = item % nblk, k0 = 64 * kb, n0 = 32 * nb;
    const float cm = (n0 >= mlo && n0 < mhi) ? mul : 1.0f;
#pragma unroll 8
    for (int i = 0; i < 32; ++i) { const int kk = 2 * i + (lane >> 5); const float g = gs ? gs[k0 + kk] * cm : cm; scr[kk * 33 + (lane & 31)] = W[(size_t)(k0 + kk) * N + n0 + (lane & 31)] * g; }
    LDS_WAIT(); asm volatile("" ::: "memory");
    const int c = lane & 7;
#pragma unroll
    for (int j = 0; j < 4; ++j) { const int n = (lane >> 3) + 8 * j; const LAS float* s = scr + (8 * c) * 33 + n;
        v4u o; o.x = pk2(s[0 * 33], s[1 * 33]); o.y = pk2(s[2 * 33], s[3 * 33]); o.z = pk2(s[4 * 33], s[5 * 33]); o.w = pk2(s[6 * 33], s[7 * 33]);
        *(GAS v4u*)(WT + (size_t)(row_off + n0 + n) * K + k0 + 8 * c) = o; }
    LDS_WAIT(); asm volatile("" ::: "memory");
}
struct P0Args { const float *xp, *xs, *meta, *norm_mix, *norm_mlp, *wqkv, *wo, *win, *wgate, *wout, *wup, *wdn; unsigned char* ws; };
__device__ __forceinline__ void p0_prologue(const P0Args& A, LAS unsigned char* lds, int vcu, int G, int wave, int lane, int tid) {
    LAS float* scr = (LAS float*)(lds + RING_OFF + wave * 16384);
    const int gw = vcu * NWAVES + wave, NGW = G * NWAVES;
    constexpr int I_QKV = (D / 64) * (NQKV / 32), I_O = (D / 64) * (D / 32), I_IN = (D / 64) * (NIN / 32), I_UP = (D / 64) * (FF / 32), I_DN = (FF / 64) * (D / 32);
    constexpr int I_MIX = I_QKV + I_O + I_IN + I_O, I_MLP = I_UP + I_DN, NITEMS = 2 * I_MIX + 4 * I_MLP;
    unsigned char* ws = A.ws;
    for (int it = gw; it < NITEMS; it += NGW) {
        int r = it;
        if (r < 2 * I_MIX) { const int j = r / I_MIX; r -= j * I_MIX;
            if (r < I_QKV) { p0_transpose_item(A.wqkv + (size_t)j * D * NQKV, A.norm_mix + (2 * j) * D, D, NQKV, (bf16*)(ws + WS_WQKV + j * SZ_WQKV), 0, 0, 0, 1.f, scr, r, lane); continue; } r -= I_QKV;
            if (r < I_O) { p0_transpose_item(A.wo + (size_t)j * D * D, nullptr, D, D, (bf16*)(ws + WS_WO + j * SZ_WO), 0, 0, 0, 1.f, scr, r, lane); continue; } r -= I_O;
            if (r < I_IN) { p0_transpose_item(A.win + (size_t)j * D * NIN, A.norm_mix + (2 * j + 1) * D, D, NIN, (bf16*)(ws + WS_WIN + j * SZ_WIN), 0, 512, 1024, 0.08838834764831845f, scr, r, lane); continue; } r -= I_IN;
            p0_transpose_item(A.wout + (size_t)j * D * D, nullptr, D, D, (bf16*)(ws + WS_WOUT + j * SZ_WO), 0, 0, 0, 1.f, scr, r, lane); continue; }
        r -= 2 * I_MIX;
        { const int i = r / I_MLP; r -= i * I_MLP;
            if (r < I_UP) { p0_transpose_item(A.wup + (size_t)i * D * FF, A.norm_mlp + i * D, D, FF, (bf16*)(ws + WS_WUP + i * SZ_WUP), 0, 0, 0, 1.f, scr, r, lane); continue; } r -= I_UP;
            p0_transpose_item(A.wdn + (size_t)i * FF * D, nullptr, FF, D, (bf16*)(ws + WS_WDN + i * SZ_WUP), 0, 0, 0, 1.f, scr, r, lane); }
    }
    { const int gt = vcu * (NWAVES * 64) + tid, NT = G * NWAVES * 64;
      for (int e = gt; e < 2 * 256 * (D / 8); e += NT) { const int j = e / (256 * (D / 8)), rem = e % (256 * (D / 8)), n = rem / (D / 8), k8 = (rem % (D / 8)) * 8;
          float f[8];
#pragma unroll
          for (int q = 0; q < 8; ++q) f[q] = (n < 8) ? A.wgate[((size_t)j * D + k8 + q) * 8 + n] * A.norm_mix[(2 * j + 1) * D + k8 + q] : 0.f;
          *(GAS v4u*)((bf16*)(ws + WS_WIN + j * SZ_WIN) + (size_t)(NIN + n) * D + k8) = pack8(f); } }
    float* X = (float*)(ws + WS_X); bf16* XB = (bf16*)(ws + WS_XB); float* SS = (float*)(ws + WS_SS); bf16* AO = (bf16*)(ws + WS_AO);
    for (int m = gw; m < MPAD; m += NGW) {
        const float* src = nullptr;
        if (m < MP) { const int b = m / LP, t = m - b * LP; src = (t < NMETA) ? A.meta + (size_t)t * D : A.xp + ((size_t)b * SEQ + (t - NMETA)) * D; }
        else if (m < MTOT) src = A.xs + (size_t)(m - MP) * D;
        f32x4 v[4]; float ss[4];
#pragma unroll
        for (int j = 0; j < 4; ++j) { v[j] = src ? ((const GAS f32x4*)src)[lane + 64 * j] : (f32x4){0.f, 0.f, 0.f, 0.f}; ss[j] = wave_sum((v[j][0] * v[j][0] + v[j][1] * v[j][1]) + (v[j][2] * v[j][2] + v[j][3] * v[j][3]), lane); }
#pragma unroll
        for (int j = 0; j < 4; ++j) { ((GAS f32x4*)(X + (size_t)m * D))[lane + 64 * j] = v[j]; v2u w; w.x = pk2(v[j][0], v[j][1]); w.y = pk2(v[j][2], v[j][3]); ((GAS v2u*)(XB + (size_t)m * D))[lane + 64 * j] = w; }
        if (lane < 16) { const int j = lane >> 2; const float s = (lane & 3) ? 0.f : (j == 0 ? ss[0] : j == 1 ? ss[1] : j == 2 ? ss[2] : ss[3]); SS[(size_t)m * 16 + lane] = s; }
        if (m >= MTOT) {
#pragma unroll
            for (int j = 0; j < 4; ++j) ((GAS v2u*)(AO + (size_t)m * D))[lane + 64 * j] = (v2u){0u, 0u}; }
    }
}

constexpr int A_KS = 0, A_KSTR = 144, A_VT = 36864, A_VSTR = 552, A_LUT = 72192, A_END = 74304;
__device__ __forceinline__ int t5_bucket(int n) {
    if (n < 16) return n;
    const int v = 16 + (int)(logf((float)n * (1.0f / 16.0f)) * (16.0f / 2.0794415416798357f));
    return v < 31 ? v : 31;
}
struct AttnP { const bf16* QKV; const float *gq, *gk, *sinks, *rel; bf16* AO; };
__device__ __forceinline__ void attn_subtile(LAS unsigned char* L, int i0, const bf16* qptr, int hh, int dist0, int jmin, float sink, const float* gq, bf16* optr, bool store, int lane) {
    const int g = lane >> 4, c = lane & 15;
    bf16x8 Bq[2];
    {
        const v4u q0 = *(const GAS v4u*)(qptr + 8 * g), q1 = *(const GAS v4u*)(qptr + 32 + 8 * g);
        float f0[8], f1[8]; unpack8(q0, f0); unpack8(q1, f1);
        float ss = 0.f;
#pragma unroll
        for (int e = 0; e < 8; ++e) ss += f0[e] * f0[e] + f1[e] * f1[e];
        ss += pg8::shx(ss, 16, lane); ss += pg8::shx(ss, 32, lane);
        const float rq = 0.125f / sqrtf(ss * (1.0f / 64.0f) + EPS);
        const f32x4 ga = *(const f32x4*)(gq + 8 * g), gb = *(const f32x4*)(gq + 8 * g + 4), gc = *(const f32x4*)(gq + 32 + 8 * g), gd = *(const f32x4*)(gq + 36 + 8 * g);
#pragma unroll
        for (int e = 0; e < 4; ++e) { f0[e] *= rq * ga[e]; f0[4 + e] *= rq * gb[e]; f1[e] *= rq * gc[e]; f1[4 + e] *= rq * gd[e]; }
        const v4u p0 = pack8(f0), p1 = pack8(f1);
        Bq[0] = __builtin_bit_cast(bf16x8, p0); Bq[1] = __builtin_bit_cast(bf16x8, p1);
    }
    f32x4 s[10];
    float mx = -1e30f;
#pragma unroll
    for (int kt = 0; kt < 9; ++kt) {
        const LAS unsigned char* kp = L + A_KS + (i0 + 16 * kt + c) * A_KSTR + 16 * g;
        f32x4 acc = {0.f, 0.f, 0.f, 0.f};
        acc = mfma16(*(const LAS bf16x8*)kp, Bq[0], acc);
        acc = mfma16(*(const LAS bf16x8*)(kp + 64), Bq[1], acc);
#pragma unroll
        for (int r = 0; r < 4; ++r) {
            const int rel = 16 * kt + 4 * g + r, dist = dist0 - rel;
            const bool ok = (dist >= 0) && (dist <= WIN) && (i0 + rel >= jmin);
            const int di = dist < 0 ? 0 : (dist > WIN ? WIN : dist);
            const float bias = *(const LAS float*)(L + A_LUT + (hh * 132 + di) * 4);
            const float v = ok ? acc[r] + bias : -1e30f;
            s[kt][r] = v; mx = fmaxf(mx, v);
        }
    }
    mx = fmaxf(mx, pg8::shx(mx, 16, lane)); mx = fmaxf(mx, pg8::shx(mx, 32, lane));
    mx = fmaxf(mx, sink);
    float l = 0.f;
#pragma unroll
    for (int kt = 0; kt < 9; ++kt)
#pragma unroll
        for (int r = 0; r < 4; ++r) { const float p = __expf(s[kt][r] - mx); s[kt][r] = p; l += p; }
    s[9] = (f32x4){0.f, 0.f, 0.f, 0.f};
    l += pg8::shx(l, 16, lane); l += pg8::shx(l, 32, lane);
    const float inv = 1.0f / (l + __expf(sink - mx));
    bf16x8 Bp[5];
#pragma unroll
    for (int ks = 0; ks < 5; ++ks) { v4u w; w.x = pk2(s[2 * ks][0], s[2 * ks][1]); w.y = pk2(s[2 * ks][2], s[2 * ks][3]); w.z = pk2(s[2 * ks + 1][0], s[2 * ks + 1][1]); w.w = pk2(s[2 * ks + 1][2], s[2 * ks + 1][3]); Bp[ks] = __builtin_bit_cast(bf16x8, w); }
#pragma unroll
    for (int dt = 0; dt < 4; ++dt) {
        f32x4 acc = {0.f, 0.f, 0.f, 0.f};
        const LAS unsigned char* vp = L + A_VT + (16 * dt + c) * A_VSTR + (i0 + 4 * g) * 2;
#pragma unroll
        for (int ks = 0; ks < 5; ++ks) { const v2u lo = *(const LAS v2u*)(vp + 64 * ks), hi = *(const LAS v2u*)(vp + 64 * ks + 32); const v4u a = {lo.x, lo.y, hi.x, hi.y};
            acc = mfma16(__builtin_bit_cast(bf16x8, a), Bp[ks], acc); }
        if (store) { v2u w; w.x = pk2(acc[0] * inv, acc[1] * inv); w.y = pk2(acc[2] * inv, acc[3] * inv); *(GAS v2u*)(optr + 16 * dt + 4 * g) = w; }
    }
}
__device__ __forceinline__ void attn_stage_row(LAS unsigned char* L, int j, int half, const bf16* krow, const bf16* vrow, const float* gk, float* ck, float* cv, int lane) {
    float kf[32], vf[32];
    if (krow) {
#pragma unroll
        for (int i = 0; i < 4; ++i) { float t[8]; unpack8(*(const GAS v4u*)(krow + 8 * i), t);
#pragma unroll
            for (int e = 0; e < 8; ++e) kf[8 * i + e] = t[e];
            unpack8(*(const GAS v4u*)(vrow + 8 * i), t);
#pragma unroll
            for (int e = 0; e < 8; ++e) vf[8 * i + e] = t[e]; }
    } else {
#pragma unroll
        for (int e = 0; e < 32; ++e) { kf[e] = 0.f; vf[e] = 0.f; }
    }
    float ss = 0.f;
#pragma unroll
    for (int e = 0; e < 32; ++e) ss += kf[e] * kf[e];
    ss += pg8::shx(ss, 1, lane);
    const float rk = 1.0f / sqrtf(ss * (1.0f / 64.0f) + EPS);
#pragma unroll
    for (int i = 0; i < 8; ++i) { const f32x4 gg = *(const f32x4*)(gk + half * 32 + 4 * i);
#pragma unroll
        for (int e = 0; e < 4; ++e) kf[4 * i + e] *= rk * gg[e]; }
#pragma unroll
    for (int i = 0; i < 4; ++i) { float t[8];
#pragma unroll
        for (int e = 0; e < 8; ++e) t[e] = kf[8 * i + e];
        *(LAS v4u*)(L + A_KS + j * A_KSTR + half * 64 + 16 * i) = pack8(t); }
#pragma unroll
    for (int e = 0; e < 32; ++e) *(LAS unsigned short*)(L + A_VT + (half * 32 + e) * A_VSTR + 2 * j) = (unsigned short)f2bf(vf[e]);
    if (ck) {
#pragma unroll
        for (int i = 0; i < 8; ++i) { *(GAS f32x4*)(ck + half * 32 + 4 * i) = (f32x4){kf[4 * i], kf[4 * i + 1], kf[4 * i + 2], kf[4 * i + 3]};
            *(GAS f32x4*)(cv + half * 32 + 4 * i) = (f32x4){vf[4 * i], vf[4 * i + 1], vf[4 * i + 2], vf[4 * i + 3]}; }
    }
}
__device__ __forceinline__ void attn_phase(LAS unsigned char* L, const AttnP& P, const float* cache_k, const float* cache_v, float* out, int jl, int vcu, int G, int tid_in, int wave_in, int lane_in) {
    constexpr int N_PROMPT = NB * 17 * AKV, N_ITEMS = N_PROMPT + DBATCH * AKV;
#pragma unroll 1
    for (int it = vcu; it < N_ITEMS; it += G) {
        int tid = tid_in; asm volatile("" : "+v"(tid));
        const int lane = tid & 63, wave = __builtin_amdgcn_readfirstlane(tid >> 6);
        const bool prompt = it < N_PROMPT;
        int b = 0, qb = 0, kvh, db = 0;
        if (prompt) { b = it / (17 * AKV); const int rem = it % (17 * AKV); qb = rem / AKV; kvh = rem % AKV; }
        else { const int si = it - N_PROMPT; db = si / AKV; kvh = si % AKV; }
        for (int e = tid; e < 4 * 129; e += NWAVES * 64) { const int hh = e / 129, d = e % 129; *(LAS float*)(L + A_LUT + (hh * 132 + d) * 4) = P.rel[t5_bucket(d) * AH + kvh * 4 + hh]; }
        if (prompt) {
            const int j = tid >> 1, half = tid & 1, tok = 128 * qb - 240 + j;
            const bf16* krow = nullptr; const bf16* vrow = nullptr; float* ck = nullptr; float* cv = nullptr;
            if (tok >= 0) { const size_t row = (size_t)b * LP + tok; krow = P.QKV + row * NQKV + 1024 + kvh * 64 + half * 32; vrow = P.QKV + row * NQKV + 1280 + kvh * 64 + half * 32; }
            if (qb == 16 && j >= 128) { const size_t o = ((((size_t)jl * NB + b) * WIN + (j - 128)) * AKV + kvh) * AHD; ck = out + O_KP + o; cv = out + O_VP + o; }
            attn_stage_row(L, j, half, krow, vrow, P.gk, ck, cv, lane);
            for (int e = tid; e < 64 * 16; e += NWAVES * 64) *(LAS unsigned short*)(L + A_VT + (e >> 4) * A_VSTR + 2 * (256 + (e & 15))) = 0;
        } else {
            const float* ckin = cache_k + (((size_t)jl * DBATCH + db) * WIN * AKV + kvh) * AHD; const float* cvin = cache_v + (((size_t)jl * DBATCH + db) * WIN * AKV + kvh) * AHD;
            float* cko = out + O_KS + (((size_t)jl * DBATCH + db) * WIN * AKV + kvh) * AHD; float* cvo = out + O_VS + (((size_t)jl * DBATCH + db) * WIN * AKV + kvh) * AHD;
#pragma unroll
            for (int i = 0; i < 4; ++i) { const int idx = tid + 512 * i, row = idx >> 4, c4 = idx & 15;
                const f32x4 kv = *(const GAS f32x4*)(ckin + (size_t)row * (AKV * AHD) + 4 * c4), vv = *(const GAS f32x4*)(cvin + (size_t)row * (AKV * AHD) + 4 * c4);
                v2u w; w.x = pk2(kv[0], kv[1]); w.y = pk2(kv[2], kv[3]); *(LAS v2u*)(L + A_KS + row * A_KSTR + 8 * c4) = w;
#pragma unroll
                for (int e = 0; e < 4; ++e) *(LAS unsigned short*)(L + A_VT + (4 * c4 + e) * A_VSTR + 2 * row) = (unsigned short)f2bf(vv[e]);
                if (row >= DSEQ) { *(GAS f32x4*)(cko + (size_t)(row - DSEQ) * (AKV * AHD) + 4 * c4) = kv; *(GAS f32x4*)(cvo + (size_t)(row - DSEQ) * (AKV * AHD) + 4 * c4) = vv; } }
            if (tid < 2 * DSEQ) { const int s = tid >> 1, half = tid & 1; const size_t row = (size_t)MP + db * DSEQ + s;
                attn_stage_row(L, WIN + s, half, P.QKV + row * NQKV + 1024 + kvh * 64 + half * 32, P.QKV + row * NQKV + 1280 + kvh * 64 + half * 32, P.gk,
                               cko + (size_t)(WIN - DSEQ + s) * (AKV * AHD), cvo + (size_t)(WIN - DSEQ + s) * (AKV * AHD), lane); }
            for (int e = tid; e < 12 * 8; e += NWAVES * 64) { unsigned z0 = 0u; asm volatile("" : "+v"(z0)); *(LAS v4u*)(L + A_KS + (132 + e / 8) * A_KSTR + 16 * (e & 7)) = (v4u){z0, z0, z0, z0}; }
            for (int e = tid; e < 64 * 28; e += NWAVES * 64) *(LAS unsigned short*)(L + A_VT + (e / 28) * A_VSTR + 2 * (132 + e % 28)) = 0;
        }
        LDS_BAR();
        if (prompt) {
            const int hh = wave & 3, rhalf = wave >> 2, head = kvh * 4 + hh; const float sink = P.sinks[head];
            const int jmin = 240 - 128 * qb;
#pragma unroll 1
            for (int st = 0; st < 4; ++st) {
                const int i0 = 64 * rhalf + 16 * st;
                if (qb == 0 && i0 < 112) continue;
                const int tok = 128 * qb - 112 + i0 + (lane & 15); const size_t row = (size_t)b * LP + tok;
                attn_subtile(L, i0, P.QKV + row * NQKV + head * 64, hh, (lane & 15) + WIN, jmin, sink, P.gq, P.AO + row * D + head * 64, true, lane);
            }
        } else if (wave == 0) {
            const int q = lane & 15, hh = q >> 2, s = q & 3, head = kvh * 4 + hh; const size_t row = (size_t)MP + db * DSEQ + s;
            attn_subtile(L, 0, P.QKV + row * NQKV + head * 64, hh, WIN + s, 0, P.sinks[head], P.gq, P.AO + row * D + head * 64, true, lane);
        }
        LDS_BAR();
    }
}

constexpr int M_QS = 0, M_KS = 17408, M_KT = 34816, M_VT = 53248, M_VW = 60160, M_CT = 67072, M_CTB = 13056;
constexpr int M_RS = 272, M_TS = 144;
struct MlP { const bf16* Z; const float* G; const float* gnorm; bf16* AO; float* HSS; };
__device__ __forceinline__ float wave_scan_add(float x, int lane) {
#pragma unroll
    for (int o = 1; o < 64; o <<= 1) { const float t = pg8::shl_from(x, lane - o); if (lane >= o) x += t; }
    return x;
}
__device__ __forceinline__ float wave_scan_max(float x, int lane) {
#pragma unroll
    for (int o = 1; o < 64; o <<= 1) { const float t = pg8::shl_from(x, lane - o); if (lane >= o) x = fmaxf(x, t); }
    return x;
}
__device__ __forceinline__ float sigmoidf_(float x) { return 1.0f / (1.0f + __expf(-x)); }
__device__ __forceinline__ float tanh_fast(float x) { return 1.0f - 2.0f / (1.0f + __expf(2.0f * x)); }
__device__ __forceinline__ float gate_i(float g) { return 15.0f * tanh_fast(g * (1.0f / 15.0f)); }
__device__ __forceinline__ float gate_f(float g) { const float x = 15.0f * tanh_fast(g * (1.0f / 15.0f)); return fminf(x, 0.f) - __logf(1.0f + __expf(-fabsf(x))); }
constexpr int M_TB = 94208, M_CS = M_TB + 33 * 192 * 4, M_MS = M_CS + 33 * 2 * 4, M_MX = M_MS + 34 * 4, M_END2 = M_MX + 34 * 4;
static_assert(M_END2 <= RING_BYTES, "mLSTM LDS map");
__device__ __forceinline__ void mlstm_prompt_item(LAS unsigned char* L, const MlP& P, float* out, int jl, int b, int h, int sl, int tid, int wave, int lane) {
    const int g = lane >> 4, c = lane & 15;
    unsigned z0 = 0u; asm volatile("" : "+v"(z0));
    for (int e = tid; e < 16 * 72; e += NWAVES * 64) { const int r = e / 72, cc = e % 72; const unsigned short one = 0x3f80;
        *(LAS unsigned short*)(L + M_VT + (32 + r) * M_TS + 2 * cc) = (r == 0) ? one : (unsigned short)0; *(LAS unsigned short*)(L + M_VW + (32 + r) * M_TS + 2 * cc) = 0; }
    for (int e = tid; e < M_CTB / 16; e += NWAVES * 64) *(LAS v4u*)(L + M_CT + 16 * e) = (v4u){z0, z0, z0, z0};
    { LAS float* TB = (LAS float*)(L + M_TB); LAS float* CS = (LAS float*)(L + M_CS);
      float gl[5], gf[5];
#pragma unroll
      for (int k = 0; k < 5; ++k) { const int cc = wave + 8 * k; const int t0_ = cc == 0 ? 0 : 16 + 64 * (cc - 1), nv_ = cc == 0 ? 16 : 64;
          if (cc < 33 && lane < nv_) { const float* gr = P.G + ((size_t)b * LP + t0_ + lane) * 8; gl[k] = gr[h]; gf[k] = gr[4 + h]; } else { gl[k] = 0.f; gf[k] = 0.f; } }
#pragma unroll
      for (int k = 0; k < 5; ++k) { const int cc = wave + 8 * k; const int nv_ = cc == 0 ? 16 : 64;
          if (cc < 33) { const float li = lane < nv_ ? gate_i(gl[k]) : -1e30f, lf = lane < nv_ ? gate_f(gf[k]) : 0.f;
              const float bcum = wave_scan_add(lf, lane), wj = li - bcum, cm = wave_scan_max(wj, lane);
              TB[cc * 192 + lane] = bcum; TB[cc * 192 + 64 + lane] = wj; TB[cc * 192 + 128 + lane] = cm;
              if (lane == 63) { CS[2 * cc] = bcum; CS[2 * cc + 1] = cm; } } }
    }
    LDS_BAR();
    if (wave == 0) {
        const LAS float* CS = (const LAS float*)(L + M_CS);
        const float bl = lane < 33 ? CS[2 * lane] : 0.f, cx = lane < 33 ? CS[2 * lane + 1] : 0.f;
        float mrun = 0.f, ms = 0.f, mx = 0.f;
#pragma unroll 1
        for (int k = 0; k < 33; ++k) { const float blk = __builtin_bit_cast(float, __builtin_amdgcn_readlane(__builtin_bit_cast(int, bl), k)), cxk = __builtin_bit_cast(float, __builtin_amdgcn_readlane(__builtin_bit_cast(int, cx), k));
            const float mxk = fmaxf(mrun, cxk); if (lane == k) { ms = mrun; mx = mxk; } mrun = blk + mxk; }
        if (lane == 33) { ms = mrun; mx = mrun; }
        if (lane < 34) { ((LAS float*)(L + M_MS))[lane] = ms; ((LAS float*)(L + M_MX))[lane] = mx; }
    }
    f32x4 cacc[6];
#pragma unroll
    for (int i = 0; i < 6; ++i) cacc[i] = (f32x4){0.f, 0.f, 0.f, 0.f};
    const int srow = lane, spiece = wave, vpiece = wave & 3;
    v4u aq0, aq1, ak0, ak1, av, bq0, bq1, bk0, bk1, bv;
    v2u po0 = {z0, z0}, po1 = {z0, z0};
#define ML_LOAD(ch, q0, q1, k0, k1, vv) do { const int t0_ = (ch) == 0 ? 0 : 16 + 64 * ((ch) - 1), nv_ = (ch) == 0 ? 16 : 64; \
        if (srow < nv_) { const bf16* zr = P.Z + ((size_t)b * LP + t0_ + srow) * NIN + h * MDK + 16 * spiece; q0 = *(const GAS v4u*)zr; q1 = *(const GAS v4u*)(zr + 8); k0 = *(const GAS v4u*)(zr + 512); k1 = *(const GAS v4u*)(zr + 520); } \
        else { q0 = q1 = k0 = k1 = (v4u){z0, z0, z0, z0}; } \
        if (wave < 4 && srow < nv_) vv = *(const GAS v4u*)(P.Z + ((size_t)b * LP + t0_ + srow) * NIN + 1024 + h * MDV + VS * sl + 8 * vpiece); else vv = (v4u){z0, z0, z0, z0}; } while (0)
#define ML_OLOAD(ch) do { const int t0_ = (ch) == 0 ? 0 : 16 + 64 * ((ch) - 1), nv_ = (ch) == 0 ? 16 : 64; const int trow_ = 16 * wave + c; \
        if (wave < 4 && trow_ < nv_) { const bf16* zo = P.Z + ((size_t)b * LP + t0_ + trow_) * NIN + 2048 + h * MDV + VS * sl + 4 * g; po0 = *(const GAS v2u*)zo; po1 = *(const GAS v2u*)(zo + 16); } } while (0)
    ML_LOAD(0, aq0, aq1, ak0, ak1, av); ML_LOAD(1, bq0, bq1, bk0, bk1, bv); ML_OLOAD(0);
    LDS_BAR();
#define ML_STEP(ch, q0, q1, k0, k1, vv) do { \
        const int t0 = (ch) == 0 ? 0 : 16 + 64 * ((ch) - 1), nvalid = (ch) == 0 ? 16 : 64, cur = (ch) & 1; \
        const float m_prev = ((const LAS float*)(L + M_MS))[ch], Mx = ((const LAS float*)(L + M_MX))[ch]; \
        const float wk = __expf(((const LAS float*)(L + M_TB))[(ch) * 192 + 64 + lane] - Mx), a = __expf(m_prev - Mx); \
          \
        *(LAS v4u*)(L + M_QS + srow * M_RS + 32 * spiece) = q0; *(LAS v4u*)(L + M_QS + srow * M_RS + 32 * spiece + 16) = q1; \
        *(LAS v4u*)(L + M_KS + srow * M_RS + 32 * spiece) = k0; *(LAS v4u*)(L + M_KS + srow * M_RS + 32 * spiece + 16) = k1; \
        { const unsigned kw[8] = {k0.x, k0.y, k0.z, k0.w, k1.x, k1.y, k1.z, k1.w}; \
          _Pragma("unroll") for (int e = 0; e < 8; ++e) { *(LAS unsigned short*)(L + M_KT + (16 * spiece + 2 * e) * M_TS + 2 * srow) = (unsigned short)(kw[e] & 0xffffu); *(LAS unsigned short*)(L + M_KT + (16 * spiece + 2 * e + 1) * M_TS + 2 * srow) = (unsigned short)(kw[e] >> 16); } } \
        if (wave < 4) { float vf[8]; unpack8(vv, vf); const unsigned vw_[4] = {vv.x, vv.y, vv.z, vv.w}; \
            _Pragma("unroll") for (int e = 0; e < 4; ++e) { *(LAS unsigned short*)(L + M_VT + (8 * vpiece + 2 * e) * M_TS + 2 * srow) = (unsigned short)(vw_[e] & 0xffffu); *(LAS unsigned short*)(L + M_VT + (8 * vpiece + 2 * e + 1) * M_TS + 2 * srow) = (unsigned short)(vw_[e] >> 16); } \
            _Pragma("unroll") for (int e = 0; e < 8; ++e) *(LAS unsigned short*)(L + M_VW + (8 * vpiece + e) * M_TS + 2 * srow) = (unsigned short)f2bf(vf[e] * wk); } \
        if (wave == 4) *(LAS unsigned short*)(L + M_VW + 32 * M_TS + 2 * lane) = (unsigned short)f2bf(wk); \
        LDS_BAR(); \
        if ((ch) + 2 < 33) ML_LOAD((ch) + 2, q0, q1, k0, k1, vv); \
        if (wave < 4) { \
            const int tt = wave, trow = 16 * tt + c; \
            bf16x8 Bq[4]; \
            _Pragma("unroll") for (int ks = 0; ks < 4; ++ks) Bq[ks] = *(const LAS bf16x8*)(L + M_QS + trow * M_RS + 64 * ks + 16 * g); \
            const LAS float* tb = (const LAS float*)(L + M_TB) + (ch) * 192; \
            const float bct = tb[trow], Mt = fmaxf(m_prev, tb[128 + trow]), ut = -Mt, wint = __expf(m_prev - Mt), einv = __expf(-(bct + Mt)); \
            f32x4 s[4]; \
            _Pragma("unroll") for (int jt = 0; jt < 4; ++jt) { \
                if (jt <= tt) { \
                    f32x4 acc = {0.f, 0.f, 0.f, 0.f}; \
                    _Pragma("unroll") for (int ks = 0; ks < 4; ++ks) acc = mfma16(*(const LAS bf16x8*)(L + M_KS + (16 * jt + c) * M_RS + 64 * ks + 16 * g), Bq[ks], acc); \
                    const f32x4 wjj = *(const LAS f32x4*)(tb + 64 + 16 * jt + 4 * g); \
                    _Pragma("unroll") for (int r = 0; r < 4; ++r) { const int j = 16 * jt + 4 * g + r; acc[r] = (j <= trow) ? acc[r] * __expf(ut + wjj[r]) : 0.f; } \
                    s[jt] = acc; \
                } else s[jt] = (f32x4){0.f, 0.f, 0.f, 0.f}; \
            } \
            bf16x8 Bs[2]; \
            _Pragma("unroll") for (int k2 = 0; k2 < 2; ++k2) { v4u w; w.x = pk2(s[2 * k2][0], s[2 * k2][1]); w.y = pk2(s[2 * k2][2], s[2 * k2][3]); w.z = pk2(s[2 * k2 + 1][0], s[2 * k2 + 1][1]); w.w = pk2(s[2 * k2 + 1][2], s[2 * k2 + 1][3]); Bs[k2] = __builtin_bit_cast(bf16x8, w); } \
            f32x4 nm[3]; \
            _Pragma("unroll") for (int vt = 0; vt < 3; ++vt) { \
                f32x4 acc = {0.f, 0.f, 0.f, 0.f}; \
                _Pragma("unroll") for (int ks = 0; ks < 4; ++ks) acc = mfma16(*(const LAS bf16x8*)(L + M_CT + cur * M_CTB + (16 * vt + c) * M_RS + 64 * ks + 16 * g), Bq[ks], acc); \
                acc = acc * wint; \
                _Pragma("unroll") for (int k2 = 0; k2 < 2; ++k2) { \
                    if (2 * k2 <= tt) { const LAS unsigned char* vp = L + M_VT + (16 * vt + c) * M_TS + (32 * k2 + 4 * g) * 2; const v2u lo = *(const LAS v2u*)vp, hi = *(const LAS v2u*)(vp + 32); const v4u av_ = {lo.x, lo.y, hi.x, hi.y}; \
                        acc = mfma16(__builtin_bit_cast(bf16x8, av_), Bs[k2], acc); } \
                } \
                nm[vt] = acc; \
            } \
            const float den = pg8::shl_from(nm[2][0], c); \
            const float inv = 1.0f / fmaxf(fabsf(den), einv); \
            float hss = 0.f; \
            _Pragma("unroll") for (int vt = 0; vt < 2; ++vt) _Pragma("unroll") for (int r = 0; r < 4; ++r) { nm[vt][r] *= inv; hss += nm[vt][r] * nm[vt][r]; } \
            hss += pg8::shx(hss, 16, lane); hss += pg8::shx(hss, 32, lane); \
            if (trow < nvalid) { \
                const size_t grow = (size_t)b * LP + t0 + trow; \
                _Pragma("unroll") for (int vt = 0; vt < 2; ++vt) { const int col = h * MDV + VS * sl + 16 * vt + 4 * g; \
                    const v2u ow = vt == 0 ? po0 : po1; const f32x4 gn = *(const f32x4*)(P.gnorm + col); \
                    v2u w; w.x = pk2(sigmoidf_(bf_lo(ow.x)) * gn[0] * nm[vt][0], sigmoidf_(bf_hi(ow.x)) * gn[1] * nm[vt][1]); w.y = pk2(sigmoidf_(bf_lo(ow.y)) * gn[2] * nm[vt][2], sigmoidf_(bf_hi(ow.y)) * gn[3] * nm[vt][3]); \
                    *(GAS v2u*)(P.AO + grow * D + col) = w; } \
                if (g == 0) P.HSS[grow * 32 + h * 8 + sl] = hss; \
            } \
            if ((ch) + 1 < 33) ML_OLOAD((ch) + 1); \
        } else { \
            const int w4 = wave - 4, nxt = cur ^ 1; \
            _Pragma("unroll") for (int i = 0; i < 6; ++i) cacc[i] = cacc[i] * a; \
            _Pragma("unroll") for (int k2 = 0; k2 < 2; ++k2) { \
                bf16x8 Bv[3]; \
                _Pragma("unroll") for (int vt = 0; vt < 3; ++vt) Bv[vt] = *(const LAS bf16x8*)(L + M_VW + (16 * vt + c) * M_TS + 64 * k2 + 16 * g); \
                _Pragma("unroll") for (int dd = 0; dd < 2; ++dd) { const bf16x8 Ak = *(const LAS bf16x8*)(L + M_KT + (16 * (2 * w4 + dd) + c) * M_TS + 64 * k2 + 16 * g); \
                    _Pragma("unroll") for (int vt = 0; vt < 3; ++vt) cacc[dd * 3 + vt] = mfma16(Ak, Bv[vt], cacc[dd * 3 + vt]); } \
            } \
            _Pragma("unroll") for (int dd = 0; dd < 2; ++dd) _Pragma("unroll") for (int vt = 0; vt < 3; ++vt) { const f32x4 v = cacc[dd * 3 + vt]; v2u w; w.x = pk2(v[0], v[1]); w.y = pk2(v[2], v[3]); \
                    *(LAS v2u*)(L + M_CT + nxt * M_CTB + (16 * vt + c) * M_RS + (16 * (2 * w4 + dd) + 4 * g) * 2) = w; } \
        } \
        LDS_BAR(); } while (0)
#pragma unroll 1
    for (int ch = 0; ch < 33; ch += 2) {
        ML_STEP(ch, aq0, aq1, ak0, ak1, av);
        if (ch + 1 < 33) ML_STEP(ch + 1, bq0, bq1, bk0, bk1, bv);
    }
#undef ML_STEP
#undef ML_LOAD
#undef ML_OLOAD
    if (wave >= 4) {
        const int w4 = wave - 4; const size_t sb = ((size_t)jl * NB + b) * MH + h;
#pragma unroll
        for (int dd = 0; dd < 2; ++dd) {
#pragma unroll
            for (int vt = 0; vt < 2; ++vt)
#pragma unroll
                for (int r = 0; r < 4; ++r) out[O_CP + (sb * MDK + 16 * (2 * w4 + dd) + 4 * g + r) * MDV + VS * sl + 16 * vt + c] = cacc[dd * 3 + vt][r];
            if (sl == 0 && c == 0) {
#pragma unroll
                for (int r = 0; r < 4; ++r) out[O_NP + sb * MDK + 16 * (2 * w4 + dd) + 4 * g + r] = cacc[dd * 3 + 2][r]; }
        }
        if (sl == 0 && wave == 4 && lane == 0) out[O_MP + sb] = ((const LAS float*)(L + M_MS))[33];
    }
    LDS_BAR();
}
constexpr int S_Q = 0, S_K = 2048, S_V = 4096, S_P = 8192, S_M = 40960, S_END = 41472;
__device__ __forceinline__ void mlstm_sample_item(LAS unsigned char* L, const MlP& P, const float* stC, const float* stN, const float* stM, float* out, int jl, int db, int h, int tid, int wave, int lane) {
    LAS float* SQ = (LAS float*)(L + S_Q); LAS float* SK = (LAS float*)(L + S_K); LAS float* SV = (LAS float*)(L + S_V); LAS float* SP = (LAS float*)(L + S_P); LAS float* SM = (LAS float*)(L + S_M);
    const size_t r0 = (size_t)MP + db * DSEQ; const size_t sb = ((size_t)jl * DBATCH + db) * MH + h;
    { const int s = tid >> 7, d = tid & 127; const bf16* zr = P.Z + (r0 + s) * NIN; SQ[s * 128 + d] = bf1(zr[h * MDK + d]); SK[s * 128 + d] = bf1(zr[512 + h * MDK + d]);
      SV[s * 256 + 2 * d] = bf1(zr[1024 + h * MDV + 2 * d]); SV[s * 256 + 2 * d + 1] = bf1(zr[1024 + h * MDV + 2 * d + 1]); }
    float li[4], lf[4], bc[4], wjv[4], Mt[4];
#pragma unroll
    for (int s = 0; s < 4; ++s) { li[s] = gate_i(P.G[(r0 + s) * 8 + h]); lf[s] = gate_f(P.G[(r0 + s) * 8 + 4 + h]); }
    const float m0 = stM[sb];
    { float acc = 0.f, cmx = -1e30f;
#pragma unroll
      for (int s = 0; s < 4; ++s) { acc += lf[s]; bc[s] = acc; wjv[s] = li[s] - acc; cmx = fmaxf(cmx, wjv[s]); Mt[s] = fmaxf(m0, cmx); } }
    const float Mx = Mt[3], blast = bc[3], m_new = blast + Mx, a = __expf(m0 - Mx);
    float wk[4];
#pragma unroll
    for (int s = 0; s < 4; ++s) wk[s] = __expf(wjv[s] - Mx);
    LDS_BAR();
    if (wave == 0) { const int p = lane >> 2, qd = lane & 3, t = p >> 2, j = p & 3; float acc = 0.f;
        for (int d = 0; d < 32; ++d) acc += SQ[t * 128 + 32 * qd + d] * SK[j * 128 + 32 * qd + d];
        acc += pg8::shx(acc, 1, lane); acc += pg8::shx(acc, 2, lane);
        const float Mtt = t == 0 ? Mt[0] : t == 1 ? Mt[1] : t == 2 ? Mt[2] : Mt[3], wjj = j == 0 ? wjv[0] : j == 1 ? wjv[1] : j == 2 ? wjv[2] : wjv[3];
        if (qd == 0) SM[p] = (j <= t) ? acc * __expf(wjj - Mtt) : 0.f; }
    if (wave == 1) { const int t = lane >> 4, part = lane & 15; float acc = 0.f;
        for (int d = 0; d < 8; ++d) acc += SQ[t * 128 + 8 * part + d] * stN[sb * MDK + 8 * part + d];
        acc += pg8::shx(acc, 1, lane); acc += pg8::shx(acc, 2, lane); acc += pg8::shx(acc, 4, lane); acc += pg8::shx(acc, 8, lane);
        if (part == 0) SM[16 + t] = acc; }
    { const int vq = tid & 63, dg = tid >> 6; const float* c0p = stC + sb * MDK * MDV; float* c1p = out + O_CS + sb * MDK * MDV;
      f32x4 vj[4];
#pragma unroll
      for (int j = 0; j < 4; ++j) vj[j] = *(const LAS f32x4*)(SV + j * 256 + 4 * vq);
      f32x4 acc[4];
#pragma unroll
      for (int t = 0; t < 4; ++t) acc[t] = (f32x4){0.f, 0.f, 0.f, 0.f};
#pragma unroll 8
      for (int i = 0; i < 16; ++i) { const int dk = 16 * dg + i; const f32x4 c0 = *(const GAS f32x4*)(c0p + (size_t)dk * MDV + 4 * vq);
          f32x4 cn = c0 * a;
#pragma unroll
          for (int t = 0; t < 4; ++t) { acc[t] += c0 * SQ[t * 128 + dk]; cn += vj[t] * (wk[t] * SK[t * 128 + dk]); }
          *(GAS f32x4*)(c1p + (size_t)dk * MDV + 4 * vq) = cn; }
#pragma unroll
      for (int t = 0; t < 4; ++t) *(LAS f32x4*)(SP + (dg * 4 + t) * 256 + 4 * vq) = acc[t];
    }
    if (tid < 128) { float nn = a * stN[sb * MDK + tid];
#pragma unroll
        for (int j = 0; j < 4; ++j) nn += wk[j] * SK[j * 128 + tid];
        out[O_NS + sb * MDK + tid] = nn; }
    if (tid == 0) out[O_MS + sb] = m_new;
    LDS_BAR();
    if (tid < 256) { const int v = tid; float hv[4];
#pragma unroll
        for (int t = 0; t < 4; ++t) { float qc = 0.f;
#pragma unroll
            for (int dg = 0; dg < 8; ++dg) qc += SP[(dg * 4 + t) * 256 + v];
            const float wint = __expf(m0 - Mt[t]); float num = wint * qc, den = wint * SM[16 + t];
#pragma unroll
            for (int j = 0; j < 4; ++j) { const float sc = SM[t * 4 + j]; num += sc * SV[j * 256 + v]; den += sc; }
            hv[t] = num / fmaxf(fabsf(den), __expf(-(bc[t] + Mt[t]))); }
#pragma unroll
        for (int t = 0; t < 4; ++t) { const float q = wave_sum(hv[t] * hv[t], lane); if (lane == 0) SM[32 + wave * 4 + t] = q; }
        const float gn = P.gnorm[h * MDV + v];
#pragma unroll
        for (int t = 0; t < 4; ++t) { const float o = bf1(P.Z[(r0 + t) * NIN + 2048 + h * MDV + v]); P.AO[(r0 + t) * D + h * MDV + v] = (bf16)f2bf(sigmoidf_(o) * gn * hv[t]); }
    }
    LDS_BAR();
    if (tid < 32) { const int t = tid >> 3, slot = tid & 7; P.HSS[(r0 + t) * 32 + h * 8 + slot] = (slot == 0) ? (SM[32 + t] + SM[36 + t]) + (SM[40 + t] + SM[44 + t]) : 0.f; }
    LDS_BAR();
}
__device__ __forceinline__ void mlstm_phase(LAS unsigned char* L, const MlP& P, const float* stC, const float* stN, const float* stM, float* out, int jl, int vcu, int G, int tid_in, int wave_in, int lane_in) {
    constexpr int N_PROMPT = NB * MH * NSL, N_ITEMS = N_PROMPT + DBATCH * MH;
#pragma unroll 1
    for (int it = vcu; it < N_ITEMS; it += G) {
        int tid = tid_in; asm volatile("" : "+v"(tid));
        const int lane = tid & 63, wave = __builtin_amdgcn_readfirstlane(tid >> 6);
        if (it < N_PROMPT) { const int bh = it / NSL, sl = it % NSL; mlstm_prompt_item(L, P, out, jl, bh / MH, bh % MH, sl, tid, wave, lane); }
        else { const int si = it - N_PROMPT; mlstm_sample_item(L, P, stC, stN, stM, out, jl, si / MH, si % MH, tid, wave, lane); }
    }
}
__device__ __forceinline__ void mlstm_fixup(bf16* AO, const float* HSS, int vcu, int G, int wave, int lane) {
    const int gw = vcu * NWAVES + wave, NGW = G * NWAVES;
    for (int m = gw; m < MTOT; m += NGW) {
        const int hd = lane >> 4; const f32x4 a = *(const GAS f32x4*)(HSS + (size_t)m * 32 + hd * 8), bq = *(const GAS f32x4*)(HSS + (size_t)m * 32 + hd * 8 + 4);
        const float r = 1.0f / sqrtf((((a[0] + a[1]) + (a[2] + a[3])) + ((bq[0] + bq[1]) + (bq[2] + bq[3]))) * (1.0f / 256.0f) + EPS);
        GAS v4u* p = (GAS v4u*)(AO + (size_t)m * D + 16 * lane);
#pragma unroll
        for (int i = 0; i < 2; ++i) { float f[8]; unpack8(p[i], f);
#pragma unroll
            for (int e = 0; e < 8; ++e) f[e] *= r;
            p[i] = pack8(f); }
    }
}

struct Args { const float* in[23]; float* out; unsigned char* ws; };
constexpr int PTAB_OFF = LDSCTL_OFF + 1024;
__device__ __forceinline__ unsigned long long ld_ptr(volatile LAS unsigned* T, int i) {
    const unsigned lo = __builtin_amdgcn_readfirstlane(T[2 * i]), hi = __builtin_amdgcn_readfirstlane(T[2 * i + 1]);
    return ((unsigned long long)hi << 32) | lo;
}
constexpr int CHAIN_OFF = LDSCTL_OFF + 2048;
constexpr int CW_CNT = 16384, CW_HEAD = CW_CNT + 6 * 67 * 64;
static_assert((CW_HEAD + 21 * 8 * 64) * 4 <= (int)CTL_ZERO_BYTES, "control words inside the memset region");
__device__ __forceinline__ void put64(volatile LAS unsigned* c, int i, const void* p) { const unsigned long long v = (unsigned long long)p; c[i] = (unsigned)v; c[i + 1] = (unsigned)(v >> 32); }
__device__ __forceinline__ void chain_common(volatile LAS unsigned* c, unsigned char* ws, float* out, int nseg, int n0, int n1, int n2, int n3, int head_idx, int zldc, const float* bgate) {
    c[pg8::CC + 0] = (unsigned)nseg; c[pg8::CC + 1] = 0u; put64(c, pg8::CC + 2, (unsigned*)(ws + WS_CTL) + CW_HEAD + 64 * 8 * head_idx);
    put64(c, pg8::CC + 4, ws + WS_X); put64(c, pg8::CC + 6, ws + WS_XB); put64(c, pg8::CC + 8, ws + WS_SS); put64(c, pg8::CC + 10, ws + WS_Z); put64(c, pg8::CC + 12, ws + WS_FF);
    put64(c, pg8::CC + 14, ws + WS_G); put64(c, pg8::CC + 16, bgate); put64(c, pg8::CC + 18, out + O_YP); put64(c, pg8::CC + 20, out + O_YS); c[pg8::CC + 22] = (unsigned)zldc;
    put64(c, pg8::CC + 30, ws + WS_PT);
    c[pg8::CCUM + 0] = 0u; c[pg8::CCUM + 1] = (unsigned)n0; c[pg8::CCUM + 2] = (unsigned)(n0 + n1); c[pg8::CCUM + 3] = (unsigned)(n0 + n1 + n2); c[pg8::CCUM + 4] = (unsigned)(n0 + n1 + n2 + n3);
}
__device__ __forceinline__ void chain_seg(volatile LAS unsigned* c, int s, const void* A, const void* Bt, int K, int nN, int kind, int first, unsigned need, const unsigned* dep, const unsigned* done, int ld = 0, int lpoff = 0, int cap = 9, int nsub = 1) {
    put64(c, 16 * s + 0, A); put64(c, 16 * s + 2, Bt); c[16 * s + 4] = (unsigned)K; c[16 * s + 5] = (unsigned)nN; c[16 * s + 6] = (unsigned)kind; c[16 * s + 7] = (unsigned)first; c[16 * s + 8] = need;
    c[16 * s + 9] = (unsigned)(ld ? ld : K); put64(c, 16 * s + 10, dep); put64(c, 16 * s + 12, done); c[16 * s + 14] = (unsigned)lpoff | ((unsigned)cap << 8) | ((unsigned)nsub << 16);
}
__device__ __forceinline__ void chain_totals(volatile LAS unsigned* c, int nseg) {
    unsigned t8 = 0u, t9 = 0u;
    for (int s = 0; s < nseg; ++s) { const unsigned w = c[16 * s + 14]; const int lpoff = (int)(w & 0xffu), cap = (int)((w >> 8) & 0xffu), nsub = (int)(w >> 16), nN = (int)c[16 * s + 5];
        int a = 8 - lpoff; a = a < 0 ? 0 : (a > cap ? cap : a); int b = 9 - lpoff; b = b < 0 ? 0 : (b > cap ? cap : b); t8 += (unsigned)(a * nN * nsub); t9 += (unsigned)(b * nN * nsub); }
    c[pg8::CC + 1] = t8; c[pg8::CC + 23] = t9;
}
__device__ __forceinline__ void down_tail_finalize(unsigned char* ws, float* out, bool final_layer, int vcu, int G, int wave, int lane) {
    const int gw = vcu * NWAVES + wave, NGW = G * NWAVES;
    float* X = (float*)(ws + WS_X); bf16* XB = (bf16*)(ws + WS_XB); float* SS = (float*)(ws + WS_SS); const float* P = (const float*)(ws + WS_PT);
    for (int r = gw; r < 768; r += NGW) { const int m = 16384 + r;
        f32x4 v[4]; float ss[4];
#pragma unroll
        for (int j = 0; j < 4; ++j) { v[j] = ((const GAS f32x4*)(X + (size_t)m * D))[lane + 64 * j];
#pragma unroll
            for (int kq = 0; kq < 4; ++kq) v[j] = v[j] + ((const GAS f32x4*)(P + ((size_t)kq * 768 + r) * D))[lane + 64 * j]; }
        if (!final_layer) {
#pragma unroll
            for (int j = 0; j < 4; ++j) { ss[j] = wave_sum((v[j][0] * v[j][0] + v[j][1] * v[j][1]) + (v[j][2] * v[j][2] + v[j][3] * v[j][3]), lane);
                ((GAS f32x4*)(X + (size_t)m * D))[lane + 64 * j] = v[j]; v2u w; w.x = pk2(v[j][0], v[j][1]); w.y = pk2(v[j][2], v[j][3]); ((GAS v2u*)(XB + (size_t)m * D))[lane + 64 * j] = w; }
            if (lane < 16) { const int j = lane >> 2; const float s = (lane & 3) ? 0.f : (j == 0 ? ss[0] : j == 1 ? ss[1] : j == 2 ? ss[2] : ss[3]); SS[(size_t)m * 16 + lane] = s; }
        } else {
            float* dst = nullptr;
            if (m < MP) { const int b = m / LP, t = m - b * LP; if (t >= NMETA) dst = out + O_YP + ((size_t)b * SEQ + (t - NMETA)) * D; }
            else if (m < MTOT) dst = out + O_YS + (size_t)(m - MP) * D;
            if (dst) {
#pragma unroll
                for (int j = 0; j < 4; ++j) ((GAS f32x4*)dst)[lane + 64 * j] = v[j]; }
        }
    }
}
__global__ void __launch_bounds__(NWAVES * 64, 2) hybrid_fwd(Args args) {
    extern __shared__ __attribute__((aligned(16))) unsigned char lds_raw[];
    LAS unsigned char* lds = (LAS unsigned char*)lds_raw;
    volatile LAS unsigned* MISC = (volatile LAS unsigned*)(lds + MISC_OFF);
    const int wave_s = __builtin_amdgcn_readfirstlane((int)threadIdx.x >> 6);
#define GG_ g_o
#define BX_ b_o
#define OPQ_GB() int g_o = (int)gridDim.x, b_o = (int)blockIdx.x; asm volatile("" : "+s"(g_o), "+s"(b_o))
#define VCU_ ((BX_ & 7) * (GG_ >> 3) + (BX_ >> 3))
    for (int u = (int)threadIdx.x; u < (LDS_BYTES - LDSCTL_OFF) / 4; u += NWAVES * 64) ((LAS unsigned*)(lds + LDSCTL_OFF))[u] = 0u;
    __syncthreads();
    volatile LAS unsigned* PT = (volatile LAS unsigned*)(lds + PTAB_OFF);
    if (threadIdx.x == 0) {
#pragma unroll
        for (int i = 0; i < 23; ++i) { const unsigned long long p = (unsigned long long)args.in[i]; PT[2 * i] = (unsigned)p; PT[2 * i + 1] = (unsigned)(p >> 32); }
        { const unsigned long long p = (unsigned long long)args.out; PT[46] = (unsigned)p; PT[47] = (unsigned)(p >> 32); }
        { const unsigned long long p = (unsigned long long)args.ws; PT[48] = (unsigned)p; PT[49] = (unsigned)(p >> 32); }
    }
    __syncthreads();
#define OPAQUE_TID() int tid_p; asm volatile("v_mbcnt_lo_u32_b32 %0, -1, 0\n\tv_mbcnt_hi_u32_b32 %0, -1, %0\n\tv_lshl_add_u32 %0, %1, 6, %0" : "=&v"(tid_p) : "s"(wave_s)); const int lane_p = tid_p & 63, wave_p = __builtin_amdgcn_readfirstlane(tid_p >> 6)
#define PIN(i) ((const float*)(const GAS float*)ld_ptr(PT, (i)))
#define POUT() ((float*)(GAS float*)ld_ptr(PT, 23))
#define PWS() ((unsigned char*)(GAS unsigned char*)ld_ptr(PT, 24))
    (void)xcd_barrier_post((unsigned*)((gu32*)(PWS() + WS_CTL) + CW_BAR), MISC + 8);
#define GRID_BAR() do { XcdBarrier b_; b_.bar = (unsigned*)((gu32*)(PWS() + WS_CTL) + CW_BAR); b_.x = xb_xcc_id(); b_.st = MISC + 8; xcd_barrier(b_); } while (0)

    { OPAQUE_TID(); OPQ_GB(); P0Args A{PIN(0), PIN(1), PIN(7), PIN(9), PIN(10), PIN(11), PIN(15), PIN(16), PIN(17), PIN(20), PIN(21), PIN(22), PWS()};
#ifndef NO_P0
      p0_prologue(A, lds, VCU_, GG_, wave_p, lane_p, tid_p);
#ifdef PROBE_P02
      GRID_BAR();
      p0_prologue(A, lds, VCU_, GG_, wave_p, lane_p, tid_p);
#endif
#endif
    }
    GRID_BAR();
    volatile LAS unsigned* CH = (volatile LAS unsigned*)(lds + CHAIN_OFF);
#pragma unroll 1
    for (;;) {
        int ito = MISC_OFF + 48; asm volatile("" : "+s"(ito)); volatile LAS unsigned* itp = (volatile LAS unsigned*)(lds + ito);
        const int it = (int)__builtin_amdgcn_readfirstlane(*itp);
        if (it > 4) break;
        const int layer = it - 1, jl = layer >> 1;
        if (it >= 1) {
            if ((layer & 1) == 0) {
                { OPAQUE_TID(); OPQ_GB(); unsigned char* ws = PWS(); AttnP P{(const bf16*)(ws + WS_Z), PIN(12) + jl * AHD, PIN(13) + jl * AHD, PIN(14) + jl * AH, PIN(8), (bf16*)(ws + WS_AO)};
#ifndef NO_ATTN
                  attn_phase(lds + RING_OFF, P, PIN(2), PIN(3), POUT(), jl, VCU_, GG_, tid_p, wave_p, lane_p);
#ifdef PROBE_ATTN2
                  GRID_BAR();
                  attn_phase(lds + RING_OFF, P, PIN(2), PIN(3), POUT(), jl, VCU_, GG_, tid_p, wave_p, lane_p);
#endif
#endif
                }
                GRID_BAR();
            } else {
                { OPAQUE_TID(); OPQ_GB(); unsigned char* ws = PWS(); MlP P{(const bf16*)(ws + WS_Z), (const float*)(ws + WS_G), PIN(19) + jl * D, (bf16*)(ws + WS_AO), (float*)(ws + WS_HSS)};
#ifndef NO_MLSTM
                  mlstm_phase(lds + RING_OFF, P, PIN(4), PIN(5), PIN(6), POUT(), jl, VCU_, GG_, tid_p, wave_p, lane_p);
#ifdef PROBE_MLSTM2
                  GRID_BAR();
                  mlstm_phase(lds + RING_OFF, P, PIN(4), PIN(5), PIN(6), POUT(), jl, VCU_, GG_, tid_p, wave_p, lane_p);
#endif
#endif
                }
                GRID_BAR();
                { OPAQUE_TID(); OPQ_GB(); unsigned char* ws = PWS(); mlstm_fixup((bf16*)(ws + WS_AO), (const float*)(ws + WS_HSS), VCU_, GG_, wave_p, lane_p); }
                GRID_BAR();
            }
        }
#define RUN_CHAIN(SETUP) do { OPAQUE_TID(); if (tid_p == 0) { unsigned char* ws = PWS(); SETUP } __syncthreads(); pg8::gemm_chain(lds + RING_OFF, CH, tid_p); } while (0)
        if (it == 0) {
            RUN_CHAIN( chain_common(CH, ws, POUT(), 1, 6, 0, 0, 0, 4 * 3 + 0, NQKV, nullptr);
                       chain_seg(CH, 0, ws + WS_XB, ws + WS_WQKV, D, 6, pg8::CK_NORM, 0, 0u, nullptr, nullptr); chain_totals(CH, 1); );
        } else {
            RUN_CHAIN( chain_common(CH, ws, POUT(), 1, 4, 0, 0, 0, layer * 3 + 0, NQKV, nullptr);
                       chain_seg(CH, 0, ws + WS_AO, (layer & 1) ? ws + WS_WOUT + jl * SZ_WO : ws + WS_WO + jl * SZ_WO, D, 4, pg8::CK_RESID, 0, 0u, nullptr, nullptr); chain_totals(CH, 1); );
            GRID_BAR();
            RUN_CHAIN( chain_common(CH, ws, POUT(), 1, 16, 0, 0, 0, layer * 3 + 1, NQKV, nullptr);
                       chain_seg(CH, 0, ws + WS_XB, ws + WS_WUP + layer * SZ_WUP, D, 16, pg8::CK_UP, 0, 0u, nullptr, nullptr); chain_totals(CH, 1); );
            GRID_BAR();
            RUN_CHAIN( chain_common(CH, ws, POUT(), 2, 4, 4, 0, 0, 13 + layer, NQKV, nullptr);
                       chain_seg(CH, 0, ws + WS_FF, ws + WS_WDN + layer * SZ_WUP, FF, 4, layer < 3 ? pg8::CK_RESID : pg8::CK_FINAL, 0, 0u, nullptr, nullptr, FF, 0, 8, 1);
                       chain_seg(CH, 1, ws + WS_FF, ws + WS_WDN + layer * SZ_WUP, D, 4, pg8::CK_PART, 0, 0u, nullptr, nullptr, FF, 8, 1, 4);
                       chain_totals(CH, 2); );
            GRID_BAR();
            { OPAQUE_TID(); OPQ_GB(); down_tail_finalize(PWS(), POUT(), layer == 3, VCU_, GG_, wave_p, lane_p); }
            if (layer < 3) {
                GRID_BAR();
                const int nl = layer + 1, njl = nl >> 1; const bool nml = (nl & 1) != 0;
                RUN_CHAIN( chain_common(CH, ws, POUT(), 1, nml ? 13 : 6, 0, 0, 0, layer * 3 + 2, nml ? NIN : NQKV, nml ? PIN(18) + njl * 8 : nullptr);
                           chain_seg(CH, 0, ws + WS_XB, nml ? ws + WS_WIN + njl * SZ_WIN : ws + WS_WQKV + njl * SZ_WQKV, D, nml ? 13 : 6, nml ? pg8::CK_NORM_GATES : pg8::CK_NORM, 0, 0u, nullptr, nullptr); chain_totals(CH, 1); );
#ifdef PROBE_INPROJ2
                GRID_BAR();
                RUN_CHAIN( chain_common(CH, ws, POUT(), 1, nml ? 13 : 6, 0, 0, 0, 16 + layer, nml ? NIN : NQKV, nml ? PIN(18) + njl * 8 : nullptr);
                           chain_seg(CH, 0, ws + WS_XB, nml ? ws + WS_WIN + njl * SZ_WIN : ws + WS_WQKV + njl * SZ_WQKV, D, nml ? 13 : 6, nml ? pg8::CK_NORM_GATES : pg8::CK_NORM, 0, 0u, nullptr, nullptr); );
#endif
            }
#ifdef PROBE_DOWN_SPLIT
            if (layer == 0) { GRID_BAR();
                RUN_CHAIN( chain_common(CH, ws, POUT(), 2, 4, 4, 0, 0, 20, NQKV, nullptr);
                       chain_seg(CH, 0, ws + WS_FF, ws + WS_WDN + layer * SZ_WUP, FF, 4, pg8::CK_FINAL, 0, 0u, nullptr, nullptr, FF, 0, 8, 1);
                       chain_seg(CH, 1, ws + WS_FF, ws + WS_WDN + layer * SZ_WUP, D, 4, pg8::CK_PART, 0, 0u, nullptr, nullptr, FF, 8, 1, 4);
                       chain_totals(CH, 2); ); }
#endif
#ifdef PROBE_DOWN_WHOLE
            if (layer == 0) { GRID_BAR();
                RUN_CHAIN( chain_common(CH, ws, POUT(), 1, 4, 0, 0, 0, 20, NQKV, nullptr);
                       chain_seg(CH, 0, ws + WS_FF, ws + WS_WDN + layer * SZ_WUP, FF, 4, pg8::CK_FINAL, 0, 0u, nullptr, nullptr);
                       chain_totals(CH, 1); ); }
#endif
#ifdef PROBE_UP
            if (layer == 0) { GRID_BAR();
                RUN_CHAIN( chain_common(CH, ws, POUT(), 1, 16, 0, 0, 0, 20, NQKV, nullptr);
                       chain_seg(CH, 0, ws + WS_XB, ws + WS_WUP + layer * SZ_WUP, D, 16, pg8::CK_UP, 0, 0u, nullptr, nullptr); chain_totals(CH, 1); ); }
#endif
        }
#undef RUN_CHAIN
        if (it < 4) GRID_BAR();
        { OPAQUE_TID(); __syncthreads();
          int itq_o = MISC_OFF + 48; asm volatile("" : "+s"(itq_o)); volatile LAS unsigned* itq = (volatile LAS unsigned*)(lds + itq_o);
          if (tid_p == 0) *itq = *itq + 1u;
          __syncthreads(); }
    }
#undef PIN
#undef OPAQUE_TID
#undef GRID_BAR
#undef GG_
#undef OPQ_GB
#undef BX_
#undef VCU_
#undef POUT
#undef PWS
}

extern "C" void kernel_launch(void* const* d_in, const int* in_sizes, int n_in, void* d_out, int out_size, void* d_ws, size_t ws_size, hipStream_t stream) {
    static int grid = 0;
    if (grid == 0) {
        if (n_in != 23 || ws_size < WS_END) { fprintf(stderr, "kernel_launch: built for 23 inputs, %zu outputs, >= %zu bytes of workspace; got n_in %d, out %d, ws %zu; nothing launched\n", (size_t)O_END, (size_t)WS_END, n_in, out_size, ws_size); grid = -1; return; }
        int dev = 0, cus = 0, per_cu = 0;
        if (hipGetDevice(&dev) != hipSuccess || hipDeviceGetAttribute(&cus, hipDeviceAttributeMultiprocessorCount, dev) != hipSuccess) { fprintf(stderr, "kernel_launch: device query failed\n"); grid = -1; return; }
        if (hipFuncSetAttribute((const void*)hybrid_fwd, hipFuncAttributeMaxDynamicSharedMemorySize, LDS_BYTES) != hipSuccess) { fprintf(stderr, "kernel_launch: hipFuncSetAttribute failed\n"); grid = -1; return; }
        if (hipOccupancyMaxActiveBlocksPerMultiprocessor(&per_cu, (const void*)hybrid_fwd, NWAVES * 64, LDS_BYTES) != hipSuccess || per_cu < 1)
            fprintf(stderr, "kernel_launch: note: occupancy query reports %d workgroups per CU\n", per_cu);
        (void)hipGetLastError();
        grid = cus - (cus % 8);
    }
    if (grid < 0) return;
    if (hipMemsetAsync((char*)d_ws + WS_CTL, 0, CTL_ZERO_BYTES, stream) != hipSuccess) { fprintf(stderr, "kernel_launch: hipMemsetAsync failed\n"); return; }
    Args a{};
    for (int i = 0; i < 23; ++i) a.in[i] = (const float*)d_in[i];
    a.out = (float*)d_out; a.ws = (unsigned char*)d_ws;
    hipLaunchKernelGGL(hybrid_fwd, dim3(grid), dim3(NWAVES * 64), LDS_BYTES, stream, a);
    const hipError_t le = hipPeekAtLastError();
    if (le != hipSuccess) fprintf(stderr, "kernel_launch: launch failed: %s\n", hipGetErrorName(le));
}
```

```cpp
#include <hip/hip_runtime.h>
#include <cstdio>
#include <cstdint>
namespace pg8 {
#define PG8_LAS __attribute__((address_space(3)))
typedef unsigned short bf16_t;
typedef short bf16x8 __attribute__((ext_vector_type(8)));
typedef float f32x4 __attribute__((ext_vector_type(4)));
typedef unsigned u32x4 __attribute__((ext_vector_type(4)));
constexpr int BM = 256, BK = 64, HALF = 128, HTB = HALF * BK * 2  , STAGE_BYTES = 8 * HTB, NXCD = 8, WGM = 8;

__host__ __device__ __forceinline__ int lds_byte(int r, int c) { const int st = (r >> 4) * 2 + (c >> 5), rr = r & 15, cc = c & 31, ob = rr * 64 + cc * 2; return st * 1024 + (ob ^ (((ob >> 9) & 1) << 5)); }
__host__ __device__ __forceinline__ void stage_rc(int b, int& R, int& C) { const int st = b / 1024, sb = b % 1024, swz = sb ^ (((sb >> 9) & 1) << 5); R = (st >> 1) * 16 + swz / 64; C = (st & 1) * 32 + (swz % 64) / 2; }
__host__ __device__ __forceinline__ int perm32(int rho) { const int n = rho >> 4, i = rho & 15; return 8 * (i >> 2) + 4 * n + (i & 3); }

struct Unit { int pm, pn; };
struct Gemm { const bf16_t* A; const bf16_t* Bt; int M, N, K; };

struct StaticOrder {
    int nM, nN, nwg, G, c;
    __host__ __device__ void init(int M, int N, int G_, int c_) { nM = M / BM; nN = N / BM; nwg = nM * nN; G = G_; c = c_; }
    __host__ __device__ bool next(int i, Unit& u) const {
        const long L = (long)i * G + c; if (L >= nwg) return false;
        int wgid = (int)L; { const int q = nwg / NXCD, r = nwg % NXCD, xcd = wgid % NXCD, off = wgid / NXCD; wgid = (xcd < r ? xcd * (q + 1) : r * (q + 1) + (xcd - r) * q) + off; }
        const int nig = WGM * nN, gid = wgid / nig, fm = gid * WGM, gsz = (nM - fm) < WGM ? (nM - fm) : WGM;
        u.pm = fm + ((wgid % nig) % gsz); u.pn = (wgid % nig) / gsz; return true;
    }
    __device__ __forceinline__ void a_ready(const Unit&) const {}
    __device__ __forceinline__ void done(const Unit&) const {}
};
__device__ __forceinline__ unsigned cvt_pk_bf16(float lo, float hi) { unsigned r; asm volatile("v_cvt_pk_bf16_f32 %0, %1, %2" : "=v"(r) : "v"(lo), "v"(hi)); return r; }
__device__ __forceinline__ float shx(float v, int mask, int lane) { return __builtin_bit_cast(float, __builtin_amdgcn_ds_bpermute((lane ^ mask) << 2, __builtin_bit_cast(int, v))); }
__device__ __forceinline__ float shl_from(float v, int src) { return __builtin_bit_cast(float, __builtin_amdgcn_ds_bpermute(src << 2, __builtin_bit_cast(int, v))); }
typedef unsigned u32x2 __attribute__((ext_vector_type(2)));
constexpr int RM_MP = 16512, RM_MTOT = 17024, RM_LP = 2064, RM_META = 16, RM_SEQ = 2048;
__device__ __forceinline__ float row_rscale(const float* SS, int row) {
    const f32x4* p = (const f32x4*)(SS + (size_t)row * 16); const f32x4 a = p[0], b = p[1], c = p[2], d = p[3];
    const float s = ((a[0] + a[1]) + (a[2] + a[3])) + ((b[0] + b[1]) + (b[2] + b[3])) + ((c[0] + c[1]) + (c[2] + c[3])) + ((d[0] + d[1]) + (d[2] + d[3]));
    return 1.0f / sqrtf(s * (1.0f / 1024.0f) + 1e-6f);
}
__device__ __forceinline__ float softcap15(float x) { return 15.0f * tanhf(x * (1.0f / 15.0f)); }
__device__ __forceinline__ float logsigmoidf(float x) { return x < 0.f ? x - log1pf(expf(x)) : -log1pf(expf(-x)); }
template <int ACT, bool GATES> struct EpiNormBf16 {
    static constexpr bool PERM = true, AFTER_DRAIN = false;
    bf16_t* O; int ldc; const float* SS; float* G; const float* bgate; int gate_pn;
    __device__ __forceinline__ void operator()(const f32x4 (&acc)[2][2][4][2], const Unit& u, int wr, int wc, int fr, int fq) const {
        const int row0 = u.pm * BM + wr * 64 + fr;
        if (GATES && u.pn == gate_pn) {
            if (wc == 0 && fq == 0) {
                const f32x4 b0 = *(const f32x4*)bgate, b1 = *(const f32x4*)(bgate + 4);
#pragma unroll
                for (int ai = 0; ai < 2; ++ai)
#pragma unroll
                    for (int m = 0; m < 4; ++m) { const int row = row0 + ai * HALF + m * 16; const float r = row_rscale(SS, row);
                        f32x4 gi = acc[ai][0][m][0] * r + b0, gf = acc[ai][0][m][1] * r + b1;
#pragma unroll
                        for (int j = 0; j < 4; ++j) { gi[j] = softcap15(gi[j]); gf[j] = logsigmoidf(softcap15(gf[j])); }
                        *(f32x4*)(G + (size_t)row * 8) = gi; *(f32x4*)(G + (size_t)row * 8 + 4) = gf; }
            }
            return;
        }
        const int col0 = u.pn * BM + wc * 32 + 8 * fq;
#pragma unroll
        for (int ai = 0; ai < 2; ++ai)
#pragma unroll
            for (int m = 0; m < 4; ++m) { const int row = row0 + ai * HALF + m * 16; const float r = row_rscale(SS, row); bf16_t* rowp = O + (size_t)row * ldc + col0;
#pragma unroll
                for (int bj = 0; bj < 2; ++bj) { f32x4 v0 = acc[ai][bj][m][0] * r, v1 = acc[ai][bj][m][1] * r;
                    if (ACT == 1) {
#pragma unroll
                        for (int j = 0; j < 4; ++j) { const float a = fmaxf(v0[j], 0.f), b = fmaxf(v1[j], 0.f); v0[j] = a * a; v1[j] = b * b; } }
                    u32x4 w; w.x = cvt_pk_bf16(v0[0], v0[1]); w.y = cvt_pk_bf16(v0[2], v0[3]); w.z = cvt_pk_bf16(v1[0], v1[1]); w.w = cvt_pk_bf16(v1[2], v1[3]);
                    *(u32x4*)(rowp + bj * HALF) = w; } }
    }
};
template <bool FINAL> struct EpiResid {
    static constexpr bool PERM = false, AFTER_DRAIN = false;
    float* X; bf16_t* Xb; float* SS; float* y_prompt; float* y_sample;
    __device__ __forceinline__ void operator()(const f32x4 (&acc)[2][2][4][2], const Unit& u, int wr, int wc, int fr, int fq) const {
        const int row0 = u.pm * BM + wr * 64 + fr, col0 = u.pn * BM + wc * 32 + 4 * fq;
#pragma unroll
        for (int ai = 0; ai < 2; ++ai)
#pragma unroll
            for (int m = 0; m < 4; ++m) { const int row = row0 + ai * HALF + m * 16; const size_t off = (size_t)row * 1024 + col0;
                f32x4 x[2][2];
#pragma unroll
                for (int bj = 0; bj < 2; ++bj)
#pragma unroll
                    for (int n = 0; n < 2; ++n) x[bj][n] = *(const f32x4*)(X + off + bj * HALF + n * 16) + acc[ai][bj][m][n];
                if (!FINAL) {
                    float s = 0.f;
#pragma unroll
                    for (int bj = 0; bj < 2; ++bj)
#pragma unroll
                        for (int n = 0; n < 2; ++n) { const f32x4 v = x[bj][n]; *(f32x4*)(X + off + bj * HALF + n * 16) = v; s += (v[0] * v[0] + v[1] * v[1]) + (v[2] * v[2] + v[3] * v[3]);
                            u32x2 w; w.x = cvt_pk_bf16(v[0], v[1]); w.y = cvt_pk_bf16(v[2], v[3]); *(u32x2*)(Xb + off + bj * HALF + n * 16) = w; }
                    s += shx(s, 16, (fr + 16 * fq)); s += shx(s, 32, (fr + 16 * fq));
                    if (fq == 0) SS[(size_t)row * 16 + u.pn * 4 + wc] = s;
                } else {
                    float* dst = nullptr;
                    if (row < RM_MP) { const int b = row / RM_LP, t = row - b * RM_LP; if (t >= RM_META) dst = y_prompt + ((size_t)b * RM_SEQ + (t - RM_META)) * 1024 + col0; }
                    else if (row < RM_MTOT) dst = y_sample + (size_t)(row - RM_MP) * 1024 + col0;
                    if (dst) {
#pragma unroll
                        for (int bj = 0; bj < 2; ++bj)
#pragma unroll
                            for (int n = 0; n < 2; ++n) *(f32x4*)(dst + bj * HALF + n * 16) = x[bj][n]; }
                }
            }
    }
};

template <class Epi, class Sched, bool ALIGN_EPI = false, bool SP2 = false>
__device__ __forceinline__ void gemm_phase(PG8_LAS unsigned char* lds, const Gemm g, const Sched& S, const Epi& E) {
    int tid_o = threadIdx.x; asm volatile("" : "+v"(tid_o));
    const int tid = tid_o, wid = __builtin_amdgcn_readfirstlane(tid >> 6), lane = tid & 63, wr = wid >> 2, wc = wid & 3, fr = lane & 15, fq = lane >> 4;
    const int K = g.K, nt = K / BK;
    unsigned voffA[2], voffB[2];
#pragma unroll
    for (int i = 0; i < 2; ++i) { int R, C; stage_rc(tid * 16 + i * 8192, R, C); const int Rb = Epi::PERM ? ((R & ~31) + perm32(R & 31)) : R;
        voffA[i] = (unsigned)(R * K + C) * 2u; voffB[i] = (unsigned)(Rb * K + C) * 2u; }
    const size_t kstep = (size_t)(BK * 2);
    const size_t hstep = (size_t)HALF * K * 2;
    const size_t tstep = 2 * hstep;
    const unsigned ldsw = (unsigned)wid * 1024u;
    const int aoff = lds_byte(wr * 64 + fr, fq * 8), boff = lds_byte(wc * 32 + fr, fq * 8);
#define PG8_SA(b, h) (((b) * 2 + (h)) * HTB)
#define PG8_SB(b, h) ((4 + (b) * 2 + (h)) * HTB)
#define PG8_STAGE(bufoff, gbase, voff) do { _Pragma("unroll") for (int _i = 0; _i < 2; ++_i) \
        __builtin_amdgcn_global_load_lds((const unsigned*)((const char*)(gbase) + (voff)[_i]), (PG8_LAS unsigned*)(lds + (bufoff) + ldsw + _i * 8192), 16, 0, 0); } while (0)
#define PG8_LDA(dst, b, h) do { _Pragma("unroll") for (int m = 0; m < 4; ++m) _Pragma("unroll") for (int k = 0; k < 2; ++k) dst[m][k] = *(const PG8_LAS bf16x8*)(lds + PG8_SA(b, h) + aoff + m * 2048 + k * 1024); } while (0)
#define PG8_LDB(dst, b, h) do { _Pragma("unroll") for (int n = 0; n < 2; ++n) _Pragma("unroll") for (int k = 0; k < 2; ++k) dst[n][k] = *(const PG8_LAS bf16x8*)(lds + PG8_SB(b, h) + boff + n * 2048 + k * 1024); } while (0)
#define PG8_MMA(ai, bj, At, Bt) do { __builtin_amdgcn_s_setprio(1); _Pragma("unroll") for (int m = 0; m < 4; ++m) _Pragma("unroll") for (int n = 0; n < 2; ++n) _Pragma("unroll") for (int k = 0; k < 2; ++k) \
        acc[ai][bj][m][n] = __builtin_amdgcn_mfma_f32_16x16x32_bf16(Bt[n][k], At[m][k], acc[ai][bj][m][n], 0, 0, 0); __builtin_amdgcn_s_setprio(0); } while (0)
#define PG8_WAIT_V(n) asm volatile("s_waitcnt vmcnt(" #n ")" ::: "memory")
#define PG8_WAIT_L(n) asm volatile("s_waitcnt lgkmcnt(" #n ")" ::: "memory")
#define PG8_BAR __builtin_amdgcn_s_barrier()
#define PG8_SCHED __builtin_amdgcn_sched_barrier(0)
    Unit cur, nxt; int ui = 0;
    if (!S.next(0, cur)) return;
    f32x4 acc[2][2][4][2];
#pragma unroll
    for (int a = 0; a < 2; ++a)
#pragma unroll
        for (int b = 0; b < 2; ++b)
#pragma unroll
            for (int m = 0; m < 4; ++m)
#pragma unroll
                for (int n = 0; n < 2; ++n) acc[a][b][m][n] = (f32x4){0.f, 0.f, 0.f, 0.f};
    bf16x8 At[4][2], B0[2][2], B1[2][2];
    const char* cA = (const char*)g.A + (size_t)cur.pm * tstep; const char* cB = (const char*)g.Bt + (size_t)cur.pn * tstep;
    S.a_ready(cur);
    if constexpr (SP2) {
        PG8_STAGE(PG8_SB(0, 0), cB, voffB); PG8_STAGE(PG8_SB(0, 1), cB + hstep, voffB); PG8_STAGE(PG8_SA(0, 0), cA, voffA); PG8_STAGE(PG8_SA(0, 1), cA + hstep, voffA);
        if (wr == 1) PG8_BAR;
        PG8_WAIT_V(2); PG8_BAR;
        PG8_STAGE(PG8_SB(1, 0), cB + kstep, voffB); PG8_STAGE(PG8_SA(1, 0), cA + kstep, voffA); PG8_STAGE(PG8_SB(1, 1), cB + hstep + kstep, voffB);
        PG8_WAIT_V(6); PG8_BAR;
    } else {
        PG8_STAGE(PG8_SB(0, 0), cB, voffB); PG8_STAGE(PG8_SA(0, 0), cA, voffA); PG8_STAGE(PG8_SB(0, 1), cB + hstep, voffB); PG8_STAGE(PG8_SA(0, 1), cA + hstep, voffA);
        if (wr == 1) PG8_BAR;
        PG8_WAIT_V(4); PG8_BAR;
        PG8_STAGE(PG8_SB(1, 0), cB + kstep, voffB); PG8_STAGE(PG8_SA(1, 0), cA + kstep, voffA); PG8_STAGE(PG8_SB(1, 1), cB + hstep + kstep, voffB);
        PG8_WAIT_V(6); PG8_BAR;
    }
    for (;;) {
        const bool has_next = S.next(ui + 1, nxt);
        const char* nA = has_next ? (const char*)g.A + (size_t)nxt.pm * tstep : cA; const char* nB = has_next ? (const char*)g.Bt + (size_t)nxt.pn * tstep : cB;
        for (int t = 0; t < nt; t += 2) {
            const bool last = (t == nt - 2);
            const char* a1 = cA + (size_t)(t + 1) * kstep;
            const char* a2 = last ? nA : cA + (size_t)(t + 2) * kstep; const char* b2 = last ? nB : cB + (size_t)(t + 2) * kstep;
            const char* a3 = a2 + kstep; const char* b3 = b2 + kstep;
            if (last && has_next) S.a_ready(nxt);
            if constexpr (SP2) {
            PG8_LDB(B0, 0, 0); PG8_LDB(B1, 0, 1); PG8_SCHED; PG8_LDA(At, 0, 0); PG8_STAGE(PG8_SA(1, 1), a1 + hstep, voffA);
            PG8_WAIT_V(8); PG8_WAIT_L(0); PG8_BAR; PG8_MMA(0, 0, At, B0); PG8_MMA(0, 1, At, B1); PG8_BAR; PG8_SCHED;
            PG8_LDA(At, 0, 1); PG8_STAGE(PG8_SB(0, 0), b2, voffB); PG8_STAGE(PG8_SB(0, 1), b2 + hstep, voffB); PG8_STAGE(PG8_SA(0, 0), a2, voffA);
            PG8_WAIT_V(8); PG8_WAIT_L(0); PG8_BAR; PG8_MMA(1, 0, At, B0); PG8_MMA(1, 1, At, B1); PG8_BAR; PG8_SCHED;
            PG8_LDB(B0, 1, 0); PG8_LDB(B1, 1, 1); PG8_SCHED; PG8_LDA(At, 1, 0); PG8_STAGE(PG8_SA(0, 1), a2 + hstep, voffA);
            PG8_WAIT_V(8); PG8_WAIT_L(0); PG8_BAR; PG8_MMA(0, 0, At, B0); PG8_MMA(0, 1, At, B1); PG8_BAR; PG8_SCHED;
            PG8_LDA(At, 1, 1); PG8_STAGE(PG8_SB(1, 0), b3, voffB); PG8_STAGE(PG8_SB(1, 1), b3 + hstep, voffB); PG8_STAGE(PG8_SA(1, 0), a3, voffA);
            PG8_WAIT_V(8); PG8_WAIT_L(0); PG8_BAR; PG8_MMA(1, 0, At, B0); PG8_MMA(1, 1, At, B1); PG8_BAR; PG8_SCHED;
            } else {
            PG8_LDB(B0, 0, 0); PG8_SCHED; PG8_LDA(At, 0, 0); PG8_STAGE(PG8_SA(1, 1), a1 + hstep, voffA);
            PG8_WAIT_L(8); PG8_BAR; PG8_WAIT_L(0); PG8_MMA(0, 0, At, B0); PG8_BAR; PG8_SCHED;
            PG8_LDB(B1, 0, 1); PG8_STAGE(PG8_SB(0, 0), b2, voffB);
            PG8_BAR; PG8_WAIT_L(0); PG8_MMA(0, 1, At, B1); PG8_BAR;
            PG8_LDA(At, 0, 1); PG8_STAGE(PG8_SA(0, 0), a2, voffA);
            PG8_BAR; PG8_WAIT_L(0); PG8_MMA(1, 0, At, B0); PG8_BAR; PG8_SCHED;
            PG8_STAGE(PG8_SB(0, 1), b2 + hstep, voffB);
            PG8_WAIT_V(6); PG8_BAR; PG8_MMA(1, 1, At, B1); PG8_BAR;
            PG8_LDB(B0, 1, 0); PG8_SCHED; PG8_LDA(At, 1, 0); PG8_STAGE(PG8_SA(0, 1), a2 + hstep, voffA);
            PG8_WAIT_L(8); PG8_BAR; PG8_WAIT_L(0); PG8_MMA(0, 0, At, B0); PG8_BAR; PG8_SCHED;
            PG8_LDB(B1, 1, 1); PG8_STAGE(PG8_SB(1, 0), b3, voffB);
            PG8_BAR; PG8_WAIT_L(0); PG8_MMA(0, 1, At, B1); PG8_BAR;
            PG8_LDA(At, 1, 1); PG8_STAGE(PG8_SA(1, 0), a3, voffA);
            PG8_BAR; PG8_WAIT_L(0); PG8_MMA(1, 0, At, B0); PG8_BAR; PG8_SCHED;
            PG8_STAGE(PG8_SB(1, 1), b3 + hstep, voffB);
            PG8_WAIT_V(6); PG8_BAR; PG8_MMA(1, 1, At, B1); PG8_BAR;
            }
        }
        if constexpr (ALIGN_EPI) { if (wr == 0) PG8_BAR; }
        if constexpr (!Epi::AFTER_DRAIN) { E(acc, cur, wr, wc, fr, fq); S.done(cur); }
        if (!has_next) break;
#pragma unroll
        for (int a = 0; a < 2; ++a)
#pragma unroll
            for (int b = 0; b < 2; ++b)
#pragma unroll
                for (int m = 0; m < 4; ++m)
#pragma unroll
                    for (int n = 0; n < 2; ++n) acc[a][b][m][n] = (f32x4){0.f, 0.f, 0.f, 0.f};
        cur = nxt; cA = nA; cB = nB; ++ui;
        if constexpr (ALIGN_EPI) { if (wr == 1) PG8_BAR; }
    }
    PG8_WAIT_V(0);
    if constexpr (!ALIGN_EPI) { if (wr == 0) PG8_BAR; }
    PG8_BAR;
    if constexpr (Epi::AFTER_DRAIN) { E.fused(acc, cur, wr, wc, fr, fq, lds, wid, lane); S.done(cur); }
#undef PG8_SA
#undef PG8_SB
#undef PG8_STAGE
#undef PG8_LDA
#undef PG8_LDB
#undef PG8_MMA
#undef PG8_WAIT_V
#undef PG8_WAIT_L
#undef PG8_BAR
#undef PG8_SCHED
}

#define PG8_GAS __attribute__((address_space(1)))
#ifndef CH_PUB_T
#define CH_PUB_T 4
#endif
#ifndef CH_FF_WT
#define CH_FF_WT 0
#endif
#ifndef CH_X_AUX
#define CH_X_AUX 0
#endif
#ifndef CH_A_AUX
#define CH_A_AUX 0
#endif
enum ChainKind { CK_NORM = 0, CK_NORM_GATES = 1, CK_UP = 2, CK_RESID = 3, CK_FINAL = 4, CK_PART = 5 };
constexpr int CC = 64, CSLOT = 96;
struct UnitD { int valid, seg, pm, pn, K, kind, ld, kq; const char* A; const char* B; };
__device__ __forceinline__ unsigned cw(volatile PG8_LAS unsigned* c, int i) { return (unsigned)__builtin_amdgcn_readfirstlane((int)c[i]); }
__device__ __forceinline__ unsigned long long cp(volatile PG8_LAS unsigned* c, int i) { const unsigned lo = cw(c, i), hi = cw(c, i + 1); return ((unsigned long long)hi << 32) | lo; }
constexpr int CCUM = CC + 24, CQ = CSLOT + 8;
__device__ __forceinline__ int chain_np(int x) { return x < 3 ? 9 : 8; }
__device__ __forceinline__ int seg_count(volatile PG8_LAS unsigned* c, int s, int np) {
    const unsigned w = cw(c, 16 * s + 14); const int lpoff = (int)(w & 0xffu), cap = (int)((w >> 8) & 0xffu), nsub = (int)(w >> 16);
    int nps = np - lpoff; nps = nps < 0 ? 0 : (nps > cap ? cap : nps);
    return nps * (int)cw(c, 16 * s + 5) * nsub;
}
__device__ __forceinline__ void decode_unit(volatile PG8_LAS unsigned* c, unsigned code, UnitD& u) {
    u.valid = code != 0xffffffffu; u.seg = 0; u.pm = 0; u.pn = 0; u.K = 1024; u.kind = 0; u.ld = 1024; u.kq = 0; u.A = nullptr; u.B = nullptr;
    if (!u.valid) return;
    const int x = (int)(code >> 16), np = chain_np(x); int i = (int)(code & 0xffffu);
    const int nseg = (int)cw(c, CC); int s = 0;
#pragma unroll
    for (int k = 0; k < 3; ++k) { if (s == k && k + 1 < nseg) { const int cnt = seg_count(c, k, np); if (i >= cnt) { i -= cnt; s = k + 1; } } }
    const unsigned w = cw(c, 16 * s + 14); const int lpoff = (int)(w & 0xffu), nsub = (int)(w >> 16);
    const int nN = (int)cw(c, 16 * s + 5), per = nN * nsub, lp = i / per, rem = i - lp * per;
    u.seg = s; u.pm = x + 8 * (lpoff + lp); u.pn = rem / nsub; u.kq = rem - u.pn * nsub; u.K = (int)cw(c, 16 * s + 4); u.kind = (int)cw(c, 16 * s + 6); u.ld = (int)cw(c, 16 * s + 9);
    u.A = (const char*)(const PG8_GAS char*)cp(c, 16 * s) + (size_t)u.pm * 512 * u.ld + (size_t)u.kq * 2 * u.K; u.B = (const char*)(const PG8_GAS char*)cp(c, 16 * s + 2) + (size_t)u.pn * 512 * u.ld + (size_t)u.kq * 2 * u.K;
}
__device__ __forceinline__ unsigned chain_deq_from(volatile PG8_LAS unsigned* c, unsigned* heads, unsigned v  ) {
    int q = (int)c[CQ], tries = (int)c[CQ + 1]; const unsigned tot8 = c[CC + 1], tot9 = c[CC + 23];
    while (v >= (q < 3 ? tot9 : tot8) && tries < 8) { q = (q + 1) & 7; ++tries; if (tries < 8) v = __hip_atomic_fetch_add(heads + 64 * q, 1u, __ATOMIC_RELAXED, __HIP_MEMORY_SCOPE_AGENT); }
    c[CQ] = (unsigned)q; c[CQ + 1] = (unsigned)tries;
    return tries < 8 ? (((unsigned)q << 16) | v) : 0xffffffffu;
}
__device__ __forceinline__ unsigned ld_relaxed(const unsigned* p) { return __hip_atomic_load(p, __ATOMIC_RELAXED, __HIP_MEMORY_SCOPE_AGENT); }
__device__ __forceinline__ void chain_wait(volatile PG8_LAS unsigned* c, const UnitD& u, int wid) {
    const unsigned long long dep = cp(c, 16 * u.seg + 10);
    if (dep) {
        if (wid == 0) { const unsigned* p = (const unsigned*)(const PG8_GAS unsigned*)dep + 64 * u.pm; const unsigned need = cw(c, 16 * u.seg + 8); unsigned spins = 0;
            while ((unsigned)__builtin_amdgcn_readfirstlane((int)ld_relaxed(p)) < need) { __builtin_amdgcn_s_sleep(2); if (++spins > (1u << 20)) break; }
            if (CH_A_AUX == 0 && u.seg == 3) __builtin_amdgcn_fence(__ATOMIC_ACQUIRE, "agent"); }
        asm volatile("s_waitcnt vmcnt(0) lgkmcnt(0)" ::: "memory"); __builtin_amdgcn_s_barrier(); asm volatile("" ::: "memory");
    }
}
__device__ __forceinline__ bool chain_try(volatile PG8_LAS unsigned* c, const UnitD& u, int wid, int lane, int ui) {
    const unsigned long long dep = cp(c, 16 * u.seg + 10);
    if (!dep) return true;
    if (wid == 0) { const unsigned* p = (const unsigned*)(const PG8_GAS unsigned*)dep + 64 * u.pm; const unsigned need = cw(c, 16 * u.seg + 8);
        const unsigned ok = (unsigned)__builtin_amdgcn_readfirstlane((int)ld_relaxed(p)) >= need ? 1u : 0u;
        if (lane == 0) c[CSLOT + 4 + (ui & 1)] = ok;
        if (CH_A_AUX == 0 && ok && u.seg == 3) { __builtin_amdgcn_fence(__ATOMIC_ACQUIRE, "agent"); asm volatile("s_waitcnt vmcnt(0)" ::: "memory"); } }
    asm volatile("s_waitcnt lgkmcnt(0)" ::: "memory"); __builtin_amdgcn_s_barrier(); asm volatile("" ::: "memory");
    return cw(c, CSLOT + 4 + (ui & 1)) != 0u;
}
typedef unsigned cu32x4 __attribute__((ext_vector_type(4)));
__device__ __forceinline__ __amdgpu_buffer_rsrc_t mk_rsrc(unsigned long long p, unsigned bytes) { return __builtin_amdgcn_make_buffer_rsrc((void*)(PG8_GAS void*)p, (short)0, (int)bytes, 0x00020000); }
__device__ __forceinline__ f32x4 ld16_sc1(__amdgpu_buffer_rsrc_t r, unsigned off) { const cu32x4 v = __builtin_amdgcn_raw_buffer_load_b128(r, (int)off, 0, CH_X_AUX); return __builtin_bit_cast(f32x4, v); }
__device__ __forceinline__ void st16_sc1(__amdgpu_buffer_rsrc_t r, unsigned off, f32x4 v) { __builtin_amdgcn_raw_buffer_store_b128(__builtin_bit_cast(cu32x4, v), r, (int)off, 0, CH_X_AUX); }
__device__ __forceinline__ void st16u_sc1(__amdgpu_buffer_rsrc_t r, unsigned off, cu32x4 v) { __builtin_amdgcn_raw_buffer_store_b128(v, r, (int)off, 0, CH_X_AUX); }
__device__ __forceinline__ void st16u_wt(__amdgpu_buffer_rsrc_t r, unsigned off, cu32x4 v) { __builtin_amdgcn_raw_buffer_store_b128(v, r, (int)off, 0, 16); }
constexpr unsigned CH_MPAD = 17152;
__device__ __forceinline__ void row_rscales_sc1(__amdgpu_buffer_rsrc_t rss, int row0, int fr, int fq, float (&rr)[2][4]) {
    f32x4 v[2][4];
#pragma unroll
    for (int ai = 0; ai < 2; ++ai)
#pragma unroll
        for (int m = 0; m < 4; ++m) { const cu32x4 t = __builtin_amdgcn_raw_buffer_load_b128(rss, (int)((unsigned)(row0 + ai * HALF + m * 16) * 64u + 16u * (unsigned)fq), 0, CH_X_AUX); v[ai][m] = __builtin_bit_cast(f32x4, t); }
#pragma unroll
    for (int ai = 0; ai < 2; ++ai)
#pragma unroll
        for (int m = 0; m < 4; ++m) { float s = (v[ai][m][0] + v[ai][m][1]) + (v[ai][m][2] + v[ai][m][3]); s += shx(s, 16, (fr + 16 * fq)); s += shx(s, 32, (fr + 16 * fq)); rr[ai][m] = 1.0f / sqrtf(s * (1.0f / 1024.0f) + 1e-6f); }
}
__device__ __forceinline__ void chain_epilogue(volatile PG8_LAS unsigned* c, const UnitD& u, const f32x4 (&acc)[2][2][4][2], int wr, int wc, int fr, int fq) {
    const int row0 = u.pm * BM + wr * 64 + fr, colw = wc * 32 + 8 * fq;
    const __amdgpu_buffer_rsrc_t rss = mk_rsrc(cp(c, CC + 8), CH_MPAD * 64u);
    if (u.kind <= CK_UP) {
        float rr[2][4]; row_rscales_sc1(rss, row0, fr, fq, rr);
        if (u.kind == CK_NORM_GATES && u.pn == 12) {
            if (wc == 0 && fq == 0) { const float* bg = (const float*)(const PG8_GAS float*)cp(c, CC + 16); float* G = (float*)(PG8_GAS float*)cp(c, CC + 14);
                const f32x4 b0 = *(const f32x4*)bg, b1 = *(const f32x4*)(bg + 4);
#pragma unroll
                for (int ai = 0; ai < 2; ++ai)
#pragma unroll
                    for (int m = 0; m < 4; ++m) { const int row = row0 + ai * HALF + m * 16; const float r = rr[ai][m];
                        const f32x4 gi = acc[ai][0][m][0] * r + b0, gf = acc[ai][0][m][1] * r + b1;
                        *(f32x4*)(G + (size_t)row * 8) = gi; *(f32x4*)(G + (size_t)row * 8 + 4) = gf; } }
            return;
        }
        const bool up = u.kind == CK_UP; const int ldc = up ? 4096 : (int)cw(c, CC + 22);
        const unsigned long long obase = up ? cp(c, CC + 12) : cp(c, CC + 10);
        const __amdgpu_buffer_rsrc_t ro = mk_rsrc(obase, CH_MPAD * (unsigned)ldc * 2u);
        const int col0 = u.pn * BM + colw;
#pragma unroll
        for (int ai = 0; ai < 2; ++ai)
#pragma unroll
            for (int m = 0; m < 4; ++m) { const int row = row0 + ai * HALF + m * 16; const float r = rr[ai][m];
#pragma unroll
                for (int bj = 0; bj < 2; ++bj) { f32x4 v0 = acc[ai][bj][m][0] * r, v1 = acc[ai][bj][m][1] * r;
                    if (up) {
#pragma unroll
                        for (int j = 0; j < 4; ++j) { const float a = fmaxf(v0[j], 0.f), b = fmaxf(v1[j], 0.f); v0[j] = a * a; v1[j] = b * b; } }
                    cu32x4 w; w.x = cvt_pk_bf16(v0[0], v0[1]); w.y = cvt_pk_bf16(v0[2], v0[3]); w.z = cvt_pk_bf16(v1[0], v1[1]); w.w = cvt_pk_bf16(v1[2], v1[3]);
                    if (up && CH_FF_WT) st16u_wt(ro, ((unsigned)row * (unsigned)ldc + (unsigned)(col0 + bj * HALF)) * 2u, w); else st16u_sc1(ro, ((unsigned)row * (unsigned)ldc + (unsigned)(col0 + bj * HALF)) * 2u, w); } }
        return;
    }
    if (u.kind == CK_PART) {
        float* P = (float*)(PG8_GAS float*)cp(c, CC + 30) + ((size_t)(u.kq * 3 + (u.pm - 64)) * 256) * 1024; const int colp = u.pn * BM + colw;
#pragma unroll
        for (int ai = 0; ai < 2; ++ai)
#pragma unroll
            for (int m = 0; m < 4; ++m) { float* rp = P + (size_t)(wr * 64 + fr + ai * HALF + m * 16) * 1024 + colp;
#pragma unroll
                for (int bj = 0; bj < 2; ++bj)
#pragma unroll
                    for (int n = 0; n < 2; ++n) *(f32x4*)(rp + bj * HALF + 4 * n) = acc[ai][bj][m][n]; }
        return;
    }
    const __amdgpu_buffer_rsrc_t rx = mk_rsrc(cp(c, CC + 4), CH_MPAD * 4096u);
    const int col0 = u.pn * BM + colw;
    if (u.kind == CK_RESID) {
        const __amdgpu_buffer_rsrc_t rxb = mk_rsrc(cp(c, CC + 6), CH_MPAD * 2048u);
        f32x4 xin[4][2][2];
#define CH_XLOAD(i) do { const unsigned off_ = (unsigned)(row0 + ((i) >> 2) * HALF + ((i) & 3) * 16) * 1024u + (unsigned)col0; \
            _Pragma("unroll") for (int bj = 0; bj < 2; ++bj) _Pragma("unroll") for (int n = 0; n < 2; ++n) xin[(i) & 3][bj][n] = ld16_sc1(rx, (off_ + bj * HALF + 4 * n) * 4u); } while (0)
        CH_XLOAD(0); CH_XLOAD(1); CH_XLOAD(2);
#pragma unroll
        for (int i = 0; i < 8; ++i) { const int ai = i >> 2, m = i & 3; const int row = row0 + ai * HALF + m * 16; const unsigned off = (unsigned)row * 1024u + (unsigned)col0;
            if (i + 3 < 8) CH_XLOAD(i + 3);
            f32x4 x[2][2];
#pragma unroll
            for (int bj = 0; bj < 2; ++bj)
#pragma unroll
                for (int n = 0; n < 2; ++n) x[bj][n] = xin[i & 3][bj][n] + acc[ai][bj][m][n];
            float s = 0.f;
#pragma unroll
            for (int bj = 0; bj < 2; ++bj) {
#pragma unroll
                for (int n = 0; n < 2; ++n) { const f32x4 v = x[bj][n]; st16_sc1(rx, (off + bj * HALF + 4 * n) * 4u, v); s += (v[0] * v[0] + v[1] * v[1]) + (v[2] * v[2] + v[3] * v[3]); }
                cu32x4 w; w.x = cvt_pk_bf16(x[bj][0][0], x[bj][0][1]); w.y = cvt_pk_bf16(x[bj][0][2], x[bj][0][3]); w.z = cvt_pk_bf16(x[bj][1][0], x[bj][1][1]); w.w = cvt_pk_bf16(x[bj][1][2], x[bj][1][3]);
                st16u_sc1(rxb, (off + bj * HALF) * 2u, w); }
            s += shx(s, 16, (fr + 16 * fq)); s += shx(s, 32, (fr + 16 * fq));
            if (fq == 0) __builtin_amdgcn_raw_buffer_store_b32(__builtin_bit_cast(unsigned, s), rss, (int)((unsigned)row * 64u + (unsigned)(u.pn * 4 + wc) * 4u), 0, CH_X_AUX);
        }
#undef CH_XLOAD
    } else {
        float* yp = (float*)(PG8_GAS float*)cp(c, CC + 18); float* ys = (float*)(PG8_GAS float*)cp(c, CC + 20);
#pragma unroll
        for (int ai = 0; ai < 2; ++ai)
#pragma unroll
            for (int m = 0; m < 4; ++m) { const int row = row0 + ai * HALF + m * 16; const unsigned off = (unsigned)row * 1024u + (unsigned)col0;
                float* dst = nullptr;
                if (row < RM_MP) { const int b = row / RM_LP, t = row - b * RM_LP; if (t >= RM_META) dst = yp + ((size_t)b * RM_SEQ + (t - RM_META)) * 1024 + col0; }
                else if (row < RM_MTOT) dst = ys + (size_t)(row - RM_MP) * 1024 + col0;
                f32x4 x[2][2];
#pragma unroll
                for (int bj = 0; bj < 2; ++bj)
#pragma unroll
                    for (int n = 0; n < 2; ++n) x[bj][n] = ld16_sc1(rx, (off + bj * HALF + 4 * n) * 4u) + acc[ai][bj][m][n];
                asm volatile("" : "+v"(x[0][0]), "+v"(x[0][1]), "+v"(x[1][0]), "+v"(x[1][1]));
                if (dst) {
#pragma unroll
                    for (int bj = 0; bj < 2; ++bj)
#pragma unroll
                        for (int n = 0; n < 2; ++n) *(f32x4*)(dst + bj * HALF + 4 * n) = x[bj][n]; }
            }
    }
}
__device__ __forceinline__ int lane_now() { int l; asm volatile("v_mbcnt_lo_u32_b32 %0, -1, 0\n\tv_mbcnt_hi_u32_b32 %0, -1, %0" : "=v"(l)); return l; }
__device__ __forceinline__ void gemm_chain(PG8_LAS unsigned char* lds, volatile PG8_LAS unsigned* c, int tid_in) {
    int tid_o = tid_in; asm volatile("" : "+v"(tid_o));
    const int tid = tid_o, wid = __builtin_amdgcn_readfirstlane(tid >> 6), lane = tid & 63, wr = wid >> 2, wc = wid & 3, fr = lane & 15, fq = lane >> 4;
    unsigned rc;
    { int R, C; stage_rc(tid * 16, R, C); rc = (2u * (unsigned)R) | ((2u * (unsigned)C) << 16); }
#define ra2 (rc & 0xffffu)
#define c2 (rc >> 16)
#define CH_RB2() (2u * (unsigned)((int)((ra2 >> 1) & ~31u) + perm32((int)((ra2 >> 1) & 31u))))
    const unsigned ldsw = (unsigned)wid * 1024u;
    const int aoff = lds_byte(wr * 64 + fr, fq * 8), boff = lds_byte(wc * 32 + fr, fq * 8);
    constexpr size_t kstep = (size_t)(BK * 2);
#define PG8_SA(b, h) (((b) * 2 + (h)) * HTB)
#define PG8_SB(b, h) ((4 + (b) * 2 + (h)) * HTB)
#define CH_STAGE_A(bufoff, gbase, K_)   do { const unsigned _vo = ra2 * (unsigned)(K_) + c2; const char* _g1 = (const char*)(gbase); const char* _g2 = _g1 + 128 * (size_t)(K_); \
        __builtin_amdgcn_global_load_lds((const unsigned*)(_g1 + _vo), (PG8_LAS unsigned*)(lds + (bufoff) + ldsw), 16, 0, CH_A_AUX); \
        __builtin_amdgcn_global_load_lds((const unsigned*)(_g2 + _vo), (PG8_LAS unsigned*)(lds + (bufoff) + ldsw + 8192), 16, 0, CH_A_AUX); } while (0)
#define CH_STAGE_B(bufoff, gbase, K_) do { const unsigned _vo = CH_RB2() * (unsigned)(K_) + c2; const char* _g1 = (const char*)(gbase); const char* _g2 = _g1 + 128 * (size_t)(K_); \
        __builtin_amdgcn_global_load_lds((const unsigned*)(_g1 + _vo), (PG8_LAS unsigned*)(lds + (bufoff) + ldsw), 16, 0, 0); \
        __builtin_amdgcn_global_load_lds((const unsigned*)(_g2 + _vo), (PG8_LAS unsigned*)(lds + (bufoff) + ldsw + 8192), 16, 0, 0); } while (0)
#define PG8_LDA(dst, b, h) do { _Pragma("unroll") for (int m = 0; m < 4; ++m) _Pragma("unroll") for (int k = 0; k < 2; ++k) dst[m][k] = *(const PG8_LAS bf16x8*)(lds + PG8_SA(b, h) + aoff + m * 2048 + k * 1024); } while (0)
#define PG8_LDB(dst, b, h) do { _Pragma("unroll") for (int n = 0; n < 2; ++n) _Pragma("unroll") for (int k = 0; k < 2; ++k) dst[n][k] = *(const PG8_LAS bf16x8*)(lds + PG8_SB(b, h) + boff + n * 2048 + k * 1024); } while (0)
#define PG8_MMA(ai, bj, At, Bt) do { __builtin_amdgcn_s_setprio(1); _Pragma("unroll") for (int m = 0; m < 4; ++m) _Pragma("unroll") for (int n = 0; n < 2; ++n) _Pragma("unroll") for (int k = 0; k < 2; ++k) \
        acc[ai][bj][m][n] = __builtin_amdgcn_mfma_f32_16x16x32_bf16(Bt[n][k], At[m][k], acc[ai][bj][m][n], 0, 0, 0); __builtin_amdgcn_s_setprio(0); } while (0)
#define PG8_WAIT_V(n) asm volatile("s_waitcnt vmcnt(" #n ")" ::: "memory")
#define PG8_WAIT_L(n) asm volatile("s_waitcnt lgkmcnt(" #n ")" ::: "memory")
#define PG8_BAR __builtin_amdgcn_s_barrier()
#define PG8_SCHED __builtin_amdgcn_sched_barrier(0)
#define CH_CODE(j) ({ const unsigned x_ = cw(c, CQ), i_ = (unsigned)(j) * cw(c, CQ + 2) + cw(c, CQ + 1); i_ < (x_ < 3u ? cw(c, CC + 23) : cw(c, CC + 1)) ? ((x_ << 16) | i_) : 0xffffffffu; })
    UnitD cur, nxt; int ui = 0;
    decode_unit(c, CH_CODE(0), cur);
    if (!cur.valid) return;
    f32x4 acc[2][2][4][2];
#pragma unroll
    for (int a = 0; a < 2; ++a)
#pragma unroll
        for (int b = 0; b < 2; ++b)
#pragma unroll
            for (int m = 0; m < 4; ++m)
#pragma unroll
                for (int n = 0; n < 2; ++n) acc[a][b][m][n] = (f32x4){0.f, 0.f, 0.f, 0.f};
    bf16x8 At[4][2], B0[2][2], B1[2][2];
    { const char* cA = cur.A; const char* cB = cur.B; const int K = cur.ld; const size_t hs = (size_t)256 * K;
      CH_STAGE_B(PG8_SB(0, 0), cB, K); CH_STAGE_B(PG8_SB(0, 1), cB + hs, K); CH_STAGE_A(PG8_SA(0, 0), cA, K); CH_STAGE_A(PG8_SA(0, 1), cA + hs, K);
      if (wr == 1) PG8_BAR;
      PG8_WAIT_V(2); PG8_BAR;
      CH_STAGE_B(PG8_SB(1, 0), cB + kstep, K); CH_STAGE_A(PG8_SA(1, 0), cA + kstep, K); CH_STAGE_B(PG8_SB(1, 1), cB + hs + kstep, K);
      PG8_WAIT_V(6); PG8_BAR; }
    for (;;) {
        bool has_next = false;
        const char* cA = cur.A; const char* cB = cur.B; const int Kc = cur.ld, nt = cur.K / BK; const size_t hsc = (size_t)256 * Kc;
        for (int t = 0; t < nt; t += 2) {
            const bool last = (t == nt - 2);
            if (last) { decode_unit(c, CH_CODE(ui + 1), nxt); has_next = nxt.valid != 0; }
            const bool into = last && has_next;
            const char* a1 = cA + (size_t)(t + 1) * kstep;
            const char* a2 = last ? (into ? nxt.A : cA) : cA + (size_t)(t + 2) * kstep; const char* b2 = last ? (into ? nxt.B : cB) : cB + (size_t)(t + 2) * kstep;
            const char* a3 = a2 + kstep; const char* b3 = b2 + kstep;
            const int K2 = into ? nxt.ld : Kc; const size_t hs2 = (size_t)256 * K2;
            PG8_LDB(B0, 0, 0); PG8_LDB(B1, 0, 1); PG8_SCHED; PG8_LDA(At, 0, 0); CH_STAGE_A(PG8_SA(1, 1), a1 + hsc, Kc);
            PG8_WAIT_V(8); PG8_WAIT_L(0); PG8_BAR; PG8_MMA(0, 0, At, B0); PG8_MMA(0, 1, At, B1); PG8_BAR; PG8_SCHED;
            PG8_LDA(At, 0, 1); CH_STAGE_B(PG8_SB(0, 0), b2, K2); CH_STAGE_B(PG8_SB(0, 1), b2 + hs2, K2); CH_STAGE_A(PG8_SA(0, 0), a2, K2);
            PG8_WAIT_V(8); PG8_WAIT_L(0); PG8_BAR; PG8_MMA(1, 0, At, B0); PG8_MMA(1, 1, At, B1); PG8_BAR; PG8_SCHED;
            PG8_LDB(B0, 1, 0); PG8_LDB(B1, 1, 1); PG8_SCHED; PG8_LDA(At, 1, 0); CH_STAGE_A(PG8_SA(0, 1), a2 + hs2, K2);
            PG8_WAIT_V(8); PG8_WAIT_L(0); PG8_BAR; PG8_MMA(0, 0, At, B0); PG8_MMA(0, 1, At, B1); PG8_BAR; PG8_SCHED;
            PG8_LDA(At, 1, 1); CH_STAGE_B(PG8_SB(1, 0), b3, K2); CH_STAGE_B(PG8_SB(1, 1), b3 + hs2, K2); CH_STAGE_A(PG8_SA(1, 0), a3, K2);
            PG8_WAIT_V(8); PG8_WAIT_L(0); PG8_BAR; PG8_MMA(1, 0, At, B0); PG8_MMA(1, 1, At, B1); PG8_BAR; PG8_SCHED;
        }
        if (wr == 0) PG8_BAR;
        { const int lane_e = lane_now();
          chain_epilogue(c, cur, acc, wr, wc, lane_e & 15, lane_e >> 4); }
#pragma unroll
        for (int a = 0; a < 2; ++a)
#pragma unroll
            for (int b = 0; b < 2; ++b)
#pragma unroll
                for (int m = 0; m < 4; ++m)
#pragma unroll
                    for (int n = 0; n < 2; ++n) acc[a][b][m][n] = (f32x4){0.f, 0.f, 0.f, 0.f};
        if (!has_next) break;
        cur = nxt; ++ui;
        if (wr == 1) PG8_BAR;
    }
    PG8_WAIT_V(0);
    PG8_BAR;
#undef CH_CODE
#undef PG8_SA
#undef PG8_SB
#undef CH_STAGE_A
#undef CH_STAGE_B
#undef CH_RB2
#undef ra2
#undef c2
#undef PG8_LDA
#undef PG8_LDB
#undef PG8_MMA
#undef PG8_WAIT_V
#undef PG8_WAIT_L
#undef PG8_BAR
#undef PG8_SCHED
}
}
#ifndef PG8_SP2
#define PG8_SP2 true
#endif
#ifndef PG8_ALIGN
#define PG8_ALIGN true
#endif
constexpr int NWAVES = 8;
constexpr int D = 1024, NB = 8, SEQ = 2048, NMETA = 16, LP = SEQ + NMETA, DBATCH = 128, DSEQ = 4;
constexpr int MP = NB * LP, MS = DBATCH * DSEQ, MTOT = MP + MS, MPAD = 17152;
constexpr int NQKV = 1536, NIN = 3072, NINP = 3328, FF = 4096;
constexpr int AH = 16, AKV = 4, AHD = 64, WIN = 128;
constexpr int MH = 4, MDK = 128, MDV = 256, MCH = 64, VS = 32, NSL = MDV / VS;
constexpr float EPS = 1e-6f;
static_assert(MPAD % 256 == 0 && MPAD >= MTOT, "row padding");
constexpr size_t MiB = 1u << 20;
constexpr size_t WS_CTL = 0, CTL_ZERO_BYTES = 1 * MiB;
constexpr size_t WS_WQKV = 2 * MiB, WS_WO = 8 * MiB, WS_WIN = 12 * MiB, WS_WOUT = 25 * MiB, WS_WUP = 29 * MiB, WS_WDN = 61 * MiB;
constexpr size_t SZ_WQKV = (size_t)NQKV * D * 2, SZ_WO = (size_t)D * D * 2, SZ_WIN = (size_t)NINP * D * 2, SZ_WUP = (size_t)FF * D * 2;
constexpr size_t WS_SS = 93 * MiB, WS_G = 95 * MiB, WS_HSS = 96 * MiB;
constexpr size_t WS_X = 100 * MiB, WS_XB = 167 * MiB, WS_Z = 201 * MiB, WS_AO = 302 * MiB, WS_FF = 336 * MiB, WS_PT = 470 * MiB, WS_END = 483 * MiB;
static_assert(WS_WQKV + 2 * SZ_WQKV <= WS_WO && WS_WO + 2 * SZ_WO <= WS_WIN && WS_WIN + 2 * SZ_WIN <= WS_WOUT && WS_WOUT + 2 * SZ_WO <= WS_WUP && WS_WUP + 4 * SZ_WUP <= WS_WDN && WS_WDN + 4 * SZ_WUP <= WS_SS, "weights map");
static_assert(WS_SS + (size_t)MPAD * 16 * 4 <= WS_G && WS_G + (size_t)MPAD * 8 * 4 <= WS_HSS && WS_HSS + (size_t)MPAD * 32 * 4 <= WS_X, "small maps");
static_assert(WS_X + (size_t)MPAD * D * 4 <= WS_XB && WS_XB + (size_t)MPAD * D * 2 <= WS_Z && WS_Z + (size_t)MPAD * NIN * 2 <= WS_AO && WS_AO + (size_t)MPAD * D * 2 <= WS_FF && WS_FF + (size_t)MPAD * FF * 2 <= WS_PT && WS_PT + (size_t)4 * 768 * D * 4 <= WS_END, "activation map");
constexpr int CW_BAR = 4096;
constexpr size_t O_YP = 0, O_YS = O_YP + (size_t)NB * SEQ * D, O_KP = O_YS + (size_t)MS * D, O_VP = O_KP + (size_t)2 * NB * WIN * AKV * AHD, O_KS = O_VP + (size_t)2 * NB * WIN * AKV * AHD,
    O_VS = O_KS + (size_t)2 * DBATCH * WIN * AKV * AHD, O_CP = O_VS + (size_t)2 * DBATCH * WIN * AKV * AHD, O_NP = O_CP + (size_t)2 * NB * MH * MDK * MDV, O_MP = O_NP + (size_t)2 * NB * MH * MDK,
    O_CS = O_MP + (size_t)2 * NB * MH, O_NS = O_CS + (size_t)2 * DBATCH * MH * MDK * MDV, O_MS = O_NS + (size_t)2 * DBATCH * MH * MDK, O_END = O_MS + (size_t)2 * DBATCH * MH;
constexpr int RING_OFF = 0, RING_BYTES = 131072;
constexpr int LDSCTL_OFF = RING_BYTES, MISC_OFF = LDSCTL_OFF + 320;
constexpr int LDS_BYTES = 147456;
#define GAS __attribute__((address_space(1)))
#define LAS __attribute__((address_space(3)))
typedef unsigned short bf16;
typedef unsigned v4u __attribute__((ext_vector_type(4)));
typedef float f32x4 __attribute__((ext_vector_type(4)));
typedef short bf16x8 __attribute__((ext_vector_type(8)));
typedef GAS unsigned gu32;
typedef GAS unsigned long long gu64;
#define RLX_AGENT __ATOMIC_RELAXED, __HIP_MEMORY_SCOPE_AGENT
#define LDS_WAIT() asm volatile("s_waitcnt lgkmcnt(0)" ::: "memory")
#define VM_WAIT() asm volatile("s_waitcnt vmcnt(0)" ::: "memory")
__device__ __forceinline__ unsigned long long rt() { return __builtin_amdgcn_s_memrealtime(); }
__device__ __forceinline__ unsigned f2bf(float f) { unsigned u = __builtin_bit_cast(unsigned, f); return (u + 0x7fffu + ((u >> 16) & 1u)) >> 16; }
__device__ __forceinline__ unsigned pk2(float lo, float hi) { return f2bf(lo) | (f2bf(hi) << 16); }

#define XB_TMO      128
#define XB_XCNT(j)  (256  + 64 * (j))
#define XB_XSUB(j)  (1280 + 64 * (j))
#define XB_XGEN(j)  (2304 + 64 * (j))
#define XB_TOP      3328
#define XB_TOPGEN   3392
#define XCD_BAR_WORDS 3456
#define XB_SPIN_CAP (1u << 18)

__device__ __forceinline__ unsigned xb_ld(unsigned* p)              { return __hip_atomic_load(p, __ATOMIC_RELAXED, __HIP_MEMORY_SCOPE_AGENT); }
__device__ __forceinline__ unsigned xb_add(unsigned* p, unsigned v) { return __hip_atomic_fetch_add(p, v, __ATOMIC_RELAXED, __HIP_MEMORY_SCOPE_AGENT); }
__device__ __forceinline__ unsigned xb_xcc_id() { return (unsigned)__builtin_amdgcn_s_getreg((3 << 11) | 20) & 0xFu; }
#define XB_SPIN(cond, bar) do { unsigned _sp = 0; while (cond) { __builtin_amdgcn_s_sleep(1); \
    if ((++_sp & 255u) == 0u) { if (xb_ld(&(bar)[XB_TMO])) break; if (_sp > XB_SPIN_CAP) { atomicAdd(&(bar)[XB_TMO], 1u); break; } } } } while (0)

struct XcdBarrier {
    unsigned* bar; unsigned x;
    volatile LAS unsigned* st;
};

__device__ __forceinline__ XcdBarrier xcd_barrier_post(unsigned* bar, volatile LAS unsigned* st) {
    XcdBarrier b; b.bar = bar; b.x = xb_xcc_id(); b.st = st;
    if (threadIdx.x == 0) (void)xb_add(&bar[XB_XCNT(b.x)], 1u);
    return b;
}
__device__ __forceinline__ void xcd_barrier_complete(unsigned* bar, unsigned x, unsigned& nloc, unsigned& nx) {
    const unsigned G = gridDim.x * gridDim.y * gridDim.z;
    unsigned sum, cnt, mine, sp = 0u;
    for (;;) {
        sum = 0u; cnt = 0u; mine = 0u;
#pragma unroll
        for (unsigned j = 0; j < 16; ++j) { const unsigned c = xb_ld(&bar[XB_XCNT(j)]); sum += c; cnt += (c > 0u) ? 1u : 0u; mine = (j == x) ? c : mine; }
        if (sum == G) break;
        __builtin_amdgcn_s_sleep(1);
        if ((++sp & 255u) == 0u) { if (xb_ld(&bar[XB_TMO])) break; if (sp > XB_SPIN_CAP) { atomicAdd(&bar[XB_TMO], 1u); break; } }
    }
    nloc = mine > 0u ? mine : 1u; nx = cnt > 0u ? cnt : 1u;
}

__device__ __forceinline__ void xcd_barrier(const XcdBarrier& b) {
    asm volatile("s_waitcnt vmcnt(0)" ::: "memory");
    __syncthreads();
    if (threadIdx.x == 0) {
        unsigned* bar = b.bar;
        __builtin_amdgcn_s_waitcnt(0);
        unsigned nloc = b.st[0], nx = b.st[1];
        if (nloc == 0u) { xcd_barrier_complete(bar, b.x, nloc, nx); b.st[0] = nloc; b.st[1] = nx; }
        const unsigned old = xb_add(&bar[XB_XSUB(b.x)], 1u);
        const unsigned gen = old / nloc;
        if (old + 1u == (gen + 1u) * nloc) {
            __builtin_amdgcn_fence(__ATOMIC_RELEASE, "agent");
            asm volatile("s_waitcnt vmcnt(0)" ::: "memory");
            const unsigned og = xb_add(&bar[XB_TOP], 1u);
            const unsigned tg = og / nx;
            if (og + 1u == (tg + 1u) * nx) xb_add(&bar[XB_TOPGEN], 1u);
            else XB_SPIN(xb_ld(&bar[XB_TOPGEN]) == tg, bar);
            __builtin_amdgcn_fence(__ATOMIC_ACQUIRE, "agent");
            xb_add(&bar[XB_XGEN(b.x)], 1u);
            asm volatile("s_waitcnt vmcnt(0)" ::: "memory");
        } else {
            XB_SPIN(xb_ld(&bar[XB_XGEN(b.x)]) == gen, bar);
            __builtin_amdgcn_fence(__ATOMIC_ACQUIRE, "agent");
            asm volatile("s_waitcnt vmcnt(0)" ::: "memory");
        }
    }
    __syncthreads();
}

typedef unsigned v2u __attribute__((ext_vector_type(2)));
__device__ __forceinline__ float bf_lo(unsigned w) { return __builtin_bit_cast(float, w << 16); }
__device__ __forceinline__ float bf_hi(unsigned w) { return __builtin_bit_cast(float, w & 0xffff0000u); }
__device__ __forceinline__ float bf1(bf16 b) { return __builtin_bit_cast(float, (unsigned)b << 16); }
__device__ __forceinline__ void unpack8(const v4u w, float (&f)[8]) { f[0] = bf_lo(w.x); f[1] = bf_hi(w.x); f[2] = bf_lo(w.y); f[3] = bf_hi(w.y); f[4] = bf_lo(w.z); f[5] = bf_hi(w.z); f[6] = bf_lo(w.w); f[7] = bf_hi(w.w); }
__device__ __forceinline__ v4u pack8(const float (&f)[8]) { v4u o; o.x = pk2(f[0], f[1]); o.y = pk2(f[2], f[3]); o.z = pk2(f[4], f[5]); o.w = pk2(f[6], f[7]); return o; }
__device__ __forceinline__ float wave_sum(float v, int lane) {
#pragma unroll
    for (int o = 1; o < 64; o <<= 1) v += pg8::shx(v, o, lane);
    return v;
}
__device__ __forceinline__ f32x4 mfma16(bf16x8 a, bf16x8 b, f32x4 c) { return __builtin_amdgcn_mfma_f32_16x16x32_bf16(a, b, c, 0, 0, 0); }
#define WG_BAR() do { asm volatile("s_waitcnt vmcnt(0) lgkmcnt(0)" ::: "memory"); __builtin_amdgcn_s_barrier(); asm volatile("" ::: "memory"); } while (0)
#define LDS_BAR() do { asm volatile("s_waitcnt lgkmcnt(0)" ::: "memory"); __builtin_amdgcn_s_barrier(); asm volatile("" ::: "memory"); } while (0)

__device__ __forceinline__ void p0_transpose_item(const float* W, const float* gs, int K, int N, bf16* WT, int row_off, int mlo, int mhi, float mul, LAS float* scr, int item, int lane) {
    const int nblk = N / 32, kb = item / nblk, nb = item % nblk, k0 = 64 * kb, n0 = 32 * nb;
    const float cm = (n0 >= mlo && n0 < mhi) ? mul : 1.0f;
#pragma unroll 8
    for (int i = 0; i < 32; ++i) { const int kk = 2 * i + (lane >> 5); const float g = gs ? gs[k0 + kk] * cm : cm; scr[kk * 33 + (lane & 31)] = W[(size_t)(k0 + kk) * N + n0 + (lane & 31)] * g; }
    LDS_WAIT(); asm volatile("" ::: "memory");
    const int c = lane & 7;
#pragma unroll
    for (int j = 0; j < 4; ++j) { const int n = (lane >> 3) + 8 * j; const LAS float* s = scr + (8 * c) * 33 + n;
        v4u o; o.x = pk2(s[0 * 33], s[1 * 33]); o.y = pk2(s[2 * 33], s[3 * 33]); o.z = pk2(s[4 * 33], s[5 * 33]); o.w = pk2(s[6 * 33], s[7 * 33]);
        *(GAS v4u*)(WT + (size_t)(row_off + n0 + n) * K + k0 + 8 * c) = o; }
    LDS_WAIT(); asm volatile("" ::: "memory");
}
struct P0Args { const float *xp, *xs, *meta, *norm_mix, *norm_mlp, *wqkv, *wo, *win, *wgate, *wout, *wup, *wdn; unsigned char* ws; };
__device__ __forceinline__ void p0_prologue(const P0Args& A, LAS unsigned char* lds, int vcu, int G, int wave, int lane, int tid) {
    LAS float* scr = (LAS float*)(lds + RING_OFF + wave * 16384);
    const int gw = vcu * NWAVES + wave, NGW = G * NWAVES;
    constexpr int I_QKV = (D / 64) * (NQKV / 32), I_O = (D / 64) * (D / 32), I_IN = (D / 64) * (NIN / 32), I_UP = (D / 64) * (FF / 32), I_DN = (FF / 64) * (D / 32);
    constexpr int I_MIX = I_QKV + I_O + I_IN + I_O, I_MLP = I_UP + I_DN, NITEMS = 2 * I_MIX + 4 * I_MLP;
    unsigned char* ws = A.ws;
    for (int it = gw; it < NITEMS; it += NGW) {
        int r = it;
        if (r < 2 * I_MIX) { const int j = r / I_MIX; r -= j * I_MIX;
            if (r < I_QKV) { p0_transpose_item(A.wqkv + (size_t)j * D * NQKV, A.norm_mix + (2 * j) * D, D, NQKV, (bf16*)(ws + WS_WQKV + j * SZ_WQKV), 0, 0, 0, 1.f, scr, r, lane); continue; } r -= I_QKV;
            if (r < I_O) { p0_transpose_item(A.wo + (size_t)j * D * D, nullptr, D, D, (bf16*)(ws + WS_WO + j * SZ_WO), 0, 0, 0, 1.f, scr, r, lane); continue; } r -= I_O;
            if (r < I_IN) { p0_transpose_item(A.win + (size_t)j * D * NIN, A.norm_mix + (2 * j + 1) * D, D, NIN, (bf16*)(ws + WS_WIN + j * SZ_WIN), 0, 512, 1024, 0.08838834764831845f, scr, r, lane); continue; } r -= I_IN;
            p0_transpose_item(A.wout + (size_t)j * D * D, nullptr, D, D, (bf16*)(ws + WS_WOUT + j * SZ_WO), 0, 0, 0, 1.f, scr, r, lane); continue; }
        r -= 2 * I_MIX;
        { const int i = r / I_MLP; r -= i * I_MLP;
            if (r < I_UP) { p0_transpose_item(A.wup + (size_t)i * D * FF, A.norm_mlp + i * D, D, FF, (bf16*)(ws + WS_WUP + i * SZ_WUP), 0, 0, 0, 1.f, scr, r, lane); continue; } r -= I_UP;
            p0_transpose_item(A.wdn + (size_t)i * FF * D, nullptr, FF, D, (bf16*)(ws + WS_WDN + i * SZ_WUP), 0, 0, 0, 1.f, scr, r, lane); }
    }
    { const int gt = vcu * (NWAVES * 64) + tid, NT = G * NWAVES * 64;
      for (int e = gt; e < 2 * 256 * (D / 8); e += NT) { const int j = e / (256 * (D / 8)), rem = e % (256 * (D / 8)), n = rem / (D / 8), k8 = (rem % (D / 8)) * 8;
          float f[8];
#pragma unroll
          for (int q = 0; q < 8; ++q) f[q] = (n < 8) ? A.wgate[((size_t)j * D + k8 + q) * 8 + n] * A.norm_mix[(2 * j + 1) * D + k8 + q] : 0.f;
          *(GAS v4u*)((bf16*)(ws + WS_WIN + j * SZ_WIN) + (size_t)(NIN + n) * D + k8) = pack8(f); } }
    float* X = (float*)(ws + WS_X); bf16* XB = (bf16*)(ws + WS_XB); float* SS = (float*)(ws + WS_SS); bf16* AO = (bf16*)(ws + WS_AO);
    for (int m = gw; m < MPAD; m += NGW) {
        const float* src = nullptr;
        if (m < MP) { const int b = m / LP, t = m - b * LP; src = (t < NMETA) ? A.meta + (size_t)t * D : A.xp + ((size_t)b * SEQ + (t - NMETA)) * D; }
        else if (m < MTOT) src = A.xs + (size_t)(m - MP) * D;
        f32x4 v[4]; float ss[4];
#pragma unroll
        for (int j = 0; j < 4; ++j) { v[j] = src ? ((const GAS f32x4*)src)[lane + 64 * j] : (f32x4){0.f, 0.f, 0.f, 0.f}; ss[j] = wave_sum((v[j][0] * v[j][0] + v[j][1] * v[j][1]) + (v[j][2] * v[j][2] + v[j][3] * v[j][3]), lane); }
#pragma unroll
        for (int j = 0; j < 4; ++j) { ((GAS f32x4*)(X + (size_t)m * D))[lane + 64 * j] = v[j]; v2u w; w.x = pk2(v[j][0], v[j][1]); w.y = pk2(v[j][2], v[j][3]); ((GAS v2u*)(XB + (size_t)m * D))[lane + 64 * j] = w; }
        if (lane < 16) { const int j = lane >> 2; const float s = (lane & 3) ? 0.f : (j == 0 ? ss[0] : j == 1 ? ss[1] : j == 2 ? ss[2] : ss[3]); SS[(size_t)m * 16 + lane] = s; }
        if (m >= MTOT) {
#pragma unroll
            for (int j = 0; j < 4; ++j) ((GAS v2u*)(AO + (size_t)m * D))[lane + 64 * j] = (v2u){0u, 0u}; }
    }
}

constexpr int A_KS = 0, A_KSTR = 144, A_VT = 36864, A_VSTR = 552, A_LUT = 72192, A_END = 74304;
__device__ __forceinline__ int t5_bucket(int n) {
    if (n < 16) return n;
    const int v = 16 + (int)(logf((float)n * (1.0f / 16.0f)) * (16.0f / 2.0794415416798357f));
    return v < 31 ? v : 31;
}
struct AttnP { const bf16* QKV; const float *gq, *gk, *sinks, *rel; bf16* AO; };
__device__ __forceinline__ void attn_subtile(LAS unsigned char* L, int i0, const bf16* qptr, int hh, int dist0, int jmin, float sink, const float* gq, bf16* optr, bool store, int lane) {
    const int g = lane >> 4, c = lane & 15;
    bf16x8 Bq[2];
    {
        const v4u q0 = *(const GAS v4u*)(qptr + 8 * g), q1 = *(const GAS v4u*)(qptr + 32 + 8 * g);
        float f0[8], f1[8]; unpack8(q0, f0); unpack8(q1, f1);
        float ss = 0.f;
#pragma unroll
        for (int e = 0; e < 8; ++e) ss += f0[e] * f0[e] + f1[e] * f1[e];
        ss += pg8::shx(ss, 16, lane); ss += pg8::shx(ss, 32, lane);
        const float rq = 0.125f / sqrtf(ss * (1.0f / 64.0f) + EPS);
        const f32x4 ga = *(const f32x4*)(gq + 8 * g), gb = *(const f32x4*)(gq + 8 * g + 4), gc = *(const f32x4*)(gq + 32 + 8 * g), gd = *(const f32x4*)(gq + 36 + 8 * g);
#pragma unroll
        for (int e = 0; e < 4; ++e) { f0[e] *= rq * ga[e]; f0[4 + e] *= rq * gb[e]; f1[e] *= rq * gc[e]; f1[4 + e] *= rq * gd[e]; }
        const v4u p0 = pack8(f0), p1 = pack8(f1);
        Bq[0] = __builtin_bit_cast(bf16x8, p0); Bq[1] = __builtin_bit_cast(bf16x8, p1);
    }
    f32x4 s[10];
    float mx = -1e30f;
#pragma unroll
    for (int kt = 0; kt < 9; ++kt) {
        const LAS unsigned char* kp = L + A_KS + (i0 + 16 * kt + c) * A_KSTR + 16 * g;
        f32x4 acc = {0.f, 0.f, 0.f, 0.f};
        acc = mfma16(*(const LAS bf16x8*)kp, Bq[0], acc);
        acc = mfma16(*(const LAS bf16x8*)(kp + 64), Bq[1], acc);
#pragma unroll
        for (int r = 0; r < 4; ++r) {
            const int rel = 16 * kt + 4 * g + r, dist = dist0 - rel;
            const bool ok = (dist >= 0) && (dist <= WIN) && (i0 + rel >= jmin);
            const int di = dist < 0 ? 0 : (dist > WIN ? WIN : dist);
            const float bias = *(const LAS float*)(L + A_LUT + (hh * 132 + di) * 4);
            const float v = ok ? acc[r] + bias : -1e30f;
            s[kt][r] = v; mx = fmaxf(mx, v);
        }
    }
    mx = fmaxf(mx, pg8::shx(mx, 16, lane)); mx = fmaxf(mx, pg8::shx(mx, 32, lane));
    mx = fmaxf(mx, sink);
    float l = 0.f;
#pragma unroll
    for (int kt = 0; kt < 9; ++kt)
#pragma unroll
        for (int r = 0; r < 4; ++r) { const float p = __expf(s[kt][r] - mx); s[kt][r] = p; l += p; }
    s[9] = (f32x4){0.f, 0.f, 0.f, 0.f};
    l += pg8::shx(l, 16, lane); l += pg8::shx(l, 32, lane);
    const float inv = 1.0f / (l + __expf(sink - mx));
    bf16x8 Bp[5];
#pragma unroll
    for (int ks = 0; ks < 5; ++ks) { v4u w; w.x = pk2(s[2 * ks][0], s[2 * ks][1]); w.y = pk2(s[2 * ks][2], s[2 * ks][3]); w.z = pk2(s[2 * ks + 1][0], s[2 * ks + 1][1]); w.w = pk2(s[2 * ks + 1][2], s[2 * ks + 1][3]); Bp[ks] = __builtin_bit_cast(bf16x8, w); }
#pragma unroll
    for (int dt = 0; dt < 4; ++dt) {
        f32x4 acc = {0.f, 0.f, 0.f, 0.f};
        const LAS unsigned char* vp = L + A_VT + (16 * dt + c) * A_VSTR + (i0 + 4 * g) * 2;
#pragma unroll
        for (int ks = 0; ks < 5; ++ks) { const v2u lo = *(const LAS v2u*)(vp + 64 * ks), hi = *(const LAS v2u*)(vp + 64 * ks + 32); const v4u a = {lo.x, lo.y, hi.x, hi.y};
            acc = mfma16(__builtin_bit_cast(bf16x8, a), Bp[ks], acc); }
        if (store) { v2u w; w.x = pk2(acc[0] * inv, acc[1] * inv); w.y = pk2(acc[2] * inv, acc[3] * inv); *(GAS v2u*)(optr + 16 * dt + 4 * g) = w; }
    }
}
__device__ __forceinline__ void attn_stage_row(LAS unsigned char* L, int j, int half, const bf16* krow, const bf16* vrow, const float* gk, float* ck, float* cv, int lane) {
    float kf[32], vf[32];
    if (krow) {
#pragma unroll
        for (int i = 0; i < 4; ++i) { float t[8]; unpack8(*(const GAS v4u*)(krow + 8 * i), t);
#pragma unroll
            for (int e = 0; e < 8; ++e) kf[8 * i + e] = t[e];
            unpack8(*(const GAS v4u*)(vrow + 8 * i), t);
#pragma unroll
            for (int e = 0; e < 8; ++e) vf[8 * i + e] = t[e]; }
    } else {
#pragma unroll
        for (int e = 0; e < 32; ++e) { kf[e] = 0.f; vf[e] = 0.f; }
    }
    float ss = 0.f;
#pragma unroll
    for (int e = 0; e < 32; ++e) ss += kf[e] * kf[e];
    ss += pg8::shx(ss, 1, lane);
    const float rk = 1.0f / sqrtf(ss * (1.0f / 64.0f) + EPS);
#pragma unroll
    for (int i = 0; i < 8; ++i) { const f32x4 gg = *(const f32x4*)(gk + half * 32 + 4 * i);
#pragma unroll
        for (int e = 0; e < 4; ++e) kf[4 * i + e] *= rk * gg[e]; }
#pragma unroll
    for (int i = 0; i < 4; ++i) { float t[8];
#pragma unroll
        for (int e = 0; e < 8; ++e) t[e] = kf[8 * i + e];
        *(LAS v4u*)(L + A_KS + j * A_KSTR + half * 64 + 16 * i) = pack8(t); }
#pragma unroll
    for (int e = 0; e < 32; ++e) *(LAS unsigned short*)(L + A_VT + (half * 32 + e) * A_VSTR + 2 * j) = (unsigned short)f2bf(vf[e]);
    if (ck) {
#pragma unroll
        for (int i = 0; i < 8; ++i) { *(GAS f32x4*)(ck + half * 32 + 4 * i) = (f32x4){kf[4 * i], kf[4 * i + 1], kf[4 * i + 2], kf[4 * i + 3]};
            *(GAS f32x4*)(cv + half * 32 + 4 * i) = (f32x4){vf[4 * i], vf[4 * i + 1], vf[4 * i + 2], vf[4 * i + 3]}; }
    }
}
__device__ __forceinline__ void attn_phase(LAS unsigned char* L, const AttnP& P, const float* cache_k, const float* cache_v, float* out, int jl, int vcu, int G, int tid_in, int wave_in, int lane_in) {
    constexpr int N_PROMPT = NB * 17 * AKV, N_ITEMS = N_PROMPT + DBATCH * AKV;
#pragma unroll 1
    for (int it = vcu; it < N_ITEMS; it += G) {
        int tid = tid_in; asm volatile("" : "+v"(tid));
        const int lane = tid & 63, wave = __builtin_amdgcn_readfirstlane(tid >> 6);
        const bool prompt = it < N_PROMPT;
        int b = 0, qb = 0, kvh, db = 0;
        if (prompt) { b = it / (17 * AKV); const int rem = it % (17 * AKV); qb = rem / AKV; kvh = rem % AKV; }
        else { const int si = it - N_PROMPT; db = si / AKV; kvh = si % AKV; }
        for (int e = tid; e < 4 * 129; e += NWAVES * 64) { const int hh = e / 129, d = e % 129; *(LAS float*)(L + A_LUT + (hh * 132 + d) * 4) = P.rel[t5_bucket(d) * AH + kvh * 4 + hh]; }
        if (prompt) {
            const int j = tid >> 1, half = tid & 1, tok = 128 * qb - 240 + j;
            const bf16* krow = nullptr; const bf16* vrow = nullptr; float* ck = nullptr; float* cv = nullptr;
            if (tok >= 0) { const size_t row = (size_t)b * LP + tok; krow = P.QKV + row * NQKV + 1024 + kvh * 64 + half * 32; vrow = P.QKV + row * NQKV + 1280 + kvh * 64 + half * 32; }
            if (qb == 16 && j >= 128) { const size_t o = ((((size_t)jl * NB + b) * WIN + (j - 128)) * AKV + kvh) * AHD; ck = out + O_KP + o; cv = out + O_VP + o; }
            attn_stage_row(L, j, half, krow, vrow, P.gk, ck, cv, lane);
            for (int e = tid; e < 64 * 16; e += NWAVES * 64) *(LAS unsigned short*)(L + A_VT + (e >> 4) * A_VSTR + 2 * (256 + (e & 15))) = 0;
        } else {
            const float* ckin = cache_k + (((size_t)jl * DBATCH + db) * WIN * AKV + kvh) * AHD; const float* cvin = cache_v + (((size_t)jl * DBATCH + db) * WIN * AKV + kvh) * AHD;
            float* cko = out + O_KS + (((size_t)jl * DBATCH + db) * WIN * AKV + kvh) * AHD; float* cvo = out + O_VS + (((size_t)jl * DBATCH + db) * WIN * AKV + kvh) * AHD;
#pragma unroll
            for (int i = 0; i < 4; ++i) { const int idx = tid + 512 * i, row = idx >> 4, c4 = idx & 15;
                const f32x4 kv = *(const GAS f32x4*)(ckin + (size_t)row * (AKV * AHD) + 4 * c4), vv = *(const GAS f32x4*)(cvin + (size_t)row * (AKV * AHD) + 4 * c4);
                v2u w; w.x = pk2(kv[0], kv[1]); w.y = pk2(kv[2], kv[3]); *(LAS v2u*)(L + A_KS + row * A_KSTR + 8 * c4) = w;
#pragma unroll
                for (int e = 0; e < 4; ++e) *(LAS unsigned short*)(L + A_VT + (4 * c4 + e) * A_VSTR + 2 * row) = (unsigned short)f2bf(vv[e]);
                if (row >= DSEQ) { *(GAS f32x4*)(cko + (size_t)(row - DSEQ) * (AKV * AHD) + 4 * c4) = kv; *(GAS f32x4*)(cvo + (size_t)(row - DSEQ) * (AKV * AHD) + 4 * c4) = vv; } }
            if (tid < 2 * DSEQ) { const int s = tid >> 1, half = tid & 1; const size_t row = (size_t)MP + db * DSEQ + s;
                attn_stage_row(L, WIN + s, half, P.QKV + row * NQKV + 1024 + kvh * 64 + half * 32, P.QKV + row * NQKV + 1280 + kvh * 64 + half * 32, P.gk,
                               cko + (size_t)(WIN - DSEQ + s) * (AKV * AHD), cvo + (size_t)(WIN - DSEQ + s) * (AKV * AHD), lane); }
            for (int e = tid; e < 12 * 8; e += NWAVES * 64) { unsigned z0 = 0u; asm volatile("" : "+v"(z0)); *(LAS v4u*)(L + A_KS + (132 + e / 8) * A_KSTR + 16 * (e & 7)) = (v4u){z0, z0, z0, z0}; }
            for (int e = tid; e < 64 * 28; e += NWAVES * 64) *(LAS unsigned short*)(L + A_VT + (e / 28) * A_VSTR + 2 * (132 + e % 28)) = 0;
        }
        LDS_BAR();
        if (prompt) {
            const int hh = wave & 3, rhalf = wave >> 2, head = kvh * 4 + hh; const float sink = P.sinks[head];
            const int jmin = 240 - 128 * qb;
#pragma unroll 1
            for (int st = 0; st < 4; ++st) {
                const int i0 = 64 * rhalf + 16 * st;
                if (qb == 0 && i0 < 112) continue;
                const int tok = 128 * qb - 112 + i0 + (lane & 15); const size_t row = (size_t)b * LP + tok;
                attn_subtile(L, i0, P.QKV + row * NQKV + head * 64, hh, (lane & 15) + WIN, jmin, sink, P.gq, P.AO + row * D + head * 64, true, lane);
            }
        } else if (wave == 0) {
            const int q = lane & 15, hh = q >> 2, s = q & 3, head = kvh * 4 + hh; const size_t row = (size_t)MP + db * DSEQ + s;
            attn_subtile(L, 0, P.QKV + row * NQKV + head * 64, hh, WIN + s, 0, P.sinks[head], P.gq, P.AO + row * D + head * 64, true, lane);
        }
        LDS_BAR();
    }
}

constexpr int M_QS = 0, M_KS = 17408, M_KT = 34816, M_VT = 53248, M_VW = 60160, M_CT = 67072, M_CTB = 13056;
constexpr int M_RS = 272, M_TS = 144;
struct MlP { const bf16* Z; const float* G; const float* gnorm; bf16* AO; float* HSS; };
__device__ __forceinline__ float wave_scan_add(float x, int lane) {
#pragma unroll
    for (int o = 1; o < 64; o <<= 1) { const float t = pg8::shl_from(x, lane - o); if (lane >= o) x += t; }
    return x;
}
__device__ __forceinline__ float wave_scan_max(float x, int lane) {
#pragma unroll
    for (int o = 1; o < 64; o <<= 1) { const float t = pg8::shl_from(x, lane - o); if (lane >= o) x = fmaxf(x, t); }
    return x;
}
__device__ __forceinline__ float sigmoidf_(float x) { return 1.0f / (1.0f + __expf(-x)); }
__device__ __forceinline__ float tanh_fast(float x) { return 1.0f - 2.0f / (1.0f + __expf(2.0f * x)); }
__device__ __forceinline__ float gate_i(float g) { return 15.0f * tanh_fast(g * (1.0f / 15.0f)); }
__device__ __forceinline__ float gate_f(float g) { const float x = 15.0f * tanh_fast(g * (1.0f / 15.0f)); return fminf(x, 0.f) - __logf(1.0f + __expf(-fabsf(x))); }
constexpr int M_TB = 94208, M_CS = M_TB + 33 * 192 * 4, M_MS = M_CS + 33 * 2 * 4, M_MX = M_MS + 34 * 4, M_END2 = M_MX + 34 * 4;
static_assert(M_END2 <= RING_BYTES, "mLSTM LDS map");
__device__ __forceinline__ void mlstm_prompt_item(LAS unsigned char* L, const MlP& P, float* out, int jl, int b, int h, int sl, int tid, int wave, int lane) {
    const int g = lane >> 4, c = lane & 15;
    unsigned z0 = 0u; asm volatile("" : "+v"(z0));
    for (int e = tid; e < 16 * 72; e += NWAVES * 64) { const int r = e / 72, cc = e % 72; const unsigned short one = 0x3f80;
        *(LAS unsigned short*)(L + M_VT + (32 + r) * M_TS + 2 * cc) = (r == 0) ? one : (unsigned short)0; *(LAS unsigned short*)(L + M_VW + (32 + r) * M_TS + 2 * cc) = 0; }
    for (int e = tid; e < M_CTB / 16; e += NWAVES * 64) *(LAS v4u*)(L + M_CT + 16 * e) = (v4u){z0, z0, z0, z0};
    { LAS float* TB = (LAS float*)(L + M_TB); LAS float* CS = (LAS float*)(L + M_CS);
      float gl[5], gf[5];
#pragma unroll
      for (int k = 0; k < 5; ++k) { const int cc = wave + 8 * k; const int t0_ = cc == 0 ? 0 : 16 + 64 * (cc - 1), nv_ = cc == 0 ? 16 : 64;
          if (cc < 33 && lane < nv_) { const float* gr = P.G + ((size_t)b * LP + t0_ + lane) * 8; gl[k] = gr[h]; gf[k] = gr[4 + h]; } else { gl[k] = 0.f; gf[k] = 0.f; } }
#pragma unroll
      for (int k = 0; k < 5; ++k) { const int cc = wave + 8 * k; const int nv_ = cc == 0 ? 16 : 64;
          if (cc < 33) { const float li = lane < nv_ ? gate_i(gl[k]) : -1e30f, lf = lane < nv_ ? gate_f(gf[k]) : 0.f;
              const float bcum = wave_scan_add(lf, lane), wj = li - bcum, cm = wave_scan_max(wj, lane);
              TB[cc * 192 + lane] = bcum; TB[cc * 192 + 64 + lane] = wj; TB[cc * 192 + 128 + lane] = cm;
              if (lane == 63) { CS[2 * cc] = bcum; CS[2 * cc + 1] = cm; } } }
    }
    LDS_BAR();
    if (wave == 0) {
        const LAS float* CS = (const LAS float*)(L + M_CS);
        const float bl = lane < 33 ? CS[2 * lane] : 0.f, cx = lane < 33 ? CS[2 * lane + 1] : 0.f;
        float mrun = 0.f, ms = 0.f, mx = 0.f;
#pragma unroll 1
        for (int k = 0; k < 33; ++k) { const float blk = __builtin_bit_cast(float, __builtin_amdgcn_readlane(__builtin_bit_cast(int, bl), k)), cxk = __builtin_bit_cast(float, __builtin_amdgcn_readlane(__builtin_bit_cast(int, cx), k));
            const float mxk = fmaxf(mrun, cxk); if (lane == k) { ms = mrun; mx = mxk; } mrun = blk + mxk; }
        if (lane == 33) { ms = mrun; mx = mrun; }
        if (lane < 34) { ((LAS float*)(L + M_MS))[lane] = ms; ((LAS float*)(L + M_MX))[lane] = mx; }
    }
    f32x4 cacc[6];
#pragma unroll
    for (int i = 0; i < 6; ++i) cacc[i] = (f32x4){0.f, 0.f, 0.f, 0.f};
    const int srow = lane, spiece = wave, vpiece = wave & 3;
    v4u aq0, aq1, ak0, ak1, av, bq0, bq1, bk0, bk1, bv;
    v2u po0 = {z0, z0}, po1 = {z0, z0};
#define ML_LOAD(ch, q0, q1, k0, k1, vv) do { const int t0_ = (ch) == 0 ? 0 : 16 + 64 * ((ch) - 1), nv_ = (ch) == 0 ? 16 : 64; \
        if (srow < nv_) { const bf16* zr = P.Z + ((size_t)b * LP + t0_ + srow) * NIN + h * MDK + 16 * spiece; q0 = *(const GAS v4u*)zr; q1 = *(const GAS v4u*)(zr + 8); k0 = *(const GAS v4u*)(zr + 512); k1 = *(const GAS v4u*)(zr + 520); } \
        else { q0 = q1 = k0 = k1 = (v4u){z0, z0, z0, z0}; } \
        if (wave < 4 && srow < nv_) vv = *(const GAS v4u*)(P.Z + ((size_t)b * LP + t0_ + srow) * NIN + 1024 + h * MDV + VS * sl + 8 * vpiece); else vv = (v4u){z0, z0, z0, z0}; } while (0)
#define ML_OLOAD(ch) do { const int t0_ = (ch) == 0 ? 0 : 16 + 64 * ((ch) - 1), nv_ = (ch) == 0 ? 16 : 64; const int trow_ = 16 * wave + c; \
        if (wave < 4 && trow_ < nv_) { const bf16* zo = P.Z + ((size_t)b * LP + t0_ + trow_) * NIN + 2048 + h * MDV + VS * sl + 4 * g; po0 = *(const GAS v2u*)zo; po1 = *(const GAS v2u*)(zo + 16); } } while (0)
    ML_LOAD(0, aq0, aq1, ak0, ak1, av); ML_LOAD(1, bq0, bq1, bk0, bk1, bv); ML_OLOAD(0);
    LDS_BAR();
#define ML_STEP(ch, q0, q1, k0, k1, vv) do { \
        const int t0 = (ch) == 0 ? 0 : 16 + 64 * ((ch) - 1), nvalid = (ch) == 0 ? 16 : 64, cur = (ch) & 1; \
        const float m_prev = ((const LAS float*)(L + M_MS))[ch], Mx = ((const LAS float*)(L + M_MX))[ch]; \
        const float wk = __expf(((const LAS float*)(L + M_TB))[(ch) * 192 + 64 + lane] - Mx), a = __expf(m_prev - Mx); \
          \
        *(LAS v4u*)(L + M_QS + srow * M_RS + 32 * spiece) = q0; *(LAS v4u*)(L + M_QS + srow * M_RS + 32 * spiece + 16) = q1; \
        *(LAS v4u*)(L + M_KS + srow * M_RS + 32 * spiece) = k0; *(LAS v4u*)(L + M_KS + srow * M_RS + 32 * spiece + 16) = k1; \
        { const unsigned kw[8] = {k0.x, k0.y, k0.z, k0.w, k1.x, k1.y, k1.z, k1.w}; \
          _Pragma("unroll") for (int e = 0; e < 8; ++e) { *(LAS unsigned short*)(L + M_KT + (16 * spiece + 2 * e) * M_TS + 2 * srow) = (unsigned short)(kw[e] & 0xffffu); *(LAS unsigned short*)(L + M_KT + (16 * spiece + 2 * e + 1) * M_TS + 2 * srow) = (unsigned short)(kw[e] >> 16); } } \
        if (wave < 4) { float vf[8]; unpack8(vv, vf); const unsigned vw_[4] = {vv.x, vv.y, vv.z, vv.w}; \
            _Pragma("unroll") for (int e = 0; e < 4; ++e) { *(LAS unsigned short*)(L + M_VT + (8 * vpiece + 2 * e) * M_TS + 2 * srow) = (unsigned short)(vw_[e] & 0xffffu); *(LAS unsigned short*)(L + M_VT + (8 * vpiece + 2 * e + 1) * M_TS + 2 * srow) = (unsigned short)(vw_[e] >> 16); } \
            _Pragma("unroll") for (int e = 0; e < 8; ++e) *(LAS unsigned short*)(L + M_VW + (8 * vpiece + e) * M_TS + 2 * srow) = (unsigned short)f2bf(vf[e] * wk); } \
        if (wave == 4) *(LAS unsigned short*)(L + M_VW + 32 * M_TS + 2 * lane) = (unsigned short)f2bf(wk); \
        LDS_BAR(); \
        if ((ch) + 2 < 33) ML_LOAD((ch) + 2, q0, q1, k0, k1, vv); \
        if (wave < 4) { \
            const int tt = wave, trow = 16 * tt + c; \
            bf16x8 Bq[4]; \
            _Pragma("unroll") for (int ks = 0; ks < 4; ++ks) Bq[ks] = *(const LAS bf16x8*)(L + M_QS + trow * M_RS + 64 * ks + 16 * g); \
            const LAS float* tb = (const LAS float*)(L + M_TB) + (ch) * 192; \
            const float bct = tb[trow], Mt = fmaxf(m_prev, tb[128 + trow]), ut = -Mt, wint = __expf(m_prev - Mt), einv = __expf(-(bct + Mt)); \
            f32x4 s[4]; \
            _Pragma("unroll") for (int jt = 0; jt < 4; ++jt) { \
                if (jt <= tt) { \
                    f32x4 acc = {0.f, 0.f, 0.f, 0.f}; \
                    _Pragma("unroll") for (int ks = 0; ks < 4; ++ks) acc = mfma16(*(const LAS bf16x8*)(L + M_KS + (16 * jt + c) * M_RS + 64 * ks + 16 * g), Bq[ks], acc); \
                    const f32x4 wjj = *(const LAS f32x4*)(tb + 64 + 16 * jt + 4 * g); \
                    _Pragma("unroll") for (int r = 0; r < 4; ++r) { const int j = 16 * jt + 4 * g + r; acc[r] = (j <= trow) ? acc[r] * __expf(ut + wjj[r]) : 0.f; } \
                    s[jt] = acc; \
                } else s[jt] = (f32x4){0.f, 0.f, 0.f, 0.f}; \
            } \
            bf16x8 Bs[2]; \
            _Pragma("unroll") for (int k2 = 0; k2 < 2; ++k2) { v4u w; w.x = pk2(s[2 * k2][0], s[2 * k2][1]); w.y = pk2(s[2 * k2][2], s[2 * k2][3]); w.z = pk2(s[2 * k2 + 1][0], s[2 * k2 + 1][1]); w.w = pk2(s[2 * k2 + 1][2], s[2 * k2 + 1][3]); Bs[k2] = __builtin_bit_cast(bf16x8, w); } \
            f32x4 nm[3]; \
            _Pragma("unroll") for (int vt = 0; vt < 3; ++vt) { \
                f32x4 acc = {0.f, 0.f, 0.f, 0.f}; \
                _Pragma("unroll") for (int ks = 0; ks < 4; ++ks) acc = mfma16(*(const LAS bf16x8*)(L + M_CT + cur * M_CTB + (16 * vt + c) * M_RS + 64 * ks + 16 * g), Bq[ks], acc); \
                acc = acc * wint; \
                _Pragma("unroll") for (int k2 = 0; k2 < 2; ++k2) { \
                    if (2 * k2 <= tt) { const LAS unsigned char* vp = L + M_VT + (16 * vt + c) * M_TS + (32 * k2 + 4 * g) * 2; const v2u lo = *(const LAS v2u*)vp, hi = *(const LAS v2u*)(vp + 32); const v4u av_ = {lo.x, lo.y, hi.x, hi.y}; \
                        acc = mfma16(__builtin_bit_cast(bf16x8, av_), Bs[k2], acc); } \
                } \
                nm[vt] = acc; \
            } \
            const float den = pg8::shl_from(nm[2][0], c); \
            const float inv = 1.0f / fmaxf(fabsf(den), einv); \
            float hss = 0.f; \
            _Pragma("unroll") for (int vt = 0; vt < 2; ++vt) _Pragma("unroll") for (int r = 0; r < 4; ++r) { nm[vt][r] *= inv; hss += nm[vt][r] * nm[vt][r]; } \
            hss += pg8::shx(hss, 16, lane); hss += pg8::shx(hss, 32, lane); \
            if (trow < nvalid) { \
                const size_t grow = (size_t)b * LP + t0 + trow; \
                _Pragma("unroll") for (int vt = 0; vt < 2; ++vt) { const int col = h * MDV + VS * sl + 16 * vt + 4 * g; \
                    const v2u ow = vt == 0 ? po0 : po1; const f32x4 gn = *(const f32x4*)(P.gnorm + col); \
                    v2u w; w.x = pk2(sigmoidf_(bf_lo(ow.x)) * gn[0] * nm[vt][0], sigmoidf_(bf_hi(ow.x)) * gn[1] * nm[vt][1]); w.y = pk2(sigmoidf_(bf_lo(ow.y)) * gn[2] * nm[vt][2], sigmoidf_(bf_hi(ow.y)) * gn[3] * nm[vt][3]); \
                    *(GAS v2u*)(P.AO + grow * D + col) = w; } \
                if (g == 0) P.HSS[grow * 32 + h * 8 + sl] = hss; \
            } \
            if ((ch) + 1 < 33) ML_OLOAD((ch) + 1); \
        } else { \
            const int w4 = wave - 4, nxt = cur ^ 1; \
            _Pragma("unroll") for (int i = 0; i < 6; ++i) cacc[i] = cacc[i] * a; \
            _Pragma("unroll") for (int k2 = 0; k2 < 2; ++k2) { \
                bf16x8 Bv[3]; \
                _Pragma("unroll") for (int vt = 0; vt < 3; ++vt) Bv[vt] = *(const LAS bf16x8*)(L + M_VW + (16 * vt + c) * M_TS + 64 * k2 + 16 * g); \
                _Pragma("unroll") for (int dd = 0; dd < 2; ++dd) { const bf16x8 Ak = *(const LAS bf16x8*)(L + M_KT + (16 * (2 * w4 + dd) + c) * M_TS + 64 * k2 + 16 * g); \
                    _Pragma("unroll") for (int vt = 0; vt < 3; ++vt) cacc[dd * 3 + vt] = mfma16(Ak, Bv[vt], cacc[dd * 3 + vt]); } \
            } \
            _Pragma("unroll") for (int dd = 0; dd < 2; ++dd) _Pragma("unroll") for (int vt = 0; vt < 3; ++vt) { const f32x4 v = cacc[dd * 3 + vt]; v2u w; w.x = pk2(v[0], v[1]); w.y = pk2(v[2], v[3]); \
                    *(LAS v2u*)(L + M_CT + nxt * M_CTB + (16 * vt + c) * M_RS + (16 * (2 * w4 + dd) + 4 * g) * 2) = w; } \
        } \
        LDS_BAR(); } while (0)
#pragma unroll 1
    for (int ch = 0; ch < 33; ch += 2) {
        ML_STEP(ch, aq0, aq1, ak0, ak1, av);
        if (ch + 1 < 33) ML_STEP(ch + 1, bq0, bq1, bk0, bk1, bv);
    }
#undef ML_STEP
#undef ML_LOAD
#undef ML_OLOAD
    if (wave >= 4) {
        const int w4 = wave - 4; const size_t sb = ((size_t)jl * NB + b) * MH + h;
#pragma unroll
        for (int dd = 0; dd < 2; ++dd) {
#pragma unroll
            for (int vt = 0; vt < 2; ++vt)
#pragma unroll
                for (int r = 0; r < 4; ++r) out[O_CP + (sb * MDK + 16 * (2 * w4 + dd) + 4 * g + r) * MDV + VS * sl + 16 * vt + c] = cacc[dd * 3 + vt][r];
            if (sl == 0 && c == 0) {
#pragma unroll
                for (int r = 0; r < 4; ++r) out[O_NP + sb * MDK + 16 * (2 * w4 + dd) + 4 * g + r] = cacc[dd * 3 + 2][r]; }
        }
        if (sl == 0 && wave == 4 && lane == 0) out[O_MP + sb] = ((const LAS float*)(L + M_MS))[33];
    }
    LDS_BAR();
}
constexpr int S_Q = 0, S_K = 2048, S_V = 4096, S_P = 8192, S_M = 40960, S_END = 41472;
__device__ __forceinline__ void mlstm_sample_item(LAS unsigned char* L, const MlP& P, const float* stC, const float* stN, const float* stM, float* out, int jl, int db, int h, int tid, int wave, int lane) {
    LAS float* SQ = (LAS float*)(L + S_Q); LAS float* SK = (LAS float*)(L + S_K); LAS float* SV = (LAS float*)(L + S_V); LAS float* SP = (LAS float*)(L + S_P); LAS float* SM = (LAS float*)(L + S_M);
    const size_t r0 = (size_t)MP + db * DSEQ; const size_t sb = ((size_t)jl * DBATCH + db) * MH + h;
    { const int s = tid >> 7, d = tid & 127; const bf16* zr = P.Z + (r0 + s) * NIN; SQ[s * 128 + d] = bf1(zr[h * MDK + d]); SK[s * 128 + d] = bf1(zr[512 + h * MDK + d]);
      SV[s * 256 + 2 * d] = bf1(zr[1024 + h * MDV + 2 * d]); SV[s * 256 + 2 * d + 1] = bf1(zr[1024 + h * MDV + 2 * d + 1]); }
    float li[4], lf[4], bc[4], wjv[4], Mt[4];
#pragma unroll
    for (int s = 0; s < 4; ++s) { li[s] = gate_i(P.G[(r0 + s) * 8 + h]); lf[s] = gate_f(P.G[(r0 + s) * 8 + 4 + h]); }
    const float m0 = stM[sb];
    { float acc = 0.f, cmx = -1e30f;
#pragma unroll
      for (int s = 0; s < 4; ++s) { acc += lf[s]; bc[s] = acc; wjv[s] = li[s] - acc; cmx = fmaxf(cmx, wjv[s]); Mt[s] = fmaxf(m0, cmx); } }
    const float Mx = Mt[3], blast = bc[3], m_new = blast + Mx, a = __expf(m0 - Mx);
    float wk[4];
#pragma unroll
    for (int s = 0; s < 4; ++s) wk[s] = __expf(wjv[s] - Mx);
    LDS_BAR();
    if (wave == 0) { const int p = lane >> 2, qd = lane & 3, t = p >> 2, j = p & 3; float acc = 0.f;
        for (int d = 0; d < 32; ++d) acc += SQ[t * 128 + 32 * qd + d] * SK[j * 128 + 32 * qd + d];
        acc += pg8::shx(acc, 1, lane); acc += pg8::shx(acc, 2, lane);
        const float Mtt = t == 0 ? Mt[0] : t == 1 ? Mt[1] : t == 2 ? Mt[2] : Mt[3], wjj = j == 0 ? wjv[0] : j == 1 ? wjv[1] : j == 2 ? wjv[2] : wjv[3];
        if (qd == 0) SM[p] = (j <= t) ? acc * __expf(wjj - Mtt) : 0.f; }
    if (wave == 1) { const int t = lane >> 4, part = lane & 15; float acc = 0.f;
        for (int d = 0; d < 8; ++d) acc += SQ[t * 128 + 8 * part + d] * stN[sb * MDK + 8 * part + d];
        acc += pg8::shx(acc, 1, lane); acc += pg8::shx(acc, 2, lane); acc += pg8::shx(acc, 4, lane); acc += pg8::shx(acc, 8, lane);
        if (part == 0) SM[16 + t] = acc; }
    { const int vq = tid & 63, dg = tid >> 6; const float* c0p = stC + sb * MDK * MDV; float* c1p = out + O_CS + sb * MDK * MDV;
      f32x4 vj[4];
#pragma unroll
      for (int j = 0; j < 4; ++j) vj[j] = *(const LAS f32x4*)(SV + j * 256 + 4 * vq);
      f32x4 acc[4];
#pragma unroll
      for (int t = 0; t < 4; ++t) acc[t] = (f32x4){0.f, 0.f, 0.f, 0.f};
#pragma unroll 8
      for (int i = 0; i < 16; ++i) { const int dk = 16 * dg + i; const f32x4 c0 = *(const GAS f32x4*)(c0p + (size_t)dk * MDV + 4 * vq);
          f32x4 cn = c0 * a;
#pragma unroll
          for (int t = 0; t < 4; ++t) { acc[t] += c0 * SQ[t * 128 + dk]; cn += vj[t] * (wk[t] * SK[t * 128 + dk]); }
          *(GAS f32x4*)(c1p + (size_t)dk * MDV + 4 * vq) = cn; }
#pragma unroll
      for (int t = 0; t < 4; ++t) *(LAS f32x4*)(SP + (dg * 4 + t) * 256 + 4 * vq) = acc[t];
    }
    if (tid < 128) { float nn = a * stN[sb * MDK + tid];
#pragma unroll
        for (int j = 0; j < 4; ++j) nn += wk[j] * SK[j * 128 + tid];
        out[O_NS + sb * MDK + tid] = nn; }
    if (tid == 0) out[O_MS + sb] = m_new;
    LDS_BAR();
    if (tid < 256) { const int v = tid; float hv[4];
#pragma unroll
        for (int t = 0; t < 4; ++t) { float qc = 0.f;
#pragma unroll
            for (int dg = 0; dg < 8; ++dg) qc += SP[(dg * 4 + t) * 256 + v];
            const float wint = __expf(m0 - Mt[t]); float num = wint * qc, den = wint * SM[16 + t];
#pragma unroll
            for (int j = 0; j < 4; ++j) { const float sc = SM[t * 4 + j]; num += sc * SV[j * 256 + v]; den += sc; }
            hv[t] = num / fmaxf(fabsf(den), __expf(-(bc[t] + Mt[t]))); }
#pragma unroll
        for (int t = 0; t < 4; ++t) { const float q = wave_sum(hv[t] * hv[t], lane); if (lane == 0) SM[32 + wave * 4 + t] = q; }
        const float gn = P.gnorm[h * MDV + v];
#pragma unroll
        for (int t = 0; t < 4; ++t) { const float o = bf1(P.Z[(r0 + t) * NIN + 2048 + h * MDV + v]); P.AO[(r0 + t) * D + h * MDV + v] = (bf16)f2bf(sigmoidf_(o) * gn * hv[t]); }
    }
    LDS_BAR();
    if (tid < 32) { const int t = tid >> 3, slot = tid & 7; P.HSS[(r0 + t) * 32 + h * 8 + slot] = (slot == 0) ? (SM[32 + t] + SM[36 + t]) + (SM[40 + t] + SM[44 + t]) : 0.f; }
    LDS_BAR();
}
__device__ __forceinline__ void mlstm_phase(LAS unsigned char* L, const MlP& P, const float* stC, const float* stN, const float* stM, float* out, int jl, int vcu, int G, int tid_in, int wave_in, int lane_in) {
    constexpr int N_PROMPT = NB * MH * NSL, N_ITEMS = N_PROMPT + DBATCH * MH;
#pragma unroll 1
    for (int it = vcu; it < N_ITEMS; it += G) {
        int tid = tid_in; asm volatile("" : "+v"(tid));
        const int lane = tid & 63, wave = __builtin_amdgcn_readfirstlane(tid >> 6);
        if (it < N_PROMPT) { const int bh = it / NSL, sl = it % NSL; mlstm_prompt_item(L, P, out, jl, bh / MH, bh % MH, sl, tid, wave, lane); }
        else { const int si = it - N_PROMPT; mlstm_sample_item(L, P, stC, stN, stM, out, jl, si / MH, si % MH, tid, wave, lane); }
    }
}
__device__ __forceinline__ void mlstm_fixup(bf16* AO, const float* HSS, int vcu, int G, int wave, int lane) {
    const int gw = vcu * NWAVES + wave, NGW = G * NWAVES;
    for (int m = gw; m < MTOT; m += NGW) {
        const int hd = lane >> 4; const f32x4 a = *(const GAS f32x4*)(HSS + (size_t)m * 32 + hd * 8), bq = *(const GAS f32x4*)(HSS + (size_t)m * 32 + hd * 8 + 4);
        const float r = 1.0f / sqrtf((((a[0] + a[1]) + (a[2] + a[3])) + ((bq[0] + bq[1]) + (bq[2] + bq[3]))) * (1.0f / 256.0f) + EPS);
        GAS v4u* p = (GAS v4u*)(AO + (size_t)m * D + 16 * lane);
#pragma unroll
        for (int i = 0; i < 2; ++i) { float f[8]; unpack8(p[i], f);
#pragma unroll
            for (int e = 0; e < 8; ++e) f[e] *= r;
            p[i] = pack8(f); }
    }
}

struct Args { const float* in[23]; float* out; unsigned char* ws; };
constexpr int PTAB_OFF = LDSCTL_OFF + 1024;
__device__ __forceinline__ unsigned long long ld_ptr(volatile LAS unsigned* T, int i) {
    const unsigned lo = __builtin_amdgcn_readfirstlane(T[2 * i]), hi = __builtin_amdgcn_readfirstlane(T[2 * i + 1]);
    return ((unsigned long long)hi << 32) | lo;
}
constexpr int CHAIN_OFF = LDSCTL_OFF + 2048;
constexpr int CW_CNT = 16384, CW_HEAD = CW_CNT + 6 * 67 * 64;
static_assert((CW_HEAD + 21 * 8 * 64) * 4 <= (int)CTL_ZERO_BYTES, "control words inside the memset region");
__device__ __forceinline__ void put64(volatile LAS unsigned* c, int i, const void* p) { const unsigned long long v = (unsigned long long)p; c[i] = (unsigned)v; c[i + 1] = (unsigned)(v >> 32); }
__device__ __forceinline__ void chain_common(volatile LAS unsigned* c, unsigned char* ws, float* out, int nseg, int n0, int n1, int n2, int n3, int head_idx, int zldc, const float* bgate) {
    c[pg8::CC + 0] = (unsigned)nseg; c[pg8::CC + 1] = 0u; put64(c, pg8::CC + 2, (unsigned*)(ws + WS_CTL) + CW_HEAD + 64 * 8 * head_idx);
    put64(c, pg8::CC + 4, ws + WS_X); put64(c, pg8::CC + 6, ws + WS_XB); put64(c, pg8::CC + 8, ws + WS_SS); put64(c, pg8::CC + 10, ws + WS_Z); put64(c, pg8::CC + 12, ws + WS_FF);
    put64(c, pg8::CC + 14, ws + WS_G); put64(c, pg8::CC + 16, bgate); put64(c, pg8::CC + 18, out + O_YP); put64(c, pg8::CC + 20, out + O_YS); c[pg8::CC + 22] = (unsigned)zldc;
    put64(c, pg8::CC + 30, ws + WS_PT);
    c[pg8::CCUM + 0] = 0u; c[pg8::CCUM + 1] = (unsigned)n0; c[pg8::CCUM + 2] = (unsigned)(n0 + n1); c[pg8::CCUM + 3] = (unsigned)(n0 + n1 + n2); c[pg8::CCUM + 4] = (unsigned)(n0 + n1 + n2 + n3);
}
__device__ __forceinline__ void chain_seg(volatile LAS unsigned* c, int s, const void* A, const void* Bt, int K, int nN, int kind, int first, unsigned need, const unsigned* dep, const unsigned* done, int ld = 0, int lpoff = 0, int cap = 9, int nsub = 1) {
    put64(c, 16 * s + 0, A); put64(c, 16 * s + 2, Bt); c[16 * s + 4] = (unsigned)K; c[16 * s + 5] = (unsigned)nN; c[16 * s + 6] = (unsigned)kind; c[16 * s + 7] = (unsigned)first; c[16 * s + 8] = need;
    c[16 * s + 9] = (unsigned)(ld ? ld : K); put64(c, 16 * s + 10, dep); put64(c, 16 * s + 12, done); c[16 * s + 14] = (unsigned)lpoff | ((unsigned)cap << 8) | ((unsigned)nsub << 16);
}
__device__ __forceinline__ void chain_totals(volatile LAS unsigned* c, int nseg) {
    unsigned t8 = 0u, t9 = 0u;
    for (int s = 0; s < nseg; ++s) { const unsigned w = c[16 * s + 14]; const int lpoff = (int)(w & 0xffu), cap = (int)((w >> 8) & 0xffu), nsub = (int)(w >> 16), nN = (int)c[16 * s + 5];
        int a = 8 - lpoff; a = a < 0 ? 0 : (a > cap ? cap : a); int b = 9 - lpoff; b = b < 0 ? 0 : (b > cap ? cap : b); t8 += (unsigned)(a * nN * nsub); t9 += (unsigned)(b * nN * nsub); }
    c[pg8::CC + 1] = t8; c[pg8::CC + 23] = t9;
}
__device__ __forceinline__ void down_tail_finalize(unsigned char* ws, float* out, bool final_layer, int vcu, int G, int wave, int lane) {
    const int gw = vcu * NWAVES + wave, NGW = G * NWAVES;
    float* X = (float*)(ws + WS_X); bf16* XB = (bf16*)(ws + WS_XB); float* SS = (float*)(ws + WS_SS); const float* P = (const float*)(ws + WS_PT);
    for (int r = gw; r < 768; r += NGW) { const int m = 16384 + r;
        f32x4 v[4]; float ss[4];
#pragma unroll
        for (int j = 0; j < 4; ++j) { v[j] = ((const GAS f32x4*)(X + (size_t)m * D))[lane + 64 * j];
#pragma unroll
            for (int kq = 0; kq < 4; ++kq) v[j] = v[j] + ((const GAS f32x4*)(P + ((size_t)kq * 768 + r) * D))[lane + 64 * j]; }
        if (!final_layer) {
#pragma unroll
            for (int j = 0; j < 4; ++j) { ss[j] = wave_sum((v[j][0] * v[j][0] + v[j][1] * v[j][1]) + (v[j][2] * v[j][2] + v[j][3] * v[j][3]), lane);
                ((GAS f32x4*)(X + (size_t)m * D))[lane + 64 * j] = v[j]; v2u w; w.x = pk2(v[j][0], v[j][1]); w.y = pk2(v[j][2], v[j][3]); ((GAS v2u*)(XB + (size_t)m * D))[lane + 64 * j] = w; }
            if (lane < 16) { const int j = lane >> 2; const float s = (lane & 3) ? 0.f : (j == 0 ? ss[0] : j == 1 ? ss[1] : j == 2 ? ss[2] : ss[3]); SS[(size_t)m * 16 + lane] = s; }
        } else {
            float* dst = nullptr;
            if (m < MP) { const int b = m / LP, t = m - b * LP; if (t >= NMETA) dst = out + O_YP + ((size_t)b * SEQ + (t - NMETA)) * D; }
            else if (m < MTOT) dst = out + O_YS + (size_t)(m - MP) * D;
            if (dst) {
#pragma unroll
                for (int j = 0; j < 4; ++j) ((GAS f32x4*)dst)[lane + 64 * j] = v[j]; }
        }
    }
}
__global__ void __launch_bounds__(NWAVES * 64, 2) hybrid_fwd(Args args) {
    extern __shared__ __attribute__((aligned(16))) unsigned char lds_raw[];
    LAS unsigned char* lds = (LAS unsigned char*)lds_raw;
    volatile LAS unsigned* MISC = (volatile LAS unsigned*)(lds + MISC_OFF);
    const int wave_s = __builtin_amdgcn_readfirstlane((int)threadIdx.x >> 6);
#define GG_ g_o
#define BX_ b_o
#define OPQ_GB() int g_o = (int)gridDim.x, b_o = (int)blockIdx.x; asm volatile("" : "+s"(g_o), "+s"(b_o))
#define VCU_ ((BX_ & 7) * (GG_ >> 3) + (BX_ >> 3))
    for (int u = (int)threadIdx.x; u < (LDS_BYTES - LDSCTL_OFF) / 4; u += NWAVES * 64) ((LAS unsigned*)(lds + LDSCTL_OFF))[u] = 0u;
    __syncthreads();
    volatile LAS unsigned* PT = (volatile LAS unsigned*)(lds + PTAB_OFF);
    if (threadIdx.x == 0) {
#pragma unroll
        for (int i = 0; i < 23; ++i) { const unsigned long long p = (unsigned long long)args.in[i]; PT[2 * i] = (unsigned)p; PT[2 * i + 1] = (unsigned)(p >> 32); }
        { const unsigned long long p = (unsigned long long)args.out; PT[46] = (unsigned)p; PT[47] = (unsigned)(p >> 32); }
        { const unsigned long long p = (unsigned long long)args.ws; PT[48] = (unsigned)p; PT[49] = (unsigned)(p >> 32); }
    }
    __syncthreads();
#define OPAQUE_TID() int tid_p; asm volatile("v_mbcnt_lo_u32_b32 %0, -1, 0\n\tv_mbcnt_hi_u32_b32 %0, -1, %0\n\tv_lshl_add_u32 %0, %1, 6, %0" : "=&v"(tid_p) : "s"(wave_s)); const int lane_p = tid_p & 63, wave_p = __builtin_amdgcn_readfirstlane(tid_p >> 6)
#define PIN(i) ((const float*)(const GAS float*)ld_ptr(PT, (i)))
#define POUT() ((float*)(GAS float*)ld_ptr(PT, 23))
#define PWS() ((unsigned char*)(GAS unsigned char*)ld_ptr(PT, 24))
    (void)xcd_barrier_post((unsigned*)((gu32*)(PWS() + WS_CTL) + CW_BAR), MISC + 8);
#define GRID_BAR() do { XcdBarrier b_; b_.bar = (unsigned*)((gu32*)(PWS() + WS_CTL) + CW_BAR); b_.x = xb_xcc_id(); b_.st = MISC + 8; xcd_barrier(b_); } while (0)

    { OPAQUE_TID(); OPQ_GB(); P0Args A{PIN(0), PIN(1), PIN(7), PIN(9), PIN(10), PIN(11), PIN(15), PIN(16), PIN(17), PIN(20), PIN(21), PIN(22), PWS()};
#ifndef NO_P0
      p0_prologue(A, lds, VCU_, GG_, wave_p, lane_p, tid_p);
#ifdef PROBE_P02
      GRID_BAR();
      p0_prologue(A, lds, VCU_, GG_, wave_p, lane_p, tid_p);
#endif
#endif
    }
    GRID_BAR();
    volatile LAS unsigned* CH = (volatile LAS unsigned*)(lds + CHAIN_OFF);
#pragma unroll 1
    for (;;) {
        int ito = MISC_OFF + 48; asm volatile("" : "+s"(ito)); volatile LAS unsigned* itp = (volatile LAS unsigned*)(lds + ito);
        const int it = (int)__builtin_amdgcn_readfirstlane(*itp);
        if (it > 4) break;
        const int layer = it - 1, jl = layer >> 1;
        if (it >= 1) {
            if ((layer & 1) == 0) {
                { OPAQUE_TID(); OPQ_GB(); unsigned char* ws = PWS(); AttnP P{(const bf16*)(ws + WS_Z), PIN(12) + jl * AHD, PIN(13) + jl * AHD, PIN(14) + jl * AH, PIN(8), (bf16*)(ws + WS_AO)};
#ifndef NO_ATTN
                  attn_phase(lds + RING_OFF, P, PIN(2), PIN(3), POUT(), jl, VCU_, GG_, tid_p, wave_p, lane_p);
#ifdef PROBE_ATTN2
                  GRID_BAR();
                  attn_phase(lds + RING_OFF, P, PIN(2), PIN(3), POUT(), jl, VCU_, GG_, tid_p, wave_p, lane_p);
#endif
#endif
                }
                GRID_BAR();
            } else {
                { OPAQUE_TID(); OPQ_GB(); unsigned char* ws = PWS(); MlP P{(const bf16*)(ws + WS_Z), (const float*)(ws + WS_G), PIN(19) + jl * D, (bf16*)(ws + WS_AO), (float*)(ws + WS_HSS)};
#ifndef NO_MLSTM
                  mlstm_phase(lds + RING_OFF, P, PIN(4), PIN(5), PIN(6), POUT(), jl, VCU_, GG_, tid_p, wave_p, lane_p);
#ifdef PROBE_MLSTM2
                  GRID_BAR();
                  mlstm_phase(lds + RING_OFF, P, PIN(4), PIN(5), PIN(6), POUT(), jl, VCU_, GG_, tid_p, wave_p, lane_p);
#endif
#endif
                }
                GRID_BAR();
                { OPAQUE_TID(); OPQ_GB(); unsigned char* ws = PWS(); mlstm_fixup((bf16*)(ws + WS_AO), (const float*)(ws + WS_HSS), VCU_, GG_, wave_p, lane_p); }
                GRID_BAR();
            }
        }
#define RUN_CHAIN(SETUP) do { OPAQUE_TID(); OPQ_GB(); if (tid_p == 0) { unsigned char* ws = PWS(); SETUP const int sh_ = GG_ >> 3, v_ = VCU_; CH[pg8::CQ] = (unsigned)(v_ / sh_); CH[pg8::CQ + 1] = (unsigned)(v_ % sh_); CH[pg8::CQ + 2] = (unsigned)sh_; } __syncthreads(); pg8::gemm_chain(lds + RING_OFF, CH, tid_p); } while (0)
        if (it == 0) {
            RUN_CHAIN( chain_common(CH, ws, POUT(), 1, 6, 0, 0, 0, 4 * 3 + 0, NQKV, nullptr);
                       chain_seg(CH, 0, ws + WS_XB, ws + WS_WQKV, D, 6, pg8::CK_NORM, 0, 0u, nullptr, nullptr); chain_totals(CH, 1); );
        } else {
            RUN_CHAIN( chain_common(CH, ws, POUT(), 1, 4, 0, 0, 0, layer * 3 + 0, NQKV, nullptr);
                       chain_seg(CH, 0, ws + WS_AO, (layer & 1) ? ws + WS_WOUT + jl * SZ_WO : ws + WS_WO + jl * SZ_WO, D, 4, pg8::CK_RESID, 0, 0u, nullptr, nullptr); chain_totals(CH, 1); );
            GRID_BAR();
            RUN_CHAIN( chain_common(CH, ws, POUT(), 1, 16, 0, 0, 0, layer * 3 + 1, NQKV, nullptr);
                       chain_seg(CH, 0, ws + WS_XB, ws + WS_WUP + layer * SZ_WUP, D, 16, pg8::CK_UP, 0, 0u, nullptr, nullptr); chain_totals(CH, 1); );
            GRID_BAR();
            RUN_CHAIN( chain_common(CH, ws, POUT(), 2, 4, 4, 0, 0, 13 + layer, NQKV, nullptr);
                       chain_seg(CH, 0, ws + WS_FF, ws + WS_WDN + layer * SZ_WUP, FF, 4, layer < 3 ? pg8::CK_RESID : pg8::CK_FINAL, 0, 0u, nullptr, nullptr, FF, 0, 8, 1);
                       chain_seg(CH, 1, ws + WS_FF, ws + WS_WDN + layer * SZ_WUP, D, 4, pg8::CK_PART, 0, 0u, nullptr, nullptr, FF, 8, 1, 4);
                       chain_totals(CH, 2); );
            GRID_BAR();
            { OPAQUE_TID(); OPQ_GB(); down_tail_finalize(PWS(), POUT(), layer == 3, VCU_, GG_, wave_p, lane_p); }
            if (layer < 3) {
                GRID_BAR();
                const int nl = layer + 1, njl = nl >> 1; const bool nml = (nl & 1) != 0;
                RUN_CHAIN( chain_common(CH, ws, POUT(), 1, nml ? 13 : 6, 0, 0, 0, layer * 3 + 2, nml ? NIN : NQKV, nml ? PIN(18) + njl * 8 : nullptr);
                           chain_seg(CH, 0, ws + WS_XB, nml ? ws + WS_WIN + njl * SZ_WIN : ws + WS_WQKV + njl * SZ_WQKV, D, nml ? 13 : 6, nml ? pg8::CK_NORM_GATES : pg8::CK_NORM, 0, 0u, nullptr, nullptr); chain_totals(CH, 1); );
#ifdef PROBE_INPROJ2
                GRID_BAR();
                RUN_CHAIN( chain_common(CH, ws, POUT(), 1, nml ? 13 : 6, 0, 0, 0, 16 + layer, nml ? NIN : NQKV, nml ? PIN(18) + njl * 8 : nullptr);
                           chain_seg(CH, 0, ws + WS_XB, nml ? ws + WS_WIN + njl * SZ_WIN : ws + WS_WQKV + njl * SZ_WQKV, D, nml ? 13 : 6, nml ? pg8::CK_NORM_GATES : pg8::CK_NORM, 0, 0u, nullptr, nullptr); );
#endif
            }
#ifdef PROBE_DOWN_SPLIT
            if (layer == 0) { GRID_BAR();
                RUN_CHAIN( chain_common(CH, ws, POUT(), 2, 4, 4, 0, 0, 20, NQKV, nullptr);
                       chain_seg(CH, 0, ws + WS_FF, ws + WS_WDN + layer * SZ_WUP, FF, 4, pg8::CK_FINAL, 0, 0u, nullptr, nullptr, FF, 0, 8, 1);
                       chain_seg(CH, 1, ws + WS_FF, ws + WS_WDN + layer * SZ_WUP, D, 4, pg8::CK_PART, 0, 0u, nullptr, nullptr, FF, 8, 1, 4);
                       chain_totals(CH, 2); ); }
#endif
#ifdef PROBE_DOWN_WHOLE
            if (layer == 0) { GRID_BAR();
                RUN_CHAIN( chain_common(CH, ws, POUT(), 1, 4, 0, 0, 0, 20, NQKV, nullptr);
                       chain_seg(CH, 0, ws + WS_FF, ws + WS_WDN + layer * SZ_WUP, FF, 4, pg8::CK_FINAL, 0, 0u, nullptr, nullptr);
                       chain_totals(CH, 1); ); }
#endif
#ifdef PROBE_UP
            if (layer == 0) { GRID_BAR();
                RUN_CHAIN( chain_common(CH, ws, POUT(), 1, 16, 0, 0, 0, 20, NQKV, nullptr);
                       chain_seg(CH, 0, ws + WS_XB, ws + WS_WUP + layer * SZ_WUP, D, 16, pg8::CK_UP, 0, 0u, nullptr, nullptr); chain_totals(CH, 1); ); }
#endif
        }
#undef RUN_CHAIN
        if (it < 4) GRID_BAR();
        { OPAQUE_TID(); __syncthreads();
          int itq_o = MISC_OFF + 48; asm volatile("" : "+s"(itq_o)); volatile LAS unsigned* itq = (volatile LAS unsigned*)(lds + itq_o);
          if (tid_p == 0) *itq = *itq + 1u;
          __syncthreads(); }
    }
#undef PIN
#undef OPAQUE_TID
#undef GRID_BAR
#undef GG_
#undef OPQ_GB
#undef BX_
#undef VCU_
#undef POUT
#undef PWS
}

extern "C" void kernel_launch(void* const* d_in, const int* in_sizes, int n_in, void* d_out, int out_size, void* d_ws, size_t ws_size, hipStream_t stream) {
    static int grid = 0;
    if (grid == 0) {
        if (n_in != 23 || ws_size < WS_END) { fprintf(stderr, "kernel_launch: built for 23 inputs, %zu outputs, >= %zu bytes of workspace; got n_in %d, out %d, ws %zu; nothing launched\n", (size_t)O_END, (size_t)WS_END, n_in, out_size, ws_size); grid = -1; return; }
        int dev = 0, cus = 0, per_cu = 0;
        if (hipGetDevice(&dev) != hipSuccess || hipDeviceGetAttribute(&cus, hipDeviceAttributeMultiprocessorCount, dev) != hipSuccess) { fprintf(stderr, "kernel_launch: device query failed\n"); grid = -1; return; }
        if (hipFuncSetAttribute((const void*)hybrid_fwd, hipFuncAttributeMaxDynamicSharedMemorySize, LDS_BYTES) != hipSuccess) { fprintf(stderr, "kernel_launch: hipFuncSetAttribute failed\n"); grid = -1; return; }
        if (hipOccupancyMaxActiveBlocksPerMultiprocessor(&per_cu, (const void*)hybrid_fwd, NWAVES * 64, LDS_BYTES) != hipSuccess || per_cu < 1)
            fprintf(stderr, "kernel_launch: note: occupancy query reports %d workgroups per CU\n", per_cu);
        (void)hipGetLastError();
        grid = cus - (cus % 8);
    }
    if (grid < 0) return;
    if (hipMemsetAsync((char*)d_ws + WS_CTL, 0, CTL_ZERO_BYTES, stream) != hipSuccess) { fprintf(stderr, "kernel_launch: hipMemsetAsync failed\n"); return; }
    Args a{};
    for (int i = 0; i < 23; ++i) a.in[i] = (const float*)d_in[i];
    a.out = (float*)d_out; a.ws = (unsigned char*)d_ws;
    hipLaunchKernelGGL(hybrid_fwd, dim3(grid), dim3(NWAVES * 64), LDS_BYTES, stream, a);
    const hipError_t le = hipPeekAtLastError();
    if (le != hipSuccess) fprintf(stderr, "kernel_launch: launch failed: %s\n", hipGetErrorName(le));
}
```

```cpp
#include <hip/hip_runtime.h>
#include <cstdio>
#include <cstdint>
namespace pg8 {
#define PG8_LAS __attribute__((address_space(3)))
typedef unsigned short bf16_t;
typedef short bf16x8 __attribute__((ext_vector_type(8)));
typedef float f32x4 __attribute__((ext_vector_type(4)));
typedef unsigned u32x4 __attribute__((ext_vector_type(4)));
constexpr int BM = 256, BK = 64, HALF = 128, HTB = HALF * BK * 2  , STAGE_BYTES = 8 * HTB, NXCD = 8, WGM = 8;

__host__ __device__ __forceinline__ int lds_byte(int r, int c) { const int st = (r >> 4) * 2 + (c >> 5), rr = r & 15, cc = c & 31, ob = rr * 64 + cc * 2; return st * 1024 + (ob ^ (((ob >> 9) & 1) << 5)); }
__host__ __device__ __forceinline__ void stage_rc(int b, int& R, int& C) { const int st = b / 1024, sb = b % 1024, swz = sb ^ (((sb >> 9) & 1) << 5); R = (st >> 1) * 16 + swz / 64; C = (st & 1) * 32 + (swz % 64) / 2; }
__host__ __device__ __forceinline__ int perm32(int rho) { const int n = rho >> 4, i = rho & 15; return 8 * (i >> 2) + 4 * n + (i & 3); }

struct Unit { int pm, pn; };
struct Gemm { const bf16_t* A; const bf16_t* Bt; int M, N, K; };

struct StaticOrder {
    int nM, nN, nwg, G, c;
    __host__ __device__ void init(int M, int N, int G_, int c_) { nM = M / BM; nN = N / BM; nwg = nM * nN; G = G_; c = c_; }
    __host__ __device__ bool next(int i, Unit& u) const {
        const long L = (long)i * G + c; if (L >= nwg) return false;
        int wgid = (int)L; { const int q = nwg / NXCD, r = nwg % NXCD, xcd = wgid % NXCD, off = wgid / NXCD; wgid = (xcd < r ? xcd * (q + 1) : r * (q + 1) + (xcd - r) * q) + off; }
        const int nig = WGM * nN, gid = wgid / nig, fm = gid * WGM, gsz = (nM - fm) < WGM ? (nM - fm) : WGM;
        u.pm = fm + ((wgid % nig) % gsz); u.pn = (wgid % nig) / gsz; return true;
    }
    __device__ __forceinline__ void a_ready(const Unit&) const {}
    __device__ __forceinline__ void done(const Unit&) const {}
};
__device__ __forceinline__ unsigned cvt_pk_bf16(float lo, float hi) { unsigned r; asm volatile("v_cvt_pk_bf16_f32 %0, %1, %2" : "=v"(r) : "v"(lo), "v"(hi)); return r; }
__device__ __forceinline__ float shx(float v, int mask, int lane) { return __builtin_bit_cast(float, __builtin_amdgcn_ds_bpermute((lane ^ mask) << 2, __builtin_bit_cast(int, v))); }
__device__ __forceinline__ float shl_from(float v, int src) { return __builtin_bit_cast(float, __builtin_amdgcn_ds_bpermute(src << 2, __builtin_bit_cast(int, v))); }
typedef unsigned u32x2 __attribute__((ext_vector_type(2)));
constexpr int RM_MP = 16512, RM_MTOT = 17024, RM_LP = 2064, RM_META = 16, RM_SEQ = 2048;
__device__ __forceinline__ float row_rscale(const float* SS, int row) {
    const f32x4* p = (const f32x4*)(SS + (size_t)row * 16); const f32x4 a = p[0], b = p[1], c = p[2], d = p[3];
    const float s = ((a[0] + a[1]) + (a[2] + a[3])) + ((b[0] + b[1]) + (b[2] + b[3])) + ((c[0] + c[1]) + (c[2] + c[3])) + ((d[0] + d[1]) + (d[2] + d[3]));
    return 1.0f / sqrtf(s * (1.0f / 1024.0f) + 1e-6f);
}
__device__ __forceinline__ float softcap15(float x) { return 15.0f * tanhf(x * (1.0f / 15.0f)); }
__device__ __forceinline__ float logsigmoidf(float x) { return x < 0.f ? x - log1pf(expf(x)) : -log1pf(expf(-x)); }
template <int ACT, bool GATES> struct EpiNormBf16 {
    static constexpr bool PERM = true, AFTER_DRAIN = false;
    bf16_t* O; int ldc; const float* SS; float* G; const float* bgate; int gate_pn;
    __device__ __forceinline__ void operator()(const f32x4 (&acc)[2][2][4][2], const Unit& u, int wr, int wc, int fr, int fq) const {
        const int row0 = u.pm * BM + wr * 64 + fr;
        if (GATES && u.pn == gate_pn) {
            if (wc == 0 && fq == 0) {
                const f32x4 b0 = *(const f32x4*)bgate, b1 = *(const f32x4*)(bgate + 4);
#pragma unroll
                for (int ai = 0; ai < 2; ++ai)
#pragma unroll
                    for (int m = 0; m < 4; ++m) { const int row = row0 + ai * HALF + m * 16; const float r = row_rscale(SS, row);
                        f32x4 gi = acc[ai][0][m][0] * r + b0, gf = acc[ai][0][m][1] * r + b1;
#pragma unroll
                        for (int j = 0; j < 4; ++j) { gi[j] = softcap15(gi[j]); gf[j] = logsigmoidf(softcap15(gf[j])); }
                        *(f32x4*)(G + (size_t)row * 8) = gi; *(f32x4*)(G + (size_t)row * 8 + 4) = gf; }
            }
            return;
        }
        const int col0 = u.pn * BM + wc * 32 + 8 * fq;
#pragma unroll
        for (int ai = 0; ai < 2; ++ai)
#pragma unroll
            for (int m = 0; m < 4; ++m) { const int row = row0 + ai * HALF + m * 16; const float r = row_rscale(SS, row); bf16_t* rowp = O + (size_t)row * ldc + col0;
#pragma unroll
                for (int bj = 0; bj < 2; ++bj) { f32x4 v0 = acc[ai][bj][m][0] * r, v1 = acc[ai][bj][m][1] * r;
                    if (ACT == 1) {
#pragma unroll
                        for (int j = 0; j < 4; ++j) { const float a = fmaxf(v0[j], 0.f), b = fmaxf(v1[j], 0.f); v0[j] = a * a; v1[j] = b * b; } }
                    u32x4 w; w.x = cvt_pk_bf16(v0[0], v0[1]); w.y = cvt_pk_bf16(v0[2], v0[3]); w.z = cvt_pk_bf16(v1[0], v1[1]); w.w = cvt_pk_bf16(v1[2], v1[3]);
                    *(u32x4*)(rowp + bj * HALF) = w; } }
    }
};
template <bool FINAL> struct EpiResid {
    static constexpr bool PERM = false, AFTER_DRAIN = false;
    float* X; bf16_t* Xb; float* SS; float* y_prompt; float* y_sample;
    __device__ __forceinline__ void operator()(const f32x4 (&acc)[2][2][4][2], const Unit& u, int wr, int wc, int fr, int fq) const {
        const int row0 = u.pm * BM + wr * 64 + fr, col0 = u.pn * BM + wc * 32 + 4 * fq;
#pragma unroll
        for (int ai = 0; ai < 2; ++ai)
#pragma unroll
            for (int m = 0; m < 4; ++m) { const int row = row0 + ai * HALF + m * 16; const size_t off = (size_t)row * 1024 + col0;
                f32x4 x[2][2];
#pragma unroll
                for (int bj = 0; bj < 2; ++bj)
#pragma unroll
                    for (int n = 0; n < 2; ++n) x[bj][n] = *(const f32x4*)(X + off + bj * HALF + n * 16) + acc[ai][bj][m][n];
                if (!FINAL) {
                    float s = 0.f;
#pragma unroll
                    for (int bj = 0; bj < 2; ++bj)
#pragma unroll
                        for (int n = 0; n < 2; ++n) { const f32x4 v = x[bj][n]; *(f32x4*)(X + off + bj * HALF + n * 16) = v; s += (v[0] * v[0] + v[1] * v[1]) + (v[2] * v[2] + v[3] * v[3]);
                            u32x2 w; w.x = cvt_pk_bf16(v[0], v[1]); w.y = cvt_pk_bf16(v[2], v[3]); *(u32x2*)(Xb + off + bj * HALF + n * 16) = w; }
                    s += shx(s, 16, (fr + 16 * fq)); s += shx(s, 32, (fr + 16 * fq));
                    if (fq == 0) SS[(size_t)row * 16 + u.pn * 4 + wc] = s;
                } else {
                    float* dst = nullptr;
                    if (row < RM_MP) { const int b = row / RM_LP, t = row - b * RM_LP; if (t >= RM_META) dst = y_prompt + ((size_t)b * RM_SEQ + (t - RM_META)) * 1024 + col0; }
                    else if (row < RM_MTOT) dst = y_sample + (size_t)(row - RM_MP) * 1024 + col0;
                    if (dst) {
#pragma unroll
                        for (int bj = 0; bj < 2; ++bj)
#pragma unroll
                            for (int n = 0; n < 2; ++n) *(f32x4*)(dst + bj * HALF + n * 16) = x[bj][n]; }
                }
            }
    }
};

template <class Epi, class Sched, bool ALIGN_EPI = false, bool SP2 = false>
__device__ __forceinline__ void gemm_phase(PG8_LAS unsigned char* lds, const Gemm g, const Sched& S, const Epi& E) {
    int tid_o = threadIdx.x; asm volatile("" : "+v"(tid_o));
    const int tid = tid_o, wid = __builtin_amdgcn_readfirstlane(tid >> 6), lane = tid & 63, wr = wid >> 2, wc = wid & 3, fr = lane & 15, fq = lane >> 4;
    const int K = g.K, nt = K / BK;
    unsigned voffA[2], voffB[2];
#pragma unroll
    for (int i = 0; i < 2; ++i) { int R, C; stage_rc(tid * 16 + i * 8192, R, C); const int Rb = Epi::PERM ? ((R & ~31) + perm32(R & 31)) : R;
        voffA[i] = (unsigned)(R * K + C) * 2u; voffB[i] = (unsigned)(Rb * K + C) * 2u; }
    const size_t kstep = (size_t)(BK * 2);
    const size_t hstep = (size_t)HALF * K * 2;
    const size_t tstep = 2 * hstep;
    const unsigned ldsw = (unsigned)wid * 1024u;
    const int aoff = lds_byte(wr * 64 + fr, fq * 8), boff = lds_byte(wc * 32 + fr, fq * 8);
#define PG8_SA(b, h) (((b) * 2 + (h)) * HTB)
#define PG8_SB(b, h) ((4 + (b) * 2 + (h)) * HTB)
#define PG8_STAGE(bufoff, gbase, voff) do { _Pragma("unroll") for (int _i = 0; _i < 2; ++_i) \
        __builtin_amdgcn_global_load_lds((const unsigned*)((const char*)(gbase) + (voff)[_i]), (PG8_LAS unsigned*)(lds + (bufoff) + ldsw + _i * 8192), 16, 0, 0); } while (0)
#define PG8_LDA(dst, b, h) do { _Pragma("unroll") for (int m = 0; m < 4; ++m) _Pragma("unroll") for (int k = 0; k < 2; ++k) dst[m][k] = *(const PG8_LAS bf16x8*)(lds + PG8_SA(b, h) + aoff + m * 2048 + k * 1024); } while (0)
#define PG8_LDB(dst, b, h) do { _Pragma("unroll") for (int n = 0; n < 2; ++n) _Pragma("unroll") for (int k = 0; k < 2; ++k) dst[n][k] = *(const PG8_LAS bf16x8*)(lds + PG8_SB(b, h) + boff + n * 2048 + k * 1024); } while (0)
#define PG8_MMA(ai, bj, At, Bt) do { __builtin_amdgcn_s_setprio(1); _Pragma("unroll") for (int m = 0; m < 4; ++m) _Pragma("unroll") for (int n = 0; n < 2; ++n) _Pragma("unroll") for (int k = 0; k < 2; ++k) \
        acc[ai][bj][m][n] = __builtin_amdgcn_mfma_f32_16x16x32_bf16(Bt[n][k], At[m][k], acc[ai][bj][m][n], 0, 0, 0); __builtin_amdgcn_s_setprio(0); } while (0)
#define PG8_WAIT_V(n) asm volatile("s_waitcnt vmcnt(" #n ")" ::: "memory")
#define PG8_WAIT_L(n) asm volatile("s_waitcnt lgkmcnt(" #n ")" ::: "memory")
#define PG8_BAR __builtin_amdgcn_s_barrier()
#define PG8_SCHED __builtin_amdgcn_sched_barrier(0)
    Unit cur, nxt; int ui = 0;
    if (!S.next(0, cur)) return;
    f32x4 acc[2][2][4][2];
#pragma unroll
    for (int a = 0; a < 2; ++a)
#pragma unroll
        for (int b = 0; b < 2; ++b)
#pragma unroll
            for (int m = 0; m < 4; ++m)
#pragma unroll
                for (int n = 0; n < 2; ++n) acc[a][b][m][n] = (f32x4){0.f, 0.f, 0.f, 0.f};
    bf16x8 At[4][2], B0[2][2], B1[2][2];
    const char* cA = (const char*)g.A + (size_t)cur.pm * tstep; const char* cB = (const char*)g.Bt + (size_t)cur.pn * tstep;
    S.a_ready(cur);
    if constexpr (SP2) {
        PG8_STAGE(PG8_SB(0, 0), cB, voffB); PG8_STAGE(PG8_SB(0, 1), cB + hstep, voffB); PG8_STAGE(PG8_SA(0, 0), cA, voffA); PG8_STAGE(PG8_SA(0, 1), cA + hstep, voffA);
        if (wr == 1) PG8_BAR;
        PG8_WAIT_V(2); PG8_BAR;
        PG8_STAGE(PG8_SB(1, 0), cB + kstep, voffB); PG8_STAGE(PG8_SA(1, 0), cA + kstep, voffA); PG8_STAGE(PG8_SB(1, 1), cB + hstep + kstep, voffB);
        PG8_WAIT_V(6); PG8_BAR;
    } else {
        PG8_STAGE(PG8_SB(0, 0), cB, voffB); PG8_STAGE(PG8_SA(0, 0), cA, voffA); PG8_STAGE(PG8_SB(0, 1), cB + hstep, voffB); PG8_STAGE(PG8_SA(0, 1), cA + hstep, voffA);
        if (wr == 1) PG8_BAR;
        PG8_WAIT_V(4); PG8_BAR;
        PG8_STAGE(PG8_SB(1, 0), cB + kstep, voffB); PG8_STAGE(PG8_SA(1, 0), cA + kstep, voffA); PG8_STAGE(PG8_SB(1, 1), cB + hstep + kstep, voffB);
        PG8_WAIT_V(6); PG8_BAR;
    }
    for (;;) {
        const bool has_next = S.next(ui + 1, nxt);
        const char* nA = has_next ? (const char*)g.A + (size_t)nxt.pm * tstep : cA; const char* nB = has_next ? (const char*)g.Bt + (size_t)nxt.pn * tstep : cB;
        for (int t = 0; t < nt; t += 2) {
            const bool last = (t == nt - 2);
            const char* a1 = cA + (size_t)(t + 1) * kstep;
            const char* a2 = last ? nA : cA + (size_t)(t + 2) * kstep; const char* b2 = last ? nB : cB + (size_t)(t + 2) * kstep;
            const char* a3 = a2 + kstep; const char* b3 = b2 + kstep;
            if (last && has_next) S.a_ready(nxt);
            if constexpr (SP2) {
            PG8_LDB(B0, 0, 0); PG8_LDB(B1, 0, 1); PG8_SCHED; PG8_LDA(At, 0, 0); PG8_STAGE(PG8_SA(1, 1), a1 + hstep, voffA);
            PG8_WAIT_V(8); PG8_WAIT_L(0); PG8_BAR; PG8_MMA(0, 0, At, B0); PG8_MMA(0, 1, At, B1); PG8_BAR; PG8_SCHED;
            PG8_LDA(At, 0, 1); PG8_STAGE(PG8_SB(0, 0), b2, voffB); PG8_STAGE(PG8_SB(0, 1), b2 + hstep, voffB); PG8_STAGE(PG8_SA(0, 0), a2, voffA);
            PG8_WAIT_V(8); PG8_WAIT_L(0); PG8_BAR; PG8_MMA(1, 0, At, B0); PG8_MMA(1, 1, At, B1); PG8_BAR; PG8_SCHED;
            PG8_LDB(B0, 1, 0); PG8_LDB(B1, 1, 1); PG8_SCHED; PG8_LDA(At, 1, 0); PG8_STAGE(PG8_SA(0, 1), a2 + hstep, voffA);
            PG8_WAIT_V(8); PG8_WAIT_L(0); PG8_BAR; PG8_MMA(0, 0, At, B0); PG8_MMA(0, 1, At, B1); PG8_BAR; PG8_SCHED;
            PG8_LDA(At, 1, 1); PG8_STAGE(PG8_SB(1, 0), b3, voffB); PG8_STAGE(PG8_SB(1, 1), b3 + hstep, voffB); PG8_STAGE(PG8_SA(1, 0), a3, voffA);
            PG8_WAIT_V(8); PG8_WAIT_L(0); PG8_BAR; PG8_MMA(1, 0, At, B0); PG8_MMA(1, 1, At, B1); PG8_BAR; PG8_SCHED;
            } else {
            PG8_LDB(B0, 0, 0); PG8_SCHED; PG8_LDA(At, 0, 0); PG8_STAGE(PG8_SA(1, 1), a1 + hstep, voffA);
            PG8_WAIT_L(8); PG8_BAR; PG8_WAIT_L(0); PG8_MMA(0, 0, At, B0); PG8_BAR; PG8_SCHED;
            PG8_LDB(B1, 0, 1); PG8_STAGE(PG8_SB(0, 0), b2, voffB);
            PG8_BAR; PG8_WAIT_L(0); PG8_MMA(0, 1, At, B1); PG8_BAR;
            PG8_LDA(At, 0, 1); PG8_STAGE(PG8_SA(0, 0), a2, voffA);
            PG8_BAR; PG8_WAIT_L(0); PG8_MMA(1, 0, At, B0); PG8_BAR; PG8_SCHED;
            PG8_STAGE(PG8_SB(0, 1), b2 + hstep, voffB);
            PG8_WAIT_V(6); PG8_BAR; PG8_MMA(1, 1, At, B1); PG8_BAR;
            PG8_LDB(B0, 1, 0); PG8_SCHED; PG8_LDA(At, 1, 0); PG8_STAGE(PG8_SA(0, 1), a2 + hstep, voffA);
            PG8_WAIT_L(8); PG8_BAR; PG8_WAIT_L(0); PG8_MMA(0, 0, At, B0); PG8_BAR; PG8_SCHED;
            PG8_LDB(B1, 1, 1); PG8_STAGE(PG8_SB(1, 0), b3, voffB);
            PG8_BAR; PG8_WAIT_L(0); PG8_MMA(0, 1, At, B1); PG8_BAR;
            PG8_LDA(At, 1, 1); PG8_STAGE(PG8_SA(1, 0), a3, voffA);
            PG8_BAR; PG8_WAIT_L(0); PG8_MMA(1, 0, At, B0); PG8_BAR; PG8_SCHED;
            PG8_STAGE(PG8_SB(1, 1), b3 + hstep, voffB);
            PG8_WAIT_V(6); PG8_BAR; PG8_MMA(1, 1, At, B1); PG8_BAR;
            }
        }
        if constexpr (ALIGN_EPI) { if (wr == 0) PG8_BAR; }
        if constexpr (!Epi::AFTER_DRAIN) { E(acc, cur, wr, wc, fr, fq); S.done(cur); }
        if (!has_next) break;
#pragma unroll
        for (int a = 0; a < 2; ++a)
#pragma unroll
            for (int b = 0; b < 2; ++b)
#pragma unroll
                for (int m = 0; m < 4; ++m)
#pragma unroll
                    for (int n = 0; n < 2; ++n) acc[a][b][m][n] = (f32x4){0.f, 0.f, 0.f, 0.f};
        cur = nxt; cA = nA; cB = nB; ++ui;
        if constexpr (ALIGN_EPI) { if (wr == 1) PG8_BAR; }
    }
    PG8_WAIT_V(0);
    if constexpr (!ALIGN_EPI) { if (wr == 0) PG8_BAR; }
    PG8_BAR;
    if constexpr (Epi::AFTER_DRAIN) { E.fused(acc, cur, wr, wc, fr, fq, lds, wid, lane); S.done(cur); }
#undef PG8_SA
#undef PG8_SB
#undef PG8_STAGE
#undef PG8_LDA
#undef PG8_LDB
#undef PG8_MMA
#undef PG8_WAIT_V
#undef PG8_WAIT_L
#undef PG8_BAR
#undef PG8_SCHED
}

#define PG8_GAS __attribute__((address_space(1)))
#ifndef CH_PUB_T
#define CH_PUB_T 4
#endif
#ifndef CH_FF_WT
#define CH_FF_WT 0
#endif
#ifndef CH_X_AUX
#define CH_X_AUX 0
#endif
#ifndef CH_A_AUX
#define CH_A_AUX 0
#endif
enum ChainKind { CK_NORM = 0, CK_NORM_GATES = 1, CK_UP = 2, CK_RESID = 3, CK_FINAL = 4, CK_PART = 5 };
constexpr int CC = 64, CSLOT = 96;
struct UnitD { int valid, seg, pm, pn, K, kind, ld, kq; const char* A; const char* B; };
__device__ __forceinline__ unsigned cw(volatile PG8_LAS unsigned* c, int i) { return (unsigned)__builtin_amdgcn_readfirstlane((int)c[i]); }
__device__ __forceinline__ unsigned long long cp(volatile PG8_LAS unsigned* c, int i) { const unsigned lo = cw(c, i), hi = cw(c, i + 1); return ((unsigned long long)hi << 32) | lo; }
constexpr int CCUM = CC + 24, CQ = CSLOT + 8;
__device__ __forceinline__ int chain_np(int x) { return x < 3 ? 9 : 8; }
__device__ __forceinline__ int seg_count(volatile PG8_LAS unsigned* c, int s, int np) {
    const unsigned w = cw(c, 16 * s + 14); const int lpoff = (int)(w & 0xffu), cap = (int)((w >> 8) & 0xffu), nsub = (int)(w >> 16);
    int nps = np - lpoff; nps = nps < 0 ? 0 : (nps > cap ? cap : nps);
    return nps * (int)cw(c, 16 * s + 5) * nsub;
}
__device__ __forceinline__ void decode_unit(volatile PG8_LAS unsigned* c, unsigned code, UnitD& u) {
    u.valid = code != 0xffffffffu; u.seg = 0; u.pm = 0; u.pn = 0; u.K = 1024; u.kind = 0; u.ld = 1024; u.kq = 0; u.A = nullptr; u.B = nullptr;
    if (!u.valid) return;
    const int x = (int)(code >> 16), np = chain_np(x); int i = (int)(code & 0xffffu);
    const int nseg = (int)cw(c, CC); int s = 0;
#pragma unroll
    for (int k = 0; k < 3; ++k) { if (s == k && k + 1 < nseg) { const int cnt = seg_count(c, k, np); if (i >= cnt) { i -= cnt; s = k + 1; } } }
    const unsigned w = cw(c, 16 * s + 14); const int lpoff = (int)(w & 0xffu), nsub = (int)(w >> 16);
    const int nN = (int)cw(c, 16 * s + 5), per = nN * nsub, lp = i / per, rem = i - lp * per;
    u.seg = s; u.pm = x + 8 * (lpoff + lp); u.pn = rem / nsub; u.kq = rem - u.pn * nsub; u.K = (int)cw(c, 16 * s + 4); u.kind = (int)cw(c, 16 * s + 6); u.ld = (int)cw(c, 16 * s + 9);
    u.A = (const char*)(const PG8_GAS char*)cp(c, 16 * s) + (size_t)u.pm * 512 * u.ld + (size_t)u.kq * 2 * u.K; u.B = (const char*)(const PG8_GAS char*)cp(c, 16 * s + 2) + (size_t)u.pn * 512 * u.ld + (size_t)u.kq * 2 * u.K;
}
__device__ __forceinline__ unsigned chain_deq_from(volatile PG8_LAS unsigned* c, unsigned* heads, unsigned v  ) {
    int q = (int)c[CQ], tries = (int)c[CQ + 1]; const unsigned tot8 = c[CC + 1], tot9 = c[CC + 23];
    while (v >= (q < 3 ? tot9 : tot8) && tries < 8) { q = (q + 1) & 7; ++tries; if (tries < 8) v = __hip_atomic_fetch_add(heads + 64 * q, 1u, __ATOMIC_RELAXED, __HIP_MEMORY_SCOPE_AGENT); }
    c[CQ] = (unsigned)q; c[CQ + 1] = (unsigned)tries;
    return tries < 8 ? (((unsigned)q << 16) | v) : 0xffffffffu;
}
__device__ __forceinline__ unsigned ld_relaxed(const unsigned* p) { return __hip_atomic_load(p, __ATOMIC_RELAXED, __HIP_MEMORY_SCOPE_AGENT); }
__device__ __forceinline__ void chain_wait(volatile PG8_LAS unsigned* c, const UnitD& u, int wid) {
    const unsigned long long dep = cp(c, 16 * u.seg + 10);
    if (dep) {
        if (wid == 0) { const unsigned* p = (const unsigned*)(const PG8_GAS unsigned*)dep + 64 * u.pm; const unsigned need = cw(c, 16 * u.seg + 8); unsigned spins = 0;
            while ((unsigned)__builtin_amdgcn_readfirstlane((int)ld_relaxed(p)) < need) { __builtin_amdgcn_s_sleep(2); if (++spins > (1u << 20)) break; }
            if (CH_A_AUX == 0 && u.seg == 3) __builtin_amdgcn_fence(__ATOMIC_ACQUIRE, "agent"); }
        asm volatile("s_waitcnt vmcnt(0) lgkmcnt(0)" ::: "memory"); __builtin_amdgcn_s_barrier(); asm volatile("" ::: "memory");
    }
}
__device__ __forceinline__ bool chain_try(volatile PG8_LAS unsigned* c, const UnitD& u, int wid, int lane, int ui) {
    const unsigned long long dep = cp(c, 16 * u.seg + 10);
    if (!dep) return true;
    if (wid == 0) { const unsigned* p = (const unsigned*)(const PG8_GAS unsigned*)dep + 64 * u.pm; const unsigned need = cw(c, 16 * u.seg + 8);
        const unsigned ok = (unsigned)__builtin_amdgcn_readfirstlane((int)ld_relaxed(p)) >= need ? 1u : 0u;
        if (lane == 0) c[CSLOT + 4 + (ui & 1)] = ok;
        if (CH_A_AUX == 0 && ok && u.seg == 3) { __builtin_amdgcn_fence(__ATOMIC_ACQUIRE, "agent"); asm volatile("s_waitcnt vmcnt(0)" ::: "memory"); } }
    asm volatile("s_waitcnt lgkmcnt(0)" ::: "memory"); __builtin_amdgcn_s_barrier(); asm volatile("" ::: "memory");
    return cw(c, CSLOT + 4 + (ui & 1)) != 0u;
}
typedef unsigned cu32x4 __attribute__((ext_vector_type(4)));
__device__ __forceinline__ __amdgpu_buffer_rsrc_t mk_rsrc(unsigned long long p, unsigned bytes) { return __builtin_amdgcn_make_buffer_rsrc((void*)(PG8_GAS void*)p, (short)0, (int)bytes, 0x00020000); }
__device__ __forceinline__ f32x4 ld16_sc1(__amdgpu_buffer_rsrc_t r, unsigned off) { const cu32x4 v = __builtin_amdgcn_raw_buffer_load_b128(r, (int)off, 0, CH_X_AUX); return __builtin_bit_cast(f32x4, v); }
__device__ __forceinline__ void st16_sc1(__amdgpu_buffer_rsrc_t r, unsigned off, f32x4 v) { __builtin_amdgcn_raw_buffer_store_b128(__builtin_bit_cast(cu32x4, v), r, (int)off, 0, CH_X_AUX); }
__device__ __forceinline__ void st16u_sc1(__amdgpu_buffer_rsrc_t r, unsigned off, cu32x4 v) { __builtin_amdgcn_raw_buffer_store_b128(v, r, (int)off, 0, CH_X_AUX); }
__device__ __forceinline__ void st16u_wt(__amdgpu_buffer_rsrc_t r, unsigned off, cu32x4 v) { __builtin_amdgcn_raw_buffer_store_b128(v, r, (int)off, 0, 16); }
constexpr unsigned CH_MPAD = 17152;
__device__ __forceinline__ void row_rscales_sc1(__amdgpu_buffer_rsrc_t rss, int row0, int fr, int fq, float (&rr)[2][4]) {
    f32x4 v[2][4];
#pragma unroll
    for (int ai = 0; ai < 2; ++ai)
#pragma unroll
        for (int m = 0; m < 4; ++m) { const cu32x4 t = __builtin_amdgcn_raw_buffer_load_b128(rss, (int)((unsigned)(row0 + ai * HALF + m * 16) * 64u + 16u * (unsigned)fq), 0, CH_X_AUX); v[ai][m] = __builtin_bit_cast(f32x4, t); }
#pragma unroll
    for (int ai = 0; ai < 2; ++ai)
#pragma unroll
        for (int m = 0; m < 4; ++m) { float s = (v[ai][m][0] + v[ai][m][1]) + (v[ai][m][2] + v[ai][m][3]); s += shx(s, 16, (fr + 16 * fq)); s += shx(s, 32, (fr + 16 * fq)); rr[ai][m] = 1.0f / sqrtf(s * (1.0f / 1024.0f) + 1e-6f); }
}
__device__ __forceinline__ void chain_epilogue(volatile PG8_LAS unsigned* c, const UnitD& u, const f32x4 (&acc)[2][2][4][2], int wr, int wc, int fr, int fq) {
    const int row0 = u.pm * BM + wr * 64 + fr, colw = wc * 32 + 8 * fq;
    const __amdgpu_buffer_rsrc_t rss = mk_rsrc(cp(c, CC + 8), CH_MPAD * 64u);
    if (u.kind <= CK_UP) {
        float rr[2][4]; row_rscales_sc1(rss, row0, fr, fq, rr);
        if (u.kind == CK_NORM_GATES && u.pn == 12) {
            if (wc == 0 && fq == 0) { const float* bg = (const float*)(const PG8_GAS float*)cp(c, CC + 16); float* G = (float*)(PG8_GAS float*)cp(c, CC + 14);
                const f32x4 b0 = *(const f32x4*)bg, b1 = *(const f32x4*)(bg + 4);
#pragma unroll
                for (int ai = 0; ai < 2; ++ai)
#pragma unroll
                    for (int m = 0; m < 4; ++m) { const int row = row0 + ai * HALF + m * 16; const float r = rr[ai][m];
                        const f32x4 gi = acc[ai][0][m][0] * r + b0, gf = acc[ai][0][m][1] * r + b1;
                        *(f32x4*)(G + (size_t)row * 8) = gi; *(f32x4*)(G + (size_t)row * 8 + 4) = gf; } }
            return;
        }
        const bool up = u.kind == CK_UP; const int ldc = up ? 4096 : (int)cw(c, CC + 22);
        const unsigned long long obase = up ? cp(c, CC + 12) : cp(c, CC + 10);
        const __amdgpu_buffer_rsrc_t ro = mk_rsrc(obase, CH_MPAD * (unsigned)ldc * 2u);
        const int col0 = u.pn * BM + colw;
#pragma unroll
        for (int ai = 0; ai < 2; ++ai)
#pragma unroll
            for (int m = 0; m < 4; ++m) { const int row = row0 + ai * HALF + m * 16; const float r = rr[ai][m];
#pragma unroll
                for (int bj = 0; bj < 2; ++bj) { f32x4 v0 = acc[ai][bj][m][0] * r, v1 = acc[ai][bj][m][1] * r;
                    if (up) {
#pragma unroll
                        for (int j = 0; j < 4; ++j) { const float a = fmaxf(v0[j], 0.f), b = fmaxf(v1[j], 0.f); v0[j] = a * a; v1[j] = b * b; } }
                    cu32x4 w; w.x = cvt_pk_bf16(v0[0], v0[1]); w.y = cvt_pk_bf16(v0[2], v0[3]); w.z = cvt_pk_bf16(v1[0], v1[1]); w.w = cvt_pk_bf16(v1[2], v1[3]);
                    if (up && CH_FF_WT) st16u_wt(ro, ((unsigned)row * (unsigned)ldc + (unsigned)(col0 + bj * HALF)) * 2u, w); else st16u_sc1(ro, ((unsigned)row * (unsigned)ldc + (unsigned)(col0 + bj * HALF)) * 2u, w); } }
        return;
    }
    if (u.kind == CK_PART) {
        float* P = (float*)(PG8_GAS float*)cp(c, CC + 30) + ((size_t)(u.kq * 3 + (u.pm - 64)) * 256) * 1024; const int colp = u.pn * BM + colw;
#pragma unroll
        for (int ai = 0; ai < 2; ++ai)
#pragma unroll
            for (int m = 0; m < 4; ++m) { float* rp = P + (size_t)(wr * 64 + fr + ai * HALF + m * 16) * 1024 + colp;
#pragma unroll
                for (int bj = 0; bj < 2; ++bj)
#pragma unroll
                    for (int n = 0; n < 2; ++n) *(f32x4*)(rp + bj * HALF + 4 * n) = acc[ai][bj][m][n]; }
        return;
    }
    const __amdgpu_buffer_rsrc_t rxb = mk_rsrc(cp(c, CC + 6), CH_MPAD * 2048u);
    const int col0 = u.pn * BM + colw;
    cu32x4 xin[4][2];
#define CH_XLOAD(i) do { _Pragma("unroll") for (int bj = 0; bj < 2; ++bj) xin[(i) & 3][bj] = __builtin_amdgcn_raw_buffer_load_b128(rxb, (int)(((unsigned)(row0 + ((i) >> 2) * HALF + ((i) & 3) * 16) * 1024u + (unsigned)(col0 + bj * HALF)) * 2u), 0, CH_X_AUX); } while (0)
    CH_XLOAD(0); CH_XLOAD(1); CH_XLOAD(2);
#define CH_UNPK(W_, v0, v1) do { const cu32x4 q_ = (W_); v0 = (f32x4){__builtin_bit_cast(float, q_.x << 16), __builtin_bit_cast(float, q_.x & 0xffff0000u), __builtin_bit_cast(float, q_.y << 16), __builtin_bit_cast(float, q_.y & 0xffff0000u)}; \
        v1 = (f32x4){__builtin_bit_cast(float, q_.z << 16), __builtin_bit_cast(float, q_.z & 0xffff0000u), __builtin_bit_cast(float, q_.w << 16), __builtin_bit_cast(float, q_.w & 0xffff0000u)}; } while (0)
    if (u.kind == CK_RESID) {
#pragma unroll
        for (int i = 0; i < 8; ++i) { const int ai = i >> 2, m = i & 3; const int row = row0 + ai * HALF + m * 16; const unsigned off = (unsigned)row * 1024u + (unsigned)col0;
            float s = 0.f; cu32x4 xc[2] = {xin[i & 3][0], xin[i & 3][1]};
            if (i + 3 < 8) CH_XLOAD(i + 3);
#pragma unroll
            for (int bj = 0; bj < 2; ++bj) { f32x4 x0, x1; CH_UNPK(xc[bj], x0, x1); x0 = x0 + acc[ai][bj][m][0]; x1 = x1 + acc[ai][bj][m][1];
                cu32x4 w; w.x = cvt_pk_bf16(x0[0], x0[1]); w.y = cvt_pk_bf16(x0[2], x0[3]); w.z = cvt_pk_bf16(x1[0], x1[1]); w.w = cvt_pk_bf16(x1[2], x1[3]);
                st16u_sc1(rxb, (off + bj * HALF) * 2u, w);
                CH_UNPK(w, x0, x1); s += ((x0[0] * x0[0] + x0[1] * x0[1]) + (x0[2] * x0[2] + x0[3] * x0[3])) + ((x1[0] * x1[0] + x1[1] * x1[1]) + (x1[2] * x1[2] + x1[3] * x1[3])); }
            s += shx(s, 16, (fr + 16 * fq)); s += shx(s, 32, (fr + 16 * fq));
            if (fq == 0) __builtin_amdgcn_raw_buffer_store_b32(__builtin_bit_cast(unsigned, s), rss, (int)((unsigned)row * 64u + (unsigned)(u.pn * 4 + wc) * 4u), 0, CH_X_AUX);
        }
    } else {
        float* yp = (float*)(PG8_GAS float*)cp(c, CC + 18); float* ys = (float*)(PG8_GAS float*)cp(c, CC + 20);
#pragma unroll
        for (int i = 0; i < 8; ++i) { const int ai = i >> 2, m = i & 3; const int row = row0 + ai * HALF + m * 16;
            float* dst = nullptr;
            if (row < RM_MP) { const int b = row / RM_LP, t = row - b * RM_LP; if (t >= RM_META) dst = yp + ((size_t)b * RM_SEQ + (t - RM_META)) * 1024 + col0; }
            else if (row < RM_MTOT) dst = ys + (size_t)(row - RM_MP) * 1024 + col0;
            f32x4 x[2][2]; cu32x4 xc[2] = {xin[i & 3][0], xin[i & 3][1]};
            if (i + 3 < 8) CH_XLOAD(i + 3);
#pragma unroll
            for (int bj = 0; bj < 2; ++bj) { CH_UNPK(xc[bj], x[bj][0], x[bj][1]); x[bj][0] = x[bj][0] + acc[ai][bj][m][0]; x[bj][1] = x[bj][1] + acc[ai][bj][m][1]; }
            if (dst) {
#pragma unroll
                for (int bj = 0; bj < 2; ++bj)
#pragma unroll
                    for (int n = 0; n < 2; ++n) *(f32x4*)(dst + bj * HALF + 4 * n) = x[bj][n]; }
        }
    }
#undef CH_UNPK
#undef CH_XLOAD
}
__device__ __forceinline__ int lane_now() { int l; asm volatile("v_mbcnt_lo_u32_b32 %0, -1, 0\n\tv_mbcnt_hi_u32_b32 %0, -1, %0" : "=v"(l)); return l; }
__device__ __forceinline__ void gemm_chain(PG8_LAS unsigned char* lds, volatile PG8_LAS unsigned* c, int tid_in) {
    int tid_o = tid_in; asm volatile("" : "+v"(tid_o));
    const int tid = tid_o, wid = __builtin_amdgcn_readfirstlane(tid >> 6), lane = tid & 63, wr = wid >> 2, wc = wid & 3, fr = lane & 15, fq = lane >> 4;
    unsigned rc;
    { int R, C; stage_rc(tid * 16, R, C); rc = (2u * (unsigned)R) | ((2u * (unsigned)C) << 16); }
#define ra2 (rc & 0xffffu)
#define c2 (rc >> 16)
#define CH_RB2() (2u * (unsigned)((int)((ra2 >> 1) & ~31u) + perm32((int)((ra2 >> 1) & 31u))))
    const unsigned ldsw = (unsigned)wid * 1024u;
    const int aoff = lds_byte(wr * 64 + fr, fq * 8), boff = lds_byte(wc * 32 + fr, fq * 8);
    constexpr size_t kstep = (size_t)(BK * 2);
#define PG8_SA(b, h) (((b) * 2 + (h)) * HTB)
#define PG8_SB(b, h) ((4 + (b) * 2 + (h)) * HTB)
#define CH_STAGE_A(bufoff, gbase, K_)   do { const unsigned _vo = ra2 * (unsigned)(K_) + c2; const char* _g1 = (const char*)(gbase); const char* _g2 = _g1 + 128 * (size_t)(K_); \
        __builtin_amdgcn_global_load_lds((const unsigned*)(_g1 + _vo), (PG8_LAS unsigned*)(lds + (bufoff) + ldsw), 16, 0, CH_A_AUX); \
        __builtin_amdgcn_global_load_lds((const unsigned*)(_g2 + _vo), (PG8_LAS unsigned*)(lds + (bufoff) + ldsw + 8192), 16, 0, CH_A_AUX); } while (0)
#define CH_STAGE_B(bufoff, gbase, K_) do { const unsigned _vo = CH_RB2() * (unsigned)(K_) + c2; const char* _g1 = (const char*)(gbase); const char* _g2 = _g1 + 128 * (size_t)(K_); \
        __builtin_amdgcn_global_load_lds((const unsigned*)(_g1 + _vo), (PG8_LAS unsigned*)(lds + (bufoff) + ldsw), 16, 0, 0); \
        __builtin_amdgcn_global_load_lds((const unsigned*)(_g2 + _vo), (PG8_LAS unsigned*)(lds + (bufoff) + ldsw + 8192), 16, 0, 0); } while (0)
#define PG8_LDA(dst, b, h) do { _Pragma("unroll") for (int m = 0; m < 4; ++m) _Pragma("unroll") for (int k = 0; k < 2; ++k) dst[m][k] = *(const PG8_LAS bf16x8*)(lds + PG8_SA(b, h) + aoff + m * 2048 + k * 1024); } while (0)
#define PG8_LDB(dst, b, h) do { _Pragma("unroll") for (int n = 0; n < 2; ++n) _Pragma("unroll") for (int k = 0; k < 2; ++k) dst[n][k] = *(const PG8_LAS bf16x8*)(lds + PG8_SB(b, h) + boff + n * 2048 + k * 1024); } while (0)
#define PG8_MMA(ai, bj, At, Bt) do { __builtin_amdgcn_s_setprio(1); _Pragma("unroll") for (int m = 0; m < 4; ++m) _Pragma("unroll") for (int n = 0; n < 2; ++n) _Pragma("unroll") for (int k = 0; k < 2; ++k) \
        acc[ai][bj][m][n] = __builtin_amdgcn_mfma_f32_16x16x32_bf16(Bt[n][k], At[m][k], acc[ai][bj][m][n], 0, 0, 0); __builtin_amdgcn_s_setprio(0); } while (0)
#define PG8_WAIT_V(n) asm volatile("s_waitcnt vmcnt(" #n ")" ::: "memory")
#define PG8_WAIT_L(n) asm volatile("s_waitcnt lgkmcnt(" #n ")" ::: "memory")
#define PG8_BAR __builtin_amdgcn_s_barrier()
#define PG8_SCHED __builtin_amdgcn_sched_barrier(0)
#define CH_CODE(j) ({ const unsigned x_ = cw(c, CQ), i_ = (unsigned)(j) * cw(c, CQ + 2) + cw(c, CQ + 1); i_ < (x_ < 3u ? cw(c, CC + 23) : cw(c, CC + 1)) ? ((x_ << 16) | i_) : 0xffffffffu; })
    UnitD cur, nxt; int ui = 0;
    decode_unit(c, CH_CODE(0), cur);
    if (!cur.valid) return;
    f32x4 acc[2][2][4][2];
#pragma unroll
    for (int a = 0; a < 2; ++a)
#pragma unroll
        for (int b = 0; b < 2; ++b)
#pragma unroll
            for (int m = 0; m < 4; ++m)
#pragma unroll
                for (int n = 0; n < 2; ++n) acc[a][b][m][n] = (f32x4){0.f, 0.f, 0.f, 0.f};
    bf16x8 At[4][2], B0[2][2], B1[2][2];
    { const char* cA = cur.A; const char* cB = cur.B; const int K = cur.ld; const size_t hs = (size_t)256 * K;
      CH_STAGE_B(PG8_SB(0, 0), cB, K); CH_STAGE_B(PG8_SB(0, 1), cB + hs, K); CH_STAGE_A(PG8_SA(0, 0), cA, K); CH_STAGE_A(PG8_SA(0, 1), cA + hs, K);
      if (wr == 1) PG8_BAR;
      PG8_WAIT_V(2); PG8_BAR;
      CH_STAGE_B(PG8_SB(1, 0), cB + kstep, K); CH_STAGE_A(PG8_SA(1, 0), cA + kstep, K); CH_STAGE_B(PG8_SB(1, 1), cB + hs + kstep, K);
      PG8_WAIT_V(6); PG8_BAR; }
    for (;;) {
        bool has_next = false;
        const char* cA = cur.A; const char* cB = cur.B; const int Kc = cur.ld, nt = cur.K / BK; const size_t hsc = (size_t)256 * Kc;
        for (int t = 0; t < nt; t += 2) {
            const bool last = (t == nt - 2);
            if (last) { decode_unit(c, CH_CODE(ui + 1), nxt); has_next = nxt.valid != 0; }
            const bool into = last && has_next;
            const char* a1 = cA + (size_t)(t + 1) * kstep;
            const char* a2 = last ? (into ? nxt.A : cA) : cA + (size_t)(t + 2) * kstep; const char* b2 = last ? (into ? nxt.B : cB) : cB + (size_t)(t + 2) * kstep;
            const char* a3 = a2 + kstep; const char* b3 = b2 + kstep;
            const int K2 = into ? nxt.ld : Kc; const size_t hs2 = (size_t)256 * K2;
            PG8_LDB(B0, 0, 0); PG8_LDB(B1, 0, 1); PG8_SCHED; PG8_LDA(At, 0, 0); CH_STAGE_A(PG8_SA(1, 1), a1 + hsc, Kc);
            PG8_WAIT_V(8); PG8_WAIT_L(0); PG8_BAR; PG8_MMA(0, 0, At, B0); PG8_MMA(0, 1, At, B1); PG8_BAR; PG8_SCHED;
            PG8_LDA(At, 0, 1); CH_STAGE_B(PG8_SB(0, 0), b2, K2); CH_STAGE_B(PG8_SB(0, 1), b2 + hs2, K2); CH_STAGE_A(PG8_SA(0, 0), a2, K2);
            PG8_WAIT_V(8); PG8_WAIT_L(0); PG8_BAR; PG8_MMA(1, 0, At, B0); PG8_MMA(1, 1, At, B1); PG8_BAR; PG8_SCHED;
            PG8_LDB(B0, 1, 0); PG8_LDB(B1, 1, 1); PG8_SCHED; PG8_LDA(At, 1, 0); CH_STAGE_A(PG8_SA(0, 1), a2 + hs2, K2);
            PG8_WAIT_V(8); PG8_WAIT_L(0); PG8_BAR; PG8_MMA(0, 0, At, B0); PG8_MMA(0, 1, At, B1); PG8_BAR; PG8_SCHED;
            PG8_LDA(At, 1, 1); CH_STAGE_B(PG8_SB(1, 0), b3, K2); CH_STAGE_B(PG8_SB(1, 1), b3 + hs2, K2); CH_STAGE_A(PG8_SA(1, 0), a3, K2);
            PG8_WAIT_V(8); PG8_WAIT_L(0); PG8_BAR; PG8_MMA(1, 0, At, B0); PG8_MMA(1, 1, At, B1); PG8_BAR; PG8_SCHED;
        }
        if (wr == 0) PG8_BAR;
        { const int lane_e = lane_now();
          chain_epilogue(c, cur, acc, wr, wc, lane_e & 15, lane_e >> 4); }
#pragma unroll
        for (int a = 0; a < 2; ++a)
#pragma unroll
            for (int b = 0; b < 2; ++b)
#pragma unroll
                for (int m = 0; m < 4; ++m)
#pragma unroll
                    for (int n = 0; n < 2; ++n) acc[a][b][m][n] = (f32x4){0.f, 0.f, 0.f, 0.f};
        if (!has_next) break;
        cur = nxt; ++ui;
        if (wr == 1) PG8_BAR;
    }
    PG8_WAIT_V(0);
    PG8_BAR;
#undef CH_CODE
#undef PG8_SA
#undef PG8_SB
#undef CH_STAGE_A
#undef CH_STAGE_B
#undef CH_RB2
#undef ra2
#undef c2
#undef PG8_LDA
#undef PG8_LDB
#undef PG8_MMA
#undef PG8_WAIT_V
#undef PG8_WAIT_L
#undef PG8_BAR
#undef PG8_SCHED
}
}
#ifndef PG8_SP2
#define PG8_SP2 true
#endif
#ifndef PG8_ALIGN
#define PG8_ALIGN true
#endif
constexpr int NWAVES = 8;
constexpr int D = 1024, NB = 8, SEQ = 2048, NMETA = 16, LP = SEQ + NMETA, DBATCH = 128, DSEQ = 4;
constexpr int MP = NB * LP, MS = DBATCH * DSEQ, MTOT = MP + MS, MPAD = 17152;
constexpr int NQKV = 1536, NIN = 3072, NINP = 3328, FF = 4096;
constexpr int AH = 16, AKV = 4, AHD = 64, WIN = 128;
constexpr int MH = 4, MDK = 128, MDV = 256, MCH = 64, VS = 32, NSL = MDV / VS;
constexpr float EPS = 1e-6f;
static_assert(MPAD % 256 == 0 && MPAD >= MTOT, "row padding");
constexpr size_t MiB = 1u << 20;
constexpr size_t WS_CTL = 0, CTL_ZERO_BYTES = 1 * MiB;
constexpr size_t WS_WQKV = 2 * MiB, WS_WO = 8 * MiB, WS_WIN = 12 * MiB, WS_WOUT = 25 * MiB, WS_WUP = 29 * MiB, WS_WDN = 61 * MiB;
constexpr size_t SZ_WQKV = (size_t)NQKV * D * 2, SZ_WO = (size_t)D * D * 2, SZ_WIN = (size_t)NINP * D * 2, SZ_WUP = (size_t)FF * D * 2;
constexpr size_t WS_SS = 93 * MiB, WS_G = 95 * MiB, WS_HSS = 96 * MiB;
constexpr size_t WS_X = 100 * MiB, WS_XB = 167 * MiB, WS_Z = 201 * MiB, WS_AO = 302 * MiB, WS_FF = 336 * MiB, WS_PT = 470 * MiB, WS_END = 483 * MiB;
static_assert(WS_WQKV + 2 * SZ_WQKV <= WS_WO && WS_WO + 2 * SZ_WO <= WS_WIN && WS_WIN + 2 * SZ_WIN <= WS_WOUT && WS_WOUT + 2 * SZ_WO <= WS_WUP && WS_WUP + 4 * SZ_WUP <= WS_WDN && WS_WDN + 4 * SZ_WUP <= WS_SS, "weights map");
static_assert(WS_SS + (size_t)MPAD * 16 * 4 <= WS_G && WS_G + (size_t)MPAD * 8 * 4 <= WS_HSS && WS_HSS + (size_t)MPAD * 32 * 4 <= WS_X, "small maps");
static_assert(WS_X + (size_t)MPAD * D * 4 <= WS_XB && WS_XB + (size_t)MPAD * D * 2 <= WS_Z && WS_Z + (size_t)MPAD * NIN * 2 <= WS_AO && WS_AO + (size_t)MPAD * D * 2 <= WS_FF && WS_FF + (size_t)MPAD * FF * 2 <= WS_PT && WS_PT + (size_t)4 * 768 * D * 4 <= WS_END, "activation map");
constexpr int CW_BAR = 4096;
constexpr size_t O_YP = 0, O_YS = O_YP + (size_t)NB * SEQ * D, O_KP = O_YS + (size_t)MS * D, O_VP = O_KP + (size_t)2 * NB * WIN * AKV * AHD, O_KS = O_VP + (size_t)2 * NB * WIN * AKV * AHD,
    O_VS = O_KS + (size_t)2 * DBATCH * WIN * AKV * AHD, O_CP = O_VS + (size_t)2 * DBATCH * WIN * AKV * AHD, O_NP = O_CP + (size_t)2 * NB * MH * MDK * MDV, O_MP = O_NP + (size_t)2 * NB * MH * MDK,
    O_CS = O_MP + (size_t)2 * NB * MH, O_NS = O_CS + (size_t)2 * DBATCH * MH * MDK * MDV, O_MS = O_NS + (size_t)2 * DBATCH * MH * MDK, O_END = O_MS + (size_t)2 * DBATCH * MH;
constexpr int RING_OFF = 0, RING_BYTES = 131072;
constexpr int LDSCTL_OFF = RING_BYTES, MISC_OFF = LDSCTL_OFF + 320;
constexpr int LDS_BYTES = 147456;
#define GAS __attribute__((address_space(1)))
#define LAS __attribute__((address_space(3)))
typedef unsigned short bf16;
typedef unsigned v4u __attribute__((ext_vector_type(4)));
typedef float f32x4 __attribute__((ext_vector_type(4)));
typedef short bf16x8 __attribute__((ext_vector_type(8)));
typedef GAS unsigned gu32;
typedef GAS unsigned long long gu64;
#define RLX_AGENT __ATOMIC_RELAXED, __HIP_MEMORY_SCOPE_AGENT
#define LDS_WAIT() asm volatile("s_waitcnt lgkmcnt(0)" ::: "memory")
#define VM_WAIT() asm volatile("s_waitcnt vmcnt(0)" ::: "memory")
__device__ __forceinline__ unsigned long long rt() { return __builtin_amdgcn_s_memrealtime(); }
__device__ __forceinline__ unsigned f2bf(float f) { unsigned u = __builtin_bit_cast(unsigned, f); return (u + 0x7fffu + ((u >> 16) & 1u)) >> 16; }
__device__ __forceinline__ unsigned pk2(float lo, float hi) { return f2bf(lo) | (f2bf(hi) << 16); }

#define XB_TMO      128
#define XB_XCNT(j)  (256  + 64 * (j))
#define XB_XSUB(j)  (1280 + 64 * (j))
#define XB_XGEN(j)  (2304 + 64 * (j))
#define XB_TOP      3328
#define XB_TOPGEN   3392
#define XCD_BAR_WORDS 3456
#define XB_SPIN_CAP (1u << 18)

__device__ __forceinline__ unsigned xb_ld(unsigned* p)              { return __hip_atomic_load(p, __ATOMIC_RELAXED, __HIP_MEMORY_SCOPE_AGENT); }
__device__ __forceinline__ unsigned xb_add(unsigned* p, unsigned v) { return __hip_atomic_fetch_add(p, v, __ATOMIC_RELAXED, __HIP_MEMORY_SCOPE_AGENT); }
__device__ __forceinline__ unsigned xb_xcc_id() { return (unsigned)__builtin_amdgcn_s_getreg((3 << 11) | 20) & 0xFu; }
#define XB_SPIN(cond, bar) do { unsigned _sp = 0; while (cond) { __builtin_amdgcn_s_sleep(1); \
    if ((++_sp & 255u) == 0u) { if (xb_ld(&(bar)[XB_TMO])) break; if (_sp > XB_SPIN_CAP) { atomicAdd(&(bar)[XB_TMO], 1u); break; } } } } while (0)

struct XcdBarrier {
    unsigned* bar; unsigned x;
    volatile LAS unsigned* st;
};

__device__ __forceinline__ XcdBarrier xcd_barrier_post(unsigned* bar, volatile LAS unsigned* st) {
    XcdBarrier b; b.bar = bar; b.x = xb_xcc_id(); b.st = st;
    if (threadIdx.x == 0) (void)xb_add(&bar[XB_XCNT(b.x)], 1u);
    return b;
}
__device__ __forceinline__ void xcd_barrier_complete(unsigned* bar, unsigned x, unsigned& nloc, unsigned& nx) {
    const unsigned G = gridDim.x * gridDim.y * gridDim.z;
    unsigned sum, cnt, mine, sp = 0u;
    for (;;) {
        sum = 0u; cnt = 0u; mine = 0u;
#pragma unroll
        for (unsigned j = 0; j < 16; ++j) { const unsigned c = xb_ld(&bar[XB_XCNT(j)]); sum += c; cnt += (c > 0u) ? 1u : 0u; mine = (j == x) ? c : mine; }
        if (sum == G) break;
        __builtin_amdgcn_s_sleep(1);
        if ((++sp & 255u) == 0u) { if (xb_ld(&bar[XB_TMO])) break; if (sp > XB_SPIN_CAP) { atomicAdd(&bar[XB_TMO], 1u); break; } }
    }
    nloc = mine > 0u ? mine : 1u; nx = cnt > 0u ? cnt : 1u;
}

__device__ __forceinline__ void xcd_barrier(const XcdBarrier& b) {
    asm volatile("s_waitcnt vmcnt(0)" ::: "memory");
    __syncthreads();
    if (threadIdx.x == 0) {
        unsigned* bar = b.bar;
        __builtin_amdgcn_s_waitcnt(0);
        unsigned nloc = b.st[0], nx = b.st[1];
        if (nloc == 0u) { xcd_barrier_complete(bar, b.x, nloc, nx); b.st[0] = nloc; b.st[1] = nx; }
        const unsigned old = xb_add(&bar[XB_XSUB(b.x)], 1u);
        const unsigned gen = old / nloc;
        if (old + 1u == (gen + 1u) * nloc) {
            __builtin_amdgcn_fence(__ATOMIC_RELEASE, "agent");
            asm volatile("s_waitcnt vmcnt(0)" ::: "memory");
            const unsigned og = xb_add(&bar[XB_TOP], 1u);
            const unsigned tg = og / nx;
            if (og + 1u == (tg + 1u) * nx) xb_add(&bar[XB_TOPGEN], 1u);
            else XB_SPIN(xb_ld(&bar[XB_TOPGEN]) == tg, bar);
            __builtin_amdgcn_fence(__ATOMIC_ACQUIRE, "agent");
            xb_add(&bar[XB_XGEN(b.x)], 1u);
            asm volatile("s_waitcnt vmcnt(0)" ::: "memory");
        } else {
            XB_SPIN(xb_ld(&bar[XB_XGEN(b.x)]) == gen, bar);
            __builtin_amdgcn_fence(__ATOMIC_ACQUIRE, "agent");
            asm volatile("s_waitcnt vmcnt(0)" ::: "memory");
        }
    }
    __syncthreads();
}

typedef unsigned v2u __attribute__((ext_vector_type(2)));
__device__ __forceinline__ float bf_lo(unsigned w) { return __builtin_bit_cast(float, w << 16); }
__device__ __forceinline__ float bf_hi(unsigned w) { return __builtin_bit_cast(float, w & 0xffff0000u); }
__device__ __forceinline__ float bf1(bf16 b) { return __builtin_bit_cast(float, (unsigned)b << 16); }
__device__ __forceinline__ void unpack8(const v4u w, float (&f)[8]) { f[0] = bf_lo(w.x); f[1] = bf_hi(w.x); f[2] = bf_lo(w.y); f[3] = bf_hi(w.y); f[4] = bf_lo(w.z); f[5] = bf_hi(w.z); f[6] = bf_lo(w.w); f[7] = bf_hi(w.w); }
__device__ __forceinline__ v4u pack8(const float (&f)[8]) { v4u o; o.x = pk2(f[0], f[1]); o.y = pk2(f[2], f[3]); o.z = pk2(f[4], f[5]); o.w = pk2(f[6], f[7]); return o; }
__device__ __forceinline__ float wave_sum(float v, int lane) {
#pragma unroll
    for (int o = 1; o < 64; o <<= 1) v += pg8::shx(v, o, lane);
    return v;
}
__device__ __forceinline__ f32x4 mfma16(bf16x8 a, bf16x8 b, f32x4 c) { return __builtin_amdgcn_mfma_f32_16x16x32_bf16(a, b, c, 0, 0, 0); }
#define WG_BAR() do { asm volatile("s_waitcnt vmcnt(0) lgkmcnt(0)" ::: "memory"); __builtin_amdgcn_s_barrier(); asm volatile("" ::: "memory"); } while (0)
#define LDS_BAR() do { asm volatile("s_waitcnt lgkmcnt(0)" ::: "memory"); __builtin_amdgcn_s_barrier(); asm volatile("" ::: "memory"); } while (0)

__device__ __forceinline__ void p0_transpose_item(const float* W, const float* gs, int K, int N, bf16* WT, int row_off, int mlo, int mhi, float mul, LAS float* scr, int item, int lane) {
    const int nblk = N / 32, kb = item / nblk, nb = item % nblk, k0 = 64 * kb, n0 = 32 * nb;
    const float cm = (n0 >= mlo && n0 < mhi) ? mul : 1.0f;
#pragma unroll 8
    for (int i = 0; i < 32; ++i) { const int kk = 2 * i + (lane >> 5); const float g = gs ? gs[k0 + kk] * cm : cm; scr[kk * 33 + (lane & 31)] = W[(size_t)(k0 + kk) * N + n0 + (lane & 31)] * g; }
    LDS_WAIT(); asm volatile("" ::: "memory");
    const int c = lane & 7;
#pragma unroll
    for (int j = 0; j < 4; ++j) { const int n = (lane >> 3) + 8 * j; const LAS float* s = scr + (8 * c) * 33 + n;
        v4u o; o.x = pk2(s[0 * 33], s[1 * 33]); o.y = pk2(s[2 * 33], s[3 * 33]); o.z = pk2(s[4 * 33], s[5 * 33]); o.w = pk2(s[6 * 33], s[7 * 33]);
        *(GAS v4u*)(WT + (size_t)(row_off + n0 + n) * K + k0 + 8 * c) = o; }
    LDS_WAIT(); asm volatile("" ::: "memory");
}
struct P0Args { const float *xp, *xs, *meta, *norm_mix, *norm_mlp, *wqkv, *wo, *win, *wgate, *wout, *wup, *wdn; unsigned char* ws; };
__device__ __forceinline__ void p0_prologue(const P0Args& A, LAS unsigned char* lds, int vcu, int G, int wave, int lane, int tid) {
    LAS float* scr = (LAS float*)(lds + RING_OFF + wave * 16384);
    const int gw = vcu * NWAVES + wave, NGW = G * NWAVES;
    constexpr int I_QKV = (D / 64) * (NQKV / 32), I_O = (D / 64) * (D / 32), I_IN = (D / 64) * (NIN / 32), I_UP = (D / 64) * (FF / 32), I_DN = (FF / 64) * (D / 32);
    constexpr int I_MIX = I_QKV + I_O + I_IN + I_O, I_MLP = I_UP + I_DN, NITEMS = 2 * I_MIX + 4 * I_MLP;
    unsigned char* ws = A.ws;
    for (int it = gw; it < NITEMS; it += NGW) {
        int r = it;
        if (r < 2 * I_MIX) { const int j = r / I_MIX; r -= j * I_MIX;
            if (r < I_QKV) { p0_transpose_item(A.wqkv + (size_t)j * D * NQKV, A.norm_mix + (2 * j) * D, D, NQKV, (bf16*)(ws + WS_WQKV + j * SZ_WQKV), 0, 0, 0, 1.f, scr, r, lane); continue; } r -= I_QKV;
            if (r < I_O) { p0_transpose_item(A.wo + (size_t)j * D * D, nullptr, D, D, (bf16*)(ws + WS_WO + j * SZ_WO), 0, 0, 0, 1.f, scr, r, lane); continue; } r -= I_O;
            if (r < I_IN) { p0_transpose_item(A.win + (size_t)j * D * NIN, A.norm_mix + (2 * j + 1) * D, D, NIN, (bf16*)(ws + WS_WIN + j * SZ_WIN), 0, 512, 1024, 0.08838834764831845f, scr, r, lane); continue; } r -= I_IN;
            p0_transpose_item(A.wout + (size_t)j * D * D, nullptr, D, D, (bf16*)(ws + WS_WOUT + j * SZ_WO), 0, 0, 0, 1.f, scr, r, lane); continue; }
        r -= 2 * I_MIX;
        { const int i = r / I_MLP; r -= i * I_MLP;
            if (r < I_UP) { p0_transpose_item(A.wup + (size_t)i * D * FF, A.norm_mlp + i * D, D, FF, (bf16*)(ws + WS_WUP + i * SZ_WUP), 0, 0, 0, 1.f, scr, r, lane); continue; } r -= I_UP;
            p0_transpose_item(A.wdn + (size_t)i * FF * D, nullptr, FF, D, (bf16*)(ws + WS_WDN + i * SZ_WUP), 0, 0, 0, 1.f, scr, r, lane); }
    }
    { const int gt = vcu * (NWAVES * 64) + tid, NT = G * NWAVES * 64;
      for (int e = gt; e < 2 * 256 * (D / 8); e += NT) { const int j = e / (256 * (D / 8)), rem = e % (256 * (D / 8)), n = rem / (D / 8), k8 = (rem % (D / 8)) * 8;
          float f[8];
#pragma unroll
          for (int q = 0; q < 8; ++q) f[q] = (n < 8) ? A.wgate[((size_t)j * D + k8 + q) * 8 + n] * A.norm_mix[(2 * j + 1) * D + k8 + q] : 0.f;
          *(GAS v4u*)((bf16*)(ws + WS_WIN + j * SZ_WIN) + (size_t)(NIN + n) * D + k8) = pack8(f); } }
    bf16* XB = (bf16*)(ws + WS_XB); float* SS = (float*)(ws + WS_SS); bf16* AO = (bf16*)(ws + WS_AO);
    for (int m = gw; m < MPAD; m += NGW) {
        const float* src = nullptr;
        if (m < MP) { const int b = m / LP, t = m - b * LP; src = (t < NMETA) ? A.meta + (size_t)t * D : A.xp + ((size_t)b * SEQ + (t - NMETA)) * D; }
        else if (m < MTOT) src = A.xs + (size_t)(m - MP) * D;
        f32x4 v[4]; float ss[4];
#pragma unroll
        for (int j = 0; j < 4; ++j) v[j] = src ? ((const GAS f32x4*)src)[lane + 64 * j] : (f32x4){0.f, 0.f, 0.f, 0.f};
#pragma unroll
        for (int j = 0; j < 4; ++j) { v2u w; w.x = pk2(v[j][0], v[j][1]); w.y = pk2(v[j][2], v[j][3]); ((GAS v2u*)(XB + (size_t)m * D))[lane + 64 * j] = w;
            const float a0 = bf_lo(w.x), a1 = bf_hi(w.x), a2 = bf_lo(w.y), a3 = bf_hi(w.y); ss[j] = wave_sum((a0 * a0 + a1 * a1) + (a2 * a2 + a3 * a3), lane); }
        if (lane < 16) { const int j = lane >> 2; const float s = (lane & 3) ? 0.f : (j == 0 ? ss[0] : j == 1 ? ss[1] : j == 2 ? ss[2] : ss[3]); SS[(size_t)m * 16 + lane] = s; }
        if (m >= MTOT) {
#pragma unroll
            for (int j = 0; j < 4; ++j) ((GAS v2u*)(AO + (size_t)m * D))[lane + 64 * j] = (v2u){0u, 0u}; }
    }
}

constexpr int A_KS = 0, A_KSTR = 144, A_VT = 36864, A_VSTR = 552, A_LUT = 72192, A_END = 74304;
__device__ __forceinline__ int t5_bucket(int n) {
    if (n < 16) return n;
    const int v = 16 + (int)(logf((float)n * (1.0f / 16.0f)) * (16.0f / 2.0794415416798357f));
    return v < 31 ? v : 31;
}
struct AttnP { const bf16* QKV; const float *gq, *gk, *sinks, *rel; bf16* AO; };
__device__ __forceinline__ void attn_subtile(LAS unsigned char* L, int i0, const bf16* qptr, int hh, int dist0, int jmin, float sink, const float* gq, bf16* optr, bool store, int lane) {
    const int g = lane >> 4, c = lane & 15;
    bf16x8 Bq[2];
    {
        const v4u q0 = *(const GAS v4u*)(qptr + 8 * g), q1 = *(const GAS v4u*)(qptr + 32 + 8 * g);
        float f0[8], f1[8]; unpack8(q0, f0); unpack8(q1, f1);
        float ss = 0.f;
#pragma unroll
        for (int e = 0; e < 8; ++e) ss += f0[e] * f0[e] + f1[e] * f1[e];
        ss += pg8::shx(ss, 16, lane); ss += pg8::shx(ss, 32, lane);
        const float rq = 0.125f / sqrtf(ss * (1.0f / 64.0f) + EPS);
        const f32x4 ga = *(const f32x4*)(gq + 8 * g), gb = *(const f32x4*)(gq + 8 * g + 4), gc = *(const f32x4*)(gq + 32 + 8 * g), gd = *(const f32x4*)(gq + 36 + 8 * g);
#pragma unroll
        for (int e = 0; e < 4; ++e) { f0[e] *= rq * ga[e]; f0[4 + e] *= rq * gb[e]; f1[e] *= rq * gc[e]; f1[4 + e] *= rq * gd[e]; }
        const v4u p0 = pack8(f0), p1 = pack8(f1);
        Bq[0] = __builtin_bit_cast(bf16x8, p0); Bq[1] = __builtin_bit_cast(bf16x8, p1);
    }
    f32x4 s[10];
    float mx = -1e30f;
#pragma unroll
    for (int kt = 0; kt < 9; ++kt) {
        const LAS unsigned char* kp = L + A_KS + (i0 + 16 * kt + c) * A_KSTR + 16 * g;
        f32x4 acc = {0.f, 0.f, 0.f, 0.f};
        acc = mfma16(*(const LAS bf16x8*)kp, Bq[0], acc);
        acc = mfma16(*(const LAS bf16x8*)(kp + 64), Bq[1], acc);
#pragma unroll
        for (int r = 0; r < 4; ++r) {
            const int rel = 16 * kt + 4 * g + r, dist = dist0 - rel;
            const bool ok = (dist >= 0) && (dist <= WIN) && (i0 + rel >= jmin);
            const int di = dist < 0 ? 0 : (dist > WIN ? WIN : dist);
            const float bias = *(const LAS float*)(L + A_LUT + (hh * 132 + di) * 4);
            const float v = ok ? acc[r] + bias : -1e30f;
            s[kt][r] = v; mx = fmaxf(mx, v);
        }
    }
    mx = fmaxf(mx, pg8::shx(mx, 16, lane)); mx = fmaxf(mx, pg8::shx(mx, 32, lane));
    mx = fmaxf(mx, sink);
    float l = 0.f;
#pragma unroll
    for (int kt = 0; kt < 9; ++kt)
#pragma unroll
        for (int r = 0; r < 4; ++r) { const float p = __expf(s[kt][r] - mx); s[kt][r] = p; l += p; }
    s[9] = (f32x4){0.f, 0.f, 0.f, 0.f};
    l += pg8::shx(l, 16, lane); l += pg8::shx(l, 32, lane);
    const float inv = 1.0f / (l + __expf(sink - mx));
    bf16x8 Bp[5];
#pragma unroll
    for (int ks = 0; ks < 5; ++ks) { v4u w; w.x = pk2(s[2 * ks][0], s[2 * ks][1]); w.y = pk2(s[2 * ks][2], s[2 * ks][3]); w.z = pk2(s[2 * ks + 1][0], s[2 * ks + 1][1]); w.w = pk2(s[2 * ks + 1][2], s[2 * ks + 1][3]); Bp[ks] = __builtin_bit_cast(bf16x8, w); }
#pragma unroll
    for (int dt = 0; dt < 4; ++dt) {
        f32x4 acc = {0.f, 0.f, 0.f, 0.f};
        const LAS unsigned char* vp = L + A_VT + (16 * dt + c) * A_VSTR + (i0 + 4 * g) * 2;
#pragma unroll
        for (int ks = 0; ks < 5; ++ks) { const v2u lo = *(const LAS v2u*)(vp + 64 * ks), hi = *(const LAS v2u*)(vp + 64 * ks + 32); const v4u a = {lo.x, lo.y, hi.x, hi.y};
            acc = mfma16(__builtin_bit_cast(bf16x8, a), Bp[ks], acc); }
        if (store) { v2u w; w.x = pk2(acc[0] * inv, acc[1] * inv); w.y = pk2(acc[2] * inv, acc[3] * inv); *(GAS v2u*)(optr + 16 * dt + 4 * g) = w; }
    }
}
__device__ __forceinline__ void attn_stage_row(LAS unsigned char* L, int j, int half, const bf16* krow, const bf16* vrow, const float* gk, float* ck, float* cv, int lane) {
    float kf[32], vf[32];
    if (krow) {
#pragma unroll
        for (int i = 0; i < 4; ++i) { float t[8]; unpack8(*(const GAS v4u*)(krow + 8 * i), t);
#pragma unroll
            for (int e = 0; e < 8; ++e) kf[8 * i + e] = t[e];
            unpack8(*(const GAS v4u*)(vrow + 8 * i), t);
#pragma unroll
            for (int e = 0; e < 8; ++e) vf[8 * i + e] = t[e]; }
    } else {
#pragma unroll
        for (int e = 0; e < 32; ++e) { kf[e] = 0.f; vf[e] = 0.f; }
    }
    float ss = 0.f;
#pragma unroll
    for (int e = 0; e < 32; ++e) ss += kf[e] * kf[e];
    ss += pg8::shx(ss, 1, lane);
    const float rk = 1.0f / sqrtf(ss * (1.0f / 64.0f) + EPS);
#pragma unroll
    for (int i = 0; i < 8; ++i) { const f32x4 gg = *(const f32x4*)(gk + half * 32 + 4 * i);
#pragma unroll
        for (int e = 0; e < 4; ++e) kf[4 * i + e] *= rk * gg[e]; }
#pragma unroll
    for (int i = 0; i < 4; ++i) { float t[8];
#pragma unroll
        for (int e = 0; e < 8; ++e) t[e] = kf[8 * i + e];
        *(LAS v4u*)(L + A_KS + j * A_KSTR + half * 64 + 16 * i) = pack8(t); }
#pragma unroll
    for (int e = 0; e < 32; ++e) *(LAS unsigned short*)(L + A_VT + (half * 32 + e) * A_VSTR + 2 * j) = (unsigned short)f2bf(vf[e]);
    if (ck) {
#pragma unroll
        for (int i = 0; i < 8; ++i) { *(GAS f32x4*)(ck + half * 32 + 4 * i) = (f32x4){kf[4 * i], kf[4 * i + 1], kf[4 * i + 2], kf[4 * i + 3]};
            *(GAS f32x4*)(cv + half * 32 + 4 * i) = (f32x4){vf[4 * i], vf[4 * i + 1], vf[4 * i + 2], vf[4 * i + 3]}; }
    }
}
__device__ __forceinline__ void attn_phase(LAS unsigned char* L, const AttnP& P, const float* cache_k, const float* cache_v, float* out, int jl, int vcu, int G, int tid_in, int wave_in, int lane_in) {
    constexpr int N_PROMPT = NB * 17 * AKV, N_ITEMS = N_PROMPT + DBATCH * AKV;
#pragma unroll 1
    for (int it = vcu; it < N_ITEMS; it += G) {
        int tid = tid_in; asm volatile("" : "+v"(tid));
        const int lane = tid & 63, wave = __builtin_amdgcn_readfirstlane(tid >> 6);
        const bool prompt = it < N_PROMPT;
        int b = 0, qb = 0, kvh, db = 0;
        if (prompt) { b = it / (17 * AKV); const int rem = it % (17 * AKV); qb = rem / AKV; kvh = rem % AKV; }
        else { const int si = it - N_PROMPT; db = si / AKV; kvh = si % AKV; }
        for (int e = tid; e < 4 * 129; e += NWAVES * 64) { const int hh = e / 129, d = e % 129; *(LAS float*)(L + A_LUT + (hh * 132 + d) * 4) = P.rel[t5_bucket(d) * AH + kvh * 4 + hh]; }
        if (prompt) {
            const int j = tid >> 1, half = tid & 1, tok = 128 * qb - 240 + j;
            const bf16* krow = nullptr; const bf16* vrow = nullptr; float* ck = nullptr; float* cv = nullptr;
            if (tok >= 0) { const size_t row = (size_t)b * LP + tok; krow = P.QKV + row * NQKV + 1024 + kvh * 64 + half * 32; vrow = P.QKV + row * NQKV + 1280 + kvh * 64 + half * 32; }
            if (qb == 16 && j >= 128) { const size_t o = ((((size_t)jl * NB + b) * WIN + (j - 128)) * AKV + kvh) * AHD; ck = out + O_KP + o; cv = out + O_VP + o; }
            attn_stage_row(L, j, half, krow, vrow, P.gk, ck, cv, lane);
            for (int e = tid; e < 64 * 16; e += NWAVES * 64) *(LAS unsigned short*)(L + A_VT + (e >> 4) * A_VSTR + 2 * (256 + (e & 15))) = 0;
        } else {
            const float* ckin = cache_k + (((size_t)jl * DBATCH + db) * WIN * AKV + kvh) * AHD; const float* cvin = cache_v + (((size_t)jl * DBATCH + db) * WIN * AKV + kvh) * AHD;
            float* cko = out + O_KS + (((size_t)jl * DBATCH + db) * WIN * AKV + kvh) * AHD; float* cvo = out + O_VS + (((size_t)jl * DBATCH + db) * WIN * AKV + kvh) * AHD;
#pragma unroll
            for (int i = 0; i < 4; ++i) { const int idx = tid + 512 * i, row = idx >> 4, c4 = idx & 15;
                const f32x4 kv = *(const GAS f32x4*)(ckin + (size_t)row * (AKV * AHD) + 4 * c4), vv = *(const GAS f32x4*)(cvin + (size_t)row * (AKV * AHD) + 4 * c4);
                v2u w; w.x = pk2(kv[0], kv[1]); w.y = pk2(kv[2], kv[3]); *(LAS v2u*)(L + A_KS + row * A_KSTR + 8 * c4) = w;
#pragma unroll
                for (int e = 0; e < 4; ++e) *(LAS unsigned short*)(L + A_VT + (4 * c4 + e) * A_VSTR + 2 * row) = (unsigned short)f2bf(vv[e]);
                if (row >= DSEQ) { *(GAS f32x4*)(cko + (size_t)(row - DSEQ) * (AKV * AHD) + 4 * c4) = kv; *(GAS f32x4*)(cvo + (size_t)(row - DSEQ) * (AKV * AHD) + 4 * c4) = vv; } }
            if (tid < 2 * DSEQ) { const int s = tid >> 1, half = tid & 1; const size_t row = (size_t)MP + db * DSEQ + s;
                attn_stage_row(L, WIN + s, half, P.QKV + row * NQKV + 1024 + kvh * 64 + half * 32, P.QKV + row * NQKV + 1280 + kvh * 64 + half * 32, P.gk,
                               cko + (size_t)(WIN - DSEQ + s) * (AKV * AHD), cvo + (size_t)(WIN - DSEQ + s) * (AKV * AHD), lane); }
            for (int e = tid; e < 12 * 8; e += NWAVES * 64) { unsigned z0 = 0u; asm volatile("" : "+v"(z0)); *(LAS v4u*)(L + A_KS + (132 + e / 8) * A_KSTR + 16 * (e & 7)) = (v4u){z0, z0, z0, z0}; }
            for (int e = tid; e < 64 * 28; e += NWAVES * 64) *(LAS unsigned short*)(L + A_VT + (e / 28) * A_VSTR + 2 * (132 + e % 28)) = 0;
        }
        LDS_BAR();
        if (prompt) {
            const int hh = wave & 3, rhalf = wave >> 2, head = kvh * 4 + hh; const float sink = P.sinks[head];
            const int jmin = 240 - 128 * qb;
#pragma unroll 1
            for (int st = 0; st < 4; ++st) {
                const int i0 = 64 * rhalf + 16 * st;
                if (qb == 0 && i0 < 112) continue;
                const int tok = 128 * qb - 112 + i0 + (lane & 15); const size_t row = (size_t)b * LP + tok;
                attn_subtile(L, i0, P.QKV + row * NQKV + head * 64, hh, (lane & 15) + WIN, jmin, sink, P.gq, P.AO + row * D + head * 64, true, lane);
            }
        } else if (wave == 0) {
            const int q = lane & 15, hh = q >> 2, s = q & 3, head = kvh * 4 + hh; const size_t row = (size_t)MP + db * DSEQ + s;
            attn_subtile(L, 0, P.QKV + row * NQKV + head * 64, hh, WIN + s, 0, P.sinks[head], P.gq, P.AO + row * D + head * 64, true, lane);
        }
        LDS_BAR();
    }
}

constexpr int M_QS = 0, M_KS = 17408, M_KT = 34816, M_VT = 53248, M_VW = 60160, M_CT = 67072, M_CTB = 13056;
constexpr int M_RS = 272, M_TS = 144;
struct MlP { const bf16* Z; const float* G; const float* gnorm; bf16* AO; float* HSS; };
__device__ __forceinline__ float wave_scan_add(float x, int lane) {
#pragma unroll
    for (int o = 1; o < 64; o <<= 1) { const float t = pg8::shl_from(x, lane - o); if (lane >= o) x += t; }
    return x;
}
__device__ __forceinline__ float wave_scan_max(float x, int lane) {
#pragma unroll
    for (int o = 1; o < 64; o <<= 1) { const float t = pg8::shl_from(x, lane - o); if (lane >= o) x = fmaxf(x, t); }
    return x;
}
__device__ __forceinline__ float sigmoidf_(float x) { return 1.0f / (1.0f + __expf(-x)); }
__device__ __forceinline__ float tanh_fast(float x) { return 1.0f - 2.0f / (1.0f + __expf(2.0f * x)); }
__device__ __forceinline__ float gate_i(float g) { return 15.0f * tanh_fast(g * (1.0f / 15.0f)); }
__device__ __forceinline__ float gate_f(float g) { const float x = 15.0f * tanh_fast(g * (1.0f / 15.0f)); return fminf(x, 0.f) - __logf(1.0f + __expf(-fabsf(x))); }
constexpr int M_TB = 94208, M_CS = M_TB + 33 * 192 * 4, M_MS = M_CS + 33 * 2 * 4, M_MX = M_MS + 34 * 4, M_END2 = M_MX + 34 * 4;
static_assert(M_END2 <= RING_BYTES, "mLSTM LDS map");
__device__ __forceinline__ void mlstm_prompt_item(LAS unsigned char* L, const MlP& P, float* out, int jl, int b, int h, int sl, int tid, int wave, int lane) {
    const int g = lane >> 4, c = lane & 15;
    unsigned z0 = 0u; asm volatile("" : "+v"(z0));
    for (int e = tid; e < 16 * 72; e += NWAVES * 64) { const int r = e / 72, cc = e % 72; const unsigned short one = 0x3f80;
        *(LAS unsigned short*)(L + M_VT + (32 + r) * M_TS + 2 * cc) = (r == 0) ? one : (unsigned short)0; *(LAS unsigned short*)(L + M_VW + (32 + r) * M_TS + 2 * cc) = 0; }
    for (int e = tid; e < M_CTB / 16; e += NWAVES * 64) *(LAS v4u*)(L + M_CT + 16 * e) = (v4u){z0, z0, z0, z0};
    { LAS float* TB = (LAS float*)(L + M_TB); LAS float* CS = (LAS float*)(L + M_CS);
      float gl[5], gf[5];
#pragma unroll
      for (int k = 0; k < 5; ++k) { const int cc = wave + 8 * k; const int t0_ = cc == 0 ? 0 : 16 + 64 * (cc - 1), nv_ = cc == 0 ? 16 : 64;
          if (cc < 33 && lane < nv_) { const float* gr = P.G + ((size_t)b * LP + t0_ + lane) * 8; gl[k] = gr[h]; gf[k] = gr[4 + h]; } else { gl[k] = 0.f; gf[k] = 0.f; } }
#pragma unroll
      for (int k = 0; k < 5; ++k) { const int cc = wave + 8 * k; const int nv_ = cc == 0 ? 16 : 64;
          if (cc < 33) { const float li = lane < nv_ ? gate_i(gl[k]) : -1e30f, lf = lane < nv_ ? gate_f(gf[k]) : 0.f;
              const float bcum = wave_scan_add(lf, lane), wj = li - bcum, cm = wave_scan_max(wj, lane);
              TB[cc * 192 + lane] = bcum; TB[cc * 192 + 64 + lane] = wj; TB[cc * 192 + 128 + lane] = cm;
              if (lane == 63) { CS[2 * cc] = bcum; CS[2 * cc + 1] = cm; } } }
    }
    LDS_BAR();
    if (wave == 0) {
        const LAS float* CS = (const LAS float*)(L + M_CS);
        const float bl = lane < 33 ? CS[2 * lane] : 0.f, cx = lane < 33 ? CS[2 * lane + 1] : 0.f;
        float mrun = 0.f, ms = 0.f, mx = 0.f;
#pragma unroll 1
        for (int k = 0; k < 33; ++k) { const float blk = __builtin_bit_cast(float, __builtin_amdgcn_readlane(__builtin_bit_cast(int, bl), k)), cxk = __builtin_bit_cast(float, __builtin_amdgcn_readlane(__builtin_bit_cast(int, cx), k));
            const float mxk = fmaxf(mrun, cxk); if (lane == k) { ms = mrun; mx = mxk; } mrun = blk + mxk; }
        if (lane == 33) { ms = mrun; mx = mrun; }
        if (lane < 34) { ((LAS float*)(L + M_MS))[lane] = ms; ((LAS float*)(L + M_MX))[lane] = mx; }
    }
    f32x4 cacc[6];
#pragma unroll
    for (int i = 0; i < 6; ++i) cacc[i] = (f32x4){0.f, 0.f, 0.f, 0.f};
    const int srow = lane, spiece = wave, vpiece = wave & 3;
    v4u aq0, aq1, ak0, ak1, av, bq0, bq1, bk0, bk1, bv;
    v2u po0 = {z0, z0}, po1 = {z0, z0};
#define ML_LOAD(ch, q0, q1, k0, k1, vv) do { const int t0_ = (ch) == 0 ? 0 : 16 + 64 * ((ch) - 1), nv_ = (ch) == 0 ? 16 : 64; \
        if (srow < nv_) { const bf16* zr = P.Z + ((size_t)b * LP + t0_ + srow) * NIN + h * MDK + 16 * spiece; q0 = *(const GAS v4u*)zr; q1 = *(const GAS v4u*)(zr + 8); k0 = *(const GAS v4u*)(zr + 512); k1 = *(const GAS v4u*)(zr + 520); } \
        else { q0 = q1 = k0 = k1 = (v4u){z0, z0, z0, z0}; } \
        if (wave < 4 && srow < nv_) vv = *(const GAS v4u*)(P.Z + ((size_t)b * LP + t0_ + srow) * NIN + 1024 + h * MDV + VS * sl + 8 * vpiece); else vv = (v4u){z0, z0, z0, z0}; } while (0)
#define ML_OLOAD(ch) do { const int t0_ = (ch) == 0 ? 0 : 16 + 64 * ((ch) - 1), nv_ = (ch) == 0 ? 16 : 64; const int trow_ = 16 * wave + c; \
        if (wave < 4 && trow_ < nv_) { const bf16* zo = P.Z + ((size_t)b * LP + t0_ + trow_) * NIN + 2048 + h * MDV + VS * sl + 4 * g; po0 = *(const GAS v2u*)zo; po1 = *(const GAS v2u*)(zo + 16); } } while (0)
    ML_LOAD(0, aq0, aq1, ak0, ak1, av); ML_LOAD(1, bq0, bq1, bk0, bk1, bv); ML_OLOAD(0);
    LDS_BAR();
#define ML_STEP(ch, q0, q1, k0, k1, vv) do { \
        const int t0 = (ch) == 0 ? 0 : 16 + 64 * ((ch) - 1), nvalid = (ch) == 0 ? 16 : 64, cur = (ch) & 1; \
        const float m_prev = ((const LAS float*)(L + M_MS))[ch], Mx = ((const LAS float*)(L + M_MX))[ch]; \
        const float wk = __expf(((const LAS float*)(L + M_TB))[(ch) * 192 + 64 + lane] - Mx), a = __expf(m_prev - Mx); \
          \
        *(LAS v4u*)(L + M_QS + srow * M_RS + 32 * spiece) = q0; *(LAS v4u*)(L + M_QS + srow * M_RS + 32 * spiece + 16) = q1; \
        *(LAS v4u*)(L + M_KS + srow * M_RS + 32 * spiece) = k0; *(LAS v4u*)(L + M_KS + srow * M_RS + 32 * spiece + 16) = k1; \
        { const unsigned kw[8] = {k0.x, k0.y, k0.z, k0.w, k1.x, k1.y, k1.z, k1.w}; \
          _Pragma("unroll") for (int e = 0; e < 8; ++e) { *(LAS unsigned short*)(L + M_KT + (16 * spiece + 2 * e) * M_TS + 2 * srow) = (unsigned short)(kw[e] & 0xffffu); *(LAS unsigned short*)(L + M_KT + (16 * spiece + 2 * e + 1) * M_TS + 2 * srow) = (unsigned short)(kw[e] >> 16); } } \
        if (wave < 4) { float vf[8]; unpack8(vv, vf); const unsigned vw_[4] = {vv.x, vv.y, vv.z, vv.w}; \
            _Pragma("unroll") for (int e = 0; e < 4; ++e) { *(LAS unsigned short*)(L + M_VT + (8 * vpiece + 2 * e) * M_TS + 2 * srow) = (unsigned short)(vw_[e] & 0xffffu); *(LAS unsigned short*)(L + M_VT + (8 * vpiece + 2 * e + 1) * M_TS + 2 * srow) = (unsigned short)(vw_[e] >> 16); } \
            _Pragma("unroll") for (int e = 0; e < 8; ++e) *(LAS unsigned short*)(L + M_VW + (8 * vpiece + e) * M_TS + 2 * srow) = (unsigned short)f2bf(vf[e] * wk); } \
        if (wave == 4) *(LAS unsigned short*)(L + M_VW + 32 * M_TS + 2 * lane) = (unsigned short)f2bf(wk); \
        LDS_BAR(); \
        if ((ch) + 2 < 33) ML_LOAD((ch) + 2, q0, q1, k0, k1, vv); \
        if (wave < 4) { \
            const int tt = wave, trow = 16 * tt + c; \
            bf16x8 Bq[4]; \
            _Pragma("unroll") for (int ks = 0; ks < 4; ++ks) Bq[ks] = *(const LAS bf16x8*)(L + M_QS + trow * M_RS + 64 * ks + 16 * g); \
            const LAS float* tb = (const LAS float*)(L + M_TB) + (ch) * 192; \
            const float bct = tb[trow], Mt = fmaxf(m_prev, tb[128 + trow]), ut = -Mt, wint = __expf(m_prev - Mt), einv = __expf(-(bct + Mt)); \
            f32x4 s[4]; \
            _Pragma("unroll") for (int jt = 0; jt < 4; ++jt) { \
                if (jt <= tt) { \
                    f32x4 acc = {0.f, 0.f, 0.f, 0.f}; \
                    _Pragma("unroll") for (int ks = 0; ks < 4; ++ks) acc = mfma16(*(const LAS bf16x8*)(L + M_KS + (16 * jt + c) * M_RS + 64 * ks + 16 * g), Bq[ks], acc); \
                    const f32x4 wjj = *(const LAS f32x4*)(tb + 64 + 16 * jt + 4 * g); \
                    _Pragma("unroll") for (int r = 0; r < 4; ++r) { const int j = 16 * jt + 4 * g + r; acc[r] = (j <= trow) ? acc[r] * __expf(ut + wjj[r]) : 0.f; } \
                    s[jt] = acc; \
                } else s[jt] = (f32x4){0.f, 0.f, 0.f, 0.f}; \
            } \
            bf16x8 Bs[2]; \
            _Pragma("unroll") for (int k2 = 0; k2 < 2; ++k2) { v4u w; w.x = pk2(s[2 * k2][0], s[2 * k2][1]); w.y = pk2(s[2 * k2][2], s[2 * k2][3]); w.z = pk2(s[2 * k2 + 1][0], s[2 * k2 + 1][1]); w.w = pk2(s[2 * k2 + 1][2], s[2 * k2 + 1][3]); Bs[k2] = __builtin_bit_cast(bf16x8, w); } \
            f32x4 nm[3]; \
            _Pragma("unroll") for (int vt = 0; vt < 3; ++vt) { \
                f32x4 acc = {0.f, 0.f, 0.f, 0.f}; \
                _Pragma("unroll") for (int ks = 0; ks < 4; ++ks) acc = mfma16(*(const LAS bf16x8*)(L + M_CT + cur * M_CTB + (16 * vt + c) * M_RS + 64 * ks + 16 * g), Bq[ks], acc); \
                acc = acc * wint; \
                _Pragma("unroll") for (int k2 = 0; k2 < 2; ++k2) { \
                    if (2 * k2 <= tt) { const LAS unsigned char* vp = L + M_VT + (16 * vt + c) * M_TS + (32 * k2 + 4 * g) * 2; const v2u lo = *(const LAS v2u*)vp, hi = *(const LAS v2u*)(vp + 32); const v4u av_ = {lo.x, lo.y, hi.x, hi.y}; \
                        acc = mfma16(__builtin_bit_cast(bf16x8, av_), Bs[k2], acc); } \
                } \
                nm[vt] = acc; \
            } \
            const float den = pg8::shl_from(nm[2][0], c); \
            const float inv = 1.0f / fmaxf(fabsf(den), einv); \
            float hss = 0.f; \
            _Pragma("unroll") for (int vt = 0; vt < 2; ++vt) _Pragma("unroll") for (int r = 0; r < 4; ++r) { nm[vt][r] *= inv; hss += nm[vt][r] * nm[vt][r]; } \
            hss += pg8::shx(hss, 16, lane); hss += pg8::shx(hss, 32, lane); \
            if (trow < nvalid) { \
                const size_t grow = (size_t)b * LP + t0 + trow; \
                _Pragma("unroll") for (int vt = 0; vt < 2; ++vt) { const int col = h * MDV + VS * sl + 16 * vt + 4 * g; \
                    const v2u ow = vt == 0 ? po0 : po1; const f32x4 gn = *(const f32x4*)(P.gnorm + col); \
                    v2u w; w.x = pk2(sigmoidf_(bf_lo(ow.x)) * gn[0] * nm[vt][0], sigmoidf_(bf_hi(ow.x)) * gn[1] * nm[vt][1]); w.y = pk2(sigmoidf_(bf_lo(ow.y)) * gn[2] * nm[vt][2], sigmoidf_(bf_hi(ow.y)) * gn[3] * nm[vt][3]); \
                    *(GAS v2u*)(P.AO + grow * D + col) = w; } \
                if (g == 0) P.HSS[grow * 32 + h * 8 + sl] = hss; \
            } \
            if ((ch) + 1 < 33) ML_OLOAD((ch) + 1); \
        } else { \
            const int w4 = wave - 4, nxt = cur ^ 1; \
            _Pragma("unroll") for (int i = 0; i < 6; ++i) cacc[i] = cacc[i] * a; \
            _Pragma("unroll") for (int k2 = 0; k2 < 2; ++k2) { \
                bf16x8 Bv[3]; \
                _Pragma("unroll") for (int vt = 0; vt < 3; ++vt) Bv[vt] = *(const LAS bf16x8*)(L + M_VW + (16 * vt + c) * M_TS + 64 * k2 + 16 * g); \
                _Pragma("unroll") for (int dd = 0; dd < 2; ++dd) { const bf16x8 Ak = *(const LAS bf16x8*)(L + M_KT + (16 * (2 * w4 + dd) + c) * M_TS + 64 * k2 + 16 * g); \
                    _Pragma("unroll") for (int vt = 0; vt < 3; ++vt) cacc[dd * 3 + vt] = mfma16(Ak, Bv[vt], cacc[dd * 3 + vt]); } \
            } \
            _Pragma("unroll") for (int dd = 0; dd < 2; ++dd) _Pragma("unroll") for (int vt = 0; vt < 3; ++vt) { const f32x4 v = cacc[dd * 3 + vt]; v2u w; w.x = pk2(v[0], v[1]); w.y = pk2(v[2], v[3]); \
                    *(LAS v2u*)(L + M_CT + nxt * M_CTB + (16 * vt + c) * M_RS + (16 * (2 * w4 + dd) + 4 * g) * 2) = w; } \
        } \
        LDS_BAR(); } while (0)
#pragma unroll 1
    for (int ch = 0; ch < 33; ch += 2) {
        ML_STEP(ch, aq0, aq1, ak0, ak1, av);
        if (ch + 1 < 33) ML_STEP(ch + 1, bq0, bq1, bk0, bk1, bv);
    }
#undef ML_STEP
#undef ML_LOAD
#undef ML_OLOAD
    if (wave >= 4) {
        const int w4 = wave - 4; const size_t sb = ((size_t)jl * NB + b) * MH + h;
#pragma unroll
        for (int dd = 0; dd < 2; ++dd) {
#pragma unroll
            for (int vt = 0; vt < 2; ++vt)
#pragma unroll
                for (int r = 0; r < 4; ++r) out[O_CP + (sb * MDK + 16 * (2 * w4 + dd) + 4 * g + r) * MDV + VS * sl + 16 * vt + c] = cacc[dd * 3 + vt][r];
            if (sl == 0 && c == 0) {
#pragma unroll
                for (int r = 0; r < 4; ++r) out[O_NP + sb * MDK + 16 * (2 * w4 + dd) + 4 * g + r] = cacc[dd * 3 + 2][r]; }
        }
        if (sl == 0 && wave == 4 && lane == 0) out[O_MP + sb] = ((const LAS float*)(L + M_MS))[33];
    }
    LDS_BAR();
}
constexpr int S_Q = 0, S_K = 2048, S_V = 4096, S_P = 8192, S_M = 40960, S_END = 41472;
__device__ __forceinline__ void mlstm_sample_item(LAS unsigned char* L, const MlP& P, const float* stC, const float* stN, const float* stM, float* out, int jl, int db, int h, int tid, int wave, int lane) {
    LAS float* SQ = (LAS float*)(L + S_Q); LAS float* SK = (LAS float*)(L + S_K); LAS float* SV = (LAS float*)(L + S_V); LAS float* SP = (LAS float*)(L + S_P); LAS float* SM = (LAS float*)(L + S_M);
    const size_t r0 = (size_t)MP + db * DSEQ; const size_t sb = ((size_t)jl * DBATCH + db) * MH + h;
    { const int s = tid >> 7, d = tid & 127; const bf16* zr = P.Z + (r0 + s) * NIN; SQ[s * 128 + d] = bf1(zr[h * MDK + d]); SK[s * 128 + d] = bf1(zr[512 + h * MDK + d]);
      SV[s * 256 + 2 * d] = bf1(zr[1024 + h * MDV + 2 * d]); SV[s * 256 + 2 * d + 1] = bf1(zr[1024 + h * MDV + 2 * d + 1]); }
    float li[4], lf[4], bc[4], wjv[4], Mt[4];
#pragma unroll
    for (int s = 0; s < 4; ++s) { li[s] = gate_i(P.G[(r0 + s) * 8 + h]); lf[s] = gate_f(P.G[(r0 + s) * 8 + 4 + h]); }
    const float m0 = stM[sb];
    { float acc = 0.f, cmx = -1e30f;
#pragma unroll
      for (int s = 0; s < 4; ++s) { acc += lf[s]; bc[s] = acc; wjv[s] = li[s] - acc; cmx = fmaxf(cmx, wjv[s]); Mt[s] = fmaxf(m0, cmx); } }
    const float Mx = Mt[3], blast = bc[3], m_new = blast + Mx, a = __expf(m0 - Mx);
    float wk[4];
#pragma unroll
    for (int s = 0; s < 4; ++s) wk[s] = __expf(wjv[s] - Mx);
    LDS_BAR();
    if (wave == 0) { const int p = lane >> 2, qd = lane & 3, t = p >> 2, j = p & 3; float acc = 0.f;
        for (int d = 0; d < 32; ++d) acc += SQ[t * 128 + 32 * qd + d] * SK[j * 128 + 32 * qd + d];
        acc += pg8::shx(acc, 1, lane); acc += pg8::shx(acc, 2, lane);
        const float Mtt = t == 0 ? Mt[0] : t == 1 ? Mt[1] : t == 2 ? Mt[2] : Mt[3], wjj = j == 0 ? wjv[0] : j == 1 ? wjv[1] : j == 2 ? wjv[2] : wjv[3];
        if (qd == 0) SM[p] = (j <= t) ? acc * __expf(wjj - Mtt) : 0.f; }
    if (wave == 1) { const int t = lane >> 4, part = lane & 15; float acc = 0.f;
        for (int d = 0; d < 8; ++d) acc += SQ[t * 128 + 8 * part + d] * stN[sb * MDK + 8 * part + d];
        acc += pg8::shx(acc, 1, lane); acc += pg8::shx(acc, 2, lane); acc += pg8::shx(acc, 4, lane); acc += pg8::shx(acc, 8, lane);
        if (part == 0) SM[16 + t] = acc; }
    { const int vq = tid & 63, dg = tid >> 6; const float* c0p = stC + sb * MDK * MDV; float* c1p = out + O_CS + sb * MDK * MDV;
      f32x4 vj[4];
#pragma unroll
      for (int j = 0; j < 4; ++j) vj[j] = *(const LAS f32x4*)(SV + j * 256 + 4 * vq);
      f32x4 acc[4];
#pragma unroll
      for (int t = 0; t < 4; ++t) acc[t] = (f32x4){0.f, 0.f, 0.f, 0.f};
#pragma unroll 8
      for (int i = 0; i < 16; ++i) { const int dk = 16 * dg + i; const f32x4 c0 = *(const GAS f32x4*)(c0p + (size_t)dk * MDV + 4 * vq);
          f32x4 cn = c0 * a;
#pragma unroll
          for (int t = 0; t < 4; ++t) { acc[t] += c0 * SQ[t * 128 + dk]; cn += vj[t] * (wk[t] * SK[t * 128 + dk]); }
          *(GAS f32x4*)(c1p + (size_t)dk * MDV + 4 * vq) = cn; }
#pragma unroll
      for (int t = 0; t < 4; ++t) *(LAS f32x4*)(SP + (dg * 4 + t) * 256 + 4 * vq) = acc[t];
    }
    if (tid < 128) { float nn = a * stN[sb * MDK + tid];
#pragma unroll
        for (int j = 0; j < 4; ++j) nn += wk[j] * SK[j * 128 + tid];
        out[O_NS + sb * MDK + tid] = nn; }
    if (tid == 0) out[O_MS + sb] = m_new;
    LDS_BAR();
    if (tid < 256) { const int v = tid; float hv[4];
#pragma unroll
        for (int t = 0; t < 4; ++t) { float qc = 0.f;
#pragma unroll
            for (int dg = 0; dg < 8; ++dg) qc += SP[(dg * 4 + t) * 256 + v];
            const float wint = __expf(m0 - Mt[t]); float num = wint * qc, den = wint * SM[16 + t];
#pragma unroll
            for (int j = 0; j < 4; ++j) { const float sc = SM[t * 4 + j]; num += sc * SV[j * 256 + v]; den += sc; }
            hv[t] = num / fmaxf(fabsf(den), __expf(-(bc[t] + Mt[t]))); }
#pragma unroll
        for (int t = 0; t < 4; ++t) { const float q = wave_sum(hv[t] * hv[t], lane); if (lane == 0) SM[32 + wave * 4 + t] = q; }
        const float gn = P.gnorm[h * MDV + v];
#pragma unroll
        for (int t = 0; t < 4; ++t) { const float o = bf1(P.Z[(r0 + t) * NIN + 2048 + h * MDV + v]); P.AO[(r0 + t) * D + h * MDV + v] = (bf16)f2bf(sigmoidf_(o) * gn * hv[t]); }
    }
    LDS_BAR();
    if (tid < 32) { const int t = tid >> 3, slot = tid & 7; P.HSS[(r0 + t) * 32 + h * 8 + slot] = (slot == 0) ? (SM[32 + t] + SM[36 + t]) + (SM[40 + t] + SM[44 + t]) : 0.f; }
    LDS_BAR();
}
__device__ __forceinline__ void mlstm_phase(LAS unsigned char* L, const MlP& P, const float* stC, const float* stN, const float* stM, float* out, int jl, int vcu, int G, int tid_in, int wave_in, int lane_in) {
    constexpr int N_PROMPT = NB * MH * NSL, N_ITEMS = N_PROMPT + DBATCH * MH;
#pragma unroll 1
    for (int it = vcu; it < N_ITEMS; it += G) {
        int tid = tid_in; asm volatile("" : "+v"(tid));
        const int lane = tid & 63, wave = __builtin_amdgcn_readfirstlane(tid >> 6);
        if (it < N_PROMPT) { const int bh = it / NSL, sl = it % NSL; mlstm_prompt_item(L, P, out, jl, bh / MH, bh % MH, sl, tid, wave, lane); }
        else { const int si = it - N_PROMPT; mlstm_sample_item(L, P, stC, stN, stM, out, jl, si / MH, si % MH, tid, wave, lane); }
    }
}
__device__ __forceinline__ void mlstm_fixup(bf16* AO, const float* HSS, int vcu, int G, int wave, int lane) {
    const int gw = vcu * NWAVES + wave, NGW = G * NWAVES;
    for (int m = gw; m < MTOT; m += NGW) {
        const int hd = lane >> 4; const f32x4 a = *(const GAS f32x4*)(HSS + (size_t)m * 32 + hd * 8), bq = *(const GAS f32x4*)(HSS + (size_t)m * 32 + hd * 8 + 4);
        const float r = 1.0f / sqrtf((((a[0] + a[1]) + (a[2] + a[3])) + ((bq[0] + bq[1]) + (bq[2] + bq[3]))) * (1.0f / 256.0f) + EPS);
        GAS v4u* p = (GAS v4u*)(AO + (size_t)m * D + 16 * lane);
#pragma unroll
        for (int i = 0; i < 2; ++i) { float f[8]; unpack8(p[i], f);
#pragma unroll
            for (int e = 0; e < 8; ++e) f[e] *= r;
            p[i] = pack8(f); }
    }
}

struct Args { const float* in[23]; float* out; unsigned char* ws; };
constexpr int PTAB_OFF = LDSCTL_OFF + 1024;
__device__ __forceinline__ unsigned long long ld_ptr(volatile LAS unsigned* T, int i) {
    const unsigned lo = __builtin_amdgcn_readfirstlane(T[2 * i]), hi = __builtin_amdgcn_readfirstlane(T[2 * i + 1]);
    return ((unsigned long long)hi << 32) | lo;
}
constexpr int CHAIN_OFF = LDSCTL_OFF + 2048;
constexpr int CW_CNT = 16384, CW_HEAD = CW_CNT + 6 * 67 * 64;
static_assert((CW_HEAD + 21 * 8 * 64) * 4 <= (int)CTL_ZERO_BYTES, "control words inside the memset region");
__device__ __forceinline__ void put64(volatile LAS unsigned* c, int i, const void* p) { const unsigned long long v = (unsigned long long)p; c[i] = (unsigned)v; c[i + 1] = (unsigned)(v >> 32); }
__device__ __forceinline__ void chain_common(volatile LAS unsigned* c, unsigned char* ws, float* out, int nseg, int n0, int n1, int n2, int n3, int head_idx, int zldc, const float* bgate) {
    c[pg8::CC + 0] = (unsigned)nseg; c[pg8::CC + 1] = 0u; put64(c, pg8::CC + 2, (unsigned*)(ws + WS_CTL) + CW_HEAD + 64 * 8 * head_idx);
    put64(c, pg8::CC + 4, ws + WS_X); put64(c, pg8::CC + 6, ws + WS_XB); put64(c, pg8::CC + 8, ws + WS_SS); put64(c, pg8::CC + 10, ws + WS_Z); put64(c, pg8::CC + 12, ws + WS_FF);
    put64(c, pg8::CC + 14, ws + WS_G); put64(c, pg8::CC + 16, bgate); put64(c, pg8::CC + 18, out + O_YP); put64(c, pg8::CC + 20, out + O_YS); c[pg8::CC + 22] = (unsigned)zldc;
    put64(c, pg8::CC + 30, ws + WS_PT);
    c[pg8::CCUM + 0] = 0u; c[pg8::CCUM + 1] = (unsigned)n0; c[pg8::CCUM + 2] = (unsigned)(n0 + n1); c[pg8::CCUM + 3] = (unsigned)(n0 + n1 + n2); c[pg8::CCUM + 4] = (unsigned)(n0 + n1 + n2 + n3);
}
__device__ __forceinline__ void chain_seg(volatile LAS unsigned* c, int s, const void* A, const void* Bt, int K, int nN, int kind, int first, unsigned need, const unsigned* dep, const unsigned* done, int ld = 0, int lpoff = 0, int cap = 9, int nsub = 1) {
    put64(c, 16 * s + 0, A); put64(c, 16 * s + 2, Bt); c[16 * s + 4] = (unsigned)K; c[16 * s + 5] = (unsigned)nN; c[16 * s + 6] = (unsigned)kind; c[16 * s + 7] = (unsigned)first; c[16 * s + 8] = need;
    c[16 * s + 9] = (unsigned)(ld ? ld : K); put64(c, 16 * s + 10, dep); put64(c, 16 * s + 12, done); c[16 * s + 14] = (unsigned)lpoff | ((unsigned)cap << 8) | ((unsigned)nsub << 16);
}
__device__ __forceinline__ void chain_totals(volatile LAS unsigned* c, int nseg) {
    unsigned t8 = 0u, t9 = 0u;
    for (int s = 0; s < nseg; ++s) { const unsigned w = c[16 * s + 14]; const int lpoff = (int)(w & 0xffu), cap = (int)((w >> 8) & 0xffu), nsub = (int)(w >> 16), nN = (int)c[16 * s + 5];
        int a = 8 - lpoff; a = a < 0 ? 0 : (a > cap ? cap : a); int b = 9 - lpoff; b = b < 0 ? 0 : (b > cap ? cap : b); t8 += (unsigned)(a * nN * nsub); t9 += (unsigned)(b * nN * nsub); }
    c[pg8::CC + 1] = t8; c[pg8::CC + 23] = t9;
}
__device__ __forceinline__ void down_tail_finalize(unsigned char* ws, float* out, bool final_layer, int vcu, int G, int wave, int lane) {
    const int gw = vcu * NWAVES + wave, NGW = G * NWAVES;
    bf16* XB = (bf16*)(ws + WS_XB); float* SS = (float*)(ws + WS_SS); const float* P = (const float*)(ws + WS_PT);
    for (int r = gw; r < 768; r += NGW) { const int m = 16384 + r;
        f32x4 v[4]; float ss[4];
#pragma unroll
        for (int j = 0; j < 4; ++j) { const v2u xw = ((const GAS v2u*)(XB + (size_t)m * D))[lane + 64 * j]; v[j] = (f32x4){bf_lo(xw.x), bf_hi(xw.x), bf_lo(xw.y), bf_hi(xw.y)};
#pragma unroll
            for (int kq = 0; kq < 4; ++kq) v[j] = v[j] + ((const GAS f32x4*)(P + ((size_t)kq * 768 + r) * D))[lane + 64 * j]; }
        if (!final_layer) {
#pragma unroll
            for (int j = 0; j < 4; ++j) { v2u w; w.x = pk2(v[j][0], v[j][1]); w.y = pk2(v[j][2], v[j][3]); ((GAS v2u*)(XB + (size_t)m * D))[lane + 64 * j] = w;
                const float a0 = bf_lo(w.x), a1 = bf_hi(w.x), a2 = bf_lo(w.y), a3 = bf_hi(w.y); ss[j] = wave_sum((a0 * a0 + a1 * a1) + (a2 * a2 + a3 * a3), lane); }
            if (lane < 16) { const int j = lane >> 2; const float s = (lane & 3) ? 0.f : (j == 0 ? ss[0] : j == 1 ? ss[1] : j == 2 ? ss[2] : ss[3]); SS[(size_t)m * 16 + lane] = s; }
        } else {
            float* dst = nullptr;
            if (m < MP) { const int b = m / LP, t = m - b * LP; if (t >= NMETA) dst = out + O_YP + ((size_t)b * SEQ + (t - NMETA)) * D; }
            else if (m < MTOT) dst = out + O_YS + (size_t)(m - MP) * D;
            if (dst) {
#pragma unroll
                for (int j = 0; j < 4; ++j) ((GAS f32x4*)dst)[lane + 64 * j] = v[j]; }
        }
    }
}
__global__ void __launch_bounds__(NWAVES * 64, 2) hybrid_fwd(Args args) {
    extern __shared__ __attribute__((aligned(16))) unsigned char lds_raw[];
    LAS unsigned char* lds = (LAS unsigned char*)lds_raw;
    volatile LAS unsigned* MISC = (volatile LAS unsigned*)(lds + MISC_OFF);
    const int wave_s = __builtin_amdgcn_readfirstlane((int)threadIdx.x >> 6);
#define GG_ g_o
#define BX_ b_o
#define OPQ_GB() int g_o = (int)gridDim.x, b_o = (int)blockIdx.x; asm volatile("" : "+s"(g_o), "+s"(b_o))
#define VCU_ ((BX_ & 7) * (GG_ >> 3) + (BX_ >> 3))
    for (int u = (int)threadIdx.x; u < (LDS_BYTES - LDSCTL_OFF) / 4; u += NWAVES * 64) ((LAS unsigned*)(lds + LDSCTL_OFF))[u] = 0u;
    __syncthreads();
    volatile LAS unsigned* PT = (volatile LAS unsigned*)(lds + PTAB_OFF);
    if (threadIdx.x == 0) {
#pragma unroll
        for (int i = 0; i < 23; ++i) { const unsigned long long p = (unsigned long long)args.in[i]; PT[2 * i] = (unsigned)p; PT[2 * i + 1] = (unsigned)(p >> 32); }
        { const unsigned long long p = (unsigned long long)args.out; PT[46] = (unsigned)p; PT[47] = (unsigned)(p >> 32); }
        { const unsigned long long p = (unsigned long long)args.ws; PT[48] = (unsigned)p; PT[49] = (unsigned)(p >> 32); }
    }
    __syncthreads();
#define OPAQUE_TID() int tid_p; asm volatile("v_mbcnt_lo_u32_b32 %0, -1, 0\n\tv_mbcnt_hi_u32_b32 %0, -1, %0\n\tv_lshl_add_u32 %0, %1, 6, %0" : "=&v"(tid_p) : "s"(wave_s)); const int lane_p = tid_p & 63, wave_p = __builtin_amdgcn_readfirstlane(tid_p >> 6)
#define PIN(i) ((const float*)(const GAS float*)ld_ptr(PT, (i)))
#define POUT() ((float*)(GAS float*)ld_ptr(PT, 23))
#define PWS() ((unsigned char*)(GAS unsigned char*)ld_ptr(PT, 24))
    (void)xcd_barrier_post((unsigned*)((gu32*)(PWS() + WS_CTL) + CW_BAR), MISC + 8);
#define GRID_BAR() do { XcdBarrier b_; b_.bar = (unsigned*)((gu32*)(PWS() + WS_CTL) + CW_BAR); b_.x = xb_xcc_id(); b_.st = MISC + 8; xcd_barrier(b_); } while (0)

    { OPAQUE_TID(); OPQ_GB(); P0Args A{PIN(0), PIN(1), PIN(7), PIN(9), PIN(10), PIN(11), PIN(15), PIN(16), PIN(17), PIN(20), PIN(21), PIN(22), PWS()};
#ifndef NO_P0
      p0_prologue(A, lds, VCU_, GG_, wave_p, lane_p, tid_p);
#ifdef PROBE_P02
      GRID_BAR();
      p0_prologue(A, lds, VCU_, GG_, wave_p, lane_p, tid_p);
#endif
#endif
    }
    GRID_BAR();
    volatile LAS unsigned* CH = (volatile LAS unsigned*)(lds + CHAIN_OFF);
#pragma unroll 1
    for (;;) {
        int ito = MISC_OFF + 48; asm volatile("" : "+s"(ito)); volatile LAS unsigned* itp = (volatile LAS unsigned*)(lds + ito);
        const int it = (int)__builtin_amdgcn_readfirstlane(*itp);
        if (it > 4) break;
        const int layer = it - 1, jl = layer >> 1;
        if (it >= 1) {
            if ((layer & 1) == 0) {
                { OPAQUE_TID(); OPQ_GB(); unsigned char* ws = PWS(); AttnP P{(const bf16*)(ws + WS_Z), PIN(12) + jl * AHD, PIN(13) + jl * AHD, PIN(14) + jl * AH, PIN(8), (bf16*)(ws + WS_AO)};
#ifndef NO_ATTN
                  attn_phase(lds + RING_OFF, P, PIN(2), PIN(3), POUT(), jl, VCU_, GG_, tid_p, wave_p, lane_p);
#ifdef PROBE_ATTN2
                  GRID_BAR();
                  attn_phase(lds + RING_OFF, P, PIN(2), PIN(3), POUT(), jl, VCU_, GG_, tid_p, wave_p, lane_p);
#endif
#endif
                }
                GRID_BAR();
            } else {
                { OPAQUE_TID(); OPQ_GB(); unsigned char* ws = PWS(); MlP P{(const bf16*)(ws + WS_Z), (const float*)(ws + WS_G), PIN(19) + jl * D, (bf16*)(ws + WS_AO), (float*)(ws + WS_HSS)};
#ifndef NO_MLSTM
                  mlstm_phase(lds + RING_OFF, P, PIN(4), PIN(5), PIN(6), POUT(), jl, VCU_, GG_, tid_p, wave_p, lane_p);
#ifdef PROBE_MLSTM2
                  GRID_BAR();
                  mlstm_phase(lds + RING_OFF, P, PIN(4), PIN(5), PIN(6), POUT(), jl, VCU_, GG_, tid_p, wave_p, lane_p);
#endif
#endif
                }
                GRID_BAR();
                { OPAQUE_TID(); OPQ_GB(); unsigned char* ws = PWS(); mlstm_fixup((bf16*)(ws + WS_AO), (const float*)(ws + WS_HSS), VCU_, GG_, wave_p, lane_p); }
                GRID_BAR();
            }
        }
#define RUN_CHAIN(SETUP) do { OPAQUE_TID(); OPQ_GB(); if (tid_p == 0) { unsigned char* ws = PWS(); SETUP const int sh_ = GG_ >> 3, v_ = VCU_; CH[pg8::CQ] = (unsigned)(v_ / sh_); CH[pg8::CQ + 1] = (unsigned)(v_ % sh_); CH[pg8::CQ + 2] = (unsigned)sh_; } __syncthreads(); pg8::gemm_chain(lds + RING_OFF, CH, tid_p); } while (0)
        if (it == 0) {
            RUN_CHAIN( chain_common(CH, ws, POUT(), 1, 6, 0, 0, 0, 4 * 3 + 0, NQKV, nullptr);
                       chain_seg(CH, 0, ws + WS_XB, ws + WS_WQKV, D, 6, pg8::CK_NORM, 0, 0u, nullptr, nullptr); chain_totals(CH, 1); );
        } else {
            RUN_CHAIN( chain_common(CH, ws, POUT(), 1, 4, 0, 0, 0, layer * 3 + 0, NQKV, nullptr);
                       chain_seg(CH, 0, ws + WS_AO, (layer & 1) ? ws + WS_WOUT + jl * SZ_WO : ws + WS_WO + jl * SZ_WO, D, 4, pg8::CK_RESID, 0, 0u, nullptr, nullptr); chain_totals(CH, 1); );
            GRID_BAR();
            RUN_CHAIN( chain_common(CH, ws, POUT(), 1, 16, 0, 0, 0, layer * 3 + 1, NQKV, nullptr);
                       chain_seg(CH, 0, ws + WS_XB, ws + WS_WUP + layer * SZ_WUP, D, 16, pg8::CK_UP, 0, 0u, nullptr, nullptr); chain_totals(CH, 1); );
            GRID_BAR();
            RUN_CHAIN( chain_common(CH, ws, POUT(), 2, 4, 4, 0, 0, 13 + layer, NQKV, nullptr);
                       chain_seg(CH, 0, ws + WS_FF, ws + WS_WDN + layer * SZ_WUP, FF, 4, layer < 3 ? pg8::CK_RESID : pg8::CK_FINAL, 0, 0u, nullptr, nullptr, FF, 0, 8, 1);
                       chain_seg(CH, 1, ws + WS_FF, ws + WS_WDN + layer * SZ_WUP, D, 4, pg8::CK_PART, 0, 0u, nullptr, nullptr, FF, 8, 1, 4);
                       chain_totals(CH, 2); );
            GRID_BAR();
            { OPAQUE_TID(); OPQ_GB(); down_tail_finalize(PWS(), POUT(), layer == 3, VCU_, GG_, wave_p, lane_p); }
            if (layer < 3) {
                GRID_BAR();
                const int nl = layer + 1, njl = nl >> 1; const bool nml = (nl & 1) != 0;
                RUN_CHAIN( chain_common(CH, ws, POUT(), 1, nml ? 13 : 6, 0, 0, 0, layer * 3 + 2, nml ? NIN : NQKV, nml ? PIN(18) + njl * 8 : nullptr);
                           chain_seg(CH, 0, ws + WS_XB, nml ? ws + WS_WIN + njl * SZ_WIN : ws + WS_WQKV + njl * SZ_WQKV, D, nml ? 13 : 6, nml ? pg8::CK_NORM_GATES : pg8::CK_NORM, 0, 0u, nullptr, nullptr); chain_totals(CH, 1); );
#ifdef PROBE_INPROJ2
                GRID_BAR();
                RUN_CHAIN( chain_common(CH, ws, POUT(), 1, nml ? 13 : 6, 0, 0, 0, 16 + layer, nml ? NIN : NQKV, nml ? PIN(18) + njl * 8 : nullptr);
                           chain_seg(CH, 0, ws + WS_XB, nml ? ws + WS_WIN + njl * SZ_WIN : ws + WS_WQKV + njl * SZ_WQKV, D, nml ? 13 : 6, nml ? pg8::CK_NORM_GATES : pg8::CK_NORM, 0, 0u, nullptr, nullptr); );
#endif
            }
#ifdef PROBE_DOWN_SPLIT
            if (layer == 0) { GRID_BAR();
                RUN_CHAIN( chain_common(CH, ws, POUT(), 2, 4, 4, 0, 0, 20, NQKV, nullptr);
                       chain_seg(CH, 0, ws + WS_FF, ws + WS_WDN + layer * SZ_WUP, FF, 4, pg8::CK_FINAL, 0, 0u, nullptr, nullptr, FF, 0, 8, 1);
                       chain_seg(CH, 1, ws + WS_FF, ws + WS_WDN + layer * SZ_WUP, D, 4, pg8::CK_PART, 0, 0u, nullptr, nullptr, FF, 8, 1, 4);
                       chain_totals(CH, 2); ); }
#endif
#ifdef PROBE_DOWN_WHOLE
            if (layer == 0) { GRID_BAR();
                RUN_CHAIN( chain_common(CH, ws, POUT(), 1, 4, 0, 0, 0, 20, NQKV, nullptr);
                       chain_seg(CH, 0, ws + WS_FF, ws + WS_WDN + layer * SZ_WUP, FF, 4, pg8::CK_FINAL, 0, 0u, nullptr, nullptr);
                       chain_totals(CH, 1); ); }
#endif
#ifdef PROBE_UP
            if (layer == 0) { GRID_BAR();
                RUN_CHAIN( chain_common(CH, ws, POUT(), 1, 16, 0, 0, 0, 20, NQKV, nullptr);
                       chain_seg(CH, 0, ws + WS_XB, ws + WS_WUP + layer * SZ_WUP, D, 16, pg8::CK_UP, 0, 0u, nullptr, nullptr); chain_totals(CH, 1); ); }
#endif
        }
#undef RUN_CHAIN
        if (it < 4) GRID_BAR();
        { OPAQUE_TID(); __syncthreads();
          int itq_o = MISC_OFF + 48; asm volatile("" : "+s"(itq_o)); volatile LAS unsigned* itq = (volatile LAS unsigned*)(lds + itq_o);
          if (tid_p == 0) *itq = *itq + 1u;
          __syncthreads(); }
    }
#undef PIN
#undef OPAQUE_TID
#undef GRID_BAR
#undef GG_
#undef OPQ_GB
#undef BX_
#undef VCU_
#undef POUT
#undef PWS
}

extern "C" void kernel_launch(void* const* d_in, const int* in_sizes, int n_in, void* d_out, int out_size, void* d_ws, size_t ws_size, hipStream_t stream) {
    static int grid = 0;
    if (grid == 0) {
        if (n_in != 23 || ws_size < WS_END) { fprintf(stderr, "kernel_launch: built for 23 inputs, %zu outputs, >= %zu bytes of workspace; got n_in %d, out %d, ws %zu; nothing launched\n", (size_t)O_END, (size_t)WS_END, n_in, out_size, ws_size); grid = -1; return; }
        int dev = 0, cus = 0, per_cu = 0;
        if (hipGetDevice(&dev) != hipSuccess || hipDeviceGetAttribute(&cus, hipDeviceAttributeMultiprocessorCount, dev) != hipSuccess) { fprintf(stderr, "kernel_launch: device query failed\n"); grid = -1; return; }
        if (hipFuncSetAttribute((const void*)hybrid_fwd, hipFuncAttributeMaxDynamicSharedMemorySize, LDS_BYTES) != hipSuccess) { fprintf(stderr, "kernel_launch: hipFuncSetAttribute failed\n"); grid = -1; return; }
        if (hipOccupancyMaxActiveBlocksPerMultiprocessor(&per_cu, (const void*)hybrid_fwd, NWAVES * 64, LDS_BYTES) != hipSuccess || per_cu < 1)
            fprintf(stderr, "kernel_launch: note: occupancy query reports %d workgroups per CU\n", per_cu);
        (void)hipGetLastError();
        grid = cus - (cus % 8);
    }
    if (grid < 0) return;
    if (hipMemsetAsync((char*)d_ws + WS_CTL, 0, CTL_ZERO_BYTES, stream) != hipSuccess) { fprintf(stderr, "kernel_launch: hipMemsetAsync failed\n"); return; }
    Args a{};
    for (int i = 0; i < 23; ++i) a.in[i] = (const float*)d_in[i];
    a.out = (float*)d_out; a.ws = (unsigned char*)d_ws;
    hipLaunchKernelGGL(hybrid_fwd, dim3(grid), dim3(NWAVES * 64), LDS_BYTES, stream, a);
    const hipError_t le = hipPeekAtLastError();
    if (le != hipSuccess) fprintf(stderr, "kernel_launch: launch failed: %s\n", hipGetErrorName(le));
}
```

```cpp
#include <hip/hip_runtime.h>
#include <cstdio>
#include <cstdint>
namespace pg8 {
#define PG8_LAS __attribute__((address_space(3)))
typedef unsigned short bf16_t;
typedef short bf16x8 __attribute__((ext_vector_type(8)));
typedef float f32x4 __attribute__((ext_vector_type(4)));
typedef unsigned u32x4 __attribute__((ext_vector_type(4)));
constexpr int BM = 256, BK = 64, HALF = 128, HTB = HALF * BK * 2  , STAGE_BYTES = 8 * HTB, NXCD = 8, WGM = 8;

__host__ __device__ __forceinline__ int lds_byte(int r, int c) { const int st = (r >> 4) * 2 + (c >> 5), rr = r & 15, cc = c & 31, ob = rr * 64 + cc * 2; return st * 1024 + (ob ^ (((ob >> 9) & 1) << 5)); }
__host__ __device__ __forceinline__ void stage_rc(int b, int& R, int& C) { const int st = b / 1024, sb = b % 1024, swz = sb ^ (((sb >> 9) & 1) << 5); R = (st >> 1) * 16 + swz / 64; C = (st & 1) * 32 + (swz % 64) / 2; }
__host__ __device__ __forceinline__ int perm32(int rho) { const int n = rho >> 4, i = rho & 15; return 8 * (i >> 2) + 4 * n + (i & 3); }

struct Unit { int pm, pn; };
struct Gemm { const bf16_t* A; const bf16_t* Bt; int M, N, K; };

struct StaticOrder {
    int nM, nN, nwg, G, c;
    __host__ __device__ void init(int M, int N, int G_, int c_) { nM = M / BM; nN = N / BM; nwg = nM * nN; G = G_; c = c_; }
    __host__ __device__ bool next(int i, Unit& u) const {
        const long L = (long)i * G + c; if (L >= nwg) return false;
        int wgid = (int)L; { const int q = nwg / NXCD, r = nwg % NXCD, xcd = wgid % NXCD, off = wgid / NXCD; wgid = (xcd < r ? xcd * (q + 1) : r * (q + 1) + (xcd - r) * q) + off; }
        const int nig = WGM * nN, gid = wgid / nig, fm = gid * WGM, gsz = (nM - fm) < WGM ? (nM - fm) : WGM;
        u.pm = fm + ((wgid % nig) % gsz); u.pn = (wgid % nig) / gsz; return true;
    }
    __device__ __forceinline__ void a_ready(const Unit&) const {}
    __device__ __forceinline__ void done(const Unit&) const {}
};
__device__ __forceinline__ unsigned cvt_pk_bf16(float lo, float hi) { unsigned r; asm volatile("v_cvt_pk_bf16_f32 %0, %1, %2" : "=v"(r) : "v"(lo), "v"(hi)); return r; }
__device__ __forceinline__ float shx(float v, int mask, int lane) { return __builtin_bit_cast(float, __builtin_amdgcn_ds_bpermute((lane ^ mask) << 2, __builtin_bit_cast(int, v))); }
__device__ __forceinline__ float shl_from(float v, int src) { return __builtin_bit_cast(float, __builtin_amdgcn_ds_bpermute(src << 2, __builtin_bit_cast(int, v))); }
typedef unsigned u32x2 __attribute__((ext_vector_type(2)));
constexpr int RM_MP = 16512, RM_MTOT = 17024, RM_LP = 2064, RM_META = 16, RM_SEQ = 2048;
__device__ __forceinline__ float row_rscale(const float* SS, int row) {
    const f32x4* p = (const f32x4*)(SS + (size_t)row * 16); const f32x4 a = p[0], b = p[1], c = p[2], d = p[3];
    const float s = ((a[0] + a[1]) + (a[2] + a[3])) + ((b[0] + b[1]) + (b[2] + b[3])) + ((c[0] + c[1]) + (c[2] + c[3])) + ((d[0] + d[1]) + (d[2] + d[3]));
    return 1.0f / sqrtf(s * (1.0f / 1024.0f) + 1e-6f);
}
__device__ __forceinline__ float softcap15(float x) { return 15.0f * tanhf(x * (1.0f / 15.0f)); }
__device__ __forceinline__ float logsigmoidf(float x) { return x < 0.f ? x - log1pf(expf(x)) : -log1pf(expf(-x)); }
template <int ACT, bool GATES> struct EpiNormBf16 {
    static constexpr bool PERM = true, AFTER_DRAIN = false;
    bf16_t* O; int ldc; const float* SS; float* G; const float* bgate; int gate_pn;
    __device__ __forceinline__ void operator()(const f32x4 (&acc)[2][2][4][2], const Unit& u, int wr, int wc, int fr, int fq) const {
        const int row0 = u.pm * BM + wr * 64 + fr;
        if (GATES && u.pn == gate_pn) {
            if (wc == 0 && fq == 0) {
                const f32x4 b0 = *(const f32x4*)bgate, b1 = *(const f32x4*)(bgate + 4);
#pragma unroll
                for (int ai = 0; ai < 2; ++ai)
#pragma unroll
                    for (int m = 0; m < 4; ++m) { const int row = row0 + ai * HALF + m * 16; const float r = row_rscale(SS, row);
                        f32x4 gi = acc[ai][0][m][0] * r + b0, gf = acc[ai][0][m][1] * r + b1;
#pragma unroll
                        for (int j = 0; j < 4; ++j) { gi[j] = softcap15(gi[j]); gf[j] = logsigmoidf(softcap15(gf[j])); }
                        *(f32x4*)(G + (size_t)row * 8) = gi; *(f32x4*)(G + (size_t)row * 8 + 4) = gf; }
            }
            return;
        }
        const int col0 = u.pn * BM + wc * 32 + 8 * fq;
#pragma unroll
        for (int ai = 0; ai < 2; ++ai)
#pragma unroll
            for (int m = 0; m < 4; ++m) { const int row = row0 + ai * HALF + m * 16; const float r = row_rscale(SS, row); bf16_t* rowp = O + (size_t)row * ldc + col0;
#pragma unroll
                for (int bj = 0; bj < 2; ++bj) { f32x4 v0 = acc[ai][bj][m][0] * r, v1 = acc[ai][bj][m][1] * r;
                    if (ACT == 1) {
#pragma unroll
                        for (int j = 0; j < 4; ++j) { const float a = fmaxf(v0[j], 0.f), b = fmaxf(v1[j], 0.f); v0[j] = a * a; v1[j] = b * b; } }
                    u32x4 w; w.x = cvt_pk_bf16(v0[0], v0[1]); w.y = cvt_pk_bf16(v0[2], v0[3]); w.z = cvt_pk_bf16(v1[0], v1[1]); w.w = cvt_pk_bf16(v1[2], v1[3]);
                    *(u32x4*)(rowp + bj * HALF) = w; } }
    }
};
template <bool FINAL> struct EpiResid {
    static constexpr bool PERM = false, AFTER_DRAIN = false;
    float* X; bf16_t* Xb; float* SS; float* y_prompt; float* y_sample;
    __device__ __forceinline__ void operator()(const f32x4 (&acc)[2][2][4][2], const Unit& u, int wr, int wc, int fr, int fq) const {
        const int row0 = u.pm * BM + wr * 64 + fr, col0 = u.pn * BM + wc * 32 + 4 * fq;
#pragma unroll
        for (int ai = 0; ai < 2; ++ai)
#pragma unroll
            for (int m = 0; m < 4; ++m) { const int row = row0 + ai * HALF + m * 16; const size_t off = (size_t)row * 1024 + col0;
                f32x4 x[2][2];
#pragma unroll
                for (int bj = 0; bj < 2; ++bj)
#pragma unroll
                    for (int n = 0; n < 2; ++n) x[bj][n] = *(const f32x4*)(X + off + bj * HALF + n * 16) + acc[ai][bj][m][n];
                if (!FINAL) {
                    float s = 0.f;
#pragma unroll
                    for (int bj = 0; bj < 2; ++bj)
#pragma unroll
                        for (int n = 0; n < 2; ++n) { const f32x4 v = x[bj][n]; *(f32x4*)(X + off + bj * HALF + n * 16) = v; s += (v[0] * v[0] + v[1] * v[1]) + (v[2] * v[2] + v[3] * v[3]);
                            u32x2 w; w.x = cvt_pk_bf16(v[0], v[1]); w.y = cvt_pk_bf16(v[2], v[3]); *(u32x2*)(Xb + off + bj * HALF + n * 16) = w; }
                    s += shx(s, 16, (fr + 16 * fq)); s += shx(s, 32, (fr + 16 * fq));
                    if (fq == 0) SS[(size_t)row * 16 + u.pn * 4 + wc] = s;
                } else {
                    float* dst = nullptr;
                    if (row < RM_MP) { const int b = row / RM_LP, t = row - b * RM_LP; if (t >= RM_META) dst = y_prompt + ((size_t)b * RM_SEQ + (t - RM_META)) * 1024 + col0; }
                    else if (row < RM_MTOT) dst = y_sample + (size_t)(row - RM_MP) * 1024 + col0;
                    if (dst) {
#pragma unroll
                        for (int bj = 0; bj < 2; ++bj)
#pragma unroll
                            for (int n = 0; n < 2; ++n) *(f32x4*)(dst + bj * HALF + n * 16) = x[bj][n]; }
                }
            }
    }
};

template <class Epi, class Sched, bool ALIGN_EPI = false, bool SP2 = false>
__device__ __forceinline__ void gemm_phase(PG8_LAS unsigned char* lds, const Gemm g, const Sched& S, const Epi& E) {
    int tid_o = threadIdx.x; asm volatile("" : "+v"(tid_o));
    const int tid = tid_o, wid = __builtin_amdgcn_readfirstlane(tid >> 6), lane = tid & 63, wr = wid >> 2, wc = wid & 3, fr = lane & 15, fq = lane >> 4;
    const int K = g.K, nt = K / BK;
    unsigned voffA[2], voffB[2];
#pragma unroll
    for (int i = 0; i < 2; ++i) { int R, C; stage_rc(tid * 16 + i * 8192, R, C); const int Rb = Epi::PERM ? ((R & ~31) + perm32(R & 31)) : R;
        voffA[i] = (unsigned)(R * K + C) * 2u; voffB[i] = (unsigned)(Rb * K + C) * 2u; }
    const size_t kstep = (size_t)(BK * 2);
    const size_t hstep = (size_t)HALF * K * 2;
    const size_t tstep = 2 * hstep;
    const unsigned ldsw = (unsigned)wid * 1024u;
    const int aoff = lds_byte(wr * 64 + fr, fq * 8), boff = lds_byte(wc * 32 + fr, fq * 8);
#define PG8_SA(b, h) (((b) * 2 + (h)) * HTB)
#define PG8_SB(b, h) ((4 + (b) * 2 + (h)) * HTB)
#define PG8_STAGE(bufoff, gbase, voff) do { _Pragma("unroll") for (int _i = 0; _i < 2; ++_i) \
        __builtin_amdgcn_global_load_lds((const unsigned*)((const char*)(gbase) + (voff)[_i]), (PG8_LAS unsigned*)(lds + (bufoff) + ldsw + _i * 8192), 16, 0, 0); } while (0)
#define PG8_LDA(dst, b, h) do { _Pragma("unroll") for (int m = 0; m < 4; ++m) _Pragma("unroll") for (int k = 0; k < 2; ++k) dst[m][k] = *(const PG8_LAS bf16x8*)(lds + PG8_SA(b, h) + aoff + m * 2048 + k * 1024); } while (0)
#define PG8_LDB(dst, b, h) do { _Pragma("unroll") for (int n = 0; n < 2; ++n) _Pragma("unroll") for (int k = 0; k < 2; ++k) dst[n][k] = *(const PG8_LAS bf16x8*)(lds + PG8_SB(b, h) + boff + n * 2048 + k * 1024); } while (0)
#define PG8_MMA(ai, bj, At, Bt) do { __builtin_amdgcn_s_setprio(1); _Pragma("unroll") for (int m = 0; m < 4; ++m) _Pragma("unroll") for (int n = 0; n < 2; ++n) _Pragma("unroll") for (int k = 0; k < 2; ++k) \
        acc[ai][bj][m][n] = __builtin_amdgcn_mfma_f32_16x16x32_bf16(Bt[n][k], At[m][k], acc[ai][bj][m][n], 0, 0, 0); __builtin_amdgcn_s_setprio(0); } while (0)
#define PG8_WAIT_V(n) asm volatile("s_waitcnt vmcnt(" #n ")" ::: "memory")
#define PG8_WAIT_L(n) asm volatile("s_waitcnt lgkmcnt(" #n ")" ::: "memory")
#define PG8_BAR __builtin_amdgcn_s_barrier()
#define PG8_SCHED __builtin_amdgcn_sched_barrier(0)
    Unit cur, nxt; int ui = 0;
    if (!S.next(0, cur)) return;
    f32x4 acc[2][2][4][2];
#pragma unroll
    for (int a = 0; a < 2; ++a)
#pragma unroll
        for (int b = 0; b < 2; ++b)
#pragma unroll
            for (int m = 0; m < 4; ++m)
#pragma unroll
                for (int n = 0; n < 2; ++n) acc[a][b][m][n] = (f32x4){0.f, 0.f, 0.f, 0.f};
    bf16x8 At[4][2], B0[2][2], B1[2][2];
    const char* cA = (const char*)g.A + (size_t)cur.pm * tstep; const char* cB = (const char*)g.Bt + (size_t)cur.pn * tstep;
    S.a_ready(cur);
    if constexpr (SP2) {
        PG8_STAGE(PG8_SB(0, 0), cB, voffB); PG8_STAGE(PG8_SB(0, 1), cB + hstep, voffB); PG8_STAGE(PG8_SA(0, 0), cA, voffA); PG8_STAGE(PG8_SA(0, 1), cA + hstep, voffA);
        if (wr == 1) PG8_BAR;
        PG8_WAIT_V(2); PG8_BAR;
        PG8_STAGE(PG8_SB(1, 0), cB + kstep, voffB); PG8_STAGE(PG8_SA(1, 0), cA + kstep, voffA); PG8_STAGE(PG8_SB(1, 1), cB + hstep + kstep, voffB);
        PG8_WAIT_V(6); PG8_BAR;
    } else {
        PG8_STAGE(PG8_SB(0, 0), cB, voffB); PG8_STAGE(PG8_SA(0, 0), cA, voffA); PG8_STAGE(PG8_SB(0, 1), cB + hstep, voffB); PG8_STAGE(PG8_SA(0, 1), cA + hstep, voffA);
        if (wr == 1) PG8_BAR;
        PG8_WAIT_V(4); PG8_BAR;
        PG8_STAGE(PG8_SB(1, 0), cB + kstep, voffB); PG8_STAGE(PG8_SA(1, 0), cA + kstep, voffA); PG8_STAGE(PG8_SB(1, 1), cB + hstep + kstep, voffB);
        PG8_WAIT_V(6); PG8_BAR;
    }
    for (;;) {
        const bool has_next = S.next(ui + 1, nxt);
        const char* nA = has_next ? (const char*)g.A + (size_t)nxt.pm * tstep : cA; const char* nB = has_next ? (const char*)g.Bt + (size_t)nxt.pn * tstep : cB;
        for (int t = 0; t < nt; t += 2) {
            const bool last = (t == nt - 2);
            const char* a1 = cA + (size_t)(t + 1) * kstep;
            const char* a2 = last ? nA : cA + (size_t)(t + 2) * kstep; const char* b2 = last ? nB : cB + (size_t)(t + 2) * kstep;
            const char* a3 = a2 + kstep; const char* b3 = b2 + kstep;
            if (last && has_next) S.a_ready(nxt);
            if constexpr (SP2) {
            PG8_LDB(B0, 0, 0); PG8_LDB(B1, 0, 1); PG8_SCHED; PG8_LDA(At, 0, 0); PG8_STAGE(PG8_SA(1, 1), a1 + hstep, voffA);
            PG8_WAIT_V(8); PG8_WAIT_L(0); PG8_BAR; PG8_MMA(0, 0, At, B0); PG8_MMA(0, 1, At, B1); PG8_BAR; PG8_SCHED;
            PG8_LDA(At, 0, 1); PG8_STAGE(PG8_SB(0, 0), b2, voffB); PG8_STAGE(PG8_SB(0, 1), b2 + hstep, voffB); PG8_STAGE(PG8_SA(0, 0), a2, voffA);
            PG8_WAIT_V(8); PG8_WAIT_L(0); PG8_BAR; PG8_MMA(1, 0, At, B0); PG8_MMA(1, 1, At, B1); PG8_BAR; PG8_SCHED;
            PG8_LDB(B0, 1, 0); PG8_LDB(B1, 1, 1); PG8_SCHED; PG8_LDA(At, 1, 0); PG8_STAGE(PG8_SA(0, 1), a2 + hstep, voffA);
            PG8_WAIT_V(8); PG8_WAIT_L(0); PG8_BAR; PG8_MMA(0, 0, At, B0); PG8_MMA(0, 1, At, B1); PG8_BAR; PG8_SCHED;
            PG8_LDA(At, 1, 1); PG8_STAGE(PG8_SB(1, 0), b3, voffB); PG8_STAGE(PG8_SB(1, 1), b3 + hstep, voffB); PG8_STAGE(PG8_SA(1, 0), a3, voffA);
            PG8_WAIT_V(8); PG8_WAIT_L(0); PG8_BAR; PG8_MMA(1, 0, At, B0); PG8_MMA(1, 1, At, B1); PG8_BAR; PG8_SCHED;
            } else {
            PG8_LDB(B0, 0, 0); PG8_SCHED; PG8_LDA(At, 0, 0); PG8_STAGE(PG8_SA(1, 1), a1 + hstep, voffA);
            PG8_WAIT_L(8); PG8_BAR; PG8_WAIT_L(0); PG8_MMA(0, 0, At, B0); PG8_BAR; PG8_SCHED;
            PG8_LDB(B1, 0, 1); PG8_STAGE(PG8_SB(0, 0), b2, voffB);
            PG8_BAR; PG8_WAIT_L(0); PG8_MMA(0, 1, At, B1); PG8_BAR;
            PG8_LDA(At, 0, 1); PG8_STAGE(PG8_SA(0, 0), a2, voffA);
            PG8_BAR; PG8_WAIT_L(0); PG8_MMA(1, 0, At, B0); PG8_BAR; PG8_SCHED;
            PG8_STAGE(PG8_SB(0, 1), b2 + hstep, voffB);
            PG8_WAIT_V(6); PG8_BAR; PG8_MMA(1, 1, At, B1); PG8_BAR;
            PG8_LDB(B0, 1, 0); PG8_SCHED; PG8_LDA(At, 1, 0); PG8_STAGE(PG8_SA(0, 1), a2 + hstep, voffA);
            PG8_WAIT_L(8); PG8_BAR; PG8_WAIT_L(0); PG8_MMA(0, 0, At, B0); PG8_BAR; PG8_SCHED;
            PG8_LDB(B1, 1, 1); PG8_STAGE(PG8_SB(1, 0), b3, voffB);
            PG8_BAR; PG8_WAIT_L(0); PG8_MMA(0, 1, At, B1); PG8_BAR;
            PG8_LDA(At, 1, 1); PG8_STAGE(PG8_SA(1, 0), a3, voffA);
            PG8_BAR; PG8_WAIT_L(0); PG8_MMA(1, 0, At, B0); PG8_BAR; PG8_SCHED;
            PG8_STAGE(PG8_SB(1, 1), b3 + hstep, voffB);
            PG8_WAIT_V(6); PG8_BAR; PG8_MMA(1, 1, At, B1); PG8_BAR;
            }
        }
        if constexpr (ALIGN_EPI) { if (wr == 0) PG8_BAR; }
        if constexpr (!Epi::AFTER_DRAIN) { E(acc, cur, wr, wc, fr, fq); S.done(cur); }
        if (!has_next) break;
#pragma unroll
        for (int a = 0; a < 2; ++a)
#pragma unroll
            for (int b = 0; b < 2; ++b)
#pragma unroll
                for (int m = 0; m < 4; ++m)
#pragma unroll
                    for (int n = 0; n < 2; ++n) acc[a][b][m][n] = (f32x4){0.f, 0.f, 0.f, 0.f};
        cur = nxt; cA = nA; cB = nB; ++ui;
        if constexpr (ALIGN_EPI) { if (wr == 1) PG8_BAR; }
    }
    PG8_WAIT_V(0);
    if constexpr (!ALIGN_EPI) { if (wr == 0) PG8_BAR; }
    PG8_BAR;
    if constexpr (Epi::AFTER_DRAIN) { E.fused(acc, cur, wr, wc, fr, fq, lds, wid, lane); S.done(cur); }
#undef PG8_SA
#undef PG8_SB
#undef PG8_STAGE
#undef PG8_LDA
#undef PG8_LDB
#undef PG8_MMA
#undef PG8_WAIT_V
#undef PG8_WAIT_L
#undef PG8_BAR
#undef PG8_SCHED
}

#define PG8_GAS __attribute__((address_space(1)))
#ifndef CH_PUB_T
#define CH_PUB_T 4
#endif
#ifndef CH_FF_WT
#define CH_FF_WT 0
#endif
#ifndef CH_X_AUX
#define CH_X_AUX 0
#endif
#ifndef CH_A_AUX
#define CH_A_AUX 0
#endif
enum ChainKind { CK_NORM = 0, CK_NORM_GATES = 1, CK_UP = 2, CK_RESID = 3, CK_FINAL = 4, CK_PART = 5 };
constexpr int CC = 64, CSLOT = 96;
struct UnitD { int valid, seg, pm, pn, K, kind, ld, kq; const char* A; const char* B; };
__device__ __forceinline__ unsigned cw(volatile PG8_LAS unsigned* c, int i) { return (unsigned)__builtin_amdgcn_readfirstlane((int)c[i]); }
__device__ __forceinline__ unsigned long long cp(volatile PG8_LAS unsigned* c, int i) { const unsigned lo = cw(c, i), hi = cw(c, i + 1); return ((unsigned long long)hi << 32) | lo; }
constexpr int CCUM = CC + 24, CQ = CSLOT + 8;
__device__ __forceinline__ int chain_np(int x) { return x < 3 ? 9 : 8; }
__device__ __forceinline__ int seg_count(volatile PG8_LAS unsigned* c, int s, int np) {
    const unsigned w = cw(c, 16 * s + 14); const int lpoff = (int)(w & 0xffu), cap = (int)((w >> 8) & 0xffu), nsub = (int)(w >> 16);
    int nps = np - lpoff; nps = nps < 0 ? 0 : (nps > cap ? cap : nps);
    return nps * (int)cw(c, 16 * s + 5) * nsub;
}
__device__ __forceinline__ void decode_unit(volatile PG8_LAS unsigned* c, unsigned code, UnitD& u) {
    u.valid = code != 0xffffffffu; u.seg = 0; u.pm = 0; u.pn = 0; u.K = 1024; u.kind = 0; u.ld = 1024; u.kq = 0; u.A = nullptr; u.B = nullptr;
    if (!u.valid) return;
    const int x = (int)(code >> 16), np = chain_np(x); int i = (int)(code & 0xffffu);
    const int nseg = (int)cw(c, CC); int s = 0;
#pragma unroll
    for (int k = 0; k < 3; ++k) { if (s == k && k + 1 < nseg) { const int cnt = seg_count(c, k, np); if (i >= cnt) { i -= cnt; s = k + 1; } } }
    const unsigned w = cw(c, 16 * s + 14); const int lpoff = (int)(w & 0xffu), nsub = (int)(w >> 16);
    const int nN = (int)cw(c, 16 * s + 5), per = nN * nsub, lp = i / per, rem = i - lp * per;
    u.seg = s; u.pm = x + 8 * (lpoff + lp); u.pn = rem / nsub; u.kq = rem - u.pn * nsub; u.K = (int)cw(c, 16 * s + 4); u.kind = (int)cw(c, 16 * s + 6); u.ld = (int)cw(c, 16 * s + 9);
    u.A = (const char*)(const PG8_GAS char*)cp(c, 16 * s) + (size_t)u.pm * 512 * u.ld + (size_t)u.kq * 2 * u.K; u.B = (const char*)(const PG8_GAS char*)cp(c, 16 * s + 2) + (size_t)u.pn * 512 * u.ld + (size_t)u.kq * 2 * u.K;
}
__device__ __forceinline__ unsigned chain_deq_from(volatile PG8_LAS unsigned* c, unsigned* heads, unsigned v  ) {
    int q = (int)c[CQ], tries = (int)c[CQ + 1]; const unsigned tot8 = c[CC + 1], tot9 = c[CC + 23];
    while (v >= (q < 3 ? tot9 : tot8) && tries < 8) { q = (q + 1) & 7; ++tries; if (tries < 8) v = __hip_atomic_fetch_add(heads + 64 * q, 1u, __ATOMIC_RELAXED, __HIP_MEMORY_SCOPE_AGENT); }
    c[CQ] = (unsigned)q; c[CQ + 1] = (unsigned)tries;
    return tries < 8 ? (((unsigned)q << 16) | v) : 0xffffffffu;
}
__device__ __forceinline__ unsigned ld_relaxed(const unsigned* p) { return __hip_atomic_load(p, __ATOMIC_RELAXED, __HIP_MEMORY_SCOPE_AGENT); }
__device__ __forceinline__ void chain_wait(volatile PG8_LAS unsigned* c, const UnitD& u, int wid) {
    const unsigned long long dep = cp(c, 16 * u.seg + 10);
    if (dep) {
        if (wid == 0) { const unsigned* p = (const unsigned*)(const PG8_GAS unsigned*)dep + 64 * u.pm; const unsigned need = cw(c, 16 * u.seg + 8); unsigned spins = 0;
            while ((unsigned)__builtin_amdgcn_readfirstlane((int)ld_relaxed(p)) < need) { __builtin_amdgcn_s_sleep(2); if (++spins > (1u << 20)) break; }
            if (CH_A_AUX == 0 && u.seg == 3) __builtin_amdgcn_fence(__ATOMIC_ACQUIRE, "agent"); }
        asm volatile("s_waitcnt vmcnt(0) lgkmcnt(0)" ::: "memory"); __builtin_amdgcn_s_barrier(); asm volatile("" ::: "memory");
    }
}
__device__ __forceinline__ bool chain_try(volatile PG8_LAS unsigned* c, const UnitD& u, int wid, int lane, int ui) {
    const unsigned long long dep = cp(c, 16 * u.seg + 10);
    if (!dep) return true;
    if (wid == 0) { const unsigned* p = (const unsigned*)(const PG8_GAS unsigned*)dep + 64 * u.pm; const unsigned need = cw(c, 16 * u.seg + 8);
        const unsigned ok = (unsigned)__builtin_amdgcn_readfirstlane((int)ld_relaxed(p)) >= need ? 1u : 0u;
        if (lane == 0) c[CSLOT + 4 + (ui & 1)] = ok;
        if (CH_A_AUX == 0 && ok && u.seg == 3) { __builtin_amdgcn_fence(__ATOMIC_ACQUIRE, "agent"); asm volatile("s_waitcnt vmcnt(0)" ::: "memory"); } }
    asm volatile("s_waitcnt lgkmcnt(0)" ::: "memory"); __builtin_amdgcn_s_barrier(); asm volatile("" ::: "memory");
    return cw(c, CSLOT + 4 + (ui & 1)) != 0u;
}
typedef unsigned cu32x4 __attribute__((ext_vector_type(4)));
__device__ __forceinline__ __amdgpu_buffer_rsrc_t mk_rsrc(unsigned long long p, unsigned bytes) { return __builtin_amdgcn_make_buffer_rsrc((void*)(PG8_GAS void*)p, (short)0, (int)bytes, 0x00020000); }
__device__ __forceinline__ f32x4 ld16_sc1(__amdgpu_buffer_rsrc_t r, unsigned off) { const cu32x4 v = __builtin_amdgcn_raw_buffer_load_b128(r, (int)off, 0, CH_X_AUX); return __builtin_bit_cast(f32x4, v); }
__device__ __forceinline__ void st16_sc1(__amdgpu_buffer_rsrc_t r, unsigned off, f32x4 v) { __builtin_amdgcn_raw_buffer_store_b128(__builtin_bit_cast(cu32x4, v), r, (int)off, 0, CH_X_AUX); }
__device__ __forceinline__ void st16u_sc1(__amdgpu_buffer_rsrc_t r, unsigned off, cu32x4 v) { __builtin_amdgcn_raw_buffer_store_b128(v, r, (int)off, 0, CH_X_AUX); }
__device__ __forceinline__ void st16u_wt(__amdgpu_buffer_rsrc_t r, unsigned off, cu32x4 v) { __builtin_amdgcn_raw_buffer_store_b128(v, r, (int)off, 0, 16); }
constexpr unsigned CH_MPAD = 17152;
__device__ __forceinline__ void row_rscales_sc1(__amdgpu_buffer_rsrc_t rss, int row0, int fr, int fq, float (&rr)[2][4]) {
    f32x4 v[2][4];
#pragma unroll
    for (int ai = 0; ai < 2; ++ai)
#pragma unroll
        for (int m = 0; m < 4; ++m) { const cu32x4 t = __builtin_amdgcn_raw_buffer_load_b128(rss, (int)((unsigned)(row0 + ai * HALF + m * 16) * 64u + 16u * (unsigned)fq), 0, CH_X_AUX); v[ai][m] = __builtin_bit_cast(f32x4, t); }
#pragma unroll
    for (int ai = 0; ai < 2; ++ai)
#pragma unroll
        for (int m = 0; m < 4; ++m) { float s = (v[ai][m][0] + v[ai][m][1]) + (v[ai][m][2] + v[ai][m][3]); s += shx(s, 16, (fr + 16 * fq)); s += shx(s, 32, (fr + 16 * fq)); rr[ai][m] = 1.0f / sqrtf(s * (1.0f / 1024.0f) + 1e-6f); }
}
__device__ __forceinline__ void chain_epilogue(volatile PG8_LAS unsigned* c, const UnitD& u, const f32x4 (&acc)[2][2][4][2], int wr, int wc, int fr, int fq) {
    const int row0 = u.pm * BM + wr * 64 + fr, colw = wc * 32 + 8 * fq;
    const __amdgpu_buffer_rsrc_t rss = mk_rsrc(cp(c, CC + 8), CH_MPAD * 64u);
    if (u.kind <= CK_UP) {
        float rr[2][4]; row_rscales_sc1(rss, row0, fr, fq, rr);
        if (u.kind == CK_NORM_GATES && u.pn == 12) {
            if (wc == 0 && fq == 0) { const float* bg = (const float*)(const PG8_GAS float*)cp(c, CC + 16); float* G = (float*)(PG8_GAS float*)cp(c, CC + 14);
                const f32x4 b0 = *(const f32x4*)bg, b1 = *(const f32x4*)(bg + 4);
#pragma unroll
                for (int ai = 0; ai < 2; ++ai)
#pragma unroll
                    for (int m = 0; m < 4; ++m) { const int row = row0 + ai * HALF + m * 16; const float r = rr[ai][m];
                        const f32x4 gi = acc[ai][0][m][0] * r + b0, gf = acc[ai][0][m][1] * r + b1;
                        *(f32x4*)(G + (size_t)row * 8) = gi; *(f32x4*)(G + (size_t)row * 8 + 4) = gf; } }
            return;
        }
        const bool up = u.kind == CK_UP; const int ldc = up ? 4096 : (int)cw(c, CC + 22);
        const unsigned long long obase = up ? cp(c, CC + 12) : cp(c, CC + 10);
        const __amdgpu_buffer_rsrc_t ro = mk_rsrc(obase, CH_MPAD * (unsigned)ldc * 2u);
        const int col0 = u.pn * BM + colw;
#pragma unroll
        for (int ai = 0; ai < 2; ++ai)
#pragma unroll
            for (int m = 0; m < 4; ++m) { const int row = row0 + ai * HALF + m * 16; const float r = rr[ai][m];
#pragma unroll
                for (int bj = 0; bj < 2; ++bj) { f32x4 v0 = acc[ai][bj][m][0] * r, v1 = acc[ai][bj][m][1] * r;
                    if (up) {
#pragma unroll
                        for (int j = 0; j < 4; ++j) { const float a = fmaxf(v0[j], 0.f), b = fmaxf(v1[j], 0.f); v0[j] = a * a; v1[j] = b * b; } }
                    cu32x4 w; w.x = cvt_pk_bf16(v0[0], v0[1]); w.y = cvt_pk_bf16(v0[2], v0[3]); w.z = cvt_pk_bf16(v1[0], v1[1]); w.w = cvt_pk_bf16(v1[2], v1[3]);
                    if (up && CH_FF_WT) st16u_wt(ro, ((unsigned)row * (unsigned)ldc + (unsigned)(col0 + bj * HALF)) * 2u, w); else st16u_sc1(ro, ((unsigned)row * (unsigned)ldc + (unsigned)(col0 + bj * HALF)) * 2u, w); } }
        return;
    }
    if (u.kind == CK_PART) {
        float* P = (float*)(PG8_GAS float*)cp(c, CC + 30) + ((size_t)(u.kq * 3 + (u.pm - 64)) * 256) * 1024; const int colp = u.pn * BM + colw;
#pragma unroll
        for (int ai = 0; ai < 2; ++ai)
#pragma unroll
            for (int m = 0; m < 4; ++m) { float* rp = P + (size_t)(wr * 64 + fr + ai * HALF + m * 16) * 1024 + colp;
#pragma unroll
                for (int bj = 0; bj < 2; ++bj)
#pragma unroll
                    for (int n = 0; n < 2; ++n) *(f32x4*)(rp + bj * HALF + 4 * n) = acc[ai][bj][m][n]; }
        return;
    }
    const __amdgpu_buffer_rsrc_t rxb = mk_rsrc(cp(c, CC + 6), CH_MPAD * 2048u);
    const int col0 = u.pn * BM + colw;
    cu32x4 xin[4][2];
#define CH_XLOAD(i) do { _Pragma("unroll") for (int bj = 0; bj < 2; ++bj) xin[(i) & 3][bj] = __builtin_amdgcn_raw_buffer_load_b128(rxb, (int)(((unsigned)(row0 + ((i) >> 2) * HALF + ((i) & 3) * 16) * 1024u + (unsigned)(col0 + bj * HALF)) * 2u), 0, CH_X_AUX); } while (0)
    CH_XLOAD(0); CH_XLOAD(1); CH_XLOAD(2);
#define CH_UNPK(W_, v0, v1) do { const cu32x4 q_ = (W_); v0 = (f32x4){__builtin_bit_cast(float, q_.x << 16), __builtin_bit_cast(float, q_.x & 0xffff0000u), __builtin_bit_cast(float, q_.y << 16), __builtin_bit_cast(float, q_.y & 0xffff0000u)}; \
        v1 = (f32x4){__builtin_bit_cast(float, q_.z << 16), __builtin_bit_cast(float, q_.z & 0xffff0000u), __builtin_bit_cast(float, q_.w << 16), __builtin_bit_cast(float, q_.w & 0xffff0000u)}; } while (0)
    if (u.kind == CK_RESID) {
#pragma unroll
        for (int i = 0; i < 8; ++i) { const int ai = i >> 2, m = i & 3; const int row = row0 + ai * HALF + m * 16; const unsigned off = (unsigned)row * 1024u + (unsigned)col0;
            float s = 0.f; cu32x4 xc[2] = {xin[i & 3][0], xin[i & 3][1]};
            if (i + 3 < 8) CH_XLOAD(i + 3);
#pragma unroll
            for (int bj = 0; bj < 2; ++bj) { f32x4 x0, x1; CH_UNPK(xc[bj], x0, x1); x0 = x0 + acc[ai][bj][m][0]; x1 = x1 + acc[ai][bj][m][1];
                cu32x4 w; w.x = cvt_pk_bf16(x0[0], x0[1]); w.y = cvt_pk_bf16(x0[2], x0[3]); w.z = cvt_pk_bf16(x1[0], x1[1]); w.w = cvt_pk_bf16(x1[2], x1[3]);
                st16u_sc1(rxb, (off + bj * HALF) * 2u, w);
                CH_UNPK(w, x0, x1); s += ((x0[0] * x0[0] + x0[1] * x0[1]) + (x0[2] * x0[2] + x0[3] * x0[3])) + ((x1[0] * x1[0] + x1[1] * x1[1]) + (x1[2] * x1[2] + x1[3] * x1[3])); }
            s += shx(s, 16, (fr + 16 * fq)); s += shx(s, 32, (fr + 16 * fq));
            if (fq == 0) __builtin_amdgcn_raw_buffer_store_b32(__builtin_bit_cast(unsigned, s), rss, (int)((unsigned)row * 64u + (unsigned)(u.pn * 4 + wc) * 4u), 0, CH_X_AUX);
        }
    } else {
        float* yp = (float*)(PG8_GAS float*)cp(c, CC + 18); float* ys = (float*)(PG8_GAS float*)cp(c, CC + 20);
#pragma unroll
        for (int i = 0; i < 8; ++i) { const int ai = i >> 2, m = i & 3; const int row = row0 + ai * HALF + m * 16;
            float* dst = nullptr;
            if (row < RM_MP) { const int b = row / RM_LP, t = row - b * RM_LP; if (t >= RM_META) dst = yp + ((size_t)b * RM_SEQ + (t - RM_META)) * 1024 + col0; }
            else if (row < RM_MTOT) dst = ys + (size_t)(row - RM_MP) * 1024 + col0;
            f32x4 x[2][2]; cu32x4 xc[2] = {xin[i & 3][0], xin[i & 3][1]};
            if (i + 3 < 8) CH_XLOAD(i + 3);
#pragma unroll
            for (int bj = 0; bj < 2; ++bj) { CH_UNPK(xc[bj], x[bj][0], x[bj][1]); x[bj][0] = x[bj][0] + acc[ai][bj][m][0]; x[bj][1] = x[bj][1] + acc[ai][bj][m][1]; }
            if (dst) {
#pragma unroll
                for (int bj = 0; bj < 2; ++bj)
#pragma unroll
                    for (int n = 0; n < 2; ++n) *(f32x4*)(dst + bj * HALF + 4 * n) = x[bj][n]; }
        }
    }
#undef CH_UNPK
#undef CH_XLOAD
}
__device__ __forceinline__ int lane_now() { int l; asm volatile("v_mbcnt_lo_u32_b32 %0, -1, 0\n\tv_mbcnt_hi_u32_b32 %0, -1, %0" : "=v"(l)); return l; }
__device__ __forceinline__ void gemm_chain(PG8_LAS unsigned char* lds, volatile PG8_LAS unsigned* c, int tid_in) {
    int tid_o = tid_in; asm volatile("" : "+v"(tid_o));
    const int tid = tid_o, wid = __builtin_amdgcn_readfirstlane(tid >> 6), lane = tid & 63, wr = wid >> 2, wc = wid & 3, fr = lane & 15, fq = lane >> 4;
    unsigned rc;
    { int R, C; stage_rc(tid * 16, R, C); rc = (2u * (unsigned)R) | ((2u * (unsigned)C) << 16); }
#define ra2 (rc & 0xffffu)
#define c2 (rc >> 16)
#define CH_RB2() (2u * (unsigned)((int)((ra2 >> 1) & ~31u) + perm32((int)((ra2 >> 1) & 31u))))
    const unsigned ldsw = (unsigned)wid * 1024u;
    const int aoff = lds_byte(wr * 64 + fr, fq * 8), boff = lds_byte(wc * 32 + fr, fq * 8);
    constexpr size_t kstep = (size_t)(BK * 2);
#define PG8_SA(b, h) (((b) * 2 + (h)) * HTB)
#define PG8_SB(b, h) ((4 + (b) * 2 + (h)) * HTB)
#define CH_STAGE_A(bufoff, gbase, K_)   do { const unsigned _vo = ra2 * (unsigned)(K_) + c2; const char* _g1 = (const char*)(gbase); const char* _g2 = _g1 + 128 * (size_t)(K_); \
        __builtin_amdgcn_global_load_lds((const unsigned*)(_g1 + _vo), (PG8_LAS unsigned*)(lds + (bufoff) + ldsw), 16, 0, CH_A_AUX); \
        __builtin_amdgcn_global_load_lds((const unsigned*)(_g2 + _vo), (PG8_LAS unsigned*)(lds + (bufoff) + ldsw + 8192), 16, 0, CH_A_AUX); } while (0)
#define CH_STAGE_B(bufoff, gbase, K_) do { const unsigned _vo = CH_RB2() * (unsigned)(K_) + c2; const char* _g1 = (const char*)(gbase); const char* _g2 = _g1 + 128 * (size_t)(K_); \
        __builtin_amdgcn_global_load_lds((const unsigned*)(_g1 + _vo), (PG8_LAS unsigned*)(lds + (bufoff) + ldsw), 16, 0, 0); \
        __builtin_amdgcn_global_load_lds((const unsigned*)(_g2 + _vo), (PG8_LAS unsigned*)(lds + (bufoff) + ldsw + 8192), 16, 0, 0); } while (0)
#define PG8_LDA(dst, b, h) do { _Pragma("unroll") for (int m = 0; m < 4; ++m) _Pragma("unroll") for (int k = 0; k < 2; ++k) dst[m][k] = *(const PG8_LAS bf16x8*)(lds + PG8_SA(b, h) + aoff + m * 2048 + k * 1024); } while (0)
#define PG8_LDB(dst, b, h) do { _Pragma("unroll") for (int n = 0; n < 2; ++n) _Pragma("unroll") for (int k = 0; k < 2; ++k) dst[n][k] = *(const PG8_LAS bf16x8*)(lds + PG8_SB(b, h) + boff + n * 2048 + k * 1024); } while (0)
#define PG8_MMA(ai, bj, At, Bt) do { __builtin_amdgcn_s_setprio(1); _Pragma("unroll") for (int m = 0; m < 4; ++m) _Pragma("unroll") for (int n = 0; n < 2; ++n) _Pragma("unroll") for (int k = 0; k < 2; ++k) \
        acc[ai][bj][m][n] = __builtin_amdgcn_mfma_f32_16x16x32_bf16(Bt[n][k], At[m][k], acc[ai][bj][m][n], 0, 0, 0); __builtin_amdgcn_s_setprio(0); } while (0)
#define PG8_WAIT_V(n) asm volatile("s_waitcnt vmcnt(" #n ")" ::: "memory")
#define PG8_WAIT_L(n) asm volatile("s_waitcnt lgkmcnt(" #n ")" ::: "memory")
#define PG8_BAR __builtin_amdgcn_s_barrier()
#define PG8_SCHED __builtin_amdgcn_sched_barrier(0)
#define CH_CODE(j) ({ const unsigned x_ = cw(c, CQ), i_ = (unsigned)(j) * cw(c, CQ + 2) + cw(c, CQ + 1); i_ < (x_ < 3u ? cw(c, CC + 23) : cw(c, CC + 1)) ? ((x_ << 16) | i_) : 0xffffffffu; })
    UnitD cur, nxt; int ui = 0;
    decode_unit(c, CH_CODE(0), cur);
    if (!cur.valid) return;
    f32x4 acc[2][2][4][2];
#pragma unroll
    for (int a = 0; a < 2; ++a)
#pragma unroll
        for (int b = 0; b < 2; ++b)
#pragma unroll
            for (int m = 0; m < 4; ++m)
#pragma unroll
                for (int n = 0; n < 2; ++n) acc[a][b][m][n] = (f32x4){0.f, 0.f, 0.f, 0.f};
    bf16x8 At[4][2], B0[2][2], B1[2][2];
    { const char* cA = cur.A; const char* cB = cur.B; const int K = cur.ld; const size_t hs = (size_t)256 * K;
      CH_STAGE_B(PG8_SB(0, 0), cB, K); CH_STAGE_B(PG8_SB(0, 1), cB + hs, K); CH_STAGE_A(PG8_SA(0, 0), cA, K); CH_STAGE_A(PG8_SA(0, 1), cA + hs, K);
      if (wr == 1) PG8_BAR;
      PG8_WAIT_V(2); PG8_BAR;
      CH_STAGE_B(PG8_SB(1, 0), cB + kstep, K); CH_STAGE_A(PG8_SA(1, 0), cA + kstep, K); CH_STAGE_B(PG8_SB(1, 1), cB + hs + kstep, K);
      PG8_WAIT_V(6); PG8_BAR; }
    for (;;) {
        bool has_next = false;
        const char* cA = cur.A; const char* cB = cur.B; const int Kc = cur.ld, nt = cur.K / BK; const size_t hsc = (size_t)256 * Kc;
        for (int t = 0; t < nt; t += 2) {
            const bool last = (t == nt - 2);
            if (last) { decode_unit(c, CH_CODE(ui + 1), nxt); has_next = nxt.valid != 0; }
            const bool into = last && has_next;
            const char* a1 = cA + (size_t)(t + 1) * kstep;
            const char* a2 = last ? (into ? nxt.A : cA) : cA + (size_t)(t + 2) * kstep; const char* b2 = last ? (into ? nxt.B : cB) : cB + (size_t)(t + 2) * kstep;
            const char* a3 = a2 + kstep; const char* b3 = b2 + kstep;
            const int K2 = into ? nxt.ld : Kc; const size_t hs2 = (size_t)256 * K2;
            PG8_LDB(B0, 0, 0); PG8_LDB(B1, 0, 1); PG8_SCHED; PG8_LDA(At, 0, 0); CH_STAGE_A(PG8_SA(1, 1), a1 + hsc, Kc);
            PG8_WAIT_V(8); PG8_WAIT_L(0); PG8_BAR; PG8_MMA(0, 0, At, B0); PG8_MMA(0, 1, At, B1); PG8_BAR; PG8_SCHED;
            PG8_LDA(At, 0, 1); CH_STAGE_B(PG8_SB(0, 0), b2, K2); CH_STAGE_B(PG8_SB(0, 1), b2 + hs2, K2); CH_STAGE_A(PG8_SA(0, 0), a2, K2);
            PG8_WAIT_V(8); PG8_WAIT_L(0); PG8_BAR; PG8_MMA(1, 0, At, B0); PG8_MMA(1, 1, At, B1); PG8_BAR; PG8_SCHED;
            PG8_LDB(B0, 1, 0); PG8_LDB(B1, 1, 1); PG8_SCHED; PG8_LDA(At, 1, 0); CH_STAGE_A(PG8_SA(0, 1), a2 + hs2, K2);
            PG8_WAIT_V(8); PG8_WAIT_L(0); PG8_BAR; PG8_MMA(0, 0, At, B0); PG8_MMA(0, 1, At, B1); PG8_BAR; PG8_SCHED;
            PG8_LDA(At, 1, 1); CH_STAGE_B(PG8_SB(1, 0), b3, K2); CH_STAGE_B(PG8_SB(1, 1), b3 + hs2, K2); CH_STAGE_A(PG8_SA(1, 0), a3, K2);
            PG8_WAIT_V(8); PG8_WAIT_L(0); PG8_BAR; PG8_MMA(1, 0, At, B0); PG8_MMA(1, 1, At, B1); PG8_BAR; PG8_SCHED;
        }
        if (wr == 0) PG8_BAR;
        { const int lane_e = lane_now();
          chain_epilogue(c, cur, acc, wr, wc, lane_e & 15, lane_e >> 4); }
#pragma unroll
        for (int a = 0; a < 2; ++a)
#pragma unroll
            for (int b = 0; b < 2; ++b)
#pragma unroll
                for (int m = 0; m < 4; ++m)
#pragma unroll
                    for (int n = 0; n < 2; ++n) acc[a][b][m][n] = (f32x4){0.f, 0.f, 0.f, 0.f};
        if (!has_next) break;
        cur = nxt; ++ui;
        if (wr == 1) PG8_BAR;
    }
    PG8_WAIT_V(0);
    PG8_BAR;
#undef CH_CODE
#undef PG8_SA
#undef PG8_SB
#undef CH_STAGE_A
#undef CH_STAGE_B
#undef CH_RB2
#undef ra2
#undef c2
#undef PG8_LDA
#undef PG8_LDB
#undef PG8_MMA
#undef PG8_WAIT_V
#undef PG8_WAIT_L
#undef PG8_BAR
#undef PG8_SCHED
}
}
#ifndef PG8_SP2
#define PG8_SP2 true
#endif
#ifndef PG8_ALIGN
#define PG8_ALIGN true
#endif
constexpr int NWAVES = 8;
constexpr int D = 1024, NB = 8, SEQ = 2048, NMETA = 16, LP = SEQ + NMETA, DBATCH = 128, DSEQ = 4;
constexpr int MP = NB * LP, MS = DBATCH * DSEQ, MTOT = MP + MS, MPAD = 17152;
constexpr int NQKV = 1536, NIN = 3072, NINP = 3328, FF = 4096;
constexpr int AH = 16, AKV = 4, AHD = 64, WIN = 128;
constexpr int MH = 4, MDK = 128, MDV = 256, MCH = 64, VS = 32, NSL = MDV / VS;
constexpr float EPS = 1e-6f;
static_assert(MPAD % 256 == 0 && MPAD >= MTOT, "row padding");
constexpr size_t MiB = 1u << 20;
constexpr size_t WS_CTL = 0, CTL_ZERO_BYTES = 1 * MiB;
constexpr size_t WS_WQKV = 2 * MiB, WS_WO = 8 * MiB, WS_WIN = 12 * MiB, WS_WOUT = 25 * MiB, WS_WUP = 29 * MiB, WS_WDN = 61 * MiB;
constexpr size_t SZ_WQKV = (size_t)NQKV * D * 2, SZ_WO = (size_t)D * D * 2, SZ_WIN = (size_t)NINP * D * 2, SZ_WUP = (size_t)FF * D * 2;
constexpr size_t WS_SS = 93 * MiB, WS_G = 95 * MiB, WS_HSS = 96 * MiB;
constexpr size_t WS_X = 100 * MiB, WS_XB = 167 * MiB, WS_Z = 201 * MiB, WS_AO = 302 * MiB, WS_FF = 336 * MiB, WS_PT = 470 * MiB, WS_END = 483 * MiB;
static_assert(WS_WQKV + 2 * SZ_WQKV <= WS_WO && WS_WO + 2 * SZ_WO <= WS_WIN && WS_WIN + 2 * SZ_WIN <= WS_WOUT && WS_WOUT + 2 * SZ_WO <= WS_WUP && WS_WUP + 4 * SZ_WUP <= WS_WDN && WS_WDN + 4 * SZ_WUP <= WS_SS, "weights map");
static_assert(WS_SS + (size_t)MPAD * 16 * 4 <= WS_G && WS_G + (size_t)MPAD * 8 * 4 <= WS_HSS && WS_HSS + (size_t)MPAD * 32 * 4 <= WS_X, "small maps");
static_assert(WS_X + (size_t)MPAD * D * 4 <= WS_XB && WS_XB + (size_t)MPAD * D * 2 <= WS_Z && WS_Z + (size_t)MPAD * NIN * 2 <= WS_AO && WS_AO + (size_t)MPAD * D * 2 <= WS_FF && WS_FF + (size_t)MPAD * FF * 2 <= WS_PT && WS_PT + (size_t)4 * 768 * D * 4 <= WS_END, "activation map");
constexpr int CW_BAR = 4096;
constexpr size_t O_YP = 0, O_YS = O_YP + (size_t)NB * SEQ * D, O_KP = O_YS + (size_t)MS * D, O_VP = O_KP + (size_t)2 * NB * WIN * AKV * AHD, O_KS = O_VP + (size_t)2 * NB * WIN * AKV * AHD,
    O_VS = O_KS + (size_t)2 * DBATCH * WIN * AKV * AHD, O_CP = O_VS + (size_t)2 * DBATCH * WIN * AKV * AHD, O_NP = O_CP + (size_t)2 * NB * MH * MDK * MDV, O_MP = O_NP + (size_t)2 * NB * MH * MDK,
    O_CS = O_MP + (size_t)2 * NB * MH, O_NS = O_CS + (size_t)2 * DBATCH * MH * MDK * MDV, O_MS = O_NS + (size_t)2 * DBATCH * MH * MDK, O_END = O_MS + (size_t)2 * DBATCH * MH;
constexpr int RING_OFF = 0, RING_BYTES = 131072;
constexpr int LDSCTL_OFF = RING_BYTES, MISC_OFF = LDSCTL_OFF + 320;
constexpr int LDS_BYTES = 147456;
#define GAS __attribute__((address_space(1)))
#define LAS __attribute__((address_space(3)))
typedef unsigned short bf16;
typedef unsigned v4u __attribute__((ext_vector_type(4)));
typedef float f32x4 __attribute__((ext_vector_type(4)));
typedef short bf16x8 __attribute__((ext_vector_type(8)));
typedef GAS unsigned gu32;
typedef GAS unsigned long long gu64;
#define RLX_AGENT __ATOMIC_RELAXED, __HIP_MEMORY_SCOPE_AGENT
#define LDS_WAIT() asm volatile("s_waitcnt lgkmcnt(0)" ::: "memory")
#define VM_WAIT() asm volatile("s_waitcnt vmcnt(0)" ::: "memory")
__device__ __forceinline__ unsigned long long rt() { return __builtin_amdgcn_s_memrealtime(); }
__device__ __forceinline__ unsigned f2bf(float f) { unsigned u = __builtin_bit_cast(unsigned, f); return (u + 0x7fffu + ((u >> 16) & 1u)) >> 16; }
__device__ __forceinline__ unsigned pk2(float lo, float hi) { return f2bf(lo) | (f2bf(hi) << 16); }

#define XB_TMO      128
#define XB_XCNT(j)  (256  + 64 * (j))
#define XB_XSUB(j)  (1280 + 64 * (j))
#define XB_XGEN(j)  (2304 + 64 * (j))
#define XB_TOP      3328
#define XB_TOPGEN   3392
#define XCD_BAR_WORDS 3456
#define XB_SPIN_CAP (1u << 18)

__device__ __forceinline__ unsigned xb_ld(unsigned* p)              { return __hip_atomic_load(p, __ATOMIC_RELAXED, __HIP_MEMORY_SCOPE_AGENT); }
__device__ __forceinline__ unsigned xb_add(unsigned* p, unsigned v) { return __hip_atomic_fetch_add(p, v, __ATOMIC_RELAXED, __HIP_MEMORY_SCOPE_AGENT); }
__device__ __forceinline__ unsigned xb_xcc_id() { return (unsigned)__builtin_amdgcn_s_getreg((3 << 11) | 20) & 0xFu; }
#define XB_SPIN(cond, bar) do { unsigned _sp = 0; while (cond) { __builtin_amdgcn_s_sleep(1); \
    if ((++_sp & 255u) == 0u) { if (xb_ld(&(bar)[XB_TMO])) break; if (_sp > XB_SPIN_CAP) { atomicAdd(&(bar)[XB_TMO], 1u); break; } } } } while (0)

struct XcdBarrier {
    unsigned* bar; unsigned x;
    volatile LAS unsigned* st;
};

__device__ __forceinline__ XcdBarrier xcd_barrier_post(unsigned* bar, volatile LAS unsigned* st) {
    XcdBarrier b; b.bar = bar; b.x = xb_xcc_id(); b.st = st;
    if (threadIdx.x == 0) (void)xb_add(&bar[XB_XCNT(b.x)], 1u);
    return b;
}
__device__ __forceinline__ void xcd_barrier_complete(unsigned* bar, unsigned x, unsigned& nloc, unsigned& nx) {
    const unsigned G = gridDim.x * gridDim.y * gridDim.z;
    unsigned sum, cnt, mine, sp = 0u;
    for (;;) {
        sum = 0u; cnt = 0u; mine = 0u;
#pragma unroll
        for (unsigned j = 0; j < 16; ++j) { const unsigned c = xb_ld(&bar[XB_XCNT(j)]); sum += c; cnt += (c > 0u) ? 1u : 0u; mine = (j == x) ? c : mine; }
        if (sum == G) break;
        __builtin_amdgcn_s_sleep(1);
        if ((++sp & 255u) == 0u) { if (xb_ld(&bar[XB_TMO])) break; if (sp > XB_SPIN_CAP) { atomicAdd(&bar[XB_TMO], 1u); break; } }
    }
    nloc = mine > 0u ? mine : 1u; nx = cnt > 0u ? cnt : 1u;
}

__device__ __forceinline__ void xcd_barrier(const XcdBarrier& b) {
    asm volatile("s_waitcnt vmcnt(0)" ::: "memory");
    __syncthreads();
    if (threadIdx.x == 0) {
        unsigned* bar = b.bar;
        __builtin_amdgcn_s_waitcnt(0);
        unsigned nloc = b.st[0], nx = b.st[1];
        if (nloc == 0u) { xcd_barrier_complete(bar, b.x, nloc, nx); b.st[0] = nloc; b.st[1] = nx; }
        const unsigned old = xb_add(&bar[XB_XSUB(b.x)], 1u);
        const unsigned gen = old / nloc;
        if (old + 1u == (gen + 1u) * nloc) {
            __builtin_amdgcn_fence(__ATOMIC_RELEASE, "agent");
            asm volatile("s_waitcnt vmcnt(0)" ::: "memory");
            const unsigned og = xb_add(&bar[XB_TOP], 1u);
            const unsigned tg = og / nx;
            if (og + 1u == (tg + 1u) * nx) xb_add(&bar[XB_TOPGEN], 1u);
            else XB_SPIN(xb_ld(&bar[XB_TOPGEN]) == tg, bar);
            __builtin_amdgcn_fence(__ATOMIC_ACQUIRE, "agent");
            xb_add(&bar[XB_XGEN(b.x)], 1u);
            asm volatile("s_waitcnt vmcnt(0)" ::: "memory");
        } else {
            XB_SPIN(xb_ld(&bar[XB_XGEN(b.x)]) == gen, bar);
            __builtin_amdgcn_fence(__ATOMIC_ACQUIRE, "agent");
            asm volatile("s_waitcnt vmcnt(0)" ::: "memory");
        }
    }
    __syncthreads();
}

typedef unsigned v2u __attribute__((ext_vector_type(2)));
__device__ __forceinline__ float bf_lo(unsigned w) { return __builtin_bit_cast(float, w << 16); }
__device__ __forceinline__ float bf_hi(unsigned w) { return __builtin_bit_cast(float, w & 0xffff0000u); }
__device__ __forceinline__ float bf1(bf16 b) { return __builtin_bit_cast(float, (unsigned)b << 16); }
__device__ __forceinline__ void unpack8(const v4u w, float (&f)[8]) { f[0] = bf_lo(w.x); f[1] = bf_hi(w.x); f[2] = bf_lo(w.y); f[3] = bf_hi(w.y); f[4] = bf_lo(w.z); f[5] = bf_hi(w.z); f[6] = bf_lo(w.w); f[7] = bf_hi(w.w); }
__device__ __forceinline__ v4u pack8(const float (&f)[8]) { v4u o; o.x = pk2(f[0], f[1]); o.y = pk2(f[2], f[3]); o.z = pk2(f[4], f[5]); o.w = pk2(f[6], f[7]); return o; }
__device__ __forceinline__ float wave_sum(float v, int lane) {
#pragma unroll
    for (int o = 1; o < 64; o <<= 1) v += pg8::shx(v, o, lane);
    return v;
}
__device__ __forceinline__ f32x4 mfma16(bf16x8 a, bf16x8 b, f32x4 c) { return __builtin_amdgcn_mfma_f32_16x16x32_bf16(a, b, c, 0, 0, 0); }
#define WG_BAR() do { asm volatile("s_waitcnt vmcnt(0) lgkmcnt(0)" ::: "memory"); __builtin_amdgcn_s_barrier(); asm volatile("" ::: "memory"); } while (0)
#define LDS_BAR() do { asm volatile("s_waitcnt lgkmcnt(0)" ::: "memory"); __builtin_amdgcn_s_barrier(); asm volatile("" ::: "memory"); } while (0)

__device__ __forceinline__ void p0_transpose_item(const float* W, const float* gs, int K, int N, bf16* WT, int row_off, int mlo, int mhi, float mul, LAS float* scr, int item, int lane) {
    const int nblk = N / 32, kb = item / nblk, nb = item % nblk, k0 = 64 * kb, n0 = 32 * nb;
    const float cm = (n0 >= mlo && n0 < mhi) ? mul : 1.0f;
    const int lr = lane >> 3, lc = 4 * (lane & 7);
    f32x4 v[8]; float g[8];
#pragma unroll
    for (int i = 0; i < 8; ++i) { v[i] = *(const GAS f32x4*)(W + (size_t)(k0 + 8 * i + lr) * N + n0 + lc); g[i] = gs ? gs[k0 + 8 * i + lr] * cm : cm; }
#pragma unroll
    for (int i = 0; i < 8; ++i) { LAS float* d = scr + (8 * i + lr) * 33 + lc; d[0] = v[i][0] * g[i]; d[1] = v[i][1] * g[i]; d[2] = v[i][2] * g[i]; d[3] = v[i][3] * g[i]; }
    LDS_WAIT(); asm volatile("" ::: "memory");
    const int c = lane & 7;
#pragma unroll
    for (int j = 0; j < 4; ++j) { const int n = (lane >> 3) + 8 * j; const LAS float* s = scr + (8 * c) * 33 + n;
        v4u o; o.x = pk2(s[0 * 33], s[1 * 33]); o.y = pk2(s[2 * 33], s[3 * 33]); o.z = pk2(s[4 * 33], s[5 * 33]); o.w = pk2(s[6 * 33], s[7 * 33]);
        *(GAS v4u*)(WT + (size_t)(row_off + n0 + n) * K + k0 + 8 * c) = o; }
    LDS_WAIT(); asm volatile("" ::: "memory");
}
struct P0Args { const float *xp, *xs, *meta, *norm_mix, *norm_mlp, *wqkv, *wo, *win, *wgate, *wout, *wup, *wdn; unsigned char* ws; };
__device__ __forceinline__ void p0_prologue(const P0Args& A, LAS unsigned char* lds, int vcu, int G, int wave, int lane, int tid) {
    LAS float* scr = (LAS float*)(lds + RING_OFF + wave * 16384);
    const int gw = vcu * NWAVES + wave, NGW = G * NWAVES;
    constexpr int I_QKV = (D / 64) * (NQKV / 32), I_O = (D / 64) * (D / 32), I_IN = (D / 64) * (NIN / 32), I_UP = (D / 64) * (FF / 32), I_DN = (FF / 64) * (D / 32);
    constexpr int I_MIX = I_QKV + I_O + I_IN + I_O, I_MLP = I_UP + I_DN, NITEMS = 2 * I_MIX + 4 * I_MLP;
    unsigned char* ws = A.ws;
    for (int it = gw; it < NITEMS; it += NGW) {
        int r = it;
        if (r < 2 * I_MIX) { const int j = r / I_MIX; r -= j * I_MIX;
            if (r < I_QKV) { p0_transpose_item(A.wqkv + (size_t)j * D * NQKV, A.norm_mix + (2 * j) * D, D, NQKV, (bf16*)(ws + WS_WQKV + j * SZ_WQKV), 0, 0, 0, 1.f, scr, r, lane); continue; } r -= I_QKV;
            if (r < I_O) { p0_transpose_item(A.wo + (size_t)j * D * D, nullptr, D, D, (bf16*)(ws + WS_WO + j * SZ_WO), 0, 0, 0, 1.f, scr, r, lane); continue; } r -= I_O;
            if (r < I_IN) { p0_transpose_item(A.win + (size_t)j * D * NIN, A.norm_mix + (2 * j + 1) * D, D, NIN, (bf16*)(ws + WS_WIN + j * SZ_WIN), 0, 512, 1024, 0.08838834764831845f, scr, r, lane); continue; } r -= I_IN;
            p0_transpose_item(A.wout + (size_t)j * D * D, nullptr, D, D, (bf16*)(ws + WS_WOUT + j * SZ_WO), 0, 0, 0, 1.f, scr, r, lane); continue; }
        r -= 2 * I_MIX;
        { const int i = r / I_MLP; r -= i * I_MLP;
            if (r < I_UP) { p0_transpose_item(A.wup + (size_t)i * D * FF, A.norm_mlp + i * D, D, FF, (bf16*)(ws + WS_WUP + i * SZ_WUP), 0, 0, 0, 1.f, scr, r, lane); continue; } r -= I_UP;
            p0_transpose_item(A.wdn + (size_t)i * FF * D, nullptr, FF, D, (bf16*)(ws + WS_WDN + i * SZ_WUP), 0, 0, 0, 1.f, scr, r, lane); }
    }
    { const int gt = vcu * (NWAVES * 64) + tid, NT = G * NWAVES * 64;
      for (int e = gt; e < 2 * 256 * (D / 8); e += NT) { const int j = e / (256 * (D / 8)), rem = e % (256 * (D / 8)), n = rem / (D / 8), k8 = (rem % (D / 8)) * 8;
          float f[8];
#pragma unroll
          for (int q = 0; q < 8; ++q) f[q] = (n < 8) ? A.wgate[((size_t)j * D + k8 + q) * 8 + n] * A.norm_mix[(2 * j + 1) * D + k8 + q] : 0.f;
          *(GAS v4u*)((bf16*)(ws + WS_WIN + j * SZ_WIN) + (size_t)(NIN + n) * D + k8) = pack8(f); } }
    bf16* XB = (bf16*)(ws + WS_XB); float* SS = (float*)(ws + WS_SS); bf16* AO = (bf16*)(ws + WS_AO);
    for (int m = gw; m < MPAD; m += NGW) {
        const float* src = nullptr;
        if (m < MP) { const int b = m / LP, t = m - b * LP; src = (t < NMETA) ? A.meta + (size_t)t * D : A.xp + ((size_t)b * SEQ + (t - NMETA)) * D; }
        else if (m < MTOT) src = A.xs + (size_t)(m - MP) * D;
        f32x4 v[4]; float ss[4];
#pragma unroll
        for (int j = 0; j < 4; ++j) v[j] = src ? ((const GAS f32x4*)src)[lane + 64 * j] : (f32x4){0.f, 0.f, 0.f, 0.f};
#pragma unroll
        for (int j = 0; j < 4; ++j) { v2u w; w.x = pk2(v[j][0], v[j][1]); w.y = pk2(v[j][2], v[j][3]); ((GAS v2u*)(XB + (size_t)m * D))[lane + 64 * j] = w;
            const float a0 = bf_lo(w.x), a1 = bf_hi(w.x), a2 = bf_lo(w.y), a3 = bf_hi(w.y); ss[j] = wave_sum((a0 * a0 + a1 * a1) + (a2 * a2 + a3 * a3), lane); }
        if (lane < 16) { const int j = lane >> 2; const float s = (lane & 3) ? 0.f : (j == 0 ? ss[0] : j == 1 ? ss[1] : j == 2 ? ss[2] : ss[3]); SS[(size_t)m * 16 + lane] = s; }
        if (m >= MTOT) {
#pragma unroll
            for (int j = 0; j < 4; ++j) ((GAS v2u*)(AO + (size_t)m * D))[lane + 64 * j] = (v2u){0u, 0u}; }
    }
}

constexpr int A_KS = 0, A_KSTR = 144, A_VT = 36864, A_VSTR = 552, A_LUT = 72192, A_END = 74304;
__device__ __forceinline__ int t5_bucket(int n) {
    if (n < 16) return n;
    const int v = 16 + (int)(logf((float)n * (1.0f / 16.0f)) * (16.0f / 2.0794415416798357f));
    return v < 31 ? v : 31;
}
struct AttnP { const bf16* QKV; const float *gq, *gk, *sinks, *rel; bf16* AO; };
__device__ __forceinline__ void attn_subtile(LAS unsigned char* L, int i0, const bf16* qptr, int hh, int dist0, int jmin, float sink, const float* gq, bf16* optr, bool store, int lane) {
    const int g = lane >> 4, c = lane & 15;
    bf16x8 Bq[2];
    {
        const v4u q0 = *(const GAS v4u*)(qptr + 8 * g), q1 = *(const GAS v4u*)(qptr + 32 + 8 * g);
        float f0[8], f1[8]; unpack8(q0, f0); unpack8(q1, f1);
        float ss = 0.f;
#pragma unroll
        for (int e = 0; e < 8; ++e) ss += f0[e] * f0[e] + f1[e] * f1[e];
        ss += pg8::shx(ss, 16, lane); ss += pg8::shx(ss, 32, lane);
        const float rq = 0.125f / sqrtf(ss * (1.0f / 64.0f) + EPS);
        const f32x4 ga = *(const f32x4*)(gq + 8 * g), gb = *(const f32x4*)(gq + 8 * g + 4), gc = *(const f32x4*)(gq + 32 + 8 * g), gd = *(const f32x4*)(gq + 36 + 8 * g);
#pragma unroll
        for (int e = 0; e < 4; ++e) { f0[e] *= rq * ga[e]; f0[4 + e] *= rq * gb[e]; f1[e] *= rq * gc[e]; f1[4 + e] *= rq * gd[e]; }
        const v4u p0 = pack8(f0), p1 = pack8(f1);
        Bq[0] = __builtin_bit_cast(bf16x8, p0); Bq[1] = __builtin_bit_cast(bf16x8, p1);
    }
    f32x4 s[10];
    float mx = -1e30f;
#pragma unroll
    for (int kt = 0; kt < 9; ++kt) {
        const LAS unsigned char* kp = L + A_KS + (i0 + 16 * kt + c) * A_KSTR + 16 * g;
        f32x4 acc = {0.f, 0.f, 0.f, 0.f};
        acc = mfma16(*(const LAS bf16x8*)kp, Bq[0], acc);
        acc = mfma16(*(const LAS bf16x8*)(kp + 64), Bq[1], acc);
#pragma unroll
        for (int r = 0; r < 4; ++r) {
            const int rel = 16 * kt + 4 * g + r, dist = dist0 - rel;
            const bool ok = (dist >= 0) && (dist <= WIN) && (i0 + rel >= jmin);
            const int di = dist < 0 ? 0 : (dist > WIN ? WIN : dist);
            const float bias = *(const LAS float*)(L + A_LUT + (hh * 132 + di) * 4);
            const float v = ok ? acc[r] + bias : -1e30f;
            s[kt][r] = v; mx = fmaxf(mx, v);
        }
    }
    mx = fmaxf(mx, pg8::shx(mx, 16, lane)); mx = fmaxf(mx, pg8::shx(mx, 32, lane));
    mx = fmaxf(mx, sink);
    float l = 0.f;
#pragma unroll
    for (int kt = 0; kt < 9; ++kt)
#pragma unroll
        for (int r = 0; r < 4; ++r) { const float p = __expf(s[kt][r] - mx); s[kt][r] = p; l += p; }
    s[9] = (f32x4){0.f, 0.f, 0.f, 0.f};
    l += pg8::shx(l, 16, lane); l += pg8::shx(l, 32, lane);
    const float inv = 1.0f / (l + __expf(sink - mx));
    bf16x8 Bp[5];
#pragma unroll
    for (int ks = 0; ks < 5; ++ks) { v4u w; w.x = pk2(s[2 * ks][0], s[2 * ks][1]); w.y = pk2(s[2 * ks][2], s[2 * ks][3]); w.z = pk2(s[2 * ks + 1][0], s[2 * ks + 1][1]); w.w = pk2(s[2 * ks + 1][2], s[2 * ks + 1][3]); Bp[ks] = __builtin_bit_cast(bf16x8, w); }
#pragma unroll
    for (int dt = 0; dt < 4; ++dt) {
        f32x4 acc = {0.f, 0.f, 0.f, 0.f};
        const LAS unsigned char* vp = L + A_VT + (16 * dt + c) * A_VSTR + (i0 + 4 * g) * 2;
#pragma unroll
        for (int ks = 0; ks < 5; ++ks) { const v2u lo = *(const LAS v2u*)(vp + 64 * ks), hi = *(const LAS v2u*)(vp + 64 * ks + 32); const v4u a = {lo.x, lo.y, hi.x, hi.y};
            acc = mfma16(__builtin_bit_cast(bf16x8, a), Bp[ks], acc); }
        if (store) { v2u w; w.x = pk2(acc[0] * inv, acc[1] * inv); w.y = pk2(acc[2] * inv, acc[3] * inv); *(GAS v2u*)(optr + 16 * dt + 4 * g) = w; }
    }
}
__device__ __forceinline__ void attn_stage_row(LAS unsigned char* L, int j, int half, const bf16* krow, const bf16* vrow, const float* gk, float* ck, float* cv, int lane) {
    float kf[32], vf[32];
    if (krow) {
#pragma unroll
        for (int i = 0; i < 4; ++i) { float t[8]; unpack8(*(const GAS v4u*)(krow + 8 * i), t);
#pragma unroll
            for (int e = 0; e < 8; ++e) kf[8 * i + e] = t[e];
            unpack8(*(const GAS v4u*)(vrow + 8 * i), t);
#pragma unroll
            for (int e = 0; e < 8; ++e) vf[8 * i + e] = t[e]; }
    } else {
#pragma unroll
        for (int e = 0; e < 32; ++e) { kf[e] = 0.f; vf[e] = 0.f; }
    }
    float ss = 0.f;
#pragma unroll
    for (int e = 0; e < 32; ++e) ss += kf[e] * kf[e];
    ss += pg8::shx(ss, 1, lane);
    const float rk = 1.0f / sqrtf(ss * (1.0f / 64.0f) + EPS);
#pragma unroll
    for (int i = 0; i < 8; ++i) { const f32x4 gg = *(const f32x4*)(gk + half * 32 + 4 * i);
#pragma unroll
        for (int e = 0; e < 4; ++e) kf[4 * i + e] *= rk * gg[e]; }
#pragma unroll
    for (int i = 0; i < 4; ++i) { float t[8];
#pragma unroll
        for (int e = 0; e < 8; ++e) t[e] = kf[8 * i + e];
        *(LAS v4u*)(L + A_KS + j * A_KSTR + half * 64 + 16 * i) = pack8(t); }
#pragma unroll
    for (int e = 0; e < 32; ++e) *(LAS unsigned short*)(L + A_VT + (half * 32 + e) * A_VSTR + 2 * j) = (unsigned short)f2bf(vf[e]);
    if (ck) {
#pragma unroll
        for (int i = 0; i < 8; ++i) { *(GAS f32x4*)(ck + half * 32 + 4 * i) = (f32x4){kf[4 * i], kf[4 * i + 1], kf[4 * i + 2], kf[4 * i + 3]};
            *(GAS f32x4*)(cv + half * 32 + 4 * i) = (f32x4){vf[4 * i], vf[4 * i + 1], vf[4 * i + 2], vf[4 * i + 3]}; }
    }
}
__device__ __forceinline__ void attn_phase(LAS unsigned char* L, const AttnP& P, const float* cache_k, const float* cache_v, float* out, int jl, int vcu, int G, int tid_in, int wave_in, int lane_in) {
    constexpr int N_PROMPT = NB * 17 * AKV, N_ITEMS = N_PROMPT + DBATCH * AKV;
#pragma unroll 1
    for (int it = vcu; it < N_ITEMS; it += G) {
        int tid = tid_in; asm volatile("" : "+v"(tid));
        const int lane = tid & 63, wave = __builtin_amdgcn_readfirstlane(tid >> 6);
        const bool prompt = it < N_PROMPT;
        int b = 0, qb = 0, kvh, db = 0;
        if (prompt) { b = it / (17 * AKV); const int rem = it % (17 * AKV); qb = rem / AKV; kvh = rem % AKV; }
        else { const int si = it - N_PROMPT; db = si / AKV; kvh = si % AKV; }
        for (int e = tid; e < 4 * 129; e += NWAVES * 64) { const int hh = e / 129, d = e % 129; *(LAS float*)(L + A_LUT + (hh * 132 + d) * 4) = P.rel[t5_bucket(d) * AH + kvh * 4 + hh]; }
        if (prompt) {
            const int j = tid >> 1, half = tid & 1, tok = 128 * qb - 240 + j;
            const bf16* krow = nullptr; const bf16* vrow = nullptr; float* ck = nullptr; float* cv = nullptr;
            if (tok >= 0) { const size_t row = (size_t)b * LP + tok; krow = P.QKV + row * NQKV + 1024 + kvh * 64 + half * 32; vrow = P.QKV + row * NQKV + 1280 + kvh * 64 + half * 32; }
            if (qb == 16 && j >= 128) { const size_t o = ((((size_t)jl * NB + b) * WIN + (j - 128)) * AKV + kvh) * AHD; ck = out + O_KP + o; cv = out + O_VP + o; }
            attn_stage_row(L, j, half, krow, vrow, P.gk, ck, cv, lane);
            for (int e = tid; e < 64 * 16; e += NWAVES * 64) *(LAS unsigned short*)(L + A_VT + (e >> 4) * A_VSTR + 2 * (256 + (e & 15))) = 0;
        } else {
            const float* ckin = cache_k + (((size_t)jl * DBATCH + db) * WIN * AKV + kvh) * AHD; const float* cvin = cache_v + (((size_t)jl * DBATCH + db) * WIN * AKV + kvh) * AHD;
            float* cko = out + O_KS + (((size_t)jl * DBATCH + db) * WIN * AKV + kvh) * AHD; float* cvo = out + O_VS + (((size_t)jl * DBATCH + db) * WIN * AKV + kvh) * AHD;
#pragma unroll
            for (int i = 0; i < 4; ++i) { const int idx = tid + 512 * i, row = idx >> 4, c4 = idx & 15;
                const f32x4 kv = *(const GAS f32x4*)(ckin + (size_t)row * (AKV * AHD) + 4 * c4), vv = *(const GAS f32x4*)(cvin + (size_t)row * (AKV * AHD) + 4 * c4);
                v2u w; w.x = pk2(kv[0], kv[1]); w.y = pk2(kv[2], kv[3]); *(LAS v2u*)(L + A_KS + row * A_KSTR + 8 * c4) = w;
#pragma unroll
                for (int e = 0; e < 4; ++e) *(LAS unsigned short*)(L + A_VT + (4 * c4 + e) * A_VSTR + 2 * row) = (unsigned short)f2bf(vv[e]);
                if (row >= DSEQ) { *(GAS f32x4*)(cko + (size_t)(row - DSEQ) * (AKV * AHD) + 4 * c4) = kv; *(GAS f32x4*)(cvo + (size_t)(row - DSEQ) * (AKV * AHD) + 4 * c4) = vv; } }
            if (tid < 2 * DSEQ) { const int s = tid >> 1, half = tid & 1; const size_t row = (size_t)MP + db * DSEQ + s;
                attn_stage_row(L, WIN + s, half, P.QKV + row * NQKV + 1024 + kvh * 64 + half * 32, P.QKV + row * NQKV + 1280 + kvh * 64 + half * 32, P.gk,
                               cko + (size_t)(WIN - DSEQ + s) * (AKV * AHD), cvo + (size_t)(WIN - DSEQ + s) * (AKV * AHD), lane); }
            for (int e = tid; e < 12 * 8; e += NWAVES * 64) { unsigned z0 = 0u; asm volatile("" : "+v"(z0)); *(LAS v4u*)(L + A_KS + (132 + e / 8) * A_KSTR + 16 * (e & 7)) = (v4u){z0, z0, z0, z0}; }
            for (int e = tid; e < 64 * 28; e += NWAVES * 64) *(LAS unsigned short*)(L + A_VT + (e / 28) * A_VSTR + 2 * (132 + e % 28)) = 0;
        }
        LDS_BAR();
        if (prompt) {
            const int hh = wave & 3, rhalf = wave >> 2, head = kvh * 4 + hh; const float sink = P.sinks[head];
            const int jmin = 240 - 128 * qb;
#pragma unroll 1
            for (int st = 0; st < 4; ++st) {
                const int i0 = 64 * rhalf + 16 * st;
                if (qb == 0 && i0 < 112) continue;
                const int tok = 128 * qb - 112 + i0 + (lane & 15); const size_t row = (size_t)b * LP + tok;
                attn_subtile(L, i0, P.QKV + row * NQKV + head * 64, hh, (lane & 15) + WIN, jmin, sink, P.gq, P.AO + row * D + head * 64, true, lane);
            }
        } else if (wave == 0) {
            const int q = lane & 15, hh = q >> 2, s = q & 3, head = kvh * 4 + hh; const size_t row = (size_t)MP + db * DSEQ + s;
            attn_subtile(L, 0, P.QKV + row * NQKV + head * 64, hh, WIN + s, 0, P.sinks[head], P.gq, P.AO + row * D + head * 64, true, lane);
        }
        LDS_BAR();
    }
}

constexpr int M_QS = 0, M_KS = 17408, M_KT = 34816, M_VT = 53248, M_VW = 60160, M_CT = 67072, M_CTB = 13056;
constexpr int M_RS = 272, M_TS = 144;
struct MlP { const bf16* Z; const float* G; const float* gnorm; bf16* AO; float* HSS; };
__device__ __forceinline__ float wave_scan_add(float x, int lane) {
#pragma unroll
    for (int o = 1; o < 64; o <<= 1) { const float t = pg8::shl_from(x, lane - o); if (lane >= o) x += t; }
    return x;
}
__device__ __forceinline__ float wave_scan_max(float x, int lane) {
#pragma unroll
    for (int o = 1; o < 64; o <<= 1) { const float t = pg8::shl_from(x, lane - o); if (lane >= o) x = fmaxf(x, t); }
    return x;
}
__device__ __forceinline__ float sigmoidf_(float x) { return 1.0f / (1.0f + __expf(-x)); }
__device__ __forceinline__ float tanh_fast(float x) { return 1.0f - 2.0f / (1.0f + __expf(2.0f * x)); }
__device__ __forceinline__ float gate_i(float g) { return 15.0f * tanh_fast(g * (1.0f / 15.0f)); }
__device__ __forceinline__ float gate_f(float g) { const float x = 15.0f * tanh_fast(g * (1.0f / 15.0f)); return fminf(x, 0.f) - __logf(1.0f + __expf(-fabsf(x))); }
constexpr int M_TB = 94208, M_CS = M_TB + 33 * 192 * 4, M_MS = M_CS + 33 * 2 * 4, M_MX = M_MS + 34 * 4, M_END2 = M_MX + 34 * 4;
static_assert(M_END2 <= RING_BYTES, "mLSTM LDS map");
__device__ __forceinline__ void mlstm_prompt_item(LAS unsigned char* L, const MlP& P, float* out, int jl, int b, int h, int sl, int tid, int wave, int lane) {
    const int g = lane >> 4, c = lane & 15;
    unsigned z0 = 0u; asm volatile("" : "+v"(z0));
    for (int e = tid; e < 16 * 72; e += NWAVES * 64) { const int r = e / 72, cc = e % 72; const unsigned short one = 0x3f80;
        *(LAS unsigned short*)(L + M_VT + (32 + r) * M_TS + 2 * cc) = (r == 0) ? one : (unsigned short)0; *(LAS unsigned short*)(L + M_VW + (32 + r) * M_TS + 2 * cc) = 0; }
    for (int e = tid; e < M_CTB / 16; e += NWAVES * 64) *(LAS v4u*)(L + M_CT + 16 * e) = (v4u){z0, z0, z0, z0};
    { LAS float* TB = (LAS float*)(L + M_TB); LAS float* CS = (LAS float*)(L + M_CS);
      float gl[5], gf[5];
#pragma unroll
      for (int k = 0; k < 5; ++k) { const int cc = wave + 8 * k; const int t0_ = cc == 0 ? 0 : 16 + 64 * (cc - 1), nv_ = cc == 0 ? 16 : 64;
          if (cc < 33 && lane < nv_) { const float* gr = P.G + ((size_t)b * LP + t0_ + lane) * 8; gl[k] = gr[h]; gf[k] = gr[4 + h]; } else { gl[k] = 0.f; gf[k] = 0.f; } }
#pragma unroll
      for (int k = 0; k < 5; ++k) { const int cc = wave + 8 * k; const int nv_ = cc == 0 ? 16 : 64;
          if (cc < 33) { const float li = lane < nv_ ? gate_i(gl[k]) : -1e30f, lf = lane < nv_ ? gate_f(gf[k]) : 0.f;
              const float bcum = wave_scan_add(lf, lane), wj = li - bcum, cm = wave_scan_max(wj, lane);
              TB[cc * 192 + lane] = bcum; TB[cc * 192 + 64 + lane] = wj; TB[cc * 192 + 128 + lane] = cm;
              if (lane == 63) { CS[2 * cc] = bcum; CS[2 * cc + 1] = cm; } } }
    }
    LDS_BAR();
    if (wave == 0) {
        const LAS float* CS = (const LAS float*)(L + M_CS);
        const float bl = lane < 33 ? CS[2 * lane] : 0.f, cx = lane < 33 ? CS[2 * lane + 1] : 0.f;
        float mrun = 0.f, ms = 0.f, mx = 0.f;
#pragma unroll 1
        for (int k = 0; k < 33; ++k) { const float blk = __builtin_bit_cast(float, __builtin_amdgcn_readlane(__builtin_bit_cast(int, bl), k)), cxk = __builtin_bit_cast(float, __builtin_amdgcn_readlane(__builtin_bit_cast(int, cx), k));
            const float mxk = fmaxf(mrun, cxk); if (lane == k) { ms = mrun; mx = mxk; } mrun = blk + mxk; }
        if (lane == 33) { ms = mrun; mx = mrun; }
        if (lane < 34) { ((LAS float*)(L + M_MS))[lane] = ms; ((LAS float*)(L + M_MX))[lane] = mx; }
    }
    f32x4 cacc[6];
#pragma unroll
    for (int i = 0; i < 6; ++i) cacc[i] = (f32x4){0.f, 0.f, 0.f, 0.f};
    const int srow = lane, spiece = wave, vpiece = wave & 3;
    v4u aq0, aq1, ak0, ak1, av, bq0, bq1, bk0, bk1, bv;
    v2u po0 = {z0, z0}, po1 = {z0, z0};
#define ML_LOAD(ch, q0, q1, k0, k1, vv) do { const int t0_ = (ch) == 0 ? 0 : 16 + 64 * ((ch) - 1), nv_ = (ch) == 0 ? 16 : 64; \
        if (srow < nv_) { const bf16* zr = P.Z + ((size_t)b * LP + t0_ + srow) * NIN + h * MDK + 16 * spiece; q0 = *(const GAS v4u*)zr; q1 = *(const GAS v4u*)(zr + 8); k0 = *(const GAS v4u*)(zr + 512); k1 = *(const GAS v4u*)(zr + 520); } \
        else { q0 = q1 = k0 = k1 = (v4u){z0, z0, z0, z0}; } \
        if (wave < 4 && srow < nv_) vv = *(const GAS v4u*)(P.Z + ((size_t)b * LP + t0_ + srow) * NIN + 1024 + h * MDV + VS * sl + 8 * vpiece); else vv = (v4u){z0, z0, z0, z0}; } while (0)
#define ML_OLOAD(ch) do { const int t0_ = (ch) == 0 ? 0 : 16 + 64 * ((ch) - 1), nv_ = (ch) == 0 ? 16 : 64; const int trow_ = 16 * wave + c; \
        if (wave < 4 && trow_ < nv_) { const bf16* zo = P.Z + ((size_t)b * LP + t0_ + trow_) * NIN + 2048 + h * MDV + VS * sl + 4 * g; po0 = *(const GAS v2u*)zo; po1 = *(const GAS v2u*)(zo + 16); } } while (0)
    ML_LOAD(0, aq0, aq1, ak0, ak1, av); ML_LOAD(1, bq0, bq1, bk0, bk1, bv); ML_OLOAD(0);
    LDS_BAR();
#define ML_STEP(ch, q0, q1, k0, k1, vv) do { \
        const int t0 = (ch) == 0 ? 0 : 16 + 64 * ((ch) - 1), nvalid = (ch) == 0 ? 16 : 64, cur = (ch) & 1; \
        const float m_prev = ((const LAS float*)(L + M_MS))[ch], Mx = ((const LAS float*)(L + M_MX))[ch]; \
        const float wk = __expf(((const LAS float*)(L + M_TB))[(ch) * 192 + 64 + lane] - Mx), a = __expf(m_prev - Mx); \
          \
        *(LAS v4u*)(L + M_QS + srow * M_RS + 32 * spiece) = q0; *(LAS v4u*)(L + M_QS + srow * M_RS + 32 * spiece + 16) = q1; \
        *(LAS v4u*)(L + M_KS + srow * M_RS + 32 * spiece) = k0; *(LAS v4u*)(L + M_KS + srow * M_RS + 32 * spiece + 16) = k1; \
        { const unsigned kw[8] = {k0.x, k0.y, k0.z, k0.w, k1.x, k1.y, k1.z, k1.w}; \
          _Pragma("unroll") for (int e = 0; e < 8; ++e) { *(LAS unsigned short*)(L + M_KT + (16 * spiece + 2 * e) * M_TS + 2 * srow) = (unsigned short)(kw[e] & 0xffffu); *(LAS unsigned short*)(L + M_KT + (16 * spiece + 2 * e + 1) * M_TS + 2 * srow) = (unsigned short)(kw[e] >> 16); } } \
        if (wave < 4) { float vf[8]; unpack8(vv, vf); const unsigned vw_[4] = {vv.x, vv.y, vv.z, vv.w}; \
            _Pragma("unroll") for (int e = 0; e < 4; ++e) { *(LAS unsigned short*)(L + M_VT + (8 * vpiece + 2 * e) * M_TS + 2 * srow) = (unsigned short)(vw_[e] & 0xffffu); *(LAS unsigned short*)(L + M_VT + (8 * vpiece + 2 * e + 1) * M_TS + 2 * srow) = (unsigned short)(vw_[e] >> 16); } \
            _Pragma("unroll") for (int e = 0; e < 8; ++e) *(LAS unsigned short*)(L + M_VW + (8 * vpiece + e) * M_TS + 2 * srow) = (unsigned short)f2bf(vf[e] * wk); } \
        if (wave == 4) *(LAS unsigned short*)(L + M_VW + 32 * M_TS + 2 * lane) = (unsigned short)f2bf(wk); \
        LDS_BAR(); \
        if ((ch) + 2 < 33) ML_LOAD((ch) + 2, q0, q1, k0, k1, vv); \
        if (wave < 4) { \
            const int tt = wave, trow = 16 * tt + c; \
            bf16x8 Bq[4]; \
            _Pragma("unroll") for (int ks = 0; ks < 4; ++ks) Bq[ks] = *(const LAS bf16x8*)(L + M_QS + trow * M_RS + 64 * ks + 16 * g); \
            const LAS float* tb = (const LAS float*)(L + M_TB) + (ch) * 192; \
            const float bct = tb[trow], Mt = fmaxf(m_prev, tb[128 + trow]), ut = -Mt, wint = __expf(m_prev - Mt), einv = __expf(-(bct + Mt)); \
            f32x4 s[4]; \
            _Pragma("unroll") for (int jt = 0; jt < 4; ++jt) { \
                if (jt <= tt) { \
                    f32x4 acc = {0.f, 0.f, 0.f, 0.f}; \
                    _Pragma("unroll") for (int ks = 0; ks < 4; ++ks) acc = mfma16(*(const LAS bf16x8*)(L + M_KS + (16 * jt + c) * M_RS + 64 * ks + 16 * g), Bq[ks], acc); \
                    const f32x4 wjj = *(const LAS f32x4*)(tb + 64 + 16 * jt + 4 * g); \
                    _Pragma("unroll") for (int r = 0; r < 4; ++r) { const int j = 16 * jt + 4 * g + r; acc[r] = (j <= trow) ? acc[r] * __expf(ut + wjj[r]) : 0.f; } \
                    s[jt] = acc; \
                } else s[jt] = (f32x4){0.f, 0.f, 0.f, 0.f}; \
            } \
            bf16x8 Bs[2]; \
            _Pragma("unroll") for (int k2 = 0; k2 < 2; ++k2) { v4u w; w.x = pk2(s[2 * k2][0], s[2 * k2][1]); w.y = pk2(s[2 * k2][2], s[2 * k2][3]); w.z = pk2(s[2 * k2 + 1][0], s[2 * k2 + 1][1]); w.w = pk2(s[2 * k2 + 1][2], s[2 * k2 + 1][3]); Bs[k2] = __builtin_bit_cast(bf16x8, w); } \
            f32x4 nm[3]; \
            _Pragma("unroll") for (int vt = 0; vt < 3; ++vt) { \
                f32x4 acc = {0.f, 0.f, 0.f, 0.f}; \
                _Pragma("unroll") for (int ks = 0; ks < 4; ++ks) acc = mfma16(*(const LAS bf16x8*)(L + M_CT + cur * M_CTB + (16 * vt + c) * M_RS + 64 * ks + 16 * g), Bq[ks], acc); \
                acc = acc * wint; \
                _Pragma("unroll") for (int k2 = 0; k2 < 2; ++k2) { \
                    if (2 * k2 <= tt) { const LAS unsigned char* vp = L + M_VT + (16 * vt + c) * M_TS + (32 * k2 + 4 * g) * 2; const v2u lo = *(const LAS v2u*)vp, hi = *(const LAS v2u*)(vp + 32); const v4u av_ = {lo.x, lo.y, hi.x, hi.y}; \
                        acc = mfma16(__builtin_bit_cast(bf16x8, av_), Bs[k2], acc); } \
                } \
                nm[vt] = acc; \
            } \
            const float den = pg8::shl_from(nm[2][0], c); \
            const float inv = 1.0f / fmaxf(fabsf(den), einv); \
            float hss = 0.f; \
            _Pragma("unroll") for (int vt = 0; vt < 2; ++vt) _Pragma("unroll") for (int r = 0; r < 4; ++r) { nm[vt][r] *= inv; hss += nm[vt][r] * nm[vt][r]; } \
            hss += pg8::shx(hss, 16, lane); hss += pg8::shx(hss, 32, lane); \
            if (trow < nvalid) { \
                const size_t grow = (size_t)b * LP + t0 + trow; \
                _Pragma("unroll") for (int vt = 0; vt < 2; ++vt) { const int col = h * MDV + VS * sl + 16 * vt + 4 * g; \
                    const v2u ow = vt == 0 ? po0 : po1; const f32x4 gn = *(const f32x4*)(P.gnorm + col); \
                    v2u w; w.x = pk2(sigmoidf_(bf_lo(ow.x)) * gn[0] * nm[vt][0], sigmoidf_(bf_hi(ow.x)) * gn[1] * nm[vt][1]); w.y = pk2(sigmoidf_(bf_lo(ow.y)) * gn[2] * nm[vt][2], sigmoidf_(bf_hi(ow.y)) * gn[3] * nm[vt][3]); \
                    *(GAS v2u*)(P.AO + grow * D + col) = w; } \
                if (g == 0) P.HSS[grow * 32 + h * 8 + sl] = hss; \
            } \
            if ((ch) + 1 < 33) ML_OLOAD((ch) + 1); \
        } else { \
            const int w4 = wave - 4, nxt = cur ^ 1; \
            _Pragma("unroll") for (int i = 0; i < 6; ++i) cacc[i] = cacc[i] * a; \
            _Pragma("unroll") for (int k2 = 0; k2 < 2; ++k2) { \
                bf16x8 Bv[3]; \
                _Pragma("unroll") for (int vt = 0; vt < 3; ++vt) Bv[vt] = *(const LAS bf16x8*)(L + M_VW + (16 * vt + c) * M_TS + 64 * k2 + 16 * g); \
                _Pragma("unroll") for (int dd = 0; dd < 2; ++dd) { const bf16x8 Ak = *(const LAS bf16x8*)(L + M_KT + (16 * (2 * w4 + dd) + c) * M_TS + 64 * k2 + 16 * g); \
                    _Pragma("unroll") for (int vt = 0; vt < 3; ++vt) cacc[dd * 3 + vt] = mfma16(Ak, Bv[vt], cacc[dd * 3 + vt]); } \
            } \
            _Pragma("unroll") for (int dd = 0; dd < 2; ++dd) _Pragma("unroll") for (int vt = 0; vt < 3; ++vt) { const f32x4 v = cacc[dd * 3 + vt]; v2u w; w.x = pk2(v[0], v[1]); w.y = pk2(v[2], v[3]); \
                    *(LAS v2u*)(L + M_CT + nxt * M_CTB + (16 * vt + c) * M_RS + (16 * (2 * w4 + dd) + 4 * g) * 2) = w; } \
        } \
        LDS_BAR(); } while (0)
#pragma unroll 1
    for (int ch = 0; ch < 33; ch += 2) {
        ML_STEP(ch, aq0, aq1, ak0, ak1, av);
        if (ch + 1 < 33) ML_STEP(ch + 1, bq0, bq1, bk0, bk1, bv);
    }
#undef ML_STEP
#undef ML_LOAD
#undef ML_OLOAD
    if (wave >= 4) {
        const int w4 = wave - 4; const size_t sb = ((size_t)jl * NB + b) * MH + h;
#pragma unroll
        for (int dd = 0; dd < 2; ++dd) {
#pragma unroll
            for (int vt = 0; vt < 2; ++vt)
#pragma unroll
                for (int r = 0; r < 4; ++r) out[O_CP + (sb * MDK + 16 * (2 * w4 + dd) + 4 * g + r) * MDV + VS * sl + 16 * vt + c] = cacc[dd * 3 + vt][r];
            if (sl == 0 && c == 0) {
#pragma unroll
                for (int r = 0; r < 4; ++r) out[O_NP + sb * MDK + 16 * (2 * w4 + dd) + 4 * g + r] = cacc[dd * 3 + 2][r]; }
        }
        if (sl == 0 && wave == 4 && lane == 0) out[O_MP + sb] = ((const LAS float*)(L + M_MS))[33];
    }
    LDS_BAR();
}
constexpr int S_Q = 0, S_K = 2048, S_V = 4096, S_P = 8192, S_M = 40960, S_END = 41472;
__device__ __forceinline__ void mlstm_sample_item(LAS unsigned char* L, const MlP& P, const float* stC, const float* stN, const float* stM, float* out, int jl, int db, int h, int tid, int wave, int lane) {
    LAS float* SQ = (LAS float*)(L + S_Q); LAS float* SK = (LAS float*)(L + S_K); LAS float* SV = (LAS float*)(L + S_V); LAS float* SP = (LAS float*)(L + S_P); LAS float* SM = (LAS float*)(L + S_M);
    const size_t r0 = (size_t)MP + db * DSEQ; const size_t sb = ((size_t)jl * DBATCH + db) * MH + h;
    { const int s = tid >> 7, d = tid & 127; const bf16* zr = P.Z + (r0 + s) * NIN; SQ[s * 128 + d] = bf1(zr[h * MDK + d]); SK[s * 128 + d] = bf1(zr[512 + h * MDK + d]);
      SV[s * 256 + 2 * d] = bf1(zr[1024 + h * MDV + 2 * d]); SV[s * 256 + 2 * d + 1] = bf1(zr[1024 + h * MDV + 2 * d + 1]); }
    float li[4], lf[4], bc[4], wjv[4], Mt[4];
#pragma unroll
    for (int s = 0; s < 4; ++s) { li[s] = gate_i(P.G[(r0 + s) * 8 + h]); lf[s] = gate_f(P.G[(r0 + s) * 8 + 4 + h]); }
    const float m0 = stM[sb];
    { float acc = 0.f, cmx = -1e30f;
#pragma unroll
      for (int s = 0; s < 4; ++s) { acc += lf[s]; bc[s] = acc; wjv[s] = li[s] - acc; cmx = fmaxf(cmx, wjv[s]); Mt[s] = fmaxf(m0, cmx); } }
    const float Mx = Mt[3], blast = bc[3], m_new = blast + Mx, a = __expf(m0 - Mx);
    float wk[4];
#pragma unroll
    for (int s = 0; s < 4; ++s) wk[s] = __expf(wjv[s] - Mx);
    LDS_BAR();
    if (wave == 0) { const int p = lane >> 2, qd = lane & 3, t = p >> 2, j = p & 3; float acc = 0.f;
        for (int d = 0; d < 32; ++d) acc += SQ[t * 128 + 32 * qd + d] * SK[j * 128 + 32 * qd + d];
        acc += pg8::shx(acc, 1, lane); acc += pg8::shx(acc, 2, lane);
        const float Mtt = t == 0 ? Mt[0] : t == 1 ? Mt[1] : t == 2 ? Mt[2] : Mt[3], wjj = j == 0 ? wjv[0] : j == 1 ? wjv[1] : j == 2 ? wjv[2] : wjv[3];
        if (qd == 0) SM[p] = (j <= t) ? acc * __expf(wjj - Mtt) : 0.f; }
    if (wave == 1) { const int t = lane >> 4, part = lane & 15; float acc = 0.f;
        for (int d = 0; d < 8; ++d) acc += SQ[t * 128 + 8 * part + d] * stN[sb * MDK + 8 * part + d];
        acc += pg8::shx(acc, 1, lane); acc += pg8::shx(acc, 2, lane); acc += pg8::shx(acc, 4, lane); acc += pg8::shx(acc, 8, lane);
        if (part == 0) SM[16 + t] = acc; }
    { const int vq = tid & 63, dg = tid >> 6; const float* c0p = stC + sb * MDK * MDV; float* c1p = out + O_CS + sb * MDK * MDV;
      f32x4 vj[4];
#pragma unroll
      for (int j = 0; j < 4; ++j) vj[j] = *(const LAS f32x4*)(SV + j * 256 + 4 * vq);
      f32x4 acc[4];
#pragma unroll
      for (int t = 0; t < 4; ++t) acc[t] = (f32x4){0.f, 0.f, 0.f, 0.f};
#pragma unroll 8
      for (int i = 0; i < 16; ++i) { const int dk = 16 * dg + i; const f32x4 c0 = *(const GAS f32x4*)(c0p + (size_t)dk * MDV + 4 * vq);
          f32x4 cn = c0 * a;
#pragma unroll
          for (int t = 0; t < 4; ++t) { acc[t] += c0 * SQ[t * 128 + dk]; cn += vj[t] * (wk[t] * SK[t * 128 + dk]); }
          *(GAS f32x4*)(c1p + (size_t)dk * MDV + 4 * vq) = cn; }
#pragma unroll
      for (int t = 0; t < 4; ++t) *(LAS f32x4*)(SP + (dg * 4 + t) * 256 + 4 * vq) = acc[t];
    }
    if (tid < 128) { float nn = a * stN[sb * MDK + tid];
#pragma unroll
        for (int j = 0; j < 4; ++j) nn += wk[j] * SK[j * 128 + tid];
        out[O_NS + sb * MDK + tid] = nn; }
    if (tid == 0) out[O_MS + sb] = m_new;
    LDS_BAR();
    if (tid < 256) { const int v = tid; float hv[4];
#pragma unroll
        for (int t = 0; t < 4; ++t) { float qc = 0.f;
#pragma unroll
            for (int dg = 0; dg < 8; ++dg) qc += SP[(dg * 4 + t) * 256 + v];
            const float wint = __expf(m0 - Mt[t]); float num = wint * qc, den = wint * SM[16 + t];
#pragma unroll
            for (int j = 0; j < 4; ++j) { const float sc = SM[t * 4 + j]; num += sc * SV[j * 256 + v]; den += sc; }
            hv[t] = num / fmaxf(fabsf(den), __expf(-(bc[t] + Mt[t]))); }
#pragma unroll
        for (int t = 0; t < 4; ++t) { const float q = wave_sum(hv[t] * hv[t], lane); if (lane == 0) SM[32 + wave * 4 + t] = q; }
        const float gn = P.gnorm[h * MDV + v];
#pragma unroll
        for (int t = 0; t < 4; ++t) { const float o = bf1(P.Z[(r0 + t) * NIN + 2048 + h * MDV + v]); P.AO[(r0 + t) * D + h * MDV + v] = (bf16)f2bf(sigmoidf_(o) * gn * hv[t]); }
    }
    LDS_BAR();
    if (tid < 32) { const int t = tid >> 3, slot = tid & 7; P.HSS[(r0 + t) * 32 + h * 8 + slot] = (slot == 0) ? (SM[32 + t] + SM[36 + t]) + (SM[40 + t] + SM[44 + t]) : 0.f; }
    LDS_BAR();
}
__device__ __forceinline__ void mlstm_phase(LAS unsigned char* L, const MlP& P, const float* stC, const float* stN, const float* stM, float* out, int jl, int vcu, int G, int tid_in, int wave_in, int lane_in) {
    constexpr int N_PROMPT = NB * MH * NSL, N_ITEMS = N_PROMPT + DBATCH * MH;
#pragma unroll 1
    for (int it = vcu; it < N_ITEMS; it += G) {
        int tid = tid_in; asm volatile("" : "+v"(tid));
        const int lane = tid & 63, wave = __builtin_amdgcn_readfirstlane(tid >> 6);
        if (it < N_PROMPT) { const int bh = it / NSL, sl = it % NSL; mlstm_prompt_item(L, P, out, jl, bh / MH, bh % MH, sl, tid, wave, lane); }
        else { const int si = it - N_PROMPT; mlstm_sample_item(L, P, stC, stN, stM, out, jl, si / MH, si % MH, tid, wave, lane); }
    }
}
__device__ __forceinline__ void mlstm_fixup(bf16* AO, const float* HSS, int vcu, int G, int wave, int lane) {
    const int gw = vcu * NWAVES + wave, NGW = G * NWAVES;
    for (int m = gw; m < MTOT; m += NGW) {
        const int hd = lane >> 4; const f32x4 a = *(const GAS f32x4*)(HSS + (size_t)m * 32 + hd * 8), bq = *(const GAS f32x4*)(HSS + (size_t)m * 32 + hd * 8 + 4);
        const float r = 1.0f / sqrtf((((a[0] + a[1]) + (a[2] + a[3])) + ((bq[0] + bq[1]) + (bq[2] + bq[3]))) * (1.0f / 256.0f) + EPS);
        GAS v4u* p = (GAS v4u*)(AO + (size_t)m * D + 16 * lane);
#pragma unroll
        for (int i = 0; i < 2; ++i) { float f[8]; unpack8(p[i], f);
#pragma unroll
            for (int e = 0; e < 8; ++e) f[e] *= r;
            p[i] = pack8(f); }
    }
}

struct Args { const float* in[23]; float* out; unsigned char* ws; };
constexpr int PTAB_OFF = LDSCTL_OFF + 1024;
__device__ __forceinline__ unsigned long long ld_ptr(volatile LAS unsigned* T, int i) {
    const unsigned lo = __builtin_amdgcn_readfirstlane(T[2 * i]), hi = __builtin_amdgcn_readfirstlane(T[2 * i + 1]);
    return ((unsigned long long)hi << 32) | lo;
}
constexpr int CHAIN_OFF = LDSCTL_OFF + 2048;
constexpr int CW_CNT = 16384, CW_HEAD = CW_CNT + 6 * 67 * 64;
static_assert((CW_HEAD + 21 * 8 * 64) * 4 <= (int)CTL_ZERO_BYTES, "control words inside the memset region");
__device__ __forceinline__ void put64(volatile LAS unsigned* c, int i, const void* p) { const unsigned long long v = (unsigned long long)p; c[i] = (unsigned)v; c[i + 1] = (unsigned)(v >> 32); }
__device__ __forceinline__ void chain_common(volatile LAS unsigned* c, unsigned char* ws, float* out, int nseg, int n0, int n1, int n2, int n3, int head_idx, int zldc, const float* bgate) {
    c[pg8::CC + 0] = (unsigned)nseg; c[pg8::CC + 1] = 0u; put64(c, pg8::CC + 2, (unsigned*)(ws + WS_CTL) + CW_HEAD + 64 * 8 * head_idx);
    put64(c, pg8::CC + 4, ws + WS_X); put64(c, pg8::CC + 6, ws + WS_XB); put64(c, pg8::CC + 8, ws + WS_SS); put64(c, pg8::CC + 10, ws + WS_Z); put64(c, pg8::CC + 12, ws + WS_FF);
    put64(c, pg8::CC + 14, ws + WS_G); put64(c, pg8::CC + 16, bgate); put64(c, pg8::CC + 18, out + O_YP); put64(c, pg8::CC + 20, out + O_YS); c[pg8::CC + 22] = (unsigned)zldc;
    put64(c, pg8::CC + 30, ws + WS_PT);
    c[pg8::CCUM + 0] = 0u; c[pg8::CCUM + 1] = (unsigned)n0; c[pg8::CCUM + 2] = (unsigned)(n0 + n1); c[pg8::CCUM + 3] = (unsigned)(n0 + n1 + n2); c[pg8::CCUM + 4] = (unsigned)(n0 + n1 + n2 + n3);
}
__device__ __forceinline__ void chain_seg(volatile LAS unsigned* c, int s, const void* A, const void* Bt, int K, int nN, int kind, int first, unsigned need, const unsigned* dep, const unsigned* done, int ld = 0, int lpoff = 0, int cap = 9, int nsub = 1) {
    put64(c, 16 * s + 0, A); put64(c, 16 * s + 2, Bt); c[16 * s + 4] = (unsigned)K; c[16 * s + 5] = (unsigned)nN; c[16 * s + 6] = (unsigned)kind; c[16 * s + 7] = (unsigned)first; c[16 * s + 8] = need;
    c[16 * s + 9] = (unsigned)(ld ? ld : K); put64(c, 16 * s + 10, dep); put64(c, 16 * s + 12, done); c[16 * s + 14] = (unsigned)lpoff | ((unsigned)cap << 8) | ((unsigned)nsub << 16);
}
__device__ __forceinline__ void chain_totals(volatile LAS unsigned* c, int nseg) {
    unsigned t8 = 0u, t9 = 0u;
    for (int s = 0; s < nseg; ++s) { const unsigned w = c[16 * s + 14]; const int lpoff = (int)(w & 0xffu), cap = (int)((w >> 8) & 0xffu), nsub = (int)(w >> 16), nN = (int)c[16 * s + 5];
        int a = 8 - lpoff; a = a < 0 ? 0 : (a > cap ? cap : a); int b = 9 - lpoff; b = b < 0 ? 0 : (b > cap ? cap : b); t8 += (unsigned)(a * nN * nsub); t9 += (unsigned)(b * nN * nsub); }
    c[pg8::CC + 1] = t8; c[pg8::CC + 23] = t9;
}
__device__ __forceinline__ void down_tail_finalize(unsigned char* ws, float* out, bool final_layer, int vcu, int G, int wave, int lane) {
    const int gw = vcu * NWAVES + wave, NGW = G * NWAVES;
    bf16* XB = (bf16*)(ws + WS_XB); float* SS = (float*)(ws + WS_SS); const float* P = (const float*)(ws + WS_PT);
    for (int r = gw; r < 768; r += NGW) { const int m = 16384 + r;
        f32x4 v[4]; float ss[4];
#pragma unroll
        for (int j = 0; j < 4; ++j) { const v2u xw = ((const GAS v2u*)(XB + (size_t)m * D))[lane + 64 * j]; v[j] = (f32x4){bf_lo(xw.x), bf_hi(xw.x), bf_lo(xw.y), bf_hi(xw.y)};
#pragma unroll
            for (int kq = 0; kq < 4; ++kq) v[j] = v[j] + ((const GAS f32x4*)(P + ((size_t)kq * 768 + r) * D))[lane + 64 * j]; }
        if (!final_layer) {
#pragma unroll
            for (int j = 0; j < 4; ++j) { v2u w; w.x = pk2(v[j][0], v[j][1]); w.y = pk2(v[j][2], v[j][3]); ((GAS v2u*)(XB + (size_t)m * D))[lane + 64 * j] = w;
                const float a0 = bf_lo(w.x), a1 = bf_hi(w.x), a2 = bf_lo(w.y), a3 = bf_hi(w.y); ss[j] = wave_sum((a0 * a0 + a1 * a1) + (a2 * a2 + a3 * a3), lane); }
            if (lane < 16) { const int j = lane >> 2; const float s = (lane & 3) ? 0.f : (j == 0 ? ss[0] : j == 1 ? ss[1] : j == 2 ? ss[2] : ss[3]); SS[(size_t)m * 16 + lane] = s; }
        } else {
            float* dst = nullptr;
            if (m < MP) { const int b = m / LP, t = m - b * LP; if (t >= NMETA) dst = out + O_YP + ((size_t)b * SEQ + (t - NMETA)) * D; }
            else if (m < MTOT) dst = out + O_YS + (size_t)(m - MP) * D;
            if (dst) {
#pragma unroll
                for (int j = 0; j < 4; ++j) ((GAS f32x4*)dst)[lane + 64 * j] = v[j]; }
        }
    }
}
__global__ void __launch_bounds__(NWAVES * 64, 2) hybrid_fwd(Args args) {
    extern __shared__ __attribute__((aligned(16))) unsigned char lds_raw[];
    LAS unsigned char* lds = (LAS unsigned char*)lds_raw;
    volatile LAS unsigned* MISC = (volatile LAS unsigned*)(lds + MISC_OFF);
    const int wave_s = __builtin_amdgcn_readfirstlane((int)threadIdx.x >> 6);
#define GG_ g_o
#define BX_ b_o
#define OPQ_GB() int g_o = (int)gridDim.x, b_o = (int)blockIdx.x; asm volatile("" : "+s"(g_o), "+s"(b_o))
#define VCU_ ((BX_ & 7) * (GG_ >> 3) + (BX_ >> 3))
    for (int u = (int)threadIdx.x; u < (LDS_BYTES - LDSCTL_OFF) / 4; u += NWAVES * 64) ((LAS unsigned*)(lds + LDSCTL_OFF))[u] = 0u;
    __syncthreads();
    volatile LAS unsigned* PT = (volatile LAS unsigned*)(lds + PTAB_OFF);
    if (threadIdx.x == 0) {
#pragma unroll
        for (int i = 0; i < 23; ++i) { const unsigned long long p = (unsigned long long)args.in[i]; PT[2 * i] = (unsigned)p; PT[2 * i + 1] = (unsigned)(p >> 32); }
        { const unsigned long long p = (unsigned long long)args.out; PT[46] = (unsigned)p; PT[47] = (unsigned)(p >> 32); }
        { const unsigned long long p = (unsigned long long)args.ws; PT[48] = (unsigned)p; PT[49] = (unsigned)(p >> 32); }
    }
    __syncthreads();
#define OPAQUE_TID() int tid_p; asm volatile("v_mbcnt_lo_u32_b32 %0, -1, 0\n\tv_mbcnt_hi_u32_b32 %0, -1, %0\n\tv_lshl_add_u32 %0, %1, 6, %0" : "=&v"(tid_p) : "s"(wave_s)); const int lane_p = tid_p & 63, wave_p = __builtin_amdgcn_readfirstlane(tid_p >> 6)
#define PIN(i) ((const float*)(const GAS float*)ld_ptr(PT, (i)))
#define POUT() ((float*)(GAS float*)ld_ptr(PT, 23))
#define PWS() ((unsigned char*)(GAS unsigned char*)ld_ptr(PT, 24))
    (void)xcd_barrier_post((unsigned*)((gu32*)(PWS() + WS_CTL) + CW_BAR), MISC + 8);
#define GRID_BAR() do { XcdBarrier b_; b_.bar = (unsigned*)((gu32*)(PWS() + WS_CTL) + CW_BAR); b_.x = xb_xcc_id(); b_.st = MISC + 8; xcd_barrier(b_); } while (0)

    { OPAQUE_TID(); OPQ_GB(); P0Args A{PIN(0), PIN(1), PIN(7), PIN(9), PIN(10), PIN(11), PIN(15), PIN(16), PIN(17), PIN(20), PIN(21), PIN(22), PWS()};
#ifndef NO_P0
      p0_prologue(A, lds, VCU_, GG_, wave_p, lane_p, tid_p);
#ifdef PROBE_P02
      GRID_BAR();
      p0_prologue(A, lds, VCU_, GG_, wave_p, lane_p, tid_p);
#endif
#endif
    }
    GRID_BAR();
    volatile LAS unsigned* CH = (volatile LAS unsigned*)(lds + CHAIN_OFF);
#pragma unroll 1
    for (;;) {
        int ito = MISC_OFF + 48; asm volatile("" : "+s"(ito)); volatile LAS unsigned* itp = (volatile LAS unsigned*)(lds + ito);
        const int it = (int)__builtin_amdgcn_readfirstlane(*itp);
        if (it > 4) break;
        const int layer = it - 1, jl = layer >> 1;
        if (it >= 1) {
            if ((layer & 1) == 0) {
                { OPAQUE_TID(); OPQ_GB(); unsigned char* ws = PWS(); AttnP P{(const bf16*)(ws + WS_Z), PIN(12) + jl * AHD, PIN(13) + jl * AHD, PIN(14) + jl * AH, PIN(8), (bf16*)(ws + WS_AO)};
#ifndef NO_ATTN
                  attn_phase(lds + RING_OFF, P, PIN(2), PIN(3), POUT(), jl, VCU_, GG_, tid_p, wave_p, lane_p);
#ifdef PROBE_ATTN2
                  GRID_BAR();
                  attn_phase(lds + RING_OFF, P, PIN(2), PIN(3), POUT(), jl, VCU_, GG_, tid_p, wave_p, lane_p);
#endif
#endif
                }
                GRID_BAR();
            } else {
                { OPAQUE_TID(); OPQ_GB(); unsigned char* ws = PWS(); MlP P{(const bf16*)(ws + WS_Z), (const float*)(ws + WS_G), PIN(19) + jl * D, (bf16*)(ws + WS_AO), (float*)(ws + WS_HSS)};
#ifndef NO_MLSTM
                  mlstm_phase(lds + RING_OFF, P, PIN(4), PIN(5), PIN(6), POUT(), jl, VCU_, GG_, tid_p, wave_p, lane_p);
#ifdef PROBE_MLSTM2
                  GRID_BAR();
                  mlstm_phase(lds + RING_OFF, P, PIN(4), PIN(5), PIN(6), POUT(), jl, VCU_, GG_, tid_p, wave_p, lane_p);
#endif
#endif
                }
                GRID_BAR();
                { OPAQUE_TID(); OPQ_GB(); unsigned char* ws = PWS(); mlstm_fixup((bf16*)(ws + WS_AO), (const float*)(ws + WS_HSS), VCU_, GG_, wave_p, lane_p); }
                GRID_BAR();
            }
        }
#define RUN_CHAIN(SETUP) do { OPAQUE_TID(); OPQ_GB(); if (tid_p == 0) { unsigned char* ws = PWS(); SETUP const int sh_ = GG_ >> 3, v_ = VCU_; CH[pg8::CQ] = (unsigned)(v_ / sh_); CH[pg8::CQ + 1] = (unsigned)(v_ % sh_); CH[pg8::CQ + 2] = (unsigned)sh_; } __syncthreads(); pg8::gemm_chain(lds + RING_OFF, CH, tid_p); } while (0)
        if (it == 0) {
            RUN_CHAIN( chain_common(CH, ws, POUT(), 1, 6, 0, 0, 0, 4 * 3 + 0, NQKV, nullptr);
                       chain_seg(CH, 0, ws + WS_XB, ws + WS_WQKV, D, 6, pg8::CK_NORM, 0, 0u, nullptr, nullptr); chain_totals(CH, 1); );
        } else {
            RUN_CHAIN( chain_common(CH, ws, POUT(), 1, 4, 0, 0, 0, layer * 3 + 0, NQKV, nullptr);
                       chain_seg(CH, 0, ws + WS_AO, (layer & 1) ? ws + WS_WOUT + jl * SZ_WO : ws + WS_WO + jl * SZ_WO, D, 4, pg8::CK_RESID, 0, 0u, nullptr, nullptr); chain_totals(CH, 1); );
            GRID_BAR();
            RUN_CHAIN( chain_common(CH, ws, POUT(), 1, 16, 0, 0, 0, layer * 3 + 1, NQKV, nullptr);
                       chain_seg(CH, 0, ws + WS_XB, ws + WS_WUP + layer * SZ_WUP, D, 16, pg8::CK_UP, 0, 0u, nullptr, nullptr); chain_totals(CH, 1); );
            GRID_BAR();
            RUN_CHAIN( chain_common(CH, ws, POUT(), 2, 4, 4, 0, 0, 13 + layer, NQKV, nullptr);
                       chain_seg(CH, 0, ws + WS_FF, ws + WS_WDN + layer * SZ_WUP, FF, 4, layer < 3 ? pg8::CK_RESID : pg8::CK_FINAL, 0, 0u, nullptr, nullptr, FF, 0, 8, 1);
                       chain_seg(CH, 1, ws + WS_FF, ws + WS_WDN + layer * SZ_WUP, D, 4, pg8::CK_PART, 0, 0u, nullptr, nullptr, FF, 8, 1, 4);
                       chain_totals(CH, 2); );
            GRID_BAR();
            { OPAQUE_TID(); OPQ_GB(); down_tail_finalize(PWS(), POUT(), layer == 3, VCU_, GG_, wave_p, lane_p); }
            if (layer < 3) {
                GRID_BAR();
                const int nl = layer + 1, njl = nl >> 1; const bool nml = (nl & 1) != 0;
                RUN_CHAIN( chain_common(CH, ws, POUT(), 1, nml ? 13 : 6, 0, 0, 0, layer * 3 + 2, nml ? NIN : NQKV, nml ? PIN(18) + njl * 8 : nullptr);
                           chain_seg(CH, 0, ws + WS_XB, nml ? ws + WS_WIN + njl * SZ_WIN : ws + WS_WQKV + njl * SZ_WQKV, D, nml ? 13 : 6, nml ? pg8::CK_NORM_GATES : pg8::CK_NORM, 0, 0u, nullptr, nullptr); chain_totals(CH, 1); );
#ifdef PROBE_INPROJ2
                GRID_BAR();
                RUN_CHAIN( chain_common(CH, ws, POUT(), 1, nml ? 13 : 6, 0, 0, 0, 16 + layer, nml ? NIN : NQKV, nml ? PIN(18) + njl * 8 : nullptr);
                           chain_seg(CH, 0, ws + WS_XB, nml ? ws + WS_WIN + njl * SZ_WIN : ws + WS_WQKV + njl * SZ_WQKV, D, nml ? 13 : 6, nml ? pg8::CK_NORM_GATES : pg8::CK_NORM, 0, 0u, nullptr, nullptr); );
#endif
            }
#ifdef PROBE_DOWN_SPLIT
            if (layer == 0) { GRID_BAR();
                RUN_CHAIN( chain_common(CH, ws, POUT(), 2, 4, 4, 0, 0, 20, NQKV, nullptr);
                       chain_seg(CH, 0, ws + WS_FF, ws + WS_WDN + layer * SZ_WUP, FF, 4, pg8::CK_FINAL, 0, 0u, nullptr, nullptr, FF, 0, 8, 1);
                       chain_seg(CH, 1, ws + WS_FF, ws + WS_WDN + layer * SZ_WUP, D, 4, pg8::CK_PART, 0, 0u, nullptr, nullptr, FF, 8, 1, 4);
                       chain_totals(CH, 2); ); }
#endif
#ifdef PROBE_DOWN_WHOLE
            if (layer == 0) { GRID_BAR();
                RUN_CHAIN( chain_common(CH, ws, POUT(), 1, 4, 0, 0, 0, 20, NQKV, nullptr);
                       chain_seg(CH, 0, ws + WS_FF, ws + WS_WDN + layer * SZ_WUP, FF, 4, pg8::CK_FINAL, 0, 0u, nullptr, nullptr);
                       chain_totals(CH, 1); ); }
#endif
#ifdef PROBE_UP
            if (layer == 0) { GRID_BAR();
                RUN_CHAIN( chain_common(CH, ws, POUT(), 1, 16, 0, 0, 0, 20, NQKV, nullptr);
                       chain_seg(CH, 0, ws + WS_XB, ws + WS_WUP + layer * SZ_WUP, D, 16, pg8::CK_UP, 0, 0u, nullptr, nullptr); chain_totals(CH, 1); ); }
#endif
        }
#undef RUN_CHAIN
        if (it < 4) GRID_BAR();
        { OPAQUE_TID(); __syncthreads();
          int itq_o = MISC_OFF + 48; asm volatile("" : "+s"(itq_o)); volatile LAS unsigned* itq = (volatile LAS unsigned*)(lds + itq_o);
          if (tid_p == 0) *itq = *itq + 1u;
          __syncthreads(); }
    }
#undef PIN
#undef OPAQUE_TID
#undef GRID_BAR
#undef GG_
#undef OPQ_GB
#undef BX_
#undef VCU_
#undef POUT
#undef PWS
}

extern "C" void kernel_launch(void* const* d_in, const int* in_sizes, int n_in, void* d_out, int out_size, void* d_ws, size_t ws_size, hipStream_t stream) {
    static int grid = 0;
    if (grid == 0) {
        if (n_in != 23 || ws_size < WS_END) { fprintf(stderr, "kernel_launch: built for 23 inputs, %zu outputs, >= %zu bytes of workspace; got n_in %d, out %d, ws %zu; nothing launched\n", (size_t)O_END, (size_t)WS_END, n_in, out_size, ws_size); grid = -1; return; }
        int dev = 0, cus = 0, per_cu = 0;
        if (hipGetDevice(&dev) != hipSuccess || hipDeviceGetAttribute(&cus, hipDeviceAttributeMultiprocessorCount, dev) != hipSuccess) { fprintf(stderr, "kernel_launch: device query failed\n"); grid = -1; return; }
        if (hipFuncSetAttribute((const void*)hybrid_fwd, hipFuncAttributeMaxDynamicSharedMemorySize, LDS_BYTES) != hipSuccess) { fprintf(stderr, "kernel_launch: hipFuncSetAttribute failed\n"); grid = -1; return; }
        if (hipOccupancyMaxActiveBlocksPerMultiprocessor(&per_cu, (const void*)hybrid_fwd, NWAVES * 64, LDS_BYTES) != hipSuccess || per_cu < 1)
            fprintf(stderr, "kernel_launch: note: occupancy query reports %d workgroups per CU\n", per_cu);
        (void)hipGetLastError();
        grid = cus - (cus % 8);
    }
    if (grid < 0) return;
    if (hipMemsetAsync((char*)d_ws + WS_CTL, 0, CTL_ZERO_BYTES, stream) != hipSuccess) { fprintf(stderr, "kernel_launch: hipMemsetAsync failed\n"); return; }
    Args a{};
    for (int i = 0; i < 23; ++i) a.in[i] = (const float*)d_in[i];
    a.out = (float*)d_out; a.ws = (unsigned char*)d_ws;
    hipLaunchKernelGGL(hybrid_fwd, dim3(grid), dim3(NWAVES * 64), LDS_BYTES, stream, a);
    const hipError_t le = hipPeekAtLastError();
    if (le != hipSuccess) fprintf(stderr, "kernel_launch: launch failed: %s\n", hipGetErrorName(le));
}
```

```cpp
#include <hip/hip_runtime.h>
#include <cstdio>
#include <cstdint>
namespace pg8 {
#define PG8_LAS __attribute__((address_space(3)))
typedef unsigned short bf16_t;
typedef short bf16x8 __attribute__((ext_vector_type(8)));
typedef float f32x4 __attribute__((ext_vector_type(4)));
typedef unsigned u32x4 __attribute__((ext_vector_type(4)));
constexpr int BM = 256, BK = 64, HALF = 128, HTB = HALF * BK * 2  , STAGE_BYTES = 8 * HTB, NXCD = 8, WGM = 8;

__host__ __device__ __forceinline__ int lds_byte(int r, int c) { const int st = (r >> 4) * 2 + (c >> 5), rr = r & 15, cc = c & 31, ob = rr * 64 + cc * 2; return st * 1024 + (ob ^ (((ob >> 9) & 1) << 5)); }
__host__ __device__ __forceinline__ void stage_rc(int b, int& R, int& C) { const int st = b / 1024, sb = b % 1024, swz = sb ^ (((sb >> 9) & 1) << 5); R = (st >> 1) * 16 + swz / 64; C = (st & 1) * 32 + (swz % 64) / 2; }
__host__ __device__ __forceinline__ int perm32(int rho) { const int n = rho >> 4, i = rho & 15; return 8 * (i >> 2) + 4 * n + (i & 3); }

struct Unit { int pm, pn; };
struct Gemm { const bf16_t* A; const bf16_t* Bt; int M, N, K; };

struct StaticOrder {
    int nM, nN, nwg, G, c;
    __host__ __device__ void init(int M, int N, int G_, int c_) { nM = M / BM; nN = N / BM; nwg = nM * nN; G = G_; c = c_; }
    __host__ __device__ bool next(int i, Unit& u) const {
        const long L = (long)i * G + c; if (L >= nwg) return false;
        int wgid = (int)L; { const int q = nwg / NXCD, r = nwg % NXCD, xcd = wgid % NXCD, off = wgid / NXCD; wgid = (xcd < r ? xcd * (q + 1) : r * (q + 1) + (xcd - r) * q) + off; }
        const int nig = WGM * nN, gid = wgid / nig, fm = gid * WGM, gsz = (nM - fm) < WGM ? (nM - fm) : WGM;
        u.pm = fm + ((wgid % nig) % gsz); u.pn = (wgid % nig) / gsz; return true;
    }
    __device__ __forceinline__ void a_ready(const Unit&) const {}
    __device__ __forceinline__ void done(const Unit&) const {}
};
__device__ __forceinline__ unsigned cvt_pk_bf16(float lo, float hi) { unsigned r; asm volatile("v_cvt_pk_bf16_f32 %0, %1, %2" : "=v"(r) : "v"(lo), "v"(hi)); return r; }
__device__ __forceinline__ float shx(float v, int mask, int lane) { return __builtin_bit_cast(float, __builtin_amdgcn_ds_bpermute((lane ^ mask) << 2, __builtin_bit_cast(int, v))); }
__device__ __forceinline__ float shl_from(float v, int src) { return __builtin_bit_cast(float, __builtin_amdgcn_ds_bpermute(src << 2, __builtin_bit_cast(int, v))); }
typedef unsigned u32x2 __attribute__((ext_vector_type(2)));
constexpr int RM_MP = 16512, RM_MTOT = 17024, RM_LP = 2064, RM_META = 16, RM_SEQ = 2048;
__device__ __forceinline__ float row_rscale(const float* SS, int row) {
    const f32x4* p = (const f32x4*)(SS + (size_t)row * 16); const f32x4 a = p[0], b = p[1], c = p[2], d = p[3];
    const float s = ((a[0] + a[1]) + (a[2] + a[3])) + ((b[0] + b[1]) + (b[2] + b[3])) + ((c[0] + c[1]) + (c[2] + c[3])) + ((d[0] + d[1]) + (d[2] + d[3]));
    return 1.0f / sqrtf(s * (1.0f / 1024.0f) + 1e-6f);
}
__device__ __forceinline__ float softcap15(float x) { return 15.0f * tanhf(x * (1.0f / 15.0f)); }
__device__ __forceinline__ float logsigmoidf(float x) { return x < 0.f ? x - log1pf(expf(x)) : -log1pf(expf(-x)); }
template <int ACT, bool GATES> struct EpiNormBf16 {
    static constexpr bool PERM = true, AFTER_DRAIN = false;
    bf16_t* O; int ldc; const float* SS; float* G; const float* bgate; int gate_pn;
    __device__ __forceinline__ void operator()(const f32x4 (&acc)[2][2][4][2], const Unit& u, int wr, int wc, int fr, int fq) const {
        const int row0 = u.pm * BM + wr * 64 + fr;
        if (GATES && u.pn == gate_pn) {
            if (wc == 0 && fq == 0) {
                const f32x4 b0 = *(const f32x4*)bgate, b1 = *(const f32x4*)(bgate + 4);
#pragma unroll
                for (int ai = 0; ai < 2; ++ai)
#pragma unroll
                    for (int m = 0; m < 4; ++m) { const int row = row0 + ai * HALF + m * 16; const float r = row_rscale(SS, row);
                        f32x4 gi = acc[ai][0][m][0] * r + b0, gf = acc[ai][0][m][1] * r + b1;
#pragma unroll
                        for (int j = 0; j < 4; ++j) { gi[j] = softcap15(gi[j]); gf[j] = logsigmoidf(softcap15(gf[j])); }
                        *(f32x4*)(G + (size_t)row * 8) = gi; *(f32x4*)(G + (size_t)row * 8 + 4) = gf; }
            }
            return;
        }
        const int col0 = u.pn * BM + wc * 32 + 8 * fq;
#pragma unroll
        for (int ai = 0; ai < 2; ++ai)
#pragma unroll
            for (int m = 0; m < 4; ++m) { const int row = row0 + ai * HALF + m * 16; const float r = row_rscale(SS, row); bf16_t* rowp = O + (size_t)row * ldc + col0;
#pragma unroll
                for (int bj = 0; bj < 2; ++bj) { f32x4 v0 = acc[ai][bj][m][0] * r, v1 = acc[ai][bj][m][1] * r;
                    if (ACT == 1) {
#pragma unroll
                        for (int j = 0; j < 4; ++j) { const float a = fmaxf(v0[j], 0.f), b = fmaxf(v1[j], 0.f); v0[j] = a * a; v1[j] = b * b; } }
                    u32x4 w; w.x = cvt_pk_bf16(v0[0], v0[1]); w.y = cvt_pk_bf16(v0[2], v0[3]); w.z = cvt_pk_bf16(v1[0], v1[1]); w.w = cvt_pk_bf16(v1[2], v1[3]);
                    *(u32x4*)(rowp + bj * HALF) = w; } }
    }
};
template <bool FINAL> struct EpiResid {
    static constexpr bool PERM = false, AFTER_DRAIN = false;
    float* X; bf16_t* Xb; float* SS; float* y_prompt; float* y_sample;
    __device__ __forceinline__ void operator()(const f32x4 (&acc)[2][2][4][2], const Unit& u, int wr, int wc, int fr, int fq) const {
        const int row0 = u.pm * BM + wr * 64 + fr, col0 = u.pn * BM + wc * 32 + 4 * fq;
#pragma unroll
        for (int ai = 0; ai < 2; ++ai)
#pragma unroll
            for (int m = 0; m < 4; ++m) { const int row = row0 + ai * HALF + m * 16; const size_t off = (size_t)row * 1024 + col0;
                f32x4 x[2][2];
#pragma unroll
                for (int bj = 0; bj < 2; ++bj)
#pragma unroll
                    for (int n = 0; n < 2; ++n) x[bj][n] = *(const f32x4*)(X + off + bj * HALF + n * 16) + acc[ai][bj][m][n];
                if (!FINAL) {
                    float s = 0.f;
#pragma unroll
                    for (int bj = 0; bj < 2; ++bj)
#pragma unroll
                        for (int n = 0; n < 2; ++n) { const f32x4 v = x[bj][n]; *(f32x4*)(X + off + bj * HALF + n * 16) = v; s += (v[0] * v[0] + v[1] * v[1]) + (v[2] * v[2] + v[3] * v[3]);
                            u32x2 w; w.x = cvt_pk_bf16(v[0], v[1]); w.y = cvt_pk_bf16(v[2], v[3]); *(u32x2*)(Xb + off + bj * HALF + n * 16) = w; }
                    s += shx(s, 16, (fr + 16 * fq)); s += shx(s, 32, (fr + 16 * fq));
                    if (fq == 0) SS[(size_t)row * 16 + u.pn * 4 + wc] = s;
                } else {
                    float* dst = nullptr;
                    if (row < RM_MP) { const int b = row / RM_LP, t = row - b * RM_LP; if (t >= RM_META) dst = y_prompt + ((size_t)b * RM_SEQ + (t - RM_META)) * 1024 + col0; }
                    else if (row < RM_MTOT) dst = y_sample + (size_t)(row - RM_MP) * 1024 + col0;
                    if (dst) {
#pragma unroll
                        for (int bj = 0; bj < 2; ++bj)
#pragma unroll
                            for (int n = 0; n < 2; ++n) *(f32x4*)(dst + bj * HALF + n * 16) = x[bj][n]; }
                }
            }
    }
};

template <class Epi, class Sched, bool ALIGN_EPI = false, bool SP2 = false>
__device__ __forceinline__ void gemm_phase(PG8_LAS unsigned char* lds, const Gemm g, const Sched& S, const Epi& E) {
    int tid_o = threadIdx.x; asm volatile("" : "+v"(tid_o));
    const int tid = tid_o, wid = __builtin_amdgcn_readfirstlane(tid >> 6), lane = tid & 63, wr = wid >> 2, wc = wid & 3, fr = lane & 15, fq = lane >> 4;
    const int K = g.K, nt = K / BK;
    unsigned voffA[2], voffB[2];
#pragma unroll
    for (int i = 0; i < 2; ++i) { int R, C; stage_rc(tid * 16 + i * 8192, R, C); const int Rb = Epi::PERM ? ((R & ~31) + perm32(R & 31)) : R;
        voffA[i] = (unsigned)(R * K + C) * 2u; voffB[i] = (unsigned)(Rb * K + C) * 2u; }
    const size_t kstep = (size_t)(BK * 2);
    const size_t hstep = (size_t)HALF * K * 2;
    const size_t tstep = 2 * hstep;
    const unsigned ldsw = (unsigned)wid * 1024u;
    const int aoff = lds_byte(wr * 64 + fr, fq * 8), boff = lds_byte(wc * 32 + fr, fq * 8);
#define PG8_SA(b, h) (((b) * 2 + (h)) * HTB)
#define PG8_SB(b, h) ((4 + (b) * 2 + (h)) * HTB)
#define PG8_STAGE(bufoff, gbase, voff) do { _Pragma("unroll") for (int _i = 0; _i < 2; ++_i) \
        __builtin_amdgcn_global_load_lds((const unsigned*)((const char*)(gbase) + (voff)[_i]), (PG8_LAS unsigned*)(lds + (bufoff) + ldsw + _i * 8192), 16, 0, 0); } while (0)
#define PG8_LDA(dst, b, h) do { _Pragma("unroll") for (int m = 0; m < 4; ++m) _Pragma("unroll") for (int k = 0; k < 2; ++k) dst[m][k] = *(const PG8_LAS bf16x8*)(lds + PG8_SA(b, h) + aoff + m * 2048 + k * 1024); } while (0)
#define PG8_LDB(dst, b, h) do { _Pragma("unroll") for (int n = 0; n < 2; ++n) _Pragma("unroll") for (int k = 0; k < 2; ++k) dst[n][k] = *(const PG8_LAS bf16x8*)(lds + PG8_SB(b, h) + boff + n * 2048 + k * 1024); } while (0)
#define PG8_MMA(ai, bj, At, Bt) do { __builtin_amdgcn_s_setprio(1); _Pragma("unroll") for (int m = 0; m < 4; ++m) _Pragma("unroll") for (int n = 0; n < 2; ++n) _Pragma("unroll") for (int k = 0; k < 2; ++k) \
        acc[ai][bj][m][n] = __builtin_amdgcn_mfma_f32_16x16x32_bf16(Bt[n][k], At[m][k], acc[ai][bj][m][n], 0, 0, 0); __builtin_amdgcn_s_setprio(0); } while (0)
#define PG8_WAIT_V(n) asm volatile("s_waitcnt vmcnt(" #n ")" ::: "memory")
#define PG8_WAIT_L(n) asm volatile("s_waitcnt lgkmcnt(" #n ")" ::: "memory")
#define PG8_BAR __builtin_amdgcn_s_barrier()
#define PG8_SCHED __builtin_amdgcn_sched_barrier(0)
    Unit cur, nxt; int ui = 0;
    if (!S.next(0, cur)) return;
    f32x4 acc[2][2][4][2];
#pragma unroll
    for (int a = 0; a < 2; ++a)
#pragma unroll
        for (int b = 0; b < 2; ++b)
#pragma unroll
            for (int m = 0; m < 4; ++m)
#pragma unroll
                for (int n = 0; n < 2; ++n) acc[a][b][m][n] = (f32x4){0.f, 0.f, 0.f, 0.f};
    bf16x8 At[4][2], B0[2][2], B1[2][2];
    const char* cA = (const char*)g.A + (size_t)cur.pm * tstep; const char* cB = (const char*)g.Bt + (size_t)cur.pn * tstep;
    S.a_ready(cur);
    if constexpr (SP2) {
        PG8_STAGE(PG8_SB(0, 0), cB, voffB); PG8_STAGE(PG8_SB(0, 1), cB + hstep, voffB); PG8_STAGE(PG8_SA(0, 0), cA, voffA); PG8_STAGE(PG8_SA(0, 1), cA + hstep, voffA);
        if (wr == 1) PG8_BAR;
        PG8_WAIT_V(2); PG8_BAR;
        PG8_STAGE(PG8_SB(1, 0), cB + kstep, voffB); PG8_STAGE(PG8_SA(1, 0), cA + kstep, voffA); PG8_STAGE(PG8_SB(1, 1), cB + hstep + kstep, voffB);
        PG8_WAIT_V(6); PG8_BAR;
    } else {
        PG8_STAGE(PG8_SB(0, 0), cB, voffB); PG8_STAGE(PG8_SA(0, 0), cA, voffA); PG8_STAGE(PG8_SB(0, 1), cB + hstep, voffB); PG8_STAGE(PG8_SA(0, 1), cA + hstep, voffA);
        if (wr == 1) PG8_BAR;
        PG8_WAIT_V(4); PG8_BAR;
        PG8_STAGE(PG8_SB(1, 0), cB + kstep, voffB); PG8_STAGE(PG8_SA(1, 0), cA + kstep, voffA); PG8_STAGE(PG8_SB(1, 1), cB + hstep + kstep, voffB);
        PG8_WAIT_V(6); PG8_BAR;
    }
    for (;;) {
        const bool has_next = S.next(ui + 1, nxt);
        const char* nA = has_next ? (const char*)g.A + (size_t)nxt.pm * tstep : cA; const char* nB = has_next ? (const char*)g.Bt + (size_t)nxt.pn * tstep : cB;
        for (int t = 0; t < nt; t += 2) {
            const bool last = (t == nt - 2);
            const char* a1 = cA + (size_t)(t + 1) * kstep;
            const char* a2 = last ? nA : cA + (size_t)(t + 2) * kstep; const char* b2 = last ? nB : cB + (size_t)(t + 2) * kstep;
            const char* a3 = a2 + kstep; const char* b3 = b2 + kstep;
            if (last && has_next) S.a_ready(nxt);
            if constexpr (SP2) {
            PG8_LDB(B0, 0, 0); PG8_LDB(B1, 0, 1); PG8_SCHED; PG8_LDA(At, 0, 0); PG8_STAGE(PG8_SA(1, 1), a1 + hstep, voffA);
            PG8_WAIT_V(8); PG8_WAIT_L(0); PG8_BAR; PG8_MMA(0, 0, At, B0); PG8_MMA(0, 1, At, B1); PG8_BAR; PG8_SCHED;
            PG8_LDA(At, 0, 1); PG8_STAGE(PG8_SB(0, 0), b2, voffB); PG8_STAGE(PG8_SB(0, 1), b2 + hstep, voffB); PG8_STAGE(PG8_SA(0, 0), a2, voffA);
            PG8_WAIT_V(8); PG8_WAIT_L(0); PG8_BAR; PG8_MMA(1, 0, At, B0); PG8_MMA(1, 1, At, B1); PG8_BAR; PG8_SCHED;
            PG8_LDB(B0, 1, 0); PG8_LDB(B1, 1, 1); PG8_SCHED; PG8_LDA(At, 1, 0); PG8_STAGE(PG8_SA(0, 1), a2 + hstep, voffA);
            PG8_WAIT_V(8); PG8_WAIT_L(0); PG8_BAR; PG8_MMA(0, 0, At, B0); PG8_MMA(0, 1, At, B1); PG8_BAR; PG8_SCHED;
            PG8_LDA(At, 1, 1); PG8_STAGE(PG8_SB(1, 0), b3, voffB); PG8_STAGE(PG8_SB(1, 1), b3 + hstep, voffB); PG8_STAGE(PG8_SA(1, 0), a3, voffA);
            PG8_WAIT_V(8); PG8_WAIT_L(0); PG8_BAR; PG8_MMA(1, 0, At, B0); PG8_MMA(1, 1, At, B1); PG8_BAR; PG8_SCHED;
            } else {
            PG8_LDB(B0, 0, 0); PG8_SCHED; PG8_LDA(At, 0, 0); PG8_STAGE(PG8_SA(1, 1), a1 + hstep, voffA);
            PG8_WAIT_L(8); PG8_BAR; PG8_WAIT_L(0); PG8_MMA(0, 0, At, B0); PG8_BAR; PG8_SCHED;
            PG8_LDB(B1, 0, 1); PG8_STAGE(PG8_SB(0, 0), b2, voffB);
            PG8_BAR; PG8_WAIT_L(0); PG8_MMA(0, 1, At, B1); PG8_BAR;
            PG8_LDA(At, 0, 1); PG8_STAGE(PG8_SA(0, 0), a2, voffA);
            PG8_BAR; PG8_WAIT_L(0); PG8_MMA(1, 0, At, B0); PG8_BAR; PG8_SCHED;
            PG8_STAGE(PG8_SB(0, 1), b2 + hstep, voffB);
            PG8_WAIT_V(6); PG8_BAR; PG8_MMA(1, 1, At, B1); PG8_BAR;
            PG8_LDB(B0, 1, 0); PG8_SCHED; PG8_LDA(At, 1, 0); PG8_STAGE(PG8_SA(0, 1), a2 + hstep, voffA);
            PG8_WAIT_L(8); PG8_BAR; PG8_WAIT_L(0); PG8_MMA(0, 0, At, B0); PG8_BAR; PG8_SCHED;
            PG8_LDB(B1, 1, 1); PG8_STAGE(PG8_SB(1, 0), b3, voffB);
            PG8_BAR; PG8_WAIT_L(0); PG8_MMA(0, 1, At, B1); PG8_BAR;
            PG8_LDA(At, 1, 1); PG8_STAGE(PG8_SA(1, 0), a3, voffA);
            PG8_BAR; PG8_WAIT_L(0); PG8_MMA(1, 0, At, B0); PG8_BAR; PG8_SCHED;
            PG8_STAGE(PG8_SB(1, 1), b3 + hstep, voffB);
            PG8_WAIT_V(6); PG8_BAR; PG8_MMA(1, 1, At, B1); PG8_BAR;
            }
        }
        if constexpr (ALIGN_EPI) { if (wr == 0) PG8_BAR; }
        if constexpr (!Epi::AFTER_DRAIN) { E(acc, cur, wr, wc, fr, fq); S.done(cur); }
        if (!has_next) break;
#pragma unroll
        for (int a = 0; a < 2; ++a)
#pragma unroll
            for (int b = 0; b < 2; ++b)
#pragma unroll
                for (int m = 0; m < 4; ++m)
#pragma unroll
                    for (int n = 0; n < 2; ++n) acc[a][b][m][n] = (f32x4){0.f, 0.f, 0.f, 0.f};
        cur = nxt; cA = nA; cB = nB; ++ui;
        if constexpr (ALIGN_EPI) { if (wr == 1) PG8_BAR; }
    }
    PG8_WAIT_V(0);
    if constexpr (!ALIGN_EPI) { if (wr == 0) PG8_BAR; }
    PG8_BAR;
    if constexpr (Epi::AFTER_DRAIN) { E.fused(acc, cur, wr, wc, fr, fq, lds, wid, lane); S.done(cur); }
#undef PG8_SA
#undef PG8_SB
#undef PG8_STAGE
#undef PG8_LDA
#undef PG8_LDB
#undef PG8_MMA
#undef PG8_WAIT_V
#undef PG8_WAIT_L
#undef PG8_BAR
#undef PG8_SCHED
}

#define PG8_GAS __attribute__((address_space(1)))
#ifndef CH_X_AUX
#define CH_X_AUX 0
#endif
#ifndef CH_A_AUX
#define CH_A_AUX 0
#endif
enum ChainKind { CK_NORM = 0, CK_NORM_GATES = 1, CK_UP = 2, CK_RESID = 3, CK_FINAL = 4, CK_PART = 5 };
constexpr int CC = 64, CSLOT = 96;
struct UnitD { int valid, seg, pm, pn, K, kind, ld, kq; const char* A; const char* B; };
__device__ __forceinline__ unsigned cw(volatile PG8_LAS unsigned* c, int i) { return (unsigned)__builtin_amdgcn_readfirstlane((int)c[i]); }
__device__ __forceinline__ unsigned long long cp(volatile PG8_LAS unsigned* c, int i) { const unsigned lo = cw(c, i), hi = cw(c, i + 1); return ((unsigned long long)hi << 32) | lo; }
struct CtlV { unsigned v0, v1; };
__device__ __forceinline__ CtlV ctl_snap(volatile PG8_LAS unsigned* c, int lane) { CtlV V; V.v0 = c[lane]; V.v1 = c[64 + lane]; return V; }
__device__ __forceinline__ unsigned cwv(const CtlV& V, int i) { return i < 64 ? (unsigned)__builtin_amdgcn_readlane((int)V.v0, i) : (unsigned)__builtin_amdgcn_readlane((int)V.v1, i - 64); }
__device__ __forceinline__ unsigned cwv0(const CtlV& V, int i) { return (unsigned)__builtin_amdgcn_readlane((int)V.v0, i); }
__device__ __forceinline__ unsigned long long cpv(const CtlV& V, int i) { const unsigned lo = cwv(V, i), hi = cwv(V, i + 1); return ((unsigned long long)hi << 32) | lo; }
__device__ __forceinline__ unsigned long long cpv0(const CtlV& V, int i) { const unsigned lo = cwv0(V, i), hi = cwv0(V, i + 1); return ((unsigned long long)hi << 32) | lo; }
constexpr int CCUM = CC + 24, CQ = CSLOT + 8;
__device__ __forceinline__ int chain_np(int x) { return x < 3 ? 9 : 8; }
__device__ __forceinline__ int seg_count(const CtlV& V, int s, int np) {
    const unsigned w = cwv0(V, 16 * s + 14); const int lpoff = (int)(w & 0xffu), cap = (int)((w >> 8) & 0xffu), nsub = (int)(w >> 16);
    int nps = np - lpoff; nps = nps < 0 ? 0 : (nps > cap ? cap : nps);
    return nps * (int)cwv0(V, 16 * s + 5) * nsub;
}
__device__ __forceinline__ void decode_unit(const CtlV& V, unsigned code, UnitD& u) {
    u.valid = code != 0xffffffffu; u.seg = 0; u.pm = 0; u.pn = 0; u.K = 1024; u.kind = 0; u.ld = 1024; u.kq = 0; u.A = nullptr; u.B = nullptr;
    if (!u.valid) return;
    const int x = (int)(code >> 16), np = chain_np(x); int i = (int)(code & 0xffffu);
    const int nseg = (int)cwv(V, CC); int s = 0;
#pragma unroll
    for (int k = 0; k < 3; ++k) { if (s == k && k + 1 < nseg) { const int cnt = seg_count(V, k, np); if (i >= cnt) { i -= cnt; s = k + 1; } } }
    const unsigned w = cwv0(V, 16 * s + 14); const int lpoff = (int)(w & 0xffu), cap = (int)((w >> 8) & 0xffu), nsub = (int)(w >> 16);
    const int nN = (int)cwv0(V, 16 * s + 5), per = nN * nsub; int lp = i / per, rem = i - lp * per;
    if (nsub == 1 && nN > 4) {
        int nps = np - lpoff; nps = nps < 0 ? 0 : (nps > cap ? cap : nps);
        const int blk = nps * 4, b = i / blk, r2 = i - b * blk, tb = (nN - 4 * b) < 4 ? (nN - 4 * b) : 4;
        const int bb = (nN & 3) == 0 ? (b + x) % (nN >> 2) : b;
        lp = r2 / tb; rem = 4 * bb + (r2 - lp * tb); }
    u.seg = s; u.pm = x + 8 * (lpoff + lp); u.pn = rem / nsub; u.kq = rem - u.pn * nsub; u.K = (int)cwv0(V, 16 * s + 4); u.kind = (int)cwv0(V, 16 * s + 6); u.ld = (int)cwv0(V, 16 * s + 9);
    u.A = (const char*)(const PG8_GAS char*)cpv0(V, 16 * s) + (size_t)u.pm * 512 * u.ld + (size_t)u.kq * 2 * u.K; u.B = (const char*)(const PG8_GAS char*)cpv0(V, 16 * s + 2) + (size_t)u.pn * 512 * u.ld + (size_t)u.kq * 2 * u.K;
}
typedef unsigned cu32x4 __attribute__((ext_vector_type(4)));
__device__ __forceinline__ __amdgpu_buffer_rsrc_t mk_rsrc(unsigned long long p, unsigned bytes) { return __builtin_amdgcn_make_buffer_rsrc((void*)(PG8_GAS void*)p, (short)0, (int)bytes, 0x00020000); }
__device__ __forceinline__ f32x4 ld16_sc1(__amdgpu_buffer_rsrc_t r, unsigned off) { const cu32x4 v = __builtin_amdgcn_raw_buffer_load_b128(r, (int)off, 0, CH_X_AUX); return __builtin_bit_cast(f32x4, v); }
__device__ __forceinline__ void st16_sc1(__amdgpu_buffer_rsrc_t r, unsigned off, f32x4 v) { __builtin_amdgcn_raw_buffer_store_b128(__builtin_bit_cast(cu32x4, v), r, (int)off, 0, CH_X_AUX); }
__device__ __forceinline__ void st16u_sc1(__amdgpu_buffer_rsrc_t r, unsigned off, cu32x4 v) { __builtin_amdgcn_raw_buffer_store_b128(v, r, (int)off, 0, CH_X_AUX); }
__device__ __forceinline__ void st16u_wt(__amdgpu_buffer_rsrc_t r, unsigned off, cu32x4 v) { __builtin_amdgcn_raw_buffer_store_b128(v, r, (int)off, 0, 16); }
constexpr unsigned CH_MPAD = 17152;
constexpr int CH_SSL = 147456;
__device__ __forceinline__ void row_rscales_lds(const PG8_LAS unsigned char* lds, int rloc0, int fr, int fq, float (&rr)[2][4]) {
    f32x4 v[2][4];
#pragma unroll
    for (int ai = 0; ai < 2; ++ai)
#pragma unroll
        for (int m = 0; m < 4; ++m) v[ai][m] = *(const PG8_LAS f32x4*)(lds + CH_SSL + (rloc0 + ai * HALF + m * 16) * 64 + 16 * fq);
#pragma unroll
    for (int ai = 0; ai < 2; ++ai)
#pragma unroll
        for (int m = 0; m < 4; ++m) { float s = (v[ai][m][0] + v[ai][m][1]) + (v[ai][m][2] + v[ai][m][3]); s += shx(s, 16, (fr + 16 * fq)); s += shx(s, 32, (fr + 16 * fq)); rr[ai][m] = __builtin_amdgcn_rsqf(s * (1.0f / 1024.0f) + 1e-6f); }
}
__device__ __forceinline__ void chain_epilogue(const PG8_LAS unsigned char* lds, const CtlV& V, const UnitD& u, const f32x4 (&acc)[2][2][4][2], int wr, int wc, int fr, int fq) {
    const int row0 = u.pm * BM + wr * 64 + fr, colw = wc * 32 + 8 * fq;
    const __amdgpu_buffer_rsrc_t rss = mk_rsrc(cpv(V, CC + 8), CH_MPAD * 64u);
    if (u.kind <= CK_UP) {
        float rr[2][4]; row_rscales_lds(lds, wr * 64 + fr, fr, fq, rr);
        if (u.kind == CK_NORM_GATES && u.pn == 12) {
            if (wc == 0 && fq == 0) { const float* bg = (const float*)(const PG8_GAS float*)cpv(V, CC + 16); float* G = (float*)(PG8_GAS float*)cpv(V, CC + 14);
                const f32x4 b0 = *(const f32x4*)bg, b1 = *(const f32x4*)(bg + 4);
#pragma unroll
                for (int ai = 0; ai < 2; ++ai)
#pragma unroll
                    for (int m = 0; m < 4; ++m) { const int row = row0 + ai * HALF + m * 16; const float r = rr[ai][m];
                        const f32x4 gi = acc[ai][0][m][0] * r + b0, gf = acc[ai][0][m][1] * r + b1;
                        *(f32x4*)(G + (size_t)row * 8) = gi; *(f32x4*)(G + (size_t)row * 8 + 4) = gf; } }
            return;
        }
        const bool up = u.kind == CK_UP; const int ldc = up ? 4096 : (int)cwv(V, CC + 22);
        const unsigned long long obase = up ? cpv(V, CC + 12) : cpv(V, CC + 10);
        const __amdgpu_buffer_rsrc_t ro = mk_rsrc(obase, CH_MPAD * (unsigned)ldc * 2u);
        const int col0 = u.pn * BM + colw;
#pragma unroll
        for (int ai = 0; ai < 2; ++ai)
#pragma unroll
            for (int m = 0; m < 4; ++m) { const int row = row0 + ai * HALF + m * 16; const float r = rr[ai][m];
#pragma unroll
                for (int bj = 0; bj < 2; ++bj) { f32x4 v0 = acc[ai][bj][m][0] * r, v1 = acc[ai][bj][m][1] * r;
                    if (up) {
#pragma unroll
                        for (int j = 0; j < 4; ++j) { const float a = fmaxf(v0[j], 0.f), b = fmaxf(v1[j], 0.f); v0[j] = a * a; v1[j] = b * b; } }
                    cu32x4 w; w.x = cvt_pk_bf16(v0[0], v0[1]); w.y = cvt_pk_bf16(v0[2], v0[3]); w.z = cvt_pk_bf16(v1[0], v1[1]); w.w = cvt_pk_bf16(v1[2], v1[3]);
                    st16u_sc1(ro, ((unsigned)row * (unsigned)ldc + (unsigned)(col0 + bj * HALF)) * 2u, w); } }
        return;
    }
    if (u.kind == CK_PART) {
        float* P = (float*)(PG8_GAS float*)cpv(V, CC + 30) + ((size_t)(u.kq * 3 + (u.pm - 64)) * 256) * 1024; const int colp = u.pn * BM + colw;
#pragma unroll
        for (int ai = 0; ai < 2; ++ai)
#pragma unroll
            for (int m = 0; m < 4; ++m) { float* rp = P + (size_t)(wr * 64 + fr + ai * HALF + m * 16) * 1024 + colp;
#pragma unroll
                for (int bj = 0; bj < 2; ++bj)
#pragma unroll
                    for (int n = 0; n < 2; ++n) *(f32x4*)(rp + bj * HALF + 4 * n) = acc[ai][bj][m][n]; }
        return;
    }
    const __amdgpu_buffer_rsrc_t rxb = mk_rsrc(cpv(V, CC + 6), CH_MPAD * 2048u);
    const int col0 = u.pn * BM + colw;
    cu32x4 xin[4][2];
#define CH_XLOAD(i) do { _Pragma("unroll") for (int bj = 0; bj < 2; ++bj) xin[(i) & 3][bj] = __builtin_amdgcn_raw_buffer_load_b128(rxb, (int)(((unsigned)(row0 + ((i) >> 2) * HALF + ((i) & 3) * 16) * 1024u + (unsigned)(col0 + bj * HALF)) * 2u), 0, CH_X_AUX); } while (0)
    CH_XLOAD(0); CH_XLOAD(1); CH_XLOAD(2);
#define CH_UNPK(W_, v0, v1) do { const cu32x4 q_ = (W_); v0 = (f32x4){__builtin_bit_cast(float, q_.x << 16), __builtin_bit_cast(float, q_.x & 0xffff0000u), __builtin_bit_cast(float, q_.y << 16), __builtin_bit_cast(float, q_.y & 0xffff0000u)}; \
        v1 = (f32x4){__builtin_bit_cast(float, q_.z << 16), __builtin_bit_cast(float, q_.z & 0xffff0000u), __builtin_bit_cast(float, q_.w << 16), __builtin_bit_cast(float, q_.w & 0xffff0000u)}; } while (0)
    if (u.kind == CK_RESID) {
#pragma unroll
        for (int i = 0; i < 8; ++i) { const int ai = i >> 2, m = i & 3; const int row = row0 + ai * HALF + m * 16; const unsigned off = (unsigned)row * 1024u + (unsigned)col0;
            float s = 0.f; cu32x4 xc[2] = {xin[i & 3][0], xin[i & 3][1]};
            if (i + 3 < 8) CH_XLOAD(i + 3);
#pragma unroll
            for (int bj = 0; bj < 2; ++bj) { f32x4 x0, x1; CH_UNPK(xc[bj], x0, x1); x0 = x0 + acc[ai][bj][m][0]; x1 = x1 + acc[ai][bj][m][1];
                cu32x4 w; w.x = cvt_pk_bf16(x0[0], x0[1]); w.y = cvt_pk_bf16(x0[2], x0[3]); w.z = cvt_pk_bf16(x1[0], x1[1]); w.w = cvt_pk_bf16(x1[2], x1[3]);
                st16u_sc1(rxb, (off + bj * HALF) * 2u, w);
                CH_UNPK(w, x0, x1); s += ((x0[0] * x0[0] + x0[1] * x0[1]) + (x0[2] * x0[2] + x0[3] * x0[3])) + ((x1[0] * x1[0] + x1[1] * x1[1]) + (x1[2] * x1[2] + x1[3] * x1[3])); }
            s += shx(s, 16, (fr + 16 * fq)); s += shx(s, 32, (fr + 16 * fq));
            if (fq == 0) __builtin_amdgcn_raw_buffer_store_b32(__builtin_bit_cast(unsigned, s), rss, (int)((unsigned)row * 64u + (unsigned)(u.pn * 4 + wc) * 4u), 0, CH_X_AUX);
        }
    } else {
        float* yp = (float*)(PG8_GAS float*)cpv(V, CC + 18); float* ys = (float*)(PG8_GAS float*)cpv(V, CC + 20);
#pragma unroll
        for (int i = 0; i < 8; ++i) { const int ai = i >> 2, m = i & 3; const int row = row0 + ai * HALF + m * 16;
            float* dst = nullptr;
            if (row < RM_MP) { const int b = row / RM_LP, t = row - b * RM_LP; if (t >= RM_META) dst = yp + ((size_t)b * RM_SEQ + (t - RM_META)) * 1024 + col0; }
            else if (row < RM_MTOT) dst = ys + (size_t)(row - RM_MP) * 1024 + col0;
            f32x4 x[2][2]; cu32x4 xc[2] = {xin[i & 3][0], xin[i & 3][1]};
            if (i + 3 < 8) CH_XLOAD(i + 3);
#pragma unroll
            for (int bj = 0; bj < 2; ++bj) { CH_UNPK(xc[bj], x[bj][0], x[bj][1]); x[bj][0] = x[bj][0] + acc[ai][bj][m][0]; x[bj][1] = x[bj][1] + acc[ai][bj][m][1]; }
            if (dst) {
#pragma unroll
                for (int bj = 0; bj < 2; ++bj)
#pragma unroll
                    for (int n = 0; n < 2; ++n) *(f32x4*)(dst + bj * HALF + 4 * n) = x[bj][n]; }
        }
    }
#undef CH_UNPK
#undef CH_XLOAD
}
__device__ __forceinline__ int lane_now() { int l; asm volatile("v_mbcnt_lo_u32_b32 %0, -1, 0\n\tv_mbcnt_hi_u32_b32 %0, -1, %0" : "=v"(l)); return l; }
__device__ __forceinline__ void gemm_chain(PG8_LAS unsigned char* lds, volatile PG8_LAS unsigned* c, int tid_in) {
    int tid_o = tid_in; asm volatile("" : "+v"(tid_o));
    const int tid = tid_o, wid = __builtin_amdgcn_readfirstlane(tid >> 6), lane = tid & 63, wr = wid >> 2, wc = wid & 3, fr = lane & 15, fq = lane >> 4;
    unsigned rc;
    { int R, C; stage_rc(tid * 16, R, C); rc = (2u * (unsigned)R) | ((2u * (unsigned)C) << 16); }
#define ra2 (rc & 0xffffu)
#define c2 (rc >> 16)
#define CH_RB2() (2u * (unsigned)((int)((ra2 >> 1) & ~31u) + perm32((int)((ra2 >> 1) & 31u))))
    const unsigned ldsw = (unsigned)wid * 1024u;
    const int aoff = lds_byte(wr * 64 + fr, fq * 8), boff = lds_byte(wc * 32 + fr, fq * 8);
    constexpr size_t kstep = (size_t)(BK * 2);
#define PG8_SA(b, h) (((b) * 2 + (h)) * HTB)
#define PG8_SB(b, h) ((4 + (b) * 2 + (h)) * HTB)
#define CH_STAGE_A(bufoff, gbase, K_)   do { const unsigned _vo = ra2 * (unsigned)(K_) + c2; const char* _g1 = (const char*)(gbase); const char* _g2 = _g1 + 128 * (size_t)(K_); \
        __builtin_amdgcn_global_load_lds((const unsigned*)(_g1 + _vo), (PG8_LAS unsigned*)(lds + (bufoff) + ldsw), 16, 0, CH_A_AUX); \
        __builtin_amdgcn_global_load_lds((const unsigned*)(_g2 + _vo), (PG8_LAS unsigned*)(lds + (bufoff) + ldsw + 8192), 16, 0, CH_A_AUX); } while (0)
#define CH_STAGE_B(bufoff, gbase, K_) do { const unsigned _vo = CH_RB2() * (unsigned)(K_) + c2; const char* _g1 = (const char*)(gbase); const char* _g2 = _g1 + 128 * (size_t)(K_); \
        __builtin_amdgcn_global_load_lds((const unsigned*)(_g1 + _vo), (PG8_LAS unsigned*)(lds + (bufoff) + ldsw), 16, 0, 0); \
        __builtin_amdgcn_global_load_lds((const unsigned*)(_g2 + _vo), (PG8_LAS unsigned*)(lds + (bufoff) + ldsw + 8192), 16, 0, 0); } while (0)
#define PG8_LDA(dst, b, h) do { _Pragma("unroll") for (int m = 0; m < 4; ++m) _Pragma("unroll") for (int k = 0; k < 2; ++k) dst[m][k] = *(const PG8_LAS bf16x8*)(lds + PG8_SA(b, h) + aoff + m * 2048 + k * 1024); } while (0)
#define PG8_LDB(dst, b, h) do { _Pragma("unroll") for (int n = 0; n < 2; ++n) _Pragma("unroll") for (int k = 0; k < 2; ++k) dst[n][k] = *(const PG8_LAS bf16x8*)(lds + PG8_SB(b, h) + boff + n * 2048 + k * 1024); } while (0)
#define PG8_MMA(ai, bj, At, Bt) do { __builtin_amdgcn_s_setprio(1); _Pragma("unroll") for (int m = 0; m < 4; ++m) _Pragma("unroll") for (int n = 0; n < 2; ++n) _Pragma("unroll") for (int k = 0; k < 2; ++k) \
        acc[ai][bj][m][n] = __builtin_amdgcn_mfma_f32_16x16x32_bf16(Bt[n][k], At[m][k], acc[ai][bj][m][n], 0, 0, 0); __builtin_amdgcn_s_setprio(0); } while (0)
#define PG8_WAIT_V(n) asm volatile("s_waitcnt vmcnt(" #n ")" ::: "memory")
#define PG8_WAIT_L(n) asm volatile("s_waitcnt lgkmcnt(" #n ")" ::: "memory")
#define PG8_BAR __builtin_amdgcn_s_barrier()
#define PG8_SCHED __builtin_amdgcn_sched_barrier(0)
#define CH_CODE(V_, j) ({ const unsigned x_ = cwv(V_, CQ), i_ = (unsigned)(j) * cwv(V_, CQ + 2) + cwv(V_, CQ + 1); i_ < (x_ < 3u ? cwv(V_, CC + 23) : cwv(V_, CC + 1)) ? ((x_ << 16) | i_) : 0xffffffffu; })
    UnitD cur, nxt; int ui = 0;
    { const CtlV V0 = ctl_snap(c, lane); decode_unit(V0, CH_CODE(V0, 0), cur); }
    if (!cur.valid) return;
    f32x4 acc[2][2][4][2];
#pragma unroll
    for (int a = 0; a < 2; ++a)
#pragma unroll
        for (int b = 0; b < 2; ++b)
#pragma unroll
            for (int m = 0; m < 4; ++m)
#pragma unroll
                for (int n = 0; n < 2; ++n) acc[a][b][m][n] = (f32x4){0.f, 0.f, 0.f, 0.f};
    bf16x8 At[4][2], B0[2][2], B1[2][2];
    { const char* cA = cur.A; const char* cB = cur.B; const int K = cur.ld; const size_t hs = (size_t)256 * K;
      CH_STAGE_B(PG8_SB(0, 0), cB, K); CH_STAGE_B(PG8_SB(0, 1), cB + hs, K); CH_STAGE_A(PG8_SA(0, 0), cA, K); CH_STAGE_A(PG8_SA(0, 1), cA + hs, K);
      if (wr == 1) PG8_BAR;
      PG8_WAIT_V(2); PG8_BAR;
      CH_STAGE_B(PG8_SB(1, 0), cB + kstep, K); CH_STAGE_A(PG8_SA(1, 0), cA + kstep, K); CH_STAGE_B(PG8_SB(1, 1), cB + hs + kstep, K);
      PG8_WAIT_V(6); PG8_BAR; }
    for (;;) {
        bool has_next = false;
        const char* cA = cur.A; const char* cB = cur.B; const int Kc = cur.ld, nt = cur.K / BK; const size_t hsc = (size_t)256 * Kc;
        for (int t = 0; t < nt; t += 2) {
            const bool last = (t == nt - 2);
            if (last) { const int ln = lane_now(); const CtlV Vn = ctl_snap(c, ln); decode_unit(Vn, CH_CODE(Vn, ui + 1), nxt); has_next = nxt.valid != 0;
                const char* ssg = (const char*)(const PG8_GAS char*)cpv(Vn, CC + 8) + ((size_t)cur.pm * 256 + 32 * wid) * 64 + 16 * ln;
                __builtin_amdgcn_global_load_lds((const unsigned*)ssg, (PG8_LAS unsigned*)(lds + CH_SSL + 2048 * wid), 16, 0, 0);
                __builtin_amdgcn_global_load_lds((const unsigned*)(ssg + 1024), (PG8_LAS unsigned*)(lds + CH_SSL + 2048 * wid + 1024), 16, 0, 0); }
            const bool into = last && has_next;
            const char* a1 = cA + (size_t)(t + 1) * kstep;
            const char* a2 = last ? (into ? nxt.A : cA) : cA + (size_t)(t + 2) * kstep; const char* b2 = last ? (into ? nxt.B : cB) : cB + (size_t)(t + 2) * kstep;
            const char* a3 = a2 + kstep; const char* b3 = b2 + kstep;
            const int K2 = into ? nxt.ld : Kc; const size_t hs2 = (size_t)256 * K2;
            PG8_LDB(B0, 0, 0); PG8_LDB(B1, 0, 1); PG8_SCHED; PG8_LDA(At, 0, 0); CH_STAGE_A(PG8_SA(1, 1), a1 + hsc, Kc);
            PG8_WAIT_V(8); PG8_WAIT_L(0); PG8_BAR; PG8_MMA(0, 0, At, B0); PG8_MMA(0, 1, At, B1); PG8_BAR; PG8_SCHED;
            PG8_LDA(At, 0, 1); CH_STAGE_B(PG8_SB(0, 0), b2, K2); CH_STAGE_B(PG8_SB(0, 1), b2 + hs2, K2); CH_STAGE_A(PG8_SA(0, 0), a2, K2);
            PG8_WAIT_V(8); PG8_WAIT_L(0); PG8_BAR; PG8_MMA(1, 0, At, B0); PG8_MMA(1, 1, At, B1); PG8_BAR; PG8_SCHED;
            PG8_LDB(B0, 1, 0); PG8_LDB(B1, 1, 1); PG8_SCHED; PG8_LDA(At, 1, 0); CH_STAGE_A(PG8_SA(0, 1), a2 + hs2, K2);
            PG8_WAIT_V(8); PG8_WAIT_L(0); PG8_BAR; PG8_MMA(0, 0, At, B0); PG8_MMA(0, 1, At, B1); PG8_BAR; PG8_SCHED;
            PG8_LDA(At, 1, 1); CH_STAGE_B(PG8_SB(1, 0), b3, K2); CH_STAGE_B(PG8_SB(1, 1), b3 + hs2, K2); CH_STAGE_A(PG8_SA(1, 0), a3, K2);
            PG8_WAIT_V(8); PG8_WAIT_L(0); PG8_BAR; PG8_MMA(1, 0, At, B0); PG8_MMA(1, 1, At, B1); PG8_BAR; PG8_SCHED;
        }
        if (wr == 0) PG8_BAR;
        { const int lane_e = lane_now();
          const CtlV Ve = ctl_snap(c, lane_e); chain_epilogue(lds, Ve, cur, acc, wr, wc, lane_e & 15, lane_e >> 4); }
#pragma unroll
        for (int a = 0; a < 2; ++a)
#pragma unroll
            for (int b = 0; b < 2; ++b)
#pragma unroll
                for (int m = 0; m < 4; ++m)
#pragma unroll
                    for (int n = 0; n < 2; ++n) acc[a][b][m][n] = (f32x4){0.f, 0.f, 0.f, 0.f};
        if (!has_next) break;
        cur = nxt; ++ui;
        if (wr == 1) PG8_BAR;
    }
    PG8_WAIT_V(0);
    PG8_BAR;
#undef CH_CODE
#undef PG8_SA
#undef PG8_SB
#undef CH_STAGE_A
#undef CH_STAGE_B
#undef CH_RB2
#undef ra2
#undef c2
#undef PG8_LDA
#undef PG8_LDB
#undef PG8_MMA
#undef PG8_WAIT_V
#undef PG8_WAIT_L
#undef PG8_BAR
#undef PG8_SCHED
}
}
#ifndef PG8_SP2
#define PG8_SP2 true
#endif
#ifndef PG8_ALIGN
#define PG8_ALIGN true
#endif
constexpr int NWAVES = 8;
constexpr int D = 1024, NB = 8, SEQ = 2048, NMETA = 16, LP = SEQ + NMETA, DBATCH = 128, DSEQ = 4;
constexpr int MP = NB * LP, MS = DBATCH * DSEQ, MTOT = MP + MS, MPAD = 17152;
constexpr int NQKV = 1536, NIN = 3072, NINP = 3328, FF = 4096;
constexpr int AH = 16, AKV = 4, AHD = 64, WIN = 128;
constexpr int MH = 4, MDK = 128, MDV = 256, MCH = 64, VS = 32, NSL = MDV / VS;
constexpr float EPS = 1e-6f;
static_assert(MPAD % 256 == 0 && MPAD >= MTOT, "row padding");
constexpr size_t MiB = 1u << 20;
constexpr size_t WS_CTL = 0, CTL_ZERO_BYTES = 1 * MiB;
constexpr size_t WS_WQKV = 2 * MiB, WS_WO = 8 * MiB, WS_WIN = 12 * MiB, WS_WOUT = 25 * MiB, WS_WUP = 29 * MiB, WS_WDN = 61 * MiB;
constexpr size_t SZ_WQKV = (size_t)NQKV * D * 2, SZ_WO = (size_t)D * D * 2, SZ_WIN = (size_t)NINP * D * 2, SZ_WUP = (size_t)FF * D * 2;
constexpr size_t WS_SS = 93 * MiB, WS_G = 95 * MiB, WS_HSS = 96 * MiB;
constexpr size_t WS_X = 100 * MiB, WS_XB = 167 * MiB, WS_Z = 201 * MiB, WS_AO = 302 * MiB, WS_FF = 336 * MiB, WS_PT = 470 * MiB, WS_END = 483 * MiB;
static_assert(WS_WQKV + 2 * SZ_WQKV <= WS_WO && WS_WO + 2 * SZ_WO <= WS_WIN && WS_WIN + 2 * SZ_WIN <= WS_WOUT && WS_WOUT + 2 * SZ_WO <= WS_WUP && WS_WUP + 4 * SZ_WUP <= WS_WDN && WS_WDN + 4 * SZ_WUP <= WS_SS, "weights map");
static_assert(WS_SS + (size_t)MPAD * 16 * 4 <= WS_G && WS_G + (size_t)MPAD * 8 * 4 <= WS_HSS && WS_HSS + (size_t)MPAD * 32 * 4 <= WS_X, "small maps");
static_assert(WS_X + (size_t)MPAD * D * 4 <= WS_XB && WS_XB + (size_t)MPAD * D * 2 <= WS_Z && WS_Z + (size_t)MPAD * NIN * 2 <= WS_AO && WS_AO + (size_t)MPAD * D * 2 <= WS_FF && WS_FF + (size_t)MPAD * FF * 2 <= WS_PT && WS_PT + (size_t)4 * 768 * D * 4 <= WS_END, "activation map");
constexpr int CW_BAR = 4096;
constexpr size_t O_YP = 0, O_YS = O_YP + (size_t)NB * SEQ * D, O_KP = O_YS + (size_t)MS * D, O_VP = O_KP + (size_t)2 * NB * WIN * AKV * AHD, O_KS = O_VP + (size_t)2 * NB * WIN * AKV * AHD,
    O_VS = O_KS + (size_t)2 * DBATCH * WIN * AKV * AHD, O_CP = O_VS + (size_t)2 * DBATCH * WIN * AKV * AHD, O_NP = O_CP + (size_t)2 * NB * MH * MDK * MDV, O_MP = O_NP + (size_t)2 * NB * MH * MDK,
    O_CS = O_MP + (size_t)2 * NB * MH, O_NS = O_CS + (size_t)2 * DBATCH * MH * MDK * MDV, O_MS = O_NS + (size_t)2 * DBATCH * MH * MDK, O_END = O_MS + (size_t)2 * DBATCH * MH;
constexpr int RING_OFF = 0, RING_BYTES = 131072;
constexpr int LDSCTL_OFF = RING_BYTES, MISC_OFF = LDSCTL_OFF + 320;
constexpr int SSL_OFF = 147456;
constexpr int LDS_BYTES = 163840;
#define GAS __attribute__((address_space(1)))
#define LAS __attribute__((address_space(3)))
typedef unsigned short bf16;
typedef unsigned v4u __attribute__((ext_vector_type(4)));
typedef float f32x4 __attribute__((ext_vector_type(4)));
typedef short bf16x8 __attribute__((ext_vector_type(8)));
typedef GAS unsigned gu32;
typedef GAS unsigned long long gu64;
#define RLX_AGENT __ATOMIC_RELAXED, __HIP_MEMORY_SCOPE_AGENT
#define LDS_WAIT() asm volatile("s_waitcnt lgkmcnt(0)" ::: "memory")
#define VM_WAIT() asm volatile("s_waitcnt vmcnt(0)" ::: "memory")
__device__ __forceinline__ unsigned long long rt() { return __builtin_amdgcn_s_memrealtime(); }
__device__ __forceinline__ unsigned f2bf(float f) { unsigned u = __builtin_bit_cast(unsigned, f); return (u + 0x7fffu + ((u >> 16) & 1u)) >> 16; }
__device__ __forceinline__ unsigned pk2(float lo, float hi) { return f2bf(lo) | (f2bf(hi) << 16); }

#define XB_TMO      128
#define XB_XCNT(j)  (256  + 64 * (j))
#define XB_XSUB(j)  (1280 + 64 * (j))
#define XB_XGEN(j)  (2304 + 64 * (j))
#define XB_TOP      3328
#define XB_TOPGEN   3392
#define XCD_BAR_WORDS 3456
#define XB_SPIN_CAP (1u << 18)

__device__ __forceinline__ unsigned xb_ld(unsigned* p)              { return __hip_atomic_load(p, __ATOMIC_RELAXED, __HIP_MEMORY_SCOPE_AGENT); }
__device__ __forceinline__ unsigned xb_add(unsigned* p, unsigned v) { return __hip_atomic_fetch_add(p, v, __ATOMIC_RELAXED, __HIP_MEMORY_SCOPE_AGENT); }
__device__ __forceinline__ unsigned xb_xcc_id() { return (unsigned)__builtin_amdgcn_s_getreg((3 << 11) | 20) & 0xFu; }
#define XB_SPIN(cond, bar) do { unsigned _sp = 0; while (cond) { __builtin_amdgcn_s_sleep(1); \
    if ((++_sp & 255u) == 0u) { if (xb_ld(&(bar)[XB_TMO])) break; if (_sp > XB_SPIN_CAP) { atomicAdd(&(bar)[XB_TMO], 1u); break; } } } } while (0)

struct XcdBarrier {
    unsigned* bar; unsigned x;
    volatile LAS unsigned* st;
};

__device__ __forceinline__ XcdBarrier xcd_barrier_post(unsigned* bar, volatile LAS unsigned* st) {
    XcdBarrier b; b.bar = bar; b.x = xb_xcc_id(); b.st = st;
    if (threadIdx.x == 0) (void)xb_add(&bar[XB_XCNT(b.x)], 1u);
    return b;
}
__device__ __forceinline__ void xcd_barrier_complete(unsigned* bar, unsigned x, unsigned& nloc, unsigned& nx) {
    const unsigned G = gridDim.x * gridDim.y * gridDim.z;
    unsigned sum, cnt, mine, sp = 0u;
    for (;;) {
        sum = 0u; cnt = 0u; mine = 0u;
#pragma unroll
        for (unsigned j = 0; j < 16; ++j) { const unsigned c = xb_ld(&bar[XB_XCNT(j)]); sum += c; cnt += (c > 0u) ? 1u : 0u; mine = (j == x) ? c : mine; }
        if (sum == G) break;
        __builtin_amdgcn_s_sleep(1);
        if ((++sp & 255u) == 0u) { if (xb_ld(&bar[XB_TMO])) break; if (sp > XB_SPIN_CAP) { atomicAdd(&bar[XB_TMO], 1u); break; } }
    }
    nloc = mine > 0u ? mine : 1u; nx = cnt > 0u ? cnt : 1u;
}

__device__ __forceinline__ void xcd_barrier(const XcdBarrier& b) {
    asm volatile("s_waitcnt vmcnt(0)" ::: "memory");
    __syncthreads();
    if (threadIdx.x == 0) {
        unsigned* bar = b.bar;
        __builtin_amdgcn_s_waitcnt(0);
        unsigned nloc = b.st[0], nx = b.st[1];
        if (nloc == 0u) { xcd_barrier_complete(bar, b.x, nloc, nx); b.st[0] = nloc; b.st[1] = nx; }
        const unsigned old = xb_add(&bar[XB_XSUB(b.x)], 1u);
        const unsigned gen = old / nloc;
        if (old + 1u == (gen + 1u) * nloc) {
            __builtin_amdgcn_fence(__ATOMIC_RELEASE, "agent");
            asm volatile("s_waitcnt vmcnt(0)" ::: "memory");
            const unsigned og = xb_add(&bar[XB_TOP], 1u);
            const unsigned tg = og / nx;
            if (og + 1u == (tg + 1u) * nx) xb_add(&bar[XB_TOPGEN], 1u);
            else XB_SPIN(xb_ld(&bar[XB_TOPGEN]) == tg, bar);
            __builtin_amdgcn_fence(__ATOMIC_ACQUIRE, "agent");
            asm volatile("s_waitcnt vmcnt(0)" ::: "memory");
        } else {
            XB_SPIN(xb_ld(&bar[XB_TOPGEN]) == gen, bar);
            __builtin_amdgcn_fence(__ATOMIC_ACQUIRE, "agent");
            asm volatile("s_waitcnt vmcnt(0)" ::: "memory");
        }
    }
    __syncthreads();
}

typedef unsigned v2u __attribute__((ext_vector_type(2)));
__device__ __forceinline__ float bf_lo(unsigned w) { return __builtin_bit_cast(float, w << 16); }
__device__ __forceinline__ float bf_hi(unsigned w) { return __builtin_bit_cast(float, w & 0xffff0000u); }
__device__ __forceinline__ float bf1(bf16 b) { return __builtin_bit_cast(float, (unsigned)b << 16); }
__device__ __forceinline__ void unpack8(const v4u w, float (&f)[8]) { f[0] = bf_lo(w.x); f[1] = bf_hi(w.x); f[2] = bf_lo(w.y); f[3] = bf_hi(w.y); f[4] = bf_lo(w.z); f[5] = bf_hi(w.z); f[6] = bf_lo(w.w); f[7] = bf_hi(w.w); }
__device__ __forceinline__ v4u pack8(const float (&f)[8]) { v4u o; o.x = pk2(f[0], f[1]); o.y = pk2(f[2], f[3]); o.z = pk2(f[4], f[5]); o.w = pk2(f[6], f[7]); return o; }
__device__ __forceinline__ float wave_sum(float v, int lane) {
#pragma unroll
    for (int o = 1; o < 64; o <<= 1) v += pg8::shx(v, o, lane);
    return v;
}
__device__ __forceinline__ f32x4 mfma16(bf16x8 a, bf16x8 b, f32x4 c) { return __builtin_amdgcn_mfma_f32_16x16x32_bf16(a, b, c, 0, 0, 0); }
#define WG_BAR() do { asm volatile("s_waitcnt vmcnt(0) lgkmcnt(0)" ::: "memory"); __builtin_amdgcn_s_barrier(); asm volatile("" ::: "memory"); } while (0)
#define LDS_BAR() do { asm volatile("s_waitcnt lgkmcnt(0)" ::: "memory"); __builtin_amdgcn_s_barrier(); asm volatile("" ::: "memory"); } while (0)

__device__ __forceinline__ void p0_transpose_item(const float* W, const float* gs, int K, int N, bf16* WT, int row_off, int mlo, int mhi, float mul, LAS float* scr, int item, int lane) {
    const int nblk = N / 32, kb = item / nblk, nb = item % nblk, k0 = 64 * kb, n0 = 32 * nb;
    const float cm = (n0 >= mlo && n0 < mhi) ? mul : 1.0f;
    const int lr = lane >> 3, lc = 4 * (lane & 7);
    f32x4 v[8]; float g[8];
#pragma unroll
    for (int i = 0; i < 8; ++i) { v[i] = *(const GAS f32x4*)(W + (size_t)(k0 + 8 * i + lr) * N + n0 + lc); g[i] = gs ? gs[k0 + 8 * i + lr] * cm : cm; }
#pragma unroll
    for (int i = 0; i < 8; ++i) { LAS float* d = scr + (8 * i + lr) * 33 + lc; d[0] = v[i][0] * g[i]; d[1] = v[i][1] * g[i]; d[2] = v[i][2] * g[i]; d[3] = v[i][3] * g[i]; }
    LDS_WAIT(); asm volatile("" ::: "memory");
    const int c = lane & 7;
#pragma unroll
    for (int j = 0; j < 4; ++j) { const int n = (lane >> 3) + 8 * j; const LAS float* s = scr + (8 * c) * 33 + n;
        v4u o; o.x = pk2(s[0 * 33], s[1 * 33]); o.y = pk2(s[2 * 33], s[3 * 33]); o.z = pk2(s[4 * 33], s[5 * 33]); o.w = pk2(s[6 * 33], s[7 * 33]);
        *(GAS v4u*)(WT + (size_t)(row_off + n0 + n) * K + k0 + 8 * c) = o; }
    LDS_WAIT(); asm volatile("" ::: "memory");
}
struct P0Args { const float *xp, *xs, *meta, *norm_mix, *norm_mlp, *wqkv, *wo, *win, *wgate, *wout, *wup, *wdn; unsigned char* ws; };
__device__ __forceinline__ void p0_prologue(const P0Args& A, LAS unsigned char* lds, int vcu, int G, int wave, int lane, int tid) {
    LAS float* scr = (LAS float*)(lds + RING_OFF + wave * 16384);
    const int gw = vcu * NWAVES + wave, NGW = G * NWAVES;
    constexpr int I_QKV = (D / 64) * (NQKV / 32), I_O = (D / 64) * (D / 32), I_IN = (D / 64) * (NIN / 32), I_UP = (D / 64) * (FF / 32), I_DN = (FF / 64) * (D / 32);
    constexpr int I_MIX = I_QKV + I_O + I_IN + I_O, I_MLP = I_UP + I_DN, NITEMS = 2 * I_MIX + 4 * I_MLP;
    unsigned char* ws = A.ws;
    for (int it = gw; it < NITEMS; it += NGW) {
        int r = it;
        if (r < 2 * I_MIX) { const int j = r / I_MIX; r -= j * I_MIX;
            if (r < I_QKV) { p0_transpose_item(A.wqkv + (size_t)j * D * NQKV, A.norm_mix + (2 * j) * D, D, NQKV, (bf16*)(ws + WS_WQKV + j * SZ_WQKV), 0, 0, 0, 1.f, scr, r, lane); continue; } r -= I_QKV;
            if (r < I_O) { p0_transpose_item(A.wo + (size_t)j * D * D, nullptr, D, D, (bf16*)(ws + WS_WO + j * SZ_WO), 0, 0, 0, 1.f, scr, r, lane); continue; } r -= I_O;
            if (r < I_IN) { p0_transpose_item(A.win + (size_t)j * D * NIN, A.norm_mix + (2 * j + 1) * D, D, NIN, (bf16*)(ws + WS_WIN + j * SZ_WIN), 0, 512, 1024, 0.08838834764831845f, scr, r, lane); continue; } r -= I_IN;
            p0_transpose_item(A.wout + (size_t)j * D * D, nullptr, D, D, (bf16*)(ws + WS_WOUT + j * SZ_WO), 0, 0, 0, 1.f, scr, r, lane); continue; }
        r -= 2 * I_MIX;
        { const int i = r / I_MLP; r -= i * I_MLP;
            if (r < I_UP) { p0_transpose_item(A.wup + (size_t)i * D * FF, A.norm_mlp + i * D, D, FF, (bf16*)(ws + WS_WUP + i * SZ_WUP), 0, 0, 0, 1.f, scr, r, lane); continue; } r -= I_UP;
            p0_transpose_item(A.wdn + (size_t)i * FF * D, nullptr, FF, D, (bf16*)(ws + WS_WDN + i * SZ_WUP), 0, 0, 0, 1.f, scr, r, lane); }
    }
    { const int gt = vcu * (NWAVES * 64) + tid, NT = G * NWAVES * 64;
      for (int e = gt; e < 2 * 256 * (D / 8); e += NT) { const int j = e / (256 * (D / 8)), rem = e % (256 * (D / 8)), n = rem / (D / 8), k8 = (rem % (D / 8)) * 8;
          float f[8];
#pragma unroll
          for (int q = 0; q < 8; ++q) f[q] = (n < 8) ? A.wgate[((size_t)j * D + k8 + q) * 8 + n] * A.norm_mix[(2 * j + 1) * D + k8 + q] : 0.f;
          *(GAS v4u*)((bf16*)(ws + WS_WIN + j * SZ_WIN) + (size_t)(NIN + n) * D + k8) = pack8(f); } }
    bf16* XB = (bf16*)(ws + WS_XB); float* SS = (float*)(ws + WS_SS); bf16* AO = (bf16*)(ws + WS_AO);
    for (int m = gw; m < MPAD; m += NGW) {
        const float* src = nullptr;
        if (m < MP) { const int b = m / LP, t = m - b * LP; src = (t < NMETA) ? A.meta + (size_t)t * D : A.xp + ((size_t)b * SEQ + (t - NMETA)) * D; }
        else if (m < MTOT) src = A.xs + (size_t)(m - MP) * D;
        f32x4 v[4]; float ss[4];
#pragma unroll
        for (int j = 0; j < 4; ++j) v[j] = src ? ((const GAS f32x4*)src)[lane + 64 * j] : (f32x4){0.f, 0.f, 0.f, 0.f};
#pragma unroll
        for (int j = 0; j < 4; ++j) { v2u w; w.x = pk2(v[j][0], v[j][1]); w.y = pk2(v[j][2], v[j][3]); ((GAS v2u*)(XB + (size_t)m * D))[lane + 64 * j] = w;
            const float a0 = bf_lo(w.x), a1 = bf_hi(w.x), a2 = bf_lo(w.y), a3 = bf_hi(w.y); ss[j] = wave_sum((a0 * a0 + a1 * a1) + (a2 * a2 + a3 * a3), lane); }
        if (lane < 16) { const int j = lane >> 2; const float s = (lane & 3) ? 0.f : (j == 0 ? ss[0] : j == 1 ? ss[1] : j == 2 ? ss[2] : ss[3]); SS[(size_t)m * 16 + lane] = s; }
        if (m >= MTOT) {
#pragma unroll
            for (int j = 0; j < 4; ++j) ((GAS v2u*)(AO + (size_t)m * D))[lane + 64 * j] = (v2u){0u, 0u}; }
    }
}

constexpr int A_KS = 0, A_KSTR = 144, A_VT = 36864, A_VSTR = 552, A_LUT = 72192, A_END = 74304;
__device__ __forceinline__ int t5_bucket(int n) {
    if (n < 16) return n;
    const int v = 16 + (int)(logf((float)n * (1.0f / 16.0f)) * (16.0f / 2.0794415416798357f));
    return v < 31 ? v : 31;
}
struct AttnP { const bf16* QKV; const float *gq, *gk, *sinks, *rel; bf16* AO; };
struct AttnQ { v4u q0, q1; };
struct AttnG { f32x4 ga, gb, gc, gd; };
__device__ __forceinline__ AttnQ attn_qload(const bf16* qptr, int lane) { const int g = lane >> 4; AttnQ q; q.q0 = *(const GAS v4u*)(qptr + 8 * g); q.q1 = *(const GAS v4u*)(qptr + 32 + 8 * g); return q; }
__device__ __forceinline__ AttnG attn_gload(const float* gq, int lane) { const int g = lane >> 4; AttnG G; G.ga = *(const GAS f32x4*)(gq + 8 * g); G.gb = *(const GAS f32x4*)(gq + 8 * g + 4); G.gc = *(const GAS f32x4*)(gq + 32 + 8 * g); G.gd = *(const GAS f32x4*)(gq + 36 + 8 * g); return G; }
__device__ __forceinline__ void attn_subtile(LAS unsigned char* L, int i0, const AttnQ& Q, const AttnG& G, int hh, int dist0, int jmin, float sink, bf16* optr, bool store, int lane) {
    const int g = lane >> 4, c = lane & 15;
    bf16x8 Bq[2];
    {
        const v4u q0 = Q.q0, q1 = Q.q1;
        float f0[8], f1[8]; unpack8(q0, f0); unpack8(q1, f1);
        float ss = 0.f;
#pragma unroll
        for (int e = 0; e < 8; ++e) ss += f0[e] * f0[e] + f1[e] * f1[e];
        ss += pg8::shx(ss, 16, lane); ss += pg8::shx(ss, 32, lane);
        const float rq = 0.125f * __builtin_amdgcn_rsqf(ss * (1.0f / 64.0f) + EPS);
        const f32x4 ga = G.ga, gb = G.gb, gc = G.gc, gd = G.gd;
#pragma unroll
        for (int e = 0; e < 4; ++e) { f0[e] *= rq * ga[e]; f0[4 + e] *= rq * gb[e]; f1[e] *= rq * gc[e]; f1[4 + e] *= rq * gd[e]; }
        const v4u p0 = pack8(f0), p1 = pack8(f1);
        Bq[0] = __builtin_bit_cast(bf16x8, p0); Bq[1] = __builtin_bit_cast(bf16x8, p1);
    }
    f32x4 s[10];
    float mx = -1e30f;
    bf16x8 Ka[9][2]; float bias[9][4];
#pragma unroll
    for (int kt = 0; kt < 9; ++kt) { const LAS unsigned char* kp = L + A_KS + (i0 + 16 * kt + c) * A_KSTR + 16 * g; Ka[kt][0] = *(const LAS bf16x8*)kp; Ka[kt][1] = *(const LAS bf16x8*)(kp + 64);
#pragma unroll
        for (int r = 0; r < 4; ++r) { const int dist = dist0 - (16 * kt + 4 * g + r); const int di = dist < 0 ? 0 : (dist > WIN ? WIN : dist); bias[kt][r] = *(const LAS float*)(L + A_LUT + (hh * 132 + di) * 4); } }
    __builtin_amdgcn_sched_barrier(0);
#pragma unroll
    for (int kt = 0; kt < 9; ++kt) {
        f32x4 acc = {0.f, 0.f, 0.f, 0.f};
        acc = mfma16(Ka[kt][0], Bq[0], acc);
        acc = mfma16(Ka[kt][1], Bq[1], acc);
#pragma unroll
        for (int r = 0; r < 4; ++r) {
            const int rel = 16 * kt + 4 * g + r, dist = dist0 - rel;
            const bool ok = (dist >= 0) && (dist <= WIN) && (i0 + rel >= jmin);
            const float v = ok ? acc[r] + bias[kt][r] : -1e30f;
            s[kt][r] = v; mx = fmaxf(mx, v);
        }
    }
    mx = fmaxf(mx, pg8::shx(mx, 16, lane)); mx = fmaxf(mx, pg8::shx(mx, 32, lane));
    mx = fmaxf(mx, sink);
    float l = 0.f;
#pragma unroll
    for (int kt = 0; kt < 9; ++kt)
#pragma unroll
        for (int r = 0; r < 4; ++r) { const float p = __expf(s[kt][r] - mx); s[kt][r] = p; l += p; }
    s[9] = (f32x4){0.f, 0.f, 0.f, 0.f};
    l += pg8::shx(l, 16, lane); l += pg8::shx(l, 32, lane);
    const float inv = __builtin_amdgcn_rcpf(l + __expf(sink - mx));
    bf16x8 Bp[5];
#pragma unroll
    for (int ks = 0; ks < 5; ++ks) { v4u w; w.x = pk2(s[2 * ks][0], s[2 * ks][1]); w.y = pk2(s[2 * ks][2], s[2 * ks][3]); w.z = pk2(s[2 * ks + 1][0], s[2 * ks + 1][1]); w.w = pk2(s[2 * ks + 1][2], s[2 * ks + 1][3]); Bp[ks] = __builtin_bit_cast(bf16x8, w); }
#pragma unroll
    for (int dp = 0; dp < 2; ++dp) {
        v4u Va[2][5];
#pragma unroll
        for (int d2 = 0; d2 < 2; ++d2) { const LAS unsigned char* vp = L + A_VT + (16 * (2 * dp + d2) + c) * A_VSTR + (i0 + 4 * g) * 2;
#pragma unroll
            for (int ks = 0; ks < 5; ++ks) { const v2u lo = *(const LAS v2u*)(vp + 64 * ks), hi = *(const LAS v2u*)(vp + 64 * ks + 32); Va[d2][ks] = (v4u){lo.x, lo.y, hi.x, hi.y}; } }
        __builtin_amdgcn_sched_barrier(0);
#pragma unroll
        for (int d2 = 0; d2 < 2; ++d2) { const int dt = 2 * dp + d2; f32x4 acc = {0.f, 0.f, 0.f, 0.f};
#pragma unroll
            for (int ks = 0; ks < 5; ++ks) acc = mfma16(__builtin_bit_cast(bf16x8, Va[d2][ks]), Bp[ks], acc);
            if (store) { v2u w; w.x = pk2(acc[0] * inv, acc[1] * inv); w.y = pk2(acc[2] * inv, acc[3] * inv); *(GAS v2u*)(optr + 16 * dt + 4 * g) = w; } }
    }
}
__device__ __forceinline__ void attn_stage_row(LAS unsigned char* L, int j, int half, const bf16* krow, const bf16* vrow, const float* gk, float* ck, float* cv, int lane) {
    float kf[32], vf[32];
    if (krow) {
#pragma unroll
        for (int i = 0; i < 4; ++i) { float t[8]; unpack8(*(const GAS v4u*)(krow + 8 * i), t);
#pragma unroll
            for (int e = 0; e < 8; ++e) kf[8 * i + e] = t[e];
            unpack8(*(const GAS v4u*)(vrow + 8 * i), t);
#pragma unroll
            for (int e = 0; e < 8; ++e) vf[8 * i + e] = t[e]; }
    } else {
#pragma unroll
        for (int e = 0; e < 32; ++e) { kf[e] = 0.f; vf[e] = 0.f; }
    }
    float ss = 0.f;
#pragma unroll
    for (int e = 0; e < 32; ++e) ss += kf[e] * kf[e];
    ss += pg8::shx(ss, 1, lane);
    const float rk = __builtin_amdgcn_rsqf(ss * (1.0f / 64.0f) + EPS);
#pragma unroll
    for (int i = 0; i < 8; ++i) { const f32x4 gg = *(const f32x4*)(gk + half * 32 + 4 * i);
#pragma unroll
        for (int e = 0; e < 4; ++e) kf[4 * i + e] *= rk * gg[e]; }
#pragma unroll
    for (int i = 0; i < 4; ++i) { float t[8];
#pragma unroll
        for (int e = 0; e < 8; ++e) t[e] = kf[8 * i + e];
        *(LAS v4u*)(L + A_KS + j * A_KSTR + half * 64 + 16 * i) = pack8(t); }
#pragma unroll
    for (int e = 0; e < 32; ++e) *(LAS unsigned short*)(L + A_VT + (half * 32 + e) * A_VSTR + 2 * j) = (unsigned short)f2bf(vf[e]);
    if (ck) {
#pragma unroll
        for (int i = 0; i < 8; ++i) { *(GAS f32x4*)(ck + half * 32 + 4 * i) = (f32x4){kf[4 * i], kf[4 * i + 1], kf[4 * i + 2], kf[4 * i + 3]};
            *(GAS f32x4*)(cv + half * 32 + 4 * i) = (f32x4){vf[4 * i], vf[4 * i + 1], vf[4 * i + 2], vf[4 * i + 3]}; }
    }
}
__device__ __forceinline__ void attn_phase(LAS unsigned char* L, const AttnP& P, const float* cache_k, const float* cache_v, float* out, int jl, int vcu, int G, int tid_in, int wave_in, int lane_in) {
    constexpr int N_PROMPT = NB * 17 * AKV, N_ITEMS = N_PROMPT + DBATCH * AKV;
    const int npr = vcu < N_PROMPT ? (N_PROMPT - vcu + G - 1) / G : 0, extra = N_PROMPT % G, sw = extra == 0 ? G : (vcu >= extra ? G - extra : 0), s0 = extra == 0 ? vcu : vcu - extra;
    int lut_kvh = -1;
#pragma unroll 1
    for (int k = 0;; ++k) {
        int it;
        if (k < npr) it = vcu + G * k;
        else { if (sw == 0) break; const int si = s0 + sw * (k - npr); if (si >= N_ITEMS - N_PROMPT) break; it = N_PROMPT + si; }
        int tid = tid_in; asm volatile("" : "+v"(tid));
        const int lane = tid & 63, wave = __builtin_amdgcn_readfirstlane(tid >> 6);
        const bool prompt = it < N_PROMPT;
        int b = 0, qb = 0, kvh, db = 0;
        if (prompt) { b = it / (17 * AKV); const int rem = it % (17 * AKV); qb = rem / AKV; kvh = rem % AKV; }
        else { const int si = it - N_PROMPT; db = si / AKV; kvh = si % AKV; }
        if (kvh != lut_kvh) for (int e = tid; e < 4 * 129; e += NWAVES * 64) { const int hh = e / 129, d = e % 129; *(LAS float*)(L + A_LUT + (hh * 132 + d) * 4) = P.rel[t5_bucket(d) * AH + kvh * 4 + hh]; }
        lut_kvh = kvh;
        if (prompt) {
            const int j = tid >> 1, half = tid & 1, tok = 128 * qb - 240 + j;
            const bf16* krow = nullptr; const bf16* vrow = nullptr; float* ck = nullptr; float* cv = nullptr;
            if (tok >= 0) { const size_t row = (size_t)b * LP + tok; krow = P.QKV + row * NQKV + 1024 + kvh * 64 + half * 32; vrow = P.QKV + row * NQKV + 1280 + kvh * 64 + half * 32; }
            if (qb == 16 && j >= 128) { const size_t o = ((((size_t)jl * NB + b) * WIN + (j - 128)) * AKV + kvh) * AHD; ck = out + O_KP + o; cv = out + O_VP + o; }
            attn_stage_row(L, j, half, krow, vrow, P.gk, ck, cv, lane);
            for (int e = tid; e < 64 * 16; e += NWAVES * 64) *(LAS unsigned short*)(L + A_VT + (e >> 4) * A_VSTR + 2 * (256 + (e & 15))) = 0;
        } else {
            const float* ckin = cache_k + (((size_t)jl * DBATCH + db) * WIN * AKV + kvh) * AHD; const float* cvin = cache_v + (((size_t)jl * DBATCH + db) * WIN * AKV + kvh) * AHD;
            float* cko = out + O_KS + (((size_t)jl * DBATCH + db) * WIN * AKV + kvh) * AHD; float* cvo = out + O_VS + (((size_t)jl * DBATCH + db) * WIN * AKV + kvh) * AHD;
#pragma unroll
            for (int i = 0; i < 4; ++i) { const int idx = tid + 512 * i, row = idx >> 4, c4 = idx & 15;
                const f32x4 kv = *(const GAS f32x4*)(ckin + (size_t)row * (AKV * AHD) + 4 * c4), vv = *(const GAS f32x4*)(cvin + (size_t)row * (AKV * AHD) + 4 * c4);
                v2u w; w.x = pk2(kv[0], kv[1]); w.y = pk2(kv[2], kv[3]); *(LAS v2u*)(L + A_KS + row * A_KSTR + 8 * c4) = w;
#pragma unroll
                for (int e = 0; e < 4; ++e) *(LAS unsigned short*)(L + A_VT + (4 * c4 + e) * A_VSTR + 2 * row) = (unsigned short)f2bf(vv[e]);
                if (row >= DSEQ) { *(GAS f32x4*)(cko + (size_t)(row - DSEQ) * (AKV * AHD) + 4 * c4) = kv; *(GAS f32x4*)(cvo + (size_t)(row - DSEQ) * (AKV * AHD) + 4 * c4) = vv; } }
            if (tid < 2 * DSEQ) { const int s = tid >> 1, half = tid & 1; const size_t row = (size_t)MP + db * DSEQ + s;
                attn_stage_row(L, WIN + s, half, P.QKV + row * NQKV + 1024 + kvh * 64 + half * 32, P.QKV + row * NQKV + 1280 + kvh * 64 + half * 32, P.gk,
                               cko + (size_t)(WIN - DSEQ + s) * (AKV * AHD), cvo + (size_t)(WIN - DSEQ + s) * (AKV * AHD), lane); }
            for (int e = tid; e < 12 * 8; e += NWAVES * 64) { unsigned z0 = 0u; asm volatile("" : "+v"(z0)); *(LAS v4u*)(L + A_KS + (132 + e / 8) * A_KSTR + 16 * (e & 7)) = (v4u){z0, z0, z0, z0}; }
            for (int e = tid; e < 64 * 28; e += NWAVES * 64) *(LAS unsigned short*)(L + A_VT + (e / 28) * A_VSTR + 2 * (132 + e % 28)) = 0;
        }
        LDS_BAR();
        if (prompt) {
            const int hh = wave & 3, rhalf = wave >> 2, head = kvh * 4 + hh; const float sink = P.sinks[head];
            const int jmin = 240 - 128 * qb;
            const AttnG G = attn_gload(P.gq, lane);
            const int st0 = (qb == 0) ? (rhalf == 0 ? 4 : 3) : 0;
            AttnQ Qn; Qn.q0 = (v4u){0u, 0u, 0u, 0u}; Qn.q1 = Qn.q0;
            if (st0 < 4) { const int tok = 128 * qb - 112 + 64 * rhalf + 16 * st0 + (lane & 15); Qn = attn_qload(P.QKV + ((size_t)b * LP + tok) * NQKV + head * 64, lane); }
#pragma unroll 1
            for (int st = st0; st < 4; ++st) {
                const int i0 = 64 * rhalf + 16 * st;
                const int tok = 128 * qb - 112 + i0 + (lane & 15); const size_t row = (size_t)b * LP + tok;
                const AttnQ Q = Qn;
                if (st + 1 < 4) Qn = attn_qload(P.QKV + (row + 16) * NQKV + head * 64, lane);
                attn_subtile(L, i0, Q, G, hh, (lane & 15) + WIN, jmin, sink, P.AO + row * D + head * 64, true, lane);
            }
        } else if (wave == 0) {
            const int q = lane & 15, hh = q >> 2, s = q & 3, head = kvh * 4 + hh; const size_t row = (size_t)MP + db * DSEQ + s;
            const AttnG G = attn_gload(P.gq, lane); const AttnQ Q = attn_qload(P.QKV + row * NQKV + head * 64, lane);
            attn_subtile(L, 0, Q, G, hh, WIN + s, 0, P.sinks[head], P.AO + row * D + head * 64, true, lane);
        }
        LDS_BAR();
    }
}

constexpr int M_QS = 0, M_KS = 17408, M_KT = 34816, M_VT = 53248, M_VW = 60160, M_CT = 67072, M_CTB = 13056;
constexpr int M_RS = 272, M_TS = 144;
struct MlP { const bf16* Z; const float* G; const float* gnorm; bf16* AO; float* HSS; };
__device__ __forceinline__ float wave_scan_add(float x, int lane) {
#pragma unroll
    for (int o = 1; o < 64; o <<= 1) { const float t = pg8::shl_from(x, lane - o); if (lane >= o) x += t; }
    return x;
}
__device__ __forceinline__ float wave_scan_max(float x, int lane) {
#pragma unroll
    for (int o = 1; o < 64; o <<= 1) { const float t = pg8::shl_from(x, lane - o); if (lane >= o) x = fmaxf(x, t); }
    return x;
}
__device__ __forceinline__ float sigmoidf_(float x) { return __builtin_amdgcn_rcpf(1.0f + __expf(-x)); }
__device__ __forceinline__ float tanh_fast(float x) { return 1.0f - 2.0f / (1.0f + __expf(2.0f * x)); }
__device__ __forceinline__ float gate_i(float g) { return 15.0f * tanh_fast(g * (1.0f / 15.0f)); }
__device__ __forceinline__ float gate_f(float g) { const float x = 15.0f * tanh_fast(g * (1.0f / 15.0f)); return fminf(x, 0.f) - __logf(1.0f + __expf(-fabsf(x))); }
constexpr int M_TB = 94208, M_CS = M_TB + 33 * 192 * 4, M_MS = M_CS + 33 * 2 * 4, M_MX = M_MS + 34 * 4, M_END2 = M_MX + 34 * 4;
static_assert(M_END2 <= RING_BYTES, "mLSTM LDS map");
__device__ __forceinline__ void mlstm_prompt_item(LAS unsigned char* L, const MlP& P, float* out, int jl, int b, int h, int sl, int tid, int wave, int lane) {
    const int g = lane >> 4, c = lane & 15;
    unsigned z0 = 0u; asm volatile("" : "+v"(z0));
    for (int e = tid; e < 16 * 72; e += NWAVES * 64) { const int r = e / 72, cc = e % 72; const unsigned short one = 0x3f80;
        *(LAS unsigned short*)(L + M_VT + (32 + r) * M_TS + 2 * cc) = (r == 0) ? one : (unsigned short)0; *(LAS unsigned short*)(L + M_VW + (32 + r) * M_TS + 2 * cc) = 0; }
    for (int e = tid; e < M_CTB / 16; e += NWAVES * 64) *(LAS v4u*)(L + M_CT + 16 * e) = (v4u){z0, z0, z0, z0};
    { LAS float* TB = (LAS float*)(L + M_TB); LAS float* CS = (LAS float*)(L + M_CS);
      float gl[5], gf[5];
#pragma unroll
      for (int k = 0; k < 5; ++k) { const int cc = wave + 8 * k; const int t0_ = cc == 0 ? 0 : 16 + 64 * (cc - 1), nv_ = cc == 0 ? 16 : 64;
          if (cc < 33 && lane < nv_) { const float* gr = P.G + ((size_t)b * LP + t0_ + lane) * 8; gl[k] = gr[h]; gf[k] = gr[4 + h]; } else { gl[k] = 0.f; gf[k] = 0.f; } }
#pragma unroll
      for (int k = 0; k < 5; ++k) { const int cc = wave + 8 * k; const int nv_ = cc == 0 ? 16 : 64;
          if (cc < 33) { const float li = lane < nv_ ? gate_i(gl[k]) : -1e30f, lf = lane < nv_ ? gate_f(gf[k]) : 0.f;
              const float bcum = wave_scan_add(lf, lane), wj = li - bcum, cm = wave_scan_max(wj, lane);
              TB[cc * 192 + lane] = bcum; TB[cc * 192 + 64 + lane] = wj; TB[cc * 192 + 128 + lane] = cm;
              if (lane == 63) { CS[2 * cc] = bcum; CS[2 * cc + 1] = cm; } } }
    }
    LDS_BAR();
    if (wave == 0) {
        const LAS float* CS = (const LAS float*)(L + M_CS);
        const float bl = lane < 33 ? CS[2 * lane] : 0.f, cx = lane < 33 ? CS[2 * lane + 1] : 0.f;
        float mrun = 0.f, ms = 0.f, mx = 0.f;
#pragma unroll 1
        for (int k = 0; k < 33; ++k) { const float blk = __builtin_bit_cast(float, __builtin_amdgcn_readlane(__builtin_bit_cast(int, bl), k)), cxk = __builtin_bit_cast(float, __builtin_amdgcn_readlane(__builtin_bit_cast(int, cx), k));
            const float mxk = fmaxf(mrun, cxk); if (lane == k) { ms = mrun; mx = mxk; } mrun = blk + mxk; }
        if (lane == 33) { ms = mrun; mx = mrun; }
        if (lane < 34) { ((LAS float*)(L + M_MS))[lane] = ms; ((LAS float*)(L + M_MX))[lane] = mx; }
    }
    f32x4 cacc[6];
#pragma unroll
    for (int i = 0; i < 6; ++i) cacc[i] = (f32x4){0.f, 0.f, 0.f, 0.f};
    const int srow = lane, spiece = wave, vpiece = wave & 3;
    v4u aq0, aq1, ak0, ak1, av, bq0, bq1, bk0, bk1, bv;
    v2u po0 = {z0, z0}, po1 = {z0, z0};
#define ML_LOAD(ch, q0, q1, k0, k1, vv) do { const int t0_ = (ch) == 0 ? 0 : 16 + 64 * ((ch) - 1), nv_ = (ch) == 0 ? 16 : 64; \
        if (srow < nv_) { const bf16* zr = P.Z + ((size_t)b * LP + t0_ + srow) * NIN + h * MDK + 16 * spiece; q0 = *(const GAS v4u*)zr; q1 = *(const GAS v4u*)(zr + 8); k0 = *(const GAS v4u*)(zr + 512); k1 = *(const GAS v4u*)(zr + 520); } \
        else { q0 = q1 = k0 = k1 = (v4u){z0, z0, z0, z0}; } \
        if (wave < 4 && srow < nv_) vv = *(const GAS v4u*)(P.Z + ((size_t)b * LP + t0_ + srow) * NIN + 1024 + h * MDV + VS * sl + 8 * vpiece); else vv = (v4u){z0, z0, z0, z0}; } while (0)
#define ML_OLOAD(ch) do { const int t0_ = (ch) == 0 ? 0 : 16 + 64 * ((ch) - 1), nv_ = (ch) == 0 ? 16 : 64; const int trow_ = 16 * wave + c; \
        if (wave < 4 && trow_ < nv_) { const bf16* zo = P.Z + ((size_t)b * LP + t0_ + trow_) * NIN + 2048 + h * MDV + VS * sl + 4 * g; po0 = *(const GAS v2u*)zo; po1 = *(const GAS v2u*)(zo + 16); } } while (0)
    const f32x4 gn0 = *(const GAS f32x4*)(P.gnorm + h * MDV + VS * sl + 4 * g), gn1 = *(const GAS f32x4*)(P.gnorm + h * MDV + VS * sl + 16 + 4 * g);
    ML_LOAD(0, aq0, aq1, ak0, ak1, av); ML_LOAD(1, bq0, bq1, bk0, bk1, bv); ML_OLOAD(0);
    LDS_BAR();
#define ML_STEP(ch, q0, q1, k0, k1, vv) do { \
        const int t0 = (ch) == 0 ? 0 : 16 + 64 * ((ch) - 1), nvalid = (ch) == 0 ? 16 : 64, cur = (ch) & 1; \
        const float m_prev = ((const LAS float*)(L + M_MS))[ch], Mx = ((const LAS float*)(L + M_MX))[ch]; \
        const float wk = __expf(((const LAS float*)(L + M_TB))[(ch) * 192 + 64 + lane] - Mx), a = __expf(m_prev - Mx); \
          \
        *(LAS v4u*)(L + M_QS + srow * M_RS + 32 * spiece) = q0; *(LAS v4u*)(L + M_QS + srow * M_RS + 32 * spiece + 16) = q1; \
        *(LAS v4u*)(L + M_KS + srow * M_RS + 32 * spiece) = k0; *(LAS v4u*)(L + M_KS + srow * M_RS + 32 * spiece + 16) = k1; \
        { const unsigned kw[8] = {k0.x, k0.y, k0.z, k0.w, k1.x, k1.y, k1.z, k1.w}; \
          _Pragma("unroll") for (int e = 0; e < 8; ++e) { *(LAS unsigned short*)(L + M_KT + (16 * spiece + 2 * e) * M_TS + 2 * srow) = (unsigned short)(kw[e] & 0xffffu); *(LAS unsigned short*)(L + M_KT + (16 * spiece + 2 * e + 1) * M_TS + 2 * srow) = (unsigned short)(kw[e] >> 16); } } \
        if (wave < 4) { float vf[8]; unpack8(vv, vf); const unsigned vw_[4] = {vv.x, vv.y, vv.z, vv.w}; \
            _Pragma("unroll") for (int e = 0; e < 4; ++e) { *(LAS unsigned short*)(L + M_VT + (8 * vpiece + 2 * e) * M_TS + 2 * srow) = (unsigned short)(vw_[e] & 0xffffu); *(LAS unsigned short*)(L + M_VT + (8 * vpiece + 2 * e + 1) * M_TS + 2 * srow) = (unsigned short)(vw_[e] >> 16); } \
            _Pragma("unroll") for (int e = 0; e < 8; ++e) *(LAS unsigned short*)(L + M_VW + (8 * vpiece + e) * M_TS + 2 * srow) = (unsigned short)f2bf(vf[e] * wk); } \
        if (wave == 4) *(LAS unsigned short*)(L + M_VW + 32 * M_TS + 2 * lane) = (unsigned short)f2bf(wk); \
        LDS_BAR(); \
        if ((ch) + 2 < 33) ML_LOAD((ch) + 2, q0, q1, k0, k1, vv); \
        if (wave < 4) { \
            const int tt = wave, trow = 16 * tt + c; \
              \
            bf16x8 Bq[4], Ka[2][4]; f32x4 wjv_[4]; \
            _Pragma("unroll") for (int ks = 0; ks < 4; ++ks) Bq[ks] = *(const LAS bf16x8*)(L + M_QS + trow * M_RS + 64 * ks + 16 * g); \
            _Pragma("unroll") for (int jt = 0; jt < 2; ++jt) _Pragma("unroll") for (int ks = 0; ks < 4; ++ks) Ka[jt][ks] = *(const LAS bf16x8*)(L + M_KS + (16 * jt + c) * M_RS + 64 * ks + 16 * g); \
            const LAS float* tb = (const LAS float*)(L + M_TB) + (ch) * 192; \
            const float bct = tb[trow], Mt = fmaxf(m_prev, tb[128 + trow]), ut = -Mt, wint = __expf(m_prev - Mt), einv = __expf(-(bct + Mt)); \
            __builtin_amdgcn_sched_barrier(0); \
            f32x4 s[4]; \
            _Pragma("unroll") for (int jt = 0; jt < 2; ++jt) { f32x4 acc = {0.f, 0.f, 0.f, 0.f}; \
                _Pragma("unroll") for (int ks = 0; ks < 4; ++ks) acc = mfma16(Ka[jt][ks], Bq[ks], acc); \
                s[jt] = acc; } \
            _Pragma("unroll") for (int jt = 0; jt < 2; ++jt) _Pragma("unroll") for (int ks = 0; ks < 4; ++ks) Ka[jt][ks] = *(const LAS bf16x8*)(L + M_KS + (16 * (jt + 2) + c) * M_RS + 64 * ks + 16 * g); \
            __builtin_amdgcn_sched_barrier(0); \
            _Pragma("unroll") for (int jt = 0; jt < 2; ++jt) { f32x4 acc = {0.f, 0.f, 0.f, 0.f}; \
                _Pragma("unroll") for (int ks = 0; ks < 4; ++ks) acc = mfma16(Ka[jt][ks], Bq[ks], acc); \
                s[jt + 2] = acc; } \
              \
            bf16x8 Ca[3][4]; v4u Va[3][2]; \
            _Pragma("unroll") for (int vt = 0; vt < 3; ++vt) _Pragma("unroll") for (int ks = 0; ks < 4; ++ks) Ca[vt][ks] = *(const LAS bf16x8*)(L + M_CT + cur * M_CTB + (16 * vt + c) * M_RS + 64 * ks + 16 * g); \
            __builtin_amdgcn_sched_barrier(0); \
            f32x4 nm[3]; \
            _Pragma("unroll") for (int vt = 0; vt < 3; ++vt) { f32x4 acc = {0.f, 0.f, 0.f, 0.f}; \
                _Pragma("unroll") for (int ks = 0; ks < 4; ++ks) acc = mfma16(Ca[vt][ks], Bq[ks], acc); \
                nm[vt] = acc * wint; } \
            _Pragma("unroll") for (int jt = 0; jt < 4; ++jt) wjv_[jt] = *(const LAS f32x4*)(tb + 64 + 16 * jt + 4 * g); \
            _Pragma("unroll") for (int vt = 0; vt < 3; ++vt) _Pragma("unroll") for (int k2 = 0; k2 < 2; ++k2) { const LAS unsigned char* vp = L + M_VT + (16 * vt + c) * M_TS + (32 * k2 + 4 * g) * 2; const v2u lo = *(const LAS v2u*)vp, hi = *(const LAS v2u*)(vp + 32); Va[vt][k2] = (v4u){lo.x, lo.y, hi.x, hi.y}; } \
            __builtin_amdgcn_sched_barrier(0); \
            _Pragma("unroll") for (int jt = 0; jt < 4; ++jt) _Pragma("unroll") for (int r = 0; r < 4; ++r) { const int j = 16 * jt + 4 * g + r; s[jt][r] = (j <= trow) ? s[jt][r] * __expf(ut + wjv_[jt][r]) : 0.f; }     \
            bf16x8 Bs[2]; \
            _Pragma("unroll") for (int k2 = 0; k2 < 2; ++k2) { v4u w; w.x = pk2(s[2 * k2][0], s[2 * k2][1]); w.y = pk2(s[2 * k2][2], s[2 * k2][3]); w.z = pk2(s[2 * k2 + 1][0], s[2 * k2 + 1][1]); w.w = pk2(s[2 * k2 + 1][2], s[2 * k2 + 1][3]); Bs[k2] = __builtin_bit_cast(bf16x8, w); } \
            _Pragma("unroll") for (int vt = 0; vt < 3; ++vt) _Pragma("unroll") for (int k2 = 0; k2 < 2; ++k2) nm[vt] = mfma16(__builtin_bit_cast(bf16x8, Va[vt][k2]), Bs[k2], nm[vt]); \
            const float den = pg8::shl_from(nm[2][0], c); \
            const float inv = __builtin_amdgcn_rcpf(fmaxf(fabsf(den), einv)); \
            float hss = 0.f; \
            _Pragma("unroll") for (int vt = 0; vt < 2; ++vt) _Pragma("unroll") for (int r = 0; r < 4; ++r) { nm[vt][r] *= inv; hss += nm[vt][r] * nm[vt][r]; } \
            hss += pg8::shx(hss, 16, lane); hss += pg8::shx(hss, 32, lane); \
            if (trow < nvalid) { \
                const size_t grow = (size_t)b * LP + t0 + trow; \
                _Pragma("unroll") for (int vt = 0; vt < 2; ++vt) { const int col = h * MDV + VS * sl + 16 * vt + 4 * g; \
                    const v2u ow = vt == 0 ? po0 : po1; const f32x4 gn = vt == 0 ? gn0 : gn1; \
                    v2u w; w.x = pk2(sigmoidf_(bf_lo(ow.x)) * gn[0] * nm[vt][0], sigmoidf_(bf_hi(ow.x)) * gn[1] * nm[vt][1]); w.y = pk2(sigmoidf_(bf_lo(ow.y)) * gn[2] * nm[vt][2], sigmoidf_(bf_hi(ow.y)) * gn[3] * nm[vt][3]); \
                    *(GAS v2u*)(P.AO + grow * D + col) = w; } \
                if (g == 0) P.HSS[grow * 32 + h * 8 + sl] = hss; \
            } \
            if ((ch) + 1 < 33) ML_OLOAD((ch) + 1); \
        } else { \
            const int w4 = wave - 4, nxt = cur ^ 1; \
            _Pragma("unroll") for (int i = 0; i < 6; ++i) cacc[i] = cacc[i] * a; \
            bf16x8 Bv[2][3], Ak[2][2]; \
            _Pragma("unroll") for (int k2 = 0; k2 < 2; ++k2) { \
                _Pragma("unroll") for (int vt = 0; vt < 3; ++vt) Bv[k2][vt] = *(const LAS bf16x8*)(L + M_VW + (16 * vt + c) * M_TS + 64 * k2 + 16 * g); \
                _Pragma("unroll") for (int dd = 0; dd < 2; ++dd) Ak[k2][dd] = *(const LAS bf16x8*)(L + M_KT + (16 * (2 * w4 + dd) + c) * M_TS + 64 * k2 + 16 * g); } \
            __builtin_amdgcn_sched_barrier(0); \
            _Pragma("unroll") for (int k2 = 0; k2 < 2; ++k2) _Pragma("unroll") for (int dd = 0; dd < 2; ++dd) _Pragma("unroll") for (int vt = 0; vt < 3; ++vt) cacc[dd * 3 + vt] = mfma16(Ak[k2][dd], Bv[k2][vt], cacc[dd * 3 + vt]); \
            _Pragma("unroll") for (int dd = 0; dd < 2; ++dd) _Pragma("unroll") for (int vt = 0; vt < 3; ++vt) { const f32x4 v = cacc[dd * 3 + vt]; v2u w; w.x = pk2(v[0], v[1]); w.y = pk2(v[2], v[3]); \
                    *(LAS v2u*)(L + M_CT + nxt * M_CTB + (16 * vt + c) * M_RS + (16 * (2 * w4 + dd) + 4 * g) * 2) = w; } \
        } \
        LDS_BAR(); } while (0)
#pragma unroll 1
    for (int ch = 0; ch < 33; ch += 2) {
        ML_STEP(ch, aq0, aq1, ak0, ak1, av);
        if (ch + 1 < 33) ML_STEP(ch + 1, bq0, bq1, bk0, bk1, bv);
    }
#undef ML_STEP
#undef ML_LOAD
#undef ML_OLOAD
    if (wave >= 4) {
        const int w4 = wave - 4; const size_t sb = ((size_t)jl * NB + b) * MH + h;
#pragma unroll
        for (int dd = 0; dd < 2; ++dd) {
#pragma unroll
            for (int vt = 0; vt < 2; ++vt)
#pragma unroll
                for (int r = 0; r < 4; ++r) out[O_CP + (sb * MDK + 16 * (2 * w4 + dd) + 4 * g + r) * MDV + VS * sl + 16 * vt + c] = cacc[dd * 3 + vt][r];
            if (sl == 0 && c == 0) {
#pragma unroll
                for (int r = 0; r < 4; ++r) out[O_NP + sb * MDK + 16 * (2 * w4 + dd) + 4 * g + r] = cacc[dd * 3 + 2][r]; }
        }
        if (sl == 0 && wave == 4 && lane == 0) out[O_MP + sb] = ((const LAS float*)(L + M_MS))[33];
    }
    LDS_BAR();
}
constexpr int S_Q = 0, S_K = 2048, S_V = 4096, S_P = 8192, S_M = 40960, S_END = 41472;
__device__ __forceinline__ void mlstm_sample_item(LAS unsigned char* L, const MlP& P, const float* stC, const float* stN, const float* stM, float* out, int jl, int db, int h, int tid, int wave, int lane) {
    LAS float* SQ = (LAS float*)(L + S_Q); LAS float* SK = (LAS float*)(L + S_K); LAS float* SV = (LAS float*)(L + S_V); LAS float* SP = (LAS float*)(L + S_P); LAS float* SM = (LAS float*)(L + S_M);
    const size_t r0 = (size_t)MP + db * DSEQ; const size_t sb = ((size_t)jl * DBATCH + db) * MH + h;
    { const int s = tid >> 7, d = tid & 127; const bf16* zr = P.Z + (r0 + s) * NIN; SQ[s * 128 + d] = bf1(zr[h * MDK + d]); SK[s * 128 + d] = bf1(zr[512 + h * MDK + d]);
      SV[s * 256 + 2 * d] = bf1(zr[1024 + h * MDV + 2 * d]); SV[s * 256 + 2 * d + 1] = bf1(zr[1024 + h * MDV + 2 * d + 1]); }
    float li[4], lf[4], bc[4], wjv[4], Mt[4];
#pragma unroll
    for (int s = 0; s < 4; ++s) { li[s] = gate_i(P.G[(r0 + s) * 8 + h]); lf[s] = gate_f(P.G[(r0 + s) * 8 + 4 + h]); }
    const float m0 = stM[sb];
    { float acc = 0.f, cmx = -1e30f;
#pragma unroll
      for (int s = 0; s < 4; ++s) { acc += lf[s]; bc[s] = acc; wjv[s] = li[s] - acc; cmx = fmaxf(cmx, wjv[s]); Mt[s] = fmaxf(m0, cmx); } }
    const float Mx = Mt[3], blast = bc[3], m_new = blast + Mx, a = __expf(m0 - Mx);
    float wk[4];
#pragma unroll
    for (int s = 0; s < 4; ++s) wk[s] = __expf(wjv[s] - Mx);
    LDS_BAR();
    if (wave == 0) { const int p = lane >> 2, qd = lane & 3, t = p >> 2, j = p & 3; float acc = 0.f;
        for (int d = 0; d < 32; ++d) acc += SQ[t * 128 + 32 * qd + d] * SK[j * 128 + 32 * qd + d];
        acc += pg8::shx(acc, 1, lane); acc += pg8::shx(acc, 2, lane);
        const float Mtt = t == 0 ? Mt[0] : t == 1 ? Mt[1] : t == 2 ? Mt[2] : Mt[3], wjj = j == 0 ? wjv[0] : j == 1 ? wjv[1] : j == 2 ? wjv[2] : wjv[3];
        if (qd == 0) SM[p] = (j <= t) ? acc * __expf(wjj - Mtt) : 0.f; }
    if (wave == 1) { const int t = lane >> 4, part = lane & 15; float acc = 0.f;
        for (int d = 0; d < 8; ++d) acc += SQ[t * 128 + 8 * part + d] * stN[sb * MDK + 8 * part + d];
        acc += pg8::shx(acc, 1, lane); acc += pg8::shx(acc, 2, lane); acc += pg8::shx(acc, 4, lane); acc += pg8::shx(acc, 8, lane);
        if (part == 0) SM[16 + t] = acc; }
    { const int vq = tid & 63, dg = tid >> 6; const float* c0p = stC + sb * MDK * MDV; float* c1p = out + O_CS + sb * MDK * MDV;
      f32x4 vj[4];
#pragma unroll
      for (int j = 0; j < 4; ++j) vj[j] = *(const LAS f32x4*)(SV + j * 256 + 4 * vq);
      f32x4 acc[4];
#pragma unroll
      for (int t = 0; t < 4; ++t) acc[t] = (f32x4){0.f, 0.f, 0.f, 0.f};
#pragma unroll 16
      for (int i = 0; i < 16; ++i) { const int dk = 16 * dg + i; const f32x4 c0 = *(const GAS f32x4*)(c0p + (size_t)dk * MDV + 4 * vq);
          f32x4 cn = c0 * a;
#pragma unroll
          for (int t = 0; t < 4; ++t) { acc[t] += c0 * SQ[t * 128 + dk]; cn += vj[t] * (wk[t] * SK[t * 128 + dk]); }
          *(GAS f32x4*)(c1p + (size_t)dk * MDV + 4 * vq) = cn; }
#pragma unroll
      for (int t = 0; t < 4; ++t) *(LAS f32x4*)(SP + (dg * 4 + t) * 256 + 4 * vq) = acc[t];
    }
    if (tid < 128) { float nn = a * stN[sb * MDK + tid];
#pragma unroll
        for (int j = 0; j < 4; ++j) nn += wk[j] * SK[j * 128 + tid];
        out[O_NS + sb * MDK + tid] = nn; }
    if (tid == 0) out[O_MS + sb] = m_new;
    LDS_BAR();
    if (tid < 256) { const int v = tid; float hv[4];
#pragma unroll
        for (int t = 0; t < 4; ++t) { float qc = 0.f;
#pragma unroll
            for (int dg = 0; dg < 8; ++dg) qc += SP[(dg * 4 + t) * 256 + v];
            const float wint = __expf(m0 - Mt[t]); float num = wint * qc, den = wint * SM[16 + t];
#pragma unroll
            for (int j = 0; j < 4; ++j) { const float sc = SM[t * 4 + j]; num += sc * SV[j * 256 + v]; den += sc; }
            hv[t] = num / fmaxf(fabsf(den), __expf(-(bc[t] + Mt[t]))); }
#pragma unroll
        for (int t = 0; t < 4; ++t) { const float q = wave_sum(hv[t] * hv[t], lane); if (lane == 0) SM[32 + wave * 4 + t] = q; }
        const float gn = P.gnorm[h * MDV + v];
#pragma unroll
        for (int t = 0; t < 4; ++t) { const float o = bf1(P.Z[(r0 + t) * NIN + 2048 + h * MDV + v]); P.AO[(r0 + t) * D + h * MDV + v] = (bf16)f2bf(sigmoidf_(o) * gn * hv[t]); }
    }
    LDS_BAR();
    if (tid < 32) { const int t = tid >> 3, slot = tid & 7; P.HSS[(r0 + t) * 32 + h * 8 + slot] = (slot == 0) ? (SM[32 + t] + SM[36 + t]) + (SM[40 + t] + SM[44 + t]) : 0.f; }
    LDS_BAR();
}
__device__ __forceinline__ void mlstm_phase(LAS unsigned char* L, const MlP& P, const float* stC, const float* stN, const float* stM, float* out, int jl, int vcu, int G, int tid_in, int wave_in, int lane_in) {
    constexpr int N_PROMPT = NB * MH * NSL, N_ITEMS = N_PROMPT + DBATCH * MH;
#pragma unroll 1
    for (int it = vcu; it < N_ITEMS; it += G) {
        int tid = tid_in; asm volatile("" : "+v"(tid));
        const int lane = tid & 63, wave = __builtin_amdgcn_readfirstlane(tid >> 6);
        if (it < N_PROMPT) { const int bh = it / NSL, sl = it % NSL; mlstm_prompt_item(L, P, out, jl, bh / MH, bh % MH, sl, tid, wave, lane); }
        else { const int si = it - N_PROMPT; mlstm_sample_item(L, P, stC, stN, stM, out, jl, si / MH, si % MH, tid, wave, lane); }
    }
}
__device__ __forceinline__ void mlstm_fixup(bf16* AO, const float* HSS, int vcu, int G, int wave, int lane) {
    const int gw = vcu * NWAVES + wave, NGW = G * NWAVES;
    for (int m = gw; m < MTOT; m += NGW) {
        const int hd = lane >> 4; const f32x4 a = *(const GAS f32x4*)(HSS + (size_t)m * 32 + hd * 8), bq = *(const GAS f32x4*)(HSS + (size_t)m * 32 + hd * 8 + 4);
        const float r = 1.0f / sqrtf((((a[0] + a[1]) + (a[2] + a[3])) + ((bq[0] + bq[1]) + (bq[2] + bq[3]))) * (1.0f / 256.0f) + EPS);
        GAS v4u* p = (GAS v4u*)(AO + (size_t)m * D + 16 * lane);
#pragma unroll
        for (int i = 0; i < 2; ++i) { float f[8]; unpack8(p[i], f);
#pragma unroll
            for (int e = 0; e < 8; ++e) f[e] *= r;
            p[i] = pack8(f); }
    }
}

struct Args { const float* in[23]; float* out; unsigned char* ws; };
constexpr int PTAB_OFF = LDSCTL_OFF + 1024;
__device__ __forceinline__ unsigned long long ld_ptr(volatile LAS unsigned* T, int i) {
    const unsigned lo = __builtin_amdgcn_readfirstlane(T[2 * i]), hi = __builtin_amdgcn_readfirstlane(T[2 * i + 1]);
    return ((unsigned long long)hi << 32) | lo;
}
constexpr int CHAIN_OFF = LDSCTL_OFF + 2048;
constexpr int CW_CNT = 16384, CW_HEAD = CW_CNT + 6 * 67 * 64;
static_assert((CW_HEAD + 21 * 8 * 64) * 4 <= (int)CTL_ZERO_BYTES, "control words inside the memset region");
__device__ __forceinline__ void put64(volatile LAS unsigned* c, int i, const void* p) { const unsigned long long v = (unsigned long long)p; c[i] = (unsigned)v; c[i + 1] = (unsigned)(v >> 32); }
__device__ __forceinline__ void chain_common(volatile LAS unsigned* c, unsigned char* ws, float* out, int nseg, int n0, int n1, int n2, int n3, int head_idx, int zldc, const float* bgate) {
    c[pg8::CC + 0] = (unsigned)nseg; c[pg8::CC + 1] = 0u; put64(c, pg8::CC + 2, (unsigned*)(ws + WS_CTL) + CW_HEAD + 64 * 8 * head_idx);
    put64(c, pg8::CC + 4, ws + WS_X); put64(c, pg8::CC + 6, ws + WS_XB); put64(c, pg8::CC + 8, ws + WS_SS); put64(c, pg8::CC + 10, ws + WS_Z); put64(c, pg8::CC + 12, ws + WS_FF);
    put64(c, pg8::CC + 14, ws + WS_G); put64(c, pg8::CC + 16, bgate); put64(c, pg8::CC + 18, out + O_YP); put64(c, pg8::CC + 20, out + O_YS); c[pg8::CC + 22] = (unsigned)zldc;
    put64(c, pg8::CC + 30, ws + WS_PT);
    c[pg8::CCUM + 0] = 0u; c[pg8::CCUM + 1] = (unsigned)n0; c[pg8::CCUM + 2] = (unsigned)(n0 + n1); c[pg8::CCUM + 3] = (unsigned)(n0 + n1 + n2); c[pg8::CCUM + 4] = (unsigned)(n0 + n1 + n2 + n3);
}
__device__ __forceinline__ void chain_seg(volatile LAS unsigned* c, int s, const void* A, const void* Bt, int K, int nN, int kind, int first, unsigned need, const unsigned* dep, const unsigned* done, int ld = 0, int lpoff = 0, int cap = 9, int nsub = 1) {
    put64(c, 16 * s + 0, A); put64(c, 16 * s + 2, Bt); c[16 * s + 4] = (unsigned)K; c[16 * s + 5] = (unsigned)nN; c[16 * s + 6] = (unsigned)kind; c[16 * s + 7] = (unsigned)first; c[16 * s + 8] = need;
    c[16 * s + 9] = (unsigned)(ld ? ld : K); put64(c, 16 * s + 10, dep); put64(c, 16 * s + 12, done); c[16 * s + 14] = (unsigned)lpoff | ((unsigned)cap << 8) | ((unsigned)nsub << 16);
}
__device__ __forceinline__ void chain_totals(volatile LAS unsigned* c, int nseg) {
    unsigned t8 = 0u, t9 = 0u;
    for (int s = 0; s < nseg; ++s) { const unsigned w = c[16 * s + 14]; const int lpoff = (int)(w & 0xffu), cap = (int)((w >> 8) & 0xffu), nsub = (int)(w >> 16), nN = (int)c[16 * s + 5];
        int a = 8 - lpoff; a = a < 0 ? 0 : (a > cap ? cap : a); int b = 9 - lpoff; b = b < 0 ? 0 : (b > cap ? cap : b); t8 += (unsigned)(a * nN * nsub); t9 += (unsigned)(b * nN * nsub); }
    c[pg8::CC + 1] = t8; c[pg8::CC + 23] = t9;
}
__device__ __forceinline__ void down_tail_finalize(unsigned char* ws, float* out, bool final_layer, int vcu, int G, int wave, int lane) {
    const int gw = vcu * NWAVES + wave, NGW = G * NWAVES;
    bf16* XB = (bf16*)(ws + WS_XB); float* SS = (float*)(ws + WS_SS); const float* P = (const float*)(ws + WS_PT);
    for (int r = gw; r < 768; r += NGW) { const int m = 16384 + r;
        f32x4 v[4]; float ss[4];
#pragma unroll
        for (int j = 0; j < 4; ++j) { const v2u xw = ((const GAS v2u*)(XB + (size_t)m * D))[lane + 64 * j]; v[j] = (f32x4){bf_lo(xw.x), bf_hi(xw.x), bf_lo(xw.y), bf_hi(xw.y)};
#pragma unroll
            for (int kq = 0; kq < 4; ++kq) v[j] = v[j] + ((const GAS f32x4*)(P + ((size_t)kq * 768 + r) * D))[lane + 64 * j]; }
        if (!final_layer) {
#pragma unroll
            for (int j = 0; j < 4; ++j) { v2u w; w.x = pk2(v[j][0], v[j][1]); w.y = pk2(v[j][2], v[j][3]); ((GAS v2u*)(XB + (size_t)m * D))[lane + 64 * j] = w;
                const float a0 = bf_lo(w.x), a1 = bf_hi(w.x), a2 = bf_lo(w.y), a3 = bf_hi(w.y); ss[j] = wave_sum((a0 * a0 + a1 * a1) + (a2 * a2 + a3 * a3), lane); }
            if (lane < 16) { const int j = lane >> 2; const float s = (lane & 3) ? 0.f : (j == 0 ? ss[0] : j == 1 ? ss[1] : j == 2 ? ss[2] : ss[3]); SS[(size_t)m * 16 + lane] = s; }
        } else {
            float* dst = nullptr;
            if (m < MP) { const int b = m / LP, t = m - b * LP; if (t >= NMETA) dst = out + O_YP + ((size_t)b * SEQ + (t - NMETA)) * D; }
            else if (m < MTOT) dst = out + O_YS + (size_t)(m - MP) * D;
            if (dst) {
#pragma unroll
                for (int j = 0; j < 4; ++j) ((GAS f32x4*)dst)[lane + 64 * j] = v[j]; }
        }
    }
}
__global__ void __launch_bounds__(NWAVES * 64, 2) hybrid_fwd(Args args) {
    extern __shared__ __attribute__((aligned(16))) unsigned char lds_raw[];
    LAS unsigned char* lds = (LAS unsigned char*)lds_raw;
    volatile LAS unsigned* MISC = (volatile LAS unsigned*)(lds + MISC_OFF);
    const int wave_s = __builtin_amdgcn_readfirstlane((int)threadIdx.x >> 6);
#define GG_ g_o
#define BX_ b_o
#define OPQ_GB() int g_o = (int)gridDim.x, b_o = (int)blockIdx.x; asm volatile("" : "+s"(g_o), "+s"(b_o))
#define VCU_ ((BX_ & 7) * (GG_ >> 3) + (BX_ >> 3))
    for (int u = (int)threadIdx.x; u < (SSL_OFF - LDSCTL_OFF) / 4; u += NWAVES * 64) ((LAS unsigned*)(lds + LDSCTL_OFF))[u] = 0u;
    __syncthreads();
    volatile LAS unsigned* PT = (volatile LAS unsigned*)(lds + PTAB_OFF);
    if (threadIdx.x == 0) {
#pragma unroll
        for (int i = 0; i < 23; ++i) { const unsigned long long p = (unsigned long long)args.in[i]; PT[2 * i] = (unsigned)p; PT[2 * i + 1] = (unsigned)(p >> 32); }
        { const unsigned long long p = (unsigned long long)args.out; PT[46] = (unsigned)p; PT[47] = (unsigned)(p >> 32); }
        { const unsigned long long p = (unsigned long long)args.ws; PT[48] = (unsigned)p; PT[49] = (unsigned)(p >> 32); }
    }
    __syncthreads();
#define OPAQUE_TID() int tid_p; asm volatile("v_mbcnt_lo_u32_b32 %0, -1, 0\n\tv_mbcnt_hi_u32_b32 %0, -1, %0\n\tv_lshl_add_u32 %0, %1, 6, %0" : "=&v"(tid_p) : "s"(wave_s)); const int lane_p = tid_p & 63, wave_p = __builtin_amdgcn_readfirstlane(tid_p >> 6)
#define PIN(i) ((const float*)(const GAS float*)ld_ptr(PT, (i)))
#define POUT() ((float*)(GAS float*)ld_ptr(PT, 23))
#define PWS() ((unsigned char*)(GAS unsigned char*)ld_ptr(PT, 24))
    (void)xcd_barrier_post((unsigned*)((gu32*)(PWS() + WS_CTL) + CW_BAR), MISC + 8);
#define GRID_BAR() do { XcdBarrier b_; b_.bar = (unsigned*)((gu32*)(PWS() + WS_CTL) + CW_BAR); b_.x = xb_xcc_id(); b_.st = MISC + 8; xcd_barrier(b_); } while (0)

    { OPAQUE_TID(); OPQ_GB(); P0Args A{PIN(0), PIN(1), PIN(7), PIN(9), PIN(10), PIN(11), PIN(15), PIN(16), PIN(17), PIN(20), PIN(21), PIN(22), PWS()};
#ifndef NO_P0
      p0_prologue(A, lds, VCU_, GG_, wave_p, lane_p, tid_p);
#ifdef PROBE_P02
      GRID_BAR();
      p0_prologue(A, lds, VCU_, GG_, wave_p, lane_p, tid_p);
#endif
#endif
    }
    GRID_BAR();
    volatile LAS unsigned* CH = (volatile LAS unsigned*)(lds + CHAIN_OFF);
#pragma unroll 1
    for (;;) {
        int ito = MISC_OFF + 48; asm volatile("" : "+s"(ito)); volatile LAS unsigned* itp = (volatile LAS unsigned*)(lds + ito);
        const int it = (int)__builtin_amdgcn_readfirstlane(*itp);
        if (it > 4) break;
        const int layer = it - 1, jl = layer >> 1;
        if (it >= 1) {
            if ((layer & 1) == 0) {
                { OPAQUE_TID(); OPQ_GB(); unsigned char* ws = PWS(); AttnP P{(const bf16*)(ws + WS_Z), PIN(12) + jl * AHD, PIN(13) + jl * AHD, PIN(14) + jl * AH, PIN(8), (bf16*)(ws + WS_AO)};
#ifndef NO_ATTN
                  attn_phase(lds + RING_OFF, P, PIN(2), PIN(3), POUT(), jl, VCU_, GG_, tid_p, wave_p, lane_p);
#ifdef PROBE_ATTN2
                  GRID_BAR();
                  attn_phase(lds + RING_OFF, P, PIN(2), PIN(3), POUT(), jl, VCU_, GG_, tid_p, wave_p, lane_p);
#endif
#endif
                }
                GRID_BAR();
            } else {
                { OPAQUE_TID(); OPQ_GB(); unsigned char* ws = PWS(); MlP P{(const bf16*)(ws + WS_Z), (const float*)(ws + WS_G), PIN(19) + jl * D, (bf16*)(ws + WS_AO), (float*)(ws + WS_HSS)};
#ifndef NO_MLSTM
                  mlstm_phase(lds + RING_OFF, P, PIN(4), PIN(5), PIN(6), POUT(), jl, VCU_, GG_, tid_p, wave_p, lane_p);
#ifdef PROBE_MLSTM2
                  GRID_BAR();
                  mlstm_phase(lds + RING_OFF, P, PIN(4), PIN(5), PIN(6), POUT(), jl, VCU_, GG_, tid_p, wave_p, lane_p);
#endif
#endif
                }
                GRID_BAR();
                { OPAQUE_TID(); OPQ_GB(); unsigned char* ws = PWS(); mlstm_fixup((bf16*)(ws + WS_AO), (const float*)(ws + WS_HSS), VCU_, GG_, wave_p, lane_p); }
                GRID_BAR();
            }
        }
#define RUN_CHAIN(SETUP) do { OPAQUE_TID(); OPQ_GB(); if (tid_p == 0) { unsigned char* ws = PWS(); SETUP const int sh_ = GG_ >> 3, v_ = VCU_; CH[pg8::CQ] = (unsigned)(v_ / sh_); CH[pg8::CQ + 1] = (unsigned)(v_ % sh_); CH[pg8::CQ + 2] = (unsigned)sh_; } __syncthreads(); pg8::gemm_chain(lds + RING_OFF, CH, tid_p); } while (0)
        if (it == 0) {
            RUN_CHAIN( chain_common(CH, ws, POUT(), 1, 6, 0, 0, 0, 4 * 3 + 0, NQKV, nullptr);
                       chain_seg(CH, 0, ws + WS_XB, ws + WS_WQKV, D, 6, pg8::CK_NORM, 0, 0u, nullptr, nullptr); chain_totals(CH, 1); );
        } else {
            RUN_CHAIN( chain_common(CH, ws, POUT(), 1, 4, 0, 0, 0, layer * 3 + 0, NQKV, nullptr);
                       chain_seg(CH, 0, ws + WS_AO, (layer & 1) ? ws + WS_WOUT + jl * SZ_WO : ws + WS_WO + jl * SZ_WO, D, 4, pg8::CK_RESID, 0, 0u, nullptr, nullptr); chain_totals(CH, 1); );
            GRID_BAR();
            RUN_CHAIN( chain_common(CH, ws, POUT(), 1, 16, 0, 0, 0, layer * 3 + 1, NQKV, nullptr);
                       chain_seg(CH, 0, ws + WS_XB, ws + WS_WUP + layer * SZ_WUP, D, 16, pg8::CK_UP, 0, 0u, nullptr, nullptr); chain_totals(CH, 1); );
            GRID_BAR();
            RUN_CHAIN( chain_common(CH, ws, POUT(), 2, 4, 4, 0, 0, 13 + layer, NQKV, nullptr);
                       chain_seg(CH, 0, ws + WS_FF, ws + WS_WDN + layer * SZ_WUP, FF, 4, layer < 3 ? pg8::CK_RESID : pg8::CK_FINAL, 0, 0u, nullptr, nullptr, FF, 0, 8, 1);
                       chain_seg(CH, 1, ws + WS_FF, ws + WS_WDN + layer * SZ_WUP, D, 4, pg8::CK_PART, 0, 0u, nullptr, nullptr, FF, 8, 1, 4);
                       chain_totals(CH, 2); );
            GRID_BAR();
            { OPAQUE_TID(); OPQ_GB(); down_tail_finalize(PWS(), POUT(), layer == 3, VCU_, GG_, wave_p, lane_p); }
            if (layer < 3) {
                GRID_BAR();
                const int nl = layer + 1, njl = nl >> 1; const bool nml = (nl & 1) != 0;
                RUN_CHAIN( chain_common(CH, ws, POUT(), 1, nml ? 13 : 6, 0, 0, 0, layer * 3 + 2, nml ? NIN : NQKV, nml ? PIN(18) + njl * 8 : nullptr);
                           chain_seg(CH, 0, ws + WS_XB, nml ? ws + WS_WIN + njl * SZ_WIN : ws + WS_WQKV + njl * SZ_WQKV, D, nml ? 13 : 6, nml ? pg8::CK_NORM_GATES : pg8::CK_NORM, 0, 0u, nullptr, nullptr); chain_totals(CH, 1); );
#ifdef PROBE_INPROJ2
                GRID_BAR();
                RUN_CHAIN( chain_common(CH, ws, POUT(), 1, nml ? 13 : 6, 0, 0, 0, 16 + layer, nml ? NIN : NQKV, nml ? PIN(18) + njl * 8 : nullptr);
                           chain_seg(CH, 0, ws + WS_XB, nml ? ws + WS_WIN + njl * SZ_WIN : ws + WS_WQKV + njl * SZ_WQKV, D, nml ? 13 : 6, nml ? pg8::CK_NORM_GATES : pg8::CK_NORM, 0, 0u, nullptr, nullptr); );
#endif
            }
#ifdef PROBE_DOWN_SPLIT
            if (layer == 0) { GRID_BAR();
                RUN_CHAIN( chain_common(CH, ws, POUT(), 2, 4, 4, 0, 0, 20, NQKV, nullptr);
                       chain_seg(CH, 0, ws + WS_FF, ws + WS_WDN + layer * SZ_WUP, FF, 4, pg8::CK_FINAL, 0, 0u, nullptr, nullptr, FF, 0, 8, 1);
                       chain_seg(CH, 1, ws + WS_FF, ws + WS_WDN + layer * SZ_WUP, D, 4, pg8::CK_PART, 0, 0u, nullptr, nullptr, FF, 8, 1, 4);
                       chain_totals(CH, 2); ); }
#endif
#ifdef PROBE_DOWN_WHOLE
            if (layer == 0) { GRID_BAR();
                RUN_CHAIN( chain_common(CH, ws, POUT(), 1, 4, 0, 0, 0, 20, NQKV, nullptr);
                       chain_seg(CH, 0, ws + WS_FF, ws + WS_WDN + layer * SZ_WUP, FF, 4, pg8::CK_FINAL, 0, 0u, nullptr, nullptr);
                       chain_totals(CH, 1); ); }
#endif
#ifdef PROBE_UP
            if (layer == 0) { GRID_BAR();
                RUN_CHAIN( chain_common(CH, ws, POUT(), 1, 16, 0, 0, 0, 20, NQKV, nullptr);
                       chain_seg(CH, 0, ws + WS_XB, ws + WS_WUP + layer * SZ_WUP, D, 16, pg8::CK_UP, 0, 0u, nullptr, nullptr); chain_totals(CH, 1); ); }
#endif
        }
#undef RUN_CHAIN
        if (it < 4) GRID_BAR();
        { OPAQUE_TID(); __syncthreads();
          int itq_o = MISC_OFF + 48; asm volatile("" : "+s"(itq_o)); volatile LAS unsigned* itq = (volatile LAS unsigned*)(lds + itq_o);
          if (tid_p == 0) *itq = *itq + 1u;
          __syncthreads(); }
    }
#undef PIN
#undef OPAQUE_TID
#undef GRID_BAR
#undef GG_
#undef OPQ_GB
#undef BX_
#undef VCU_
#undef POUT
#undef PWS
}

extern "C" void kernel_launch(void* const* d_in, const int* in_sizes, int n_in, void* d_out, int out_size, void* d_ws, size_t ws_size, hipStream_t stream) {
    static int grid = 0;
    if (grid == 0) {
        if (n_in != 23 || ws_size < WS_END) { fprintf(stderr, "kernel_launch: built for 23 inputs, %zu outputs, >= %zu bytes of workspace; got n_in %d, out %d, ws %zu; nothing launched\n", (size_t)O_END, (size_t)WS_END, n_in, out_size, ws_size); grid = -1; return; }
        int dev = 0, cus = 0, per_cu = 0;
        if (hipGetDevice(&dev) != hipSuccess || hipDeviceGetAttribute(&cus, hipDeviceAttributeMultiprocessorCount, dev) != hipSuccess) { fprintf(stderr, "kernel_launch: device query failed\n"); grid = -1; return; }
        if (hipFuncSetAttribute((const void*)hybrid_fwd, hipFuncAttributeMaxDynamicSharedMemorySize, LDS_BYTES) != hipSuccess) { fprintf(stderr, "kernel_launch: hipFuncSetAttribute failed\n"); grid = -1; return; }
        if (hipOccupancyMaxActiveBlocksPerMultiprocessor(&per_cu, (const void*)hybrid_fwd, NWAVES * 64, LDS_BYTES) != hipSuccess || per_cu < 1)
            fprintf(stderr, "kernel_launch: note: occupancy query reports %d workgroups per CU\n", per_cu);
        (void)hipGetLastError();
        grid = cus - (cus % 8);
    }
    if (grid < 0) return;
    if (hipMemsetAsync((char*)d_ws + WS_CTL, 0, CTL_ZERO_BYTES, stream) != hipSuccess) { fprintf(stderr, "kernel_launch: hipMemsetAsync failed\n"); return; }
    Args a{};
    for (int i = 0; i < 23; ++i) a.in[i] = (const float*)d_in[i];
    a.out = (float*)d_out; a.ws = (unsigned char*)d_ws;
    hipLaunchKernelGGL(hybrid_fwd, dim3(grid), dim3(NWAVES * 64), LDS_BYTES, stream, a);
    const hipError_t le = hipPeekAtLastError();
    if (le != hipSuccess) fprintf(stderr, "kernel_launch: launch failed: %s\n", hipGetErrorName(le));
}
```
